# Optimizing an MI355X kernel written in HIP

```python
import math
import jax, jax.numpy as jnp
from jax import lax
import numpy as np

D_MODEL = 1024
BATCH = 8
SEQ = 4096
DEPTH = 1

CHUNK = 64
Q_BLOCK = 128
MIX_WIDTH = D_MODEL
CONV_CH = MIX_WIDTH // 2
CONV_K = 31
N_HEADS = 8
V_HEAD_DIM = (MIX_WIDTH - CONV_CH) // N_HEADS
QK_NOPE_DIM = 64
QK_ROPE_DIM = 32
QK_HEAD_DIM = QK_NOPE_DIM + QK_ROPE_DIM
Q_LORA_RANK = D_MODEL // 4
KV_LORA_RANK = D_MODEL // 8
ROPE_THETA = 10000.0
IN_WIDTH = 2 * CONV_CH + Q_LORA_RANK + KV_LORA_RANK + QK_ROPE_DIM
N_GROUPS = 4
EXPERTS_PER_GROUP = 8
N_EXPERTS = N_GROUPS * EXPERTS_PER_GROUP
TOP_K = 2
D_EXPERT = D_MODEL // 4
EPS = 1e-6

kernel_name = "hybrid_conv_mla_hmoe_block"


def rms_norm(x, g):
    xf = x.astype(jnp.float32)
    y = xf * lax.rsqrt(jnp.mean(xf * xf, axis=-1, keepdims=True) + EPS)
    return (y * g.astype(jnp.float32)).astype(x.dtype)


def layer_norm(x, g, b):
    xf = x.astype(jnp.float32)
    mu = jnp.mean(xf, axis=-1, keepdims=True)
    var = jnp.mean(jnp.square(xf - mu), axis=-1, keepdims=True)
    y = (xf - mu) * lax.rsqrt(var + EPS)
    return (y * g.astype(jnp.float32) + b.astype(jnp.float32)).astype(x.dtype)


def apply_rope(x, cos, sin):
    x1, x2 = jnp.split(x, 2, axis=-1)
    cos = cos.astype(x.dtype)
    sin = sin.astype(x.dtype)
    return jnp.concatenate([x1 * cos - x2 * sin, x1 * sin + x2 * cos], axis=-1)


def conv_group(val, gate, conv_w, conv_b, ln_g, ln_b):
    u = val * jax.nn.sigmoid(gate)
    kern = conv_w[:, None, :].astype(u.dtype)
    dw = lax.conv_general_dilated(
        u, kern, window_strides=(1,), padding=[(CONV_K - 1, 0)],
        dimension_numbers=("NWC", "WIO", "NWC"),
        feature_group_count=CONV_CH) + conv_b.astype(u.dtype)
    return jax.nn.silu(layer_norm(dw, ln_g, ln_b))


def mla_group(c_q, c_kv, k_rope, cos, sin, q_a_norm, w_q_b, kv_a_norm, w_kv_b,
              q_norm, k_norm):
    b, s, _ = c_q.shape
    q = (rms_norm(c_q, q_a_norm) @ w_q_b).reshape(b, s, N_HEADS, QK_HEAD_DIM)
    kv = (rms_norm(c_kv, kv_a_norm) @ w_kv_b).reshape(b, s, N_HEADS, QK_NOPE_DIM + V_HEAD_DIM)
    k_nope, v = kv[..., :QK_NOPE_DIM], kv[..., QK_NOPE_DIM:]
    k_r = jnp.broadcast_to(k_rope[:, :, None, :], (b, s, N_HEADS, QK_ROPE_DIM))
    k = jnp.concatenate([k_nope, k_r], axis=-1)
    q = rms_norm(q, q_norm)
    k = rms_norm(k, k_norm)
    cos_h, sin_h = cos[:, :, None, :], sin[:, :, None, :]
    q = jnp.concatenate([q[..., :QK_NOPE_DIM], apply_rope(q[..., QK_NOPE_DIM:], cos_h, sin_h)], axis=-1)
    k = jnp.concatenate([k[..., :QK_NOPE_DIM], apply_rope(k[..., QK_NOPE_DIM:], cos_h, sin_h)], axis=-1)

    n_blk = s // Q_BLOCK
    key_chunk = jnp.arange(s) // CHUNK
    scale = QK_HEAD_DIM ** -0.5
    q_blocks = q.reshape(b, n_blk, Q_BLOCK, N_HEADS, QK_HEAD_DIM).swapaxes(0, 1)

    def block_attn(args):
        qb, blk = args
        sc = jnp.einsum("bqhd,bkhd->bhqk", qb, k).astype(jnp.float32) * scale
        q_chunk = (blk * Q_BLOCK + jnp.arange(Q_BLOCK)) // CHUNK
        mask = key_chunk[None, :] <= q_chunk[:, None]
        sc = jnp.where(mask[None, None], sc, -jnp.inf)
        p = jax.nn.softmax(sc, axis=-1).astype(v.dtype)
        return jnp.einsum("bhqk,bkhd->bqhd", p, v)

    out = lax.map(block_attn, (q_blocks, jnp.arange(n_blk)))
    return out.swapaxes(0, 1).reshape(b, s, N_HEADS * V_HEAD_DIM)


def hier_moe(h, w_group, b_group, w_expert, b_expert, w_gate_e, w_up_e, w_down_e):
    n = h.shape[0]
    g_logits = (h @ w_group).astype(jnp.float32) + b_group.astype(jnp.float32)
    g_prob = jax.nn.softmax(g_logits, axis=-1)
    g_top, g_idx = lax.top_k(g_prob, 1)
    e_logits = ((h @ w_expert).astype(jnp.float32) + b_expert.astype(jnp.float32)
                ).reshape(n, N_GROUPS, EXPERTS_PER_GROUP)
    sel = jnp.broadcast_to(g_idx[:, :, None], (n, 1, EXPERTS_PER_GROUP))
    e_in = jnp.take_along_axis(e_logits, sel, axis=1)[:, 0]
    e_prob = jax.nn.softmax(e_in, axis=-1)
    e_top, e_idx = lax.top_k(e_prob, TOP_K)
    w = g_top * e_top / jnp.sum(e_top, axis=-1, keepdims=True)
    glob_idx = g_idx * EXPERTS_PER_GROUP + e_idx
    gates = jnp.sum(jax.nn.one_hot(glob_idx, N_EXPERTS, dtype=jnp.float32) * w[..., None],
                    axis=1).astype(h.dtype)
    y = jnp.zeros_like(h)
    for e in range(N_EXPERTS):
        a = jax.nn.silu(h @ w_gate_e[e]) * (h @ w_up_e[e])
        y = y + gates[:, e:e + 1] * (a @ w_down_e[e])
    return y


def hybrid_layer(x, c, cos, sin, w_ada, b_ada, norm_mix, w_in, conv_w, conv_b,
                 conv_ln_g, conv_ln_b, q_a_norm, w_q_b, kv_a_norm, w_kv_b, q_norm,
                 k_norm, w_out, norm_ffn, w_group, b_group, w_expert, b_expert,
                 w_gate_e, w_up_e, w_down_e):
    b, s, d = x.shape
    mod = jax.nn.silu(c) @ w_ada + b_ada
    sh_a, sc_a, g_a, sh_f, sc_f, g_f = jnp.split(mod, 6, axis=-1)

    h = rms_norm(x, norm_mix) * (1 + sc_a[:, None]) + sh_a[:, None]
    proj = h @ w_in
    o1 = CONV_CH
    o2 = o1 + CONV_CH
    o3 = o2 + Q_LORA_RANK
    o4 = o3 + KV_LORA_RANK
    conv_val, conv_gate, c_q, c_kv, k_rope = jnp.split(proj, [o1, o2, o3, o4], axis=-1)
    y_conv = conv_group(conv_val, conv_gate, conv_w, conv_b, conv_ln_g, conv_ln_b)
    y_attn = mla_group(c_q, c_kv, k_rope, cos, sin, q_a_norm, w_q_b, kv_a_norm,
                       w_kv_b, q_norm, k_norm)
    mixed = jnp.concatenate([y_conv, y_attn], axis=-1) @ w_out
    x = x + g_a[:, None] * mixed

    h2 = rms_norm(x, norm_ffn) * (1 + sc_f[:, None]) + sh_f[:, None]
    y = hier_moe(h2.reshape(b * s, d), w_group, b_group, w_expert, b_expert,
                 w_gate_e, w_up_e, w_down_e).reshape(b, s, d)
    return x + g_f[:, None] * y


def setup_inputs(seed: int = 0) -> dict:
    key = jax.random.key(seed)
    ks = jax.random.split(key, 32)
    f32 = jnp.float32

    def nrm(k, shape, scale):
        return jax.random.normal(k, shape, f32) * scale

    def gain(k, n):
        return 1.0 + 0.01 * jax.random.normal(k, (DEPTH, n), f32)

    positions = (jax.random.randint(ks[2], (BATCH, 1), 0, 4096, dtype=jnp.int32)
                 + jnp.arange(SEQ, dtype=jnp.int32)[None, :])
    return {
        "x": nrm(ks[0], (BATCH, SEQ, D_MODEL), 1.0),
        "c": nrm(ks[1], (BATCH, D_MODEL), 1.0),
        "positions": positions,
        "w_ada": nrm(ks[3], (DEPTH, D_MODEL, 6 * D_MODEL), 0.5 * D_MODEL ** -0.5),
        "b_ada": nrm(ks[4], (DEPTH, 6 * D_MODEL), 0.01),
        "norm_mix": gain(ks[5], D_MODEL),
        "w_in": nrm(ks[6], (DEPTH, D_MODEL, IN_WIDTH), D_MODEL ** -0.5),
        "conv_w": nrm(ks[7], (DEPTH, CONV_K, CONV_CH), CONV_K ** -0.5),
        "conv_b": nrm(ks[8], (DEPTH, CONV_CH), 0.01),
        "conv_ln_g": gain(ks[9], CONV_CH),
        "conv_ln_b": nrm(ks[10], (DEPTH, CONV_CH), 0.01),
        "q_a_norm": gain(ks[11], Q_LORA_RANK),
        "w_q_b": nrm(ks[12], (DEPTH, Q_LORA_RANK, N_HEADS * QK_HEAD_DIM), Q_LORA_RANK ** -0.5),
        "kv_a_norm": gain(ks[13], KV_LORA_RANK),
        "w_kv_b": nrm(ks[14], (DEPTH, KV_LORA_RANK, N_HEADS * (QK_NOPE_DIM + V_HEAD_DIM)), KV_LORA_RANK ** -0.5),
        "q_norm": gain(ks[15], QK_HEAD_DIM),
        "k_norm": gain(ks[16], QK_HEAD_DIM),
        "w_out": nrm(ks[17], (DEPTH, MIX_WIDTH, D_MODEL), MIX_WIDTH ** -0.5),
        "norm_ffn": gain(ks[18], D_MODEL),
        "w_group": nrm(ks[19], (DEPTH, D_MODEL, N_GROUPS), D_MODEL ** -0.5),
        "b_group": nrm(ks[20], (DEPTH, N_GROUPS), 0.01),
        "w_expert": nrm(ks[21], (DEPTH, D_MODEL, N_EXPERTS), D_MODEL ** -0.5),
        "b_expert": nrm(ks[22], (DEPTH, N_EXPERTS), 0.01),
        "w_gate_e": nrm(ks[23], (DEPTH, N_EXPERTS, D_MODEL, D_EXPERT), D_MODEL ** -0.5),
        "w_up_e": nrm(ks[24], (DEPTH, N_EXPERTS, D_MODEL, D_EXPERT), D_MODEL ** -0.5),
        "w_down_e": nrm(ks[25], (DEPTH, N_EXPERTS, D_EXPERT, D_MODEL), D_EXPERT ** -0.5),
    }


def reference(x, c, positions, w_ada, b_ada, norm_mix, w_in, conv_w, conv_b,
              conv_ln_g, conv_ln_b, q_a_norm, w_q_b, kv_a_norm, w_kv_b, q_norm,
              k_norm, w_out, norm_ffn, w_group, b_group, w_expert, b_expert,
              w_gate_e, w_up_e, w_down_e):
    inv_freq = ROPE_THETA ** (-jnp.arange(0, QK_ROPE_DIM, 2, dtype=jnp.float32) / QK_ROPE_DIM)
    ang = positions.astype(jnp.float32)[..., None] * inv_freq
    cos, sin = jnp.cos(ang), jnp.sin(ang)
    for l in range(DEPTH):
        x = hybrid_layer(x, c, cos, sin, w_ada[l], b_ada[l], norm_mix[l], w_in[l],
                         conv_w[l], conv_b[l], conv_ln_g[l], conv_ln_b[l],
                         q_a_norm[l], w_q_b[l], kv_a_norm[l], w_kv_b[l], q_norm[l],
                         k_norm[l], w_out[l], norm_ffn[l], w_group[l], b_group[l],
                         w_expert[l], b_expert[l], w_gate_e[l], w_up_e[l], w_down_e[l])
    return x
```

```cpp
#include <hip/hip_runtime.h>
#include <cstdio>
#include <cstdint>

#ifndef N_LAUNCH_SPLIT
#define N_LAUNCH_SPLIT 0
#endif
#ifndef DBG_LAST_PHASE
#define DBG_LAST_PHASE 9
#endif

#define LAS __attribute__((address_space(3)))
#define GAS __attribute__((address_space(1)))
typedef unsigned short bf16_t;
typedef short bf16x8 __attribute__((ext_vector_type(8)));
typedef float f32x4 __attribute__((ext_vector_type(4)));
typedef float f32x2 __attribute__((ext_vector_type(2)));
typedef float f32x16 __attribute__((ext_vector_type(16)));
typedef unsigned u32x4 __attribute__((ext_vector_type(4)));
typedef unsigned u32x2 __attribute__((ext_vector_type(2)));
typedef __bf16 bf16x2_t __attribute__((ext_vector_type(2)));

constexpr int NB = 8, SEQ = 4096, DM = 1024, MT = NB * SEQ;
constexpr int NHEAD = 8, DQK = 96, DV = 64;
constexpr int NEXP = 32;
constexpr float EPS = 1e-6f;
constexpr float QSCALE = 0.14724444602590306f;
constexpr int NPH = 10;

constexpr size_t MiB = 1u << 20;
constexpr size_t WS_CTL = 0, CTL_BYTES = 1 * MiB;
constexpr size_t WS_MOD = 1 * MiB;
constexpr size_t WS_ROPE = 2 * MiB;
constexpr size_t WS_WIN = 6 * MiB;
constexpr size_t WS_WQ = 9 * MiB;
constexpr size_t WS_WKV = 9 * MiB + 512 * 1024;
constexpr size_t WS_WR = 9 * MiB + 768 * 1024;
constexpr size_t WS_WOUT = 10 * MiB;
constexpr size_t WS_WGU = 12 * MiB;
constexpr size_t WS_WD = 44 * MiB;
constexpr size_t WS_SSQQ = 60 * MiB;
constexpr size_t WS_SSQKV = 60 * MiB + 512 * 1024;
constexpr size_t WS_SSQKR = 60 * MiB + 768 * 1024;
constexpr size_t WS_SSQ1 = 61 * MiB;
constexpr size_t WS_TOKW = 63 * MiB;
constexpr size_t WS_KROPE = 64 * MiB;
constexpr size_t WS_CQ = 68 * MiB;
constexpr size_t WS_CKV = 84 * MiB;
constexpr size_t WS_LIST = 92 * MiB;
constexpr size_t WS_H = 100 * MiB;
constexpr size_t WS_U = 164 * MiB;
constexpr size_t WS_Q = 196 * MiB;
constexpr size_t WS_K = 244 * MiB;
constexpr size_t WS_VT = 292 * MiB;
constexpr size_t WS_CAT = 324 * MiB;
constexpr size_t WS_ABUF = 388 * MiB;
constexpr size_t WS_END = 420 * MiB;
constexpr int CW_BAR = 4096;
constexpr int CW_CNT = 16384;

constexpr int SCR_BYTES = 155648;
constexpr int MISC_OFF = SCR_BYTES;
constexpr int LDS_BYTES = SCR_BYTES + 1024;

__device__ __forceinline__ unsigned cvtpk(float lo, float hi) { f32x2 v = {lo, hi}; bf16x2_t b = __builtin_convertvector(v, bf16x2_t); return __builtin_bit_cast(unsigned, b); }
__device__ __forceinline__ float bf2f(unsigned short h) { return __builtin_bit_cast(float, (unsigned)h << 16); }
__device__ __forceinline__ unsigned short f2bf(float f) { return (unsigned short)(cvtpk(f, 0.f) & 0xffffu); }
__device__ __forceinline__ float sigmoidf_(float x) { return 1.0f / (1.0f + __expf(-x)); }
__device__ __forceinline__ float siluf_(float x) { return x / (1.0f + __expf(-x)); }
__device__ __forceinline__ float wave_sum(float v) {
#pragma unroll
    for (int o = 1; o < 64; o <<= 1) v += __shfl_xor(v, o);
    return v;
}

#define XB_TMO      128
#define XB_XCNT(j)  (256  + 64 * (j))
#define XB_XSUB(j)  (1280 + 64 * (j))
#define XB_XGEN(j)  (2304 + 64 * (j))
#define XB_TOP      3328
#define XB_TOPGEN   3392
#define XCD_BAR_WORDS 3456
#define XB_SPIN_CAP (1u << 20)
__device__ __forceinline__ unsigned xb_ld(unsigned* p)              { return __hip_atomic_load(p, __ATOMIC_RELAXED, __HIP_MEMORY_SCOPE_AGENT); }
__device__ __forceinline__ unsigned xb_add(unsigned* p, unsigned v) { return __hip_atomic_fetch_add(p, v, __ATOMIC_RELAXED, __HIP_MEMORY_SCOPE_AGENT); }
__device__ __forceinline__ unsigned xb_xcc_id() { return (unsigned)__builtin_amdgcn_s_getreg((3 << 11) | 20) & 0xFu; }
#define XB_SPIN(cond, bar) do { unsigned _sp = 0; while (cond) { __builtin_amdgcn_s_sleep(1); \
    if ((++_sp & 255u) == 0u) { if (xb_ld(&(bar)[XB_TMO])) break; if (_sp > XB_SPIN_CAP) { atomicAdd(&(bar)[XB_TMO], 1u); break; } } } } while (0)
struct XcdBarrier { unsigned* bar; unsigned x; volatile LAS unsigned* st; };
__device__ __forceinline__ XcdBarrier xcd_barrier_post(unsigned* bar, volatile LAS unsigned* st) {
    XcdBarrier b; b.bar = bar; b.x = xb_xcc_id(); b.st = st;
    if (threadIdx.x == 0) (void)xb_add(&bar[XB_XCNT(b.x)], 1u);
    return b;
}
__device__ __forceinline__ void xcd_barrier_complete(unsigned* bar, unsigned x, unsigned& nloc, unsigned& nx) {
    const unsigned G = gridDim.x * gridDim.y * gridDim.z;
    unsigned sum, cnt, mine, sp = 0u;
    for (;;) {
        sum = 0u; cnt = 0u; mine = 0u;
#pragma unroll
        for (unsigned j = 0; j < 16; ++j) { const unsigned c = xb_ld(&bar[XB_XCNT(j)]); sum += c; cnt += (c > 0u) ? 1u : 0u; mine = (j == x) ? c : mine; }
        if (sum == G) break;
        __builtin_amdgcn_s_sleep(1);
        if ((++sp & 255u) == 0u) { if (xb_ld(&bar[XB_TMO])) break; if (sp > XB_SPIN_CAP) { atomicAdd(&bar[XB_TMO], 1u); break; } }
    }
    nloc = mine > 0u ? mine : 1u; nx = cnt > 0u ? cnt : 1u;
}
__device__ __forceinline__ void xcd_barrier(const XcdBarrier& b) {
    asm volatile("s_waitcnt vmcnt(0)" ::: "memory");
    __syncthreads();
    if (threadIdx.x == 0) {
        unsigned* bar = b.bar;
        __builtin_amdgcn_s_waitcnt(0);
        unsigned nloc = b.st[0], nx = b.st[1];
        if (nloc == 0u) { xcd_barrier_complete(bar, b.x, nloc, nx); b.st[0] = nloc; b.st[1] = nx; }
        const unsigned old = xb_add(&bar[XB_XSUB(b.x)], 1u);
        const unsigned gen = old / nloc;
        if (old + 1u == (gen + 1u) * nloc) {
            __builtin_amdgcn_fence(__ATOMIC_RELEASE, "agent");
            asm volatile("s_waitcnt vmcnt(0)" ::: "memory");
            const unsigned og = xb_add(&bar[XB_TOP], 1u);
            const unsigned tg = og / nx;
            if (og + 1u == (tg + 1u) * nx) xb_add(&bar[XB_TOPGEN], 1u);
            else XB_SPIN(xb_ld(&bar[XB_TOPGEN]) == tg, bar);
            __builtin_amdgcn_fence(__ATOMIC_ACQUIRE, "agent");
            xb_add(&bar[XB_XGEN(b.x)], 1u);
            asm volatile("s_waitcnt vmcnt(0)" ::: "memory");
        } else {
            XB_SPIN(xb_ld(&bar[XB_XGEN(b.x)]) == gen, bar);
            __builtin_amdgcn_fence(__ATOMIC_ACQUIRE, "agent");
            asm volatile("s_waitcnt vmcnt(0)" ::: "memory");
        }
    }
    __syncthreads();
}

__device__ __forceinline__ int lds_byte2(int r, int c) { const int st = (r >> 4) * 2 + (c >> 5), ob = (r & 15) * 64 + (c & 31) * 2; return st * 1024 + (ob ^ (((ob >> 9) & 1) << 5)); }
__device__ __forceinline__ void stage_rc2(int b, int& R, int& C) { const int st = b >> 10, sb = b & 1023, swz = sb ^ (((sb >> 9) & 1) << 5); R = (st >> 1) * 16 + swz / 64; C = (st & 1) * 32 + (swz % 64) / 2; }

template <int MI, int NI, bool TRANS>
__device__ __forceinline__ void gemm_block(LAS unsigned char* lds, const bf16_t* const (&ap)[MI / 2], const bf16_t* const (&bp)[NI], int nkt, f32x4 (&acc)[MI][NI]) {
    constexpr int BM = 32 * MI, BN = 64 * NI, TA = BM * 128, TB = BN * 128, STG = TA + TB, GLA = MI / 2, GLB = NI;
    static_assert(2 * STG <= SCR_BYTES, "LDS");
    const int tid = threadIdx.x, lane = tid & 63, wid = __builtin_amdgcn_readfirstlane(tid >> 6), wr = wid >> 2, wc = wid & 3, fr = lane & 15, fq = lane >> 4;
    const int aoff = lds_byte2(wr * (MI * 16) + fr, fq * 8), boff = TA + lds_byte2(wc * (NI * 16) + fr, fq * 8);
#define GB_STAGE(buf, kt) do { \
        _Pragma("unroll") for (int i_ = 0; i_ < GLA; ++i_) __builtin_amdgcn_global_load_lds((const unsigned*)(ap[i_] + (kt) * 64), (LAS unsigned*)(lds + (buf) * STG + wid * 1024 + i_ * 8192), 16, 0, 0); \
        _Pragma("unroll") for (int i_ = 0; i_ < GLB; ++i_) __builtin_amdgcn_global_load_lds((const unsigned*)(bp[i_] + (kt) * 64), (LAS unsigned*)(lds + (buf) * STG + TA + wid * 1024 + i_ * 8192), 16, 0, 0); } while (0)
    GB_STAGE(0, 0);
    asm volatile("s_waitcnt vmcnt(0)" ::: "memory"); __syncthreads();
    for (int t = 0; t < nkt; ++t) {
        const int cur = t & 1;
        if (t + 1 < nkt) GB_STAGE(cur ^ 1, t + 1);
        const LAS unsigned char* sb = lds + cur * STG;
#pragma unroll
        for (int ks = 0; ks < 2; ++ks) {
            bf16x8 At[MI], Bf[NI];
#pragma unroll
            for (int m = 0; m < MI; ++m) At[m] = *(const LAS bf16x8*)(sb + aoff + m * 2048 + ks * 1024);
#pragma unroll
            for (int n = 0; n < NI; ++n) Bf[n] = *(const LAS bf16x8*)(sb + boff + n * 2048 + ks * 1024);
#pragma unroll
            for (int m = 0; m < MI; ++m)
#pragma unroll
                for (int n = 0; n < NI; ++n)
                    acc[m][n] = TRANS ? __builtin_amdgcn_mfma_f32_16x16x32_bf16(Bf[n], At[m], acc[m][n], 0, 0, 0)
                                      : __builtin_amdgcn_mfma_f32_16x16x32_bf16(At[m], Bf[n], acc[m][n], 0, 0, 0);
        }
        asm volatile("s_waitcnt vmcnt(0)" ::: "memory"); __syncthreads();
    }
#undef GB_STAGE
}
template <int GL>
__device__ __forceinline__ void stage_ptrs_dense(const bf16_t* base, size_t ld, int r0, const bf16_t* (&p)[GL]) {
    const int tid = threadIdx.x, lane = tid & 63, wid = tid >> 6;
#pragma unroll
    for (int i = 0; i < GL; ++i) { int R, C; stage_rc2(wid * 1024 + i * 8192 + lane * 16, R, C); p[i] = base + (size_t)(r0 + R) * ld + C; }
}

struct Params {
    const void* in[26];
    float* out;
    unsigned char* ws;
    int ph_lo, ph_hi;
};

__device__ const float INVF[16] = {1.000000000e+00f, 5.623413324e-01f, 3.162277639e-01f, 1.778279394e-01f, 1.000000015e-01f, 5.623413250e-02f, 3.162277490e-02f, 1.778279431e-02f,
                                   9.999999776e-03f, 5.623413250e-03f, 3.162277630e-03f, 1.778279431e-03f, 1.000000047e-03f, 5.623413017e-04f, 3.162277571e-04f, 1.778279402e-04f};

__device__ __forceinline__ void tr_item(const float* srcp, int ldw, const float* kscale, bf16_t* WT, int Kd, int k0, int n0, LAS float* scr, int lane) {
#pragma unroll 8
    for (int i = 0; i < 32; ++i) { const int kk = 2 * i + (lane >> 5); float v = 0.f; if (srcp) { v = srcp[(size_t)(k0 + kk) * ldw]; if (kscale) v *= kscale[k0 + kk]; } scr[kk * 33 + (lane & 31)] = v; }
    asm volatile("s_waitcnt lgkmcnt(0)" ::: "memory");
    const int c = lane & 7;
#pragma unroll
    for (int j = 0; j < 4; ++j) { const int n = (lane >> 3) + 8 * j; const LAS float* s = scr + (8 * c) * 33 + n;
        u32x4 o; o.x = cvtpk(s[0 * 33], s[1 * 33]); o.y = cvtpk(s[2 * 33], s[3 * 33]); o.z = cvtpk(s[4 * 33], s[5 * 33]); o.w = cvtpk(s[6 * 33], s[7 * 33]);
        *(u32x4*)(WT + (size_t)(n0 + n) * Kd + k0 + 8 * c) = o; }
    asm volatile("s_waitcnt lgkmcnt(0)" ::: "memory");
}

__device__ __forceinline__ void phase0(const Params& p, LAS unsigned char* lds) {
    const int tid = threadIdx.x, lane = tid & 63, wave = __builtin_amdgcn_readfirstlane(tid >> 6);
    const int G = gridDim.x, bid = blockIdx.x;
    unsigned char* ws = p.ws;
    if (bid < 192) {
        const float* c = (const float*)p.in[1]; const float* w_ada = (const float*)p.in[3]; const float* b_ada = (const float*)p.in[4];
        LAS float* sc = (LAS float*)lds;
        LAS float* red = (LAS float*)(lds + 32768);
        for (int i = tid; i < 8192; i += 512) sc[i] = siluf_(c[i]);
        __syncthreads();
        const int col = tid & 31, ks = tid >> 5, n0 = bid * 32;
        float a[8] = {0, 0, 0, 0, 0, 0, 0, 0};
#pragma unroll 8
        for (int i = 0; i < 64; ++i) { const int k = ks * 64 + i; const float w = w_ada[(size_t)k * 6144 + n0 + col];
#pragma unroll
            for (int b = 0; b < 8; ++b) a[b] += sc[b * 1024 + k] * w; }
#pragma unroll
        for (int b = 0; b < 8; ++b) red[(ks * 32 + col) * 8 + b] = a[b];
        __syncthreads();
        if (tid < 256) { const int cc = tid & 31, b = tid >> 5; float s = 0.f;
#pragma unroll
            for (int k2 = 0; k2 < 16; ++k2) s += red[(k2 * 32 + cc) * 8 + b];
            ((float*)(ws + WS_MOD))[b * 6144 + n0 + cc] = s + b_ada[n0 + cc]; }
        __syncthreads();
    }
    {
        const int* pos = (const int*)p.in[2]; f32x2* rt = (f32x2*)(ws + WS_ROPE);
        for (int e = bid * 512 + tid; e < MT * 16; e += G * 512) {
            const int tok = e >> 4, i = e & 15;
            const float a32 = (float)pos[tok] * INVF[i];
            const double rev = (double)a32 * 0.15915494309189535;
            const float fr = (float)(rev - __builtin_rint(rev));
            rt[e] = (f32x2){__builtin_amdgcn_cosf(fr), __builtin_amdgcn_sinf(fr)};
        }
    }
    {
        LAS float* scr = (LAS float*)(lds + 65536) + wave * 2112;
        const int gw = bid * 8 + wave, NGW = G * 8;
        const float* w_in = (const float*)p.in[6]; const float* qan = (const float*)p.in[11]; const float* w_qb = (const float*)p.in[12];
        const float* kvan = (const float*)p.in[13]; const float* w_kvb = (const float*)p.in[14]; const float* w_out = (const float*)p.in[17];
        const float* w_group = (const float*)p.in[19]; const float* w_expert = (const float*)p.in[21];
        const float* w_gate = (const float*)p.in[23]; const float* w_up = (const float*)p.in[24]; const float* w_down = (const float*)p.in[25];
        constexpr int I0 = 16 * 48, I1 = 4 * 32, I2 = 2 * 32, I3 = 16 * 32, I4 = 32 * 256, I5 = 32 * 128, I6 = 16 * 2;
        constexpr int NIT = I0 + I1 + I2 + I3 + I4 + I5 + I6;
        const int nl = lane & 31;
        for (int it = gw; it < NIT; it += NGW) {
            int r = it;
            if (r < I0) {
                const int kb = r / 48, nb = r % 48, n0 = nb * 32, np = n0 + nl;
                const int pn = np >> 8, wc = (np >> 6) & 3, n = (np >> 4) & 3, f = np & 15; int src;
                if (pn < 4) { const int ch = pn * 128 + wc * 32 + (n >> 1) * 16 + f; src = (n & 1) ? 512 + ch : ch; }
                else if (pn == 4) src = np;
                else { const int j = np - 1280; src = (j < 160) ? 1280 + j : -1; }
                tr_item(src >= 0 ? w_in + src : nullptr, 1440, nullptr, (bf16_t*)(ws + WS_WIN), 1024, kb * 64, n0, scr, lane); continue; }
            r -= I0;
            if (r < I1) {
                const int kb = r / 32, nb = r % 32, n0 = nb * 32, np = n0 + nl, hd = np >> 7, j = np & 127;
                tr_item(j < 96 ? w_qb + hd * 96 + j : nullptr, 768, qan, (bf16_t*)(ws + WS_WQ), 256, kb * 64, n0, scr, lane); continue; }
            r -= I1;
            if (r < I2) {
                const int kb = r / 32, nb = r % 32, n0 = nb * 32, np = n0 + nl;
                tr_item(w_kvb + np, 1024, kvan, (bf16_t*)(ws + WS_WKV), 128, kb * 64, n0, scr, lane); continue; }
            r -= I2;
            if (r < I3) {
                const int kb = r / 32, nb = r % 32, n0 = nb * 32, np = n0 + nl;
                tr_item(w_out + np, 1024, nullptr, (bf16_t*)(ws + WS_WOUT), 1024, kb * 64, n0, scr, lane); continue; }
            r -= I3;
            if (r < I4) {
                const int e = r >> 8, q = r & 255, kb = q / 16, nb = q % 16, n0 = nb * 32, np = n0 + nl;
                const int ct = np >> 8, wc = (np >> 6) & 3, n = (np >> 4) & 3, f = np & 15, ch = ct * 128 + wc * 32 + (n >> 1) * 16 + f;
                const float* src = ((n & 1) ? w_up : w_gate) + (size_t)e * 1024 * 256 + ch;
                tr_item(src, 256, nullptr, (bf16_t*)(ws + WS_WGU) + (size_t)e * 512 * 1024, 1024, kb * 64, n0, scr, lane); continue; }
            r -= I4;
            if (r < I5) {
                const int e = r >> 7, q = r & 127, kb = q / 32, nb = q % 32, n0 = nb * 32, np = n0 + nl;
                tr_item(w_down + (size_t)e * 256 * 1024 + np, 1024, nullptr, (bf16_t*)(ws + WS_WD) + (size_t)e * 1024 * 256, 256, kb * 64, n0, scr, lane); continue; }
            r -= I5;
            {
                const int kb = r >> 1, nb = r & 1, n0 = nb * 32, np = n0 + nl, k0 = kb * 64;
                const float* srcp = nullptr; int ldw = 0;
                if (np < 4) { srcp = w_group + np; ldw = 4; } else if (np < 36) { srcp = w_expert + (np - 4); ldw = 32; }
#pragma unroll 8
                for (int i = 0; i < 32; ++i) { const int kk = 2 * i + (lane >> 5); scr[kk * 33 + nl] = srcp ? srcp[(size_t)(k0 + kk) * ldw] : 0.f; }
                asm volatile("s_waitcnt lgkmcnt(0)" ::: "memory");
                const int c = lane & 7;
#pragma unroll
                for (int j = 0; j < 4; ++j) { const int n = (lane >> 3) + 8 * j; const LAS float* s = scr + (8 * c) * 33 + n;
                    float v[8], l[8];
#pragma unroll
                    for (int q = 0; q < 8; ++q) { v[q] = s[q * 33]; l[q] = v[q] - bf2f(f2bf(v[q])); }
                    if (n0 + n < 48) {
                        u32x4 o; o.x = cvtpk(v[0], v[1]); o.y = cvtpk(v[2], v[3]); o.z = cvtpk(v[4], v[5]); o.w = cvtpk(v[6], v[7]);
                        *(u32x4*)((bf16_t*)(ws + WS_WR) + (size_t)(n0 + n) * 1024 + k0 + 8 * c) = o;
                        u32x4 o2; o2.x = cvtpk(l[0], l[1]); o2.y = cvtpk(l[2], l[3]); o2.z = cvtpk(l[4], l[5]); o2.w = cvtpk(l[6], l[7]);
                        *(u32x4*)((bf16_t*)(ws + WS_WR) + 48 * 1024 + (size_t)(n0 + n) * 1024 + k0 + 8 * c) = o2; } }
                asm volatile("s_waitcnt lgkmcnt(0)" ::: "memory");
            }
        }
    }
}

__device__ __forceinline__ void phase1a(const Params& p) {
    const int tid = threadIdx.x, lane = tid & 63, wave = tid >> 6;
    const int gw = blockIdx.x * 8 + wave, NGW = gridDim.x * 8;
    const float* x = (const float*)p.in[0]; const float* nm = (const float*)p.in[5]; const float* mod = (const float*)(p.ws + WS_MOD);
    bf16_t* h = (bf16_t*)(p.ws + WS_H);
    for (int grp = gw; grp < MT / 16; grp += NGW) {
        const int r0 = grp * 16, b = r0 >> 12;
        f32x4 gm[4], sh[4];
#pragma unroll
        for (int j = 0; j < 4; ++j) { const int col = 4 * lane + 256 * j; const f32x4 g = *(const f32x4*)(nm + col), s = *(const f32x4*)(mod + b * 6144 + 1024 + col);
            gm[j] = g * (s + 1.0f); sh[j] = *(const f32x4*)(mod + b * 6144 + col); }
        for (int rr = 0; rr < 16; ++rr) {
            const float* xr = x + (size_t)(r0 + rr) * DM; f32x4 v[4]; float s = 0.f;
#pragma unroll
            for (int j = 0; j < 4; ++j) { v[j] = *(const f32x4*)(xr + 4 * lane + 256 * j); s += (v[j].x * v[j].x + v[j].y * v[j].y) + (v[j].z * v[j].z + v[j].w * v[j].w); }
            const float rstd = 1.0f / sqrtf(wave_sum(s) * (1.0f / DM) + EPS);
            bf16_t* hr = h + (size_t)(r0 + rr) * DM;
#pragma unroll
            for (int j = 0; j < 4; ++j) { const f32x4 o = v[j] * rstd * gm[j] + sh[j]; u32x2 w; w.x = cvtpk(o.x, o.y); w.y = cvtpk(o.z, o.w); *(u32x2*)(hr + 4 * lane + 256 * j) = w; }
        }
    }
}

__device__ __forceinline__ void phase1b(const Params& p, LAS unsigned char* lds) {
    const int tid = threadIdx.x, lane = tid & 63, wid = __builtin_amdgcn_readfirstlane(tid >> 6), wr = wid >> 2, wc = wid & 3, fr = lane & 15, fq = lane >> 4;
    unsigned char* ws = p.ws;
    const bf16_t* h = (const bf16_t*)(ws + WS_H); const bf16_t* win = (const bf16_t*)(ws + WS_WIN);
    for (int u = blockIdx.x; u < 128 * 6; u += gridDim.x) {
        const int pm = u / 6, pn = u % 6;
        const bf16_t* ap[4]; const bf16_t* bp[4];
        stage_ptrs_dense<4>(h, 1024, pm * 256, ap); stage_ptrs_dense<4>(win, 1024, pn * 256, bp);
        f32x4 acc[8][4];
#pragma unroll
        for (int m = 0; m < 8; ++m)
#pragma unroll
            for (int n = 0; n < 4; ++n) acc[m][n] = (f32x4){0.f, 0.f, 0.f, 0.f};
        gemm_block<8, 4, true>(lds, ap, bp, 16, acc);
        const int rowb = pm * 256 + wr * 128 + fr;
        if (pn < 4) {
            bf16_t* ub = (bf16_t*)(ws + WS_U);
#pragma unroll
            for (int m = 0; m < 8; ++m) { const size_t row = rowb + m * 16;
#pragma unroll
                for (int h2 = 0; h2 < 2; ++h2) { const f32x4 v = acc[m][2 * h2], g = acc[m][2 * h2 + 1];
                    const int ch = pn * 128 + wc * 32 + h2 * 16 + fq * 4;
                    u32x2 w; w.x = cvtpk(v.x * sigmoidf_(g.x), v.y * sigmoidf_(g.y)); w.y = cvtpk(v.z * sigmoidf_(g.z), v.w * sigmoidf_(g.w));
                    *(u32x2*)(ub + row * 512 + ch) = w; } }
        } else if (pn == 4) {
            bf16_t* cq = (bf16_t*)(ws + WS_CQ); float* sq = (float*)(ws + WS_SSQQ);
#pragma unroll
            for (int m = 0; m < 8; ++m) { const size_t row = rowb + m * 16; float s = 0.f;
#pragma unroll
                for (int n = 0; n < 4; ++n) { const f32x4 v = acc[m][n]; s += (v.x * v.x + v.y * v.y) + (v.z * v.z + v.w * v.w);
                    u32x2 w; w.x = cvtpk(v.x, v.y); w.y = cvtpk(v.z, v.w); *(u32x2*)(cq + row * 256 + wc * 64 + n * 16 + fq * 4) = w; }
                s += __shfl_xor(s, 16); s += __shfl_xor(s, 32);
                if (fq == 0) sq[row * 4 + wc] = s; }
        } else {
            if (wc < 2) {
                bf16_t* ckv = (bf16_t*)(ws + WS_CKV); float* sq = (float*)(ws + WS_SSQKV);
#pragma unroll
                for (int m = 0; m < 8; ++m) { const size_t row = rowb + m * 16; float s = 0.f;
#pragma unroll
                    for (int n = 0; n < 4; ++n) { const f32x4 v = acc[m][n]; s += (v.x * v.x + v.y * v.y) + (v.z * v.z + v.w * v.w);
                        u32x2 w; w.x = cvtpk(v.x, v.y); w.y = cvtpk(v.z, v.w); *(u32x2*)(ckv + row * 128 + wc * 64 + n * 16 + fq * 4) = w; }
                    s += __shfl_xor(s, 16); s += __shfl_xor(s, 32);
                    if (fq == 0) sq[row * 2 + wc] = s; }
            } else if (wc == 2) {
                float* kr = (float*)(ws + WS_KROPE); float* sq = (float*)(ws + WS_SSQKR);
#pragma unroll
                for (int m = 0; m < 8; ++m) { const size_t row = rowb + m * 16; float s = 0.f;
#pragma unroll
                    for (int n = 0; n < 2; ++n) { const f32x4 v = acc[m][n]; s += (v.x * v.x + v.y * v.y) + (v.z * v.z + v.w * v.w);
                        *(f32x4*)(kr + row * 32 + n * 16 + fq * 4) = v; }
                    s += __shfl_xor(s, 16); s += __shfl_xor(s, 32);
                    if (fq == 0) sq[row] = s; }
            }
        }
    }
}

__device__ __forceinline__ void q_unit(const Params& p, LAS unsigned char* lds, int pm, int pn) {
    const int tid = threadIdx.x, lane = tid & 63, wid = __builtin_amdgcn_readfirstlane(tid >> 6), wr = wid >> 2, wc = wid & 3, fr = lane & 15, fq = lane >> 4;
    unsigned char* ws = p.ws;
    const bf16_t* ap[2]; const bf16_t* bp[4];
    stage_ptrs_dense<2>((const bf16_t*)(ws + WS_CQ), 256, pm * 128, ap); stage_ptrs_dense<4>((const bf16_t*)(ws + WS_WQ), 256, pn * 256, bp);
    f32x4 acc[4][4];
#pragma unroll
    for (int m = 0; m < 4; ++m)
#pragma unroll
        for (int n = 0; n < 4; ++n) acc[m][n] = (f32x4){0.f, 0.f, 0.f, 0.f};
    gemm_block<4, 4, true>(lds, ap, bp, 4, acc);
    const float* sq = (const float*)(ws + WS_SSQQ); const float* qn = (const float*)p.in[15];
    LAS float* part = (LAS float*)lds;
    const int rowb = pm * 128 + wr * 64 + fr;
    float rq[4];
#pragma unroll
    for (int m = 0; m < 4; ++m) { const f32x4 s4 = *(const f32x4*)(sq + (size_t)(rowb + m * 16) * 4); rq[m] = 1.0f / sqrtf(((s4.x + s4.y) + (s4.z + s4.w)) * (1.0f / 256.0f) + EPS); }
    const int nval = (wc & 1) ? 2 : 4;
#pragma unroll
    for (int m = 0; m < 4; ++m) { float s = 0.f;
#pragma unroll
        for (int n = 0; n < 4; ++n) { acc[m][n] = acc[m][n] * rq[m]; if (n < nval) { const f32x4 v = acc[m][n]; s += (v.x * v.x + v.y * v.y) + (v.z * v.z + v.w * v.w); } }
        s += __shfl_xor(s, 16); s += __shfl_xor(s, 32);
        if (fq == 0) part[wid * 64 + m * 16 + fr] = s; }
    __syncthreads();
    const int hd = pn * 2 + (wc >> 1);
    bf16_t* qb = (bf16_t*)(ws + WS_Q); const f32x2* rope = (const f32x2*)(ws + WS_ROPE);
#pragma unroll
    for (int m = 0; m < 4; ++m) {
        const float tot = part[wid * 64 + m * 16 + fr] + part[(wid ^ 1) * 64 + m * 16 + fr];
        const float rh = 1.0f / sqrtf(tot * (1.0f / 96.0f) + EPS) * QSCALE;
        const int tok = rowb + m * 16, b = tok >> 12, s = tok & 4095;
        bf16_t* dst = qb + ((size_t)(b * 8 + hd) * 4096 + s) * 96;
        if ((wc & 1) == 0) {
#pragma unroll
            for (int n = 0; n < 4; ++n) { const int j = n * 16 + fq * 4; const f32x4 g = *(const f32x4*)(qn + j); const f32x4 v = acc[m][n] * rh * g;
                u32x2 w; w.x = cvtpk(v.x, v.y); w.y = cvtpk(v.z, v.w); *(u32x2*)(dst + j) = w; }
        } else {
            const int i0 = fq * 4; const f32x4 g1 = *(const f32x4*)(qn + 64 + i0), g2 = *(const f32x4*)(qn + 80 + i0);
            const f32x4 x1 = acc[m][0] * rh * g1, x2 = acc[m][1] * rh * g2;
            const f32x4 cs01 = *(const f32x4*)(rope + (size_t)tok * 16 + i0), cs23 = *(const f32x4*)(rope + (size_t)tok * 16 + i0 + 2);
            f32x4 o1, o2;
            o1.x = x1.x * cs01.x - x2.x * cs01.y; o2.x = x1.x * cs01.y + x2.x * cs01.x;
            o1.y = x1.y * cs01.z - x2.y * cs01.w; o2.y = x1.y * cs01.w + x2.y * cs01.z;
            o1.z = x1.z * cs23.x - x2.z * cs23.y; o2.z = x1.z * cs23.y + x2.z * cs23.x;
            o1.w = x1.w * cs23.z - x2.w * cs23.w; o2.w = x1.w * cs23.w + x2.w * cs23.z;
            u32x2 w; w.x = cvtpk(o1.x, o1.y); w.y = cvtpk(o1.z, o1.w); *(u32x2*)(dst + 64 + i0) = w;
            w.x = cvtpk(o2.x, o2.y); w.y = cvtpk(o2.z, o2.w); *(u32x2*)(dst + 80 + i0) = w;
        }
    }
    __syncthreads();
}

__device__ __forceinline__ void kv_unit(const Params& p, LAS unsigned char* lds, int pm, int pn) {
    const int tid = threadIdx.x, lane = tid & 63, wid = __builtin_amdgcn_readfirstlane(tid >> 6), wr = wid >> 2, wc = wid & 3, fr = lane & 15, fq = lane >> 4;
    unsigned char* ws = p.ws;
    const bf16_t* ap[2]; const bf16_t* bp[4];
    stage_ptrs_dense<2>((const bf16_t*)(ws + WS_CKV), 128, pm * 128, ap); stage_ptrs_dense<4>((const bf16_t*)(ws + WS_WKV), 128, pn * 256, bp);
    f32x4 acc[4][4];
#pragma unroll
    for (int m = 0; m < 4; ++m)
#pragma unroll
        for (int n = 0; n < 4; ++n) acc[m][n] = (f32x4){0.f, 0.f, 0.f, 0.f};
    gemm_block<4, 4, false>(lds, ap, bp, 2, acc);
    const float* sqkv = (const float*)(ws + WS_SSQKV); const float* sqkr = (const float*)(ws + WS_SSQKR); const float* kn = (const float*)p.in[16];
    const float* krp = (const float*)(ws + WS_KROPE); const f32x2* rope = (const f32x2*)(ws + WS_ROPE);
    const int hd = pn * 2 + (wc >> 1);
    const int rowb = pm * 128 + wr * 64 + fq * 4;
    if ((wc & 1) == 0) {
        bf16_t* kb = (bf16_t*)(ws + WS_K);
        float g[4]; for (int n = 0; n < 4; ++n) g[n] = kn[n * 16 + fr];
        const float g1 = kn[64 + fr], g2 = kn[80 + fr];
#pragma unroll
        for (int m = 0; m < 4; ++m) {
#pragma unroll
            for (int j = 0; j < 4; ++j) {
                const int tok = rowb + m * 16 + j, b = tok >> 12, s = tok & 4095;
                const f32x2 s2 = *(const f32x2*)(sqkv + (size_t)tok * 2);
                const float rkv = 1.0f / sqrtf((s2.x + s2.y) * (1.0f / 128.0f) + EPS);
                float v[4], ss = 0.f;
#pragma unroll
                for (int n = 0; n < 4; ++n) { v[n] = acc[m][n][j] * rkv; ss += v[n] * v[n]; }
                ss += __shfl_xor(ss, 1); ss += __shfl_xor(ss, 2); ss += __shfl_xor(ss, 4); ss += __shfl_xor(ss, 8);
                const float rk = 1.0f / sqrtf((ss + sqkr[tok]) * (1.0f / 96.0f) + EPS);
                bf16_t* dst = kb + ((size_t)(b * 8 + hd) * 4096 + s) * 96;
#pragma unroll
                for (int n = 0; n < 4; ++n) dst[n * 16 + fr] = f2bf(v[n] * rk * g[n]);
                const float x1 = krp[(size_t)tok * 32 + fr] * rk * g1, x2 = krp[(size_t)tok * 32 + 16 + fr] * rk * g2;
                const f32x2 cs = rope[(size_t)tok * 16 + fr];
                dst[64 + fr] = f2bf(x1 * cs.x - x2 * cs.y); dst[80 + fr] = f2bf(x1 * cs.y + x2 * cs.x);
            }
        }
    } else {
        bf16_t* vt = (bf16_t*)(ws + WS_VT);
#pragma unroll
        for (int m = 0; m < 4; ++m) {
            const int tok0 = rowb + m * 16, b = tok0 >> 12, s0 = tok0 & 4095;
            float rkv[4];
#pragma unroll
            for (int j = 0; j < 4; ++j) { const f32x2 s2 = *(const f32x2*)(sqkv + (size_t)(tok0 + j) * 2); rkv[j] = 1.0f / sqrtf((s2.x + s2.y) * (1.0f / 128.0f) + EPS); }
#pragma unroll
            for (int n = 0; n < 4; ++n) { const int d = n * 16 + fr; const f32x4 a = acc[m][n];
                u32x2 w; w.x = cvtpk(a.x * rkv[0], a.y * rkv[1]); w.y = cvtpk(a.z * rkv[2], a.w * rkv[3]);
                *(u32x2*)(vt + ((size_t)(b * 8 + hd) * 64 + d) * 4096 + s0) = w; }
        }
    }
}

__device__ __forceinline__ void conv_unit(const Params& p, LAS unsigned char* lds, int cu) {
    const int tid = threadIdx.x, lane = tid & 63, wave = tid >> 6;
    const int b = cu >> 7, s0 = (cu & 127) * 32, c = tid;
    const bf16_t* ub = (const bf16_t*)(p.ws + WS_U);
    const float* cw = (const float*)p.in[7]; const float* cb = (const float*)p.in[8]; const float* lg = (const float*)p.in[9]; const float* lb = (const float*)p.in[10];
    float w[31];
#pragma unroll
    for (int j = 0; j < 31; ++j) w[j] = cw[j * 512 + c];
    const float bias = cb[c];
    float win[62];
#pragma unroll
    for (int r = 0; r < 62; ++r) { const int s = s0 - 30 + r; win[r] = (s >= 0) ? bf2f(ub[((size_t)b * 4096 + s) * 512 + c]) : 0.f; }
    float o[32];
#pragma unroll
    for (int t = 0; t < 32; ++t) { float a = bias;
#pragma unroll
        for (int j = 0; j < 31; ++j) a += w[j] * win[t + j];
        o[t] = a; }
    LAS float* red = (LAS float*)lds;
    LAS float* stat = (LAS float*)(lds + 2048);
#pragma unroll
    for (int t = 0; t < 32; ++t) { const float s1 = wave_sum(o[t]), s2 = wave_sum(o[t] * o[t]); if (lane == 0) { red[(wave * 32 + t) * 2] = s1; red[(wave * 32 + t) * 2 + 1] = s2; } }
    __syncthreads();
    if (tid < 32) { float s1 = 0.f, s2 = 0.f;
#pragma unroll
        for (int k = 0; k < 8; ++k) { s1 += red[(k * 32 + tid) * 2]; s2 += red[(k * 32 + tid) * 2 + 1]; }
        const float mean = s1 * (1.0f / 512.0f); float var = s2 * (1.0f / 512.0f) - mean * mean; var = var < 0.f ? 0.f : var;
        stat[tid * 2] = mean; stat[tid * 2 + 1] = 1.0f / sqrtf(var + EPS); }
    __syncthreads();
    const float g = lg[c], bb = lb[c];
    bf16_t* cat = (bf16_t*)(p.ws + WS_CAT);
#pragma unroll
    for (int t = 0; t < 32; ++t) { const float y = (o[t] - stat[t * 2]) * stat[t * 2 + 1] * g + bb; cat[((size_t)b * 4096 + s0 + t) * 1024 + c] = f2bf(siluf_(y)); }
    __syncthreads();
}

__device__ __forceinline__ void phase1c(const Params& p, LAS unsigned char* lds) {
    for (int u = blockIdx.x; u < 3072; u += gridDim.x) {
        if (u < 1024) q_unit(p, lds, u >> 2, u & 3);
        else if (u < 2048) kv_unit(p, lds, (u - 1024) >> 2, (u - 1024) & 3);
        else conv_unit(p, lds, u - 2048);
    }
}

__device__ __forceinline__ int swap23(int r) { return (r & ~12) | ((r & 4) << 1) | ((r & 8) >> 1); }
constexpr int KROW = 208, VROW = 144, KBUF = 64 * KROW, VBUF = 64 * VROW, ABUF = KBUF + VBUF;
__device__ __forceinline__ void attn_unit(const Params& p, LAS unsigned char* lds, int bh, int qblk) {
    const int tid = threadIdx.x, lane = tid & 63, wid = __builtin_amdgcn_readfirstlane(tid >> 6), q = lane & 31, H = lane >> 5;
    unsigned char* ws = p.ws;
    const bf16_t* qg = (const bf16_t*)(ws + WS_Q) + (size_t)bh * 4096 * 96;
    const bf16_t* kg = (const bf16_t*)(ws + WS_K) + (size_t)bh * 4096 * 96;
    const bf16_t* vg = (const bf16_t*)(ws + WS_VT) + (size_t)bh * 64 * 4096;
    const int row0 = qblk * 256 + wid * 32, mychunk = 4 * qblk + (wid >> 1), NT = 4 * qblk + 4;
    bf16x8 qf[6];
#pragma unroll
    for (int s = 0; s < 6; ++s) qf[s] = *(const bf16x8*)(qg + (size_t)(row0 + q) * 96 + 16 * s + 8 * H);
    const int kr0 = tid / 12, kc0 = tid % 12, kr1 = (tid + 512) / 12, kc1 = (tid + 512) % 12, vd = tid >> 3, vc = tid & 7;
    const bool k1 = tid < 256;
    const bf16_t* ksrc0 = kg + (size_t)kr0 * 96 + kc0 * 8; const bf16_t* ksrc1 = kg + (size_t)kr1 * 96 + kc1 * 8; const bf16_t* vsrc = vg + (size_t)vd * 4096 + vc * 8;
    const int kdst0 = kr0 * KROW + kc0 * 16, kdst1 = kr1 * KROW + kc1 * 16, vdst = KBUF + vd * VROW + vc * 16;
    u32x4 rk0, rk1 = (u32x4){0, 0, 0, 0}, rv;
#define AT_LOAD(t) do { rk0 = *(const u32x4*)(ksrc0 + (size_t)(t) * 64 * 96); if (k1) rk1 = *(const u32x4*)(ksrc1 + (size_t)(t) * 64 * 96); rv = *(const u32x4*)(vsrc + (t) * 64); } while (0)
#define AT_WRITE(buf) do { LAS unsigned char* b_ = lds + (buf) * ABUF; *(LAS u32x4*)(b_ + kdst0) = rk0; if (k1) *(LAS u32x4*)(b_ + kdst1) = rk1; *(LAS u32x4*)(b_ + vdst) = rv; } while (0)
    AT_LOAD(0); AT_WRITE(0);
    __syncthreads();
    f32x16 o0 = {0}, o1 = {0};
    float mrun = -INFINITY, lsum = 0.f;
    const int koff = swap23(q) * KROW + 16 * H, voff = KBUF + q * VROW + 16 * H;
    for (int t = 0; t < NT; ++t) {
        if (t + 1 < NT) AT_LOAD(t + 1);
        if (t <= mychunk) {
            const LAS unsigned char* kb = lds + (t & 1) * ABUF + koff; const LAS unsigned char* vb = lds + (t & 1) * ABUF + voff;
            f32x16 s0 = {0}, s1 = {0};
#pragma unroll
            for (int s = 0; s < 6; ++s) {
                const bf16x8 a0 = *(const LAS bf16x8*)(kb + 32 * s), a1 = *(const LAS bf16x8*)(kb + 32 * KROW + 32 * s);
                s0 = __builtin_amdgcn_mfma_f32_32x32x16_bf16(a0, qf[s], s0, 0, 0, 0);
                s1 = __builtin_amdgcn_mfma_f32_32x32x16_bf16(a1, qf[s], s1, 0, 0, 0);
            }
            float mloc = s0[0];
#pragma unroll
            for (int r = 1; r < 16; ++r) mloc = fmaxf(mloc, s0[r]);
#pragma unroll
            for (int r = 0; r < 16; ++r) mloc = fmaxf(mloc, s1[r]);
            mloc = fmaxf(mloc, __shfl_xor(mloc, 32));
            const float mnew = fmaxf(mrun, mloc);
            const float alpha = __builtin_amdgcn_exp2f(mrun - mnew);
            mrun = mnew;
            float ps = 0.f;
#pragma unroll
            for (int r = 0; r < 16; ++r) { s0[r] = __builtin_amdgcn_exp2f(s0[r] - mnew); s1[r] = __builtin_amdgcn_exp2f(s1[r] - mnew); ps += s0[r] + s1[r]; }
            lsum = lsum * alpha + ps;
#pragma unroll
            for (int r = 0; r < 16; ++r) { o0[r] *= alpha; o1[r] *= alpha; }
            u32x4 pw[4];
            pw[0] = (u32x4){cvtpk(s0[0], s0[1]), cvtpk(s0[2], s0[3]), cvtpk(s0[4], s0[5]), cvtpk(s0[6], s0[7])};
            pw[1] = (u32x4){cvtpk(s0[8], s0[9]), cvtpk(s0[10], s0[11]), cvtpk(s0[12], s0[13]), cvtpk(s0[14], s0[15])};
            pw[2] = (u32x4){cvtpk(s1[0], s1[1]), cvtpk(s1[2], s1[3]), cvtpk(s1[4], s1[5]), cvtpk(s1[6], s1[7])};
            pw[3] = (u32x4){cvtpk(s1[8], s1[9]), cvtpk(s1[10], s1[11]), cvtpk(s1[12], s1[13]), cvtpk(s1[14], s1[15])};
#pragma unroll
            for (int ks = 0; ks < 4; ++ks) {
                const bf16x8 v0 = *(const LAS bf16x8*)(vb + 32 * ks), v1 = *(const LAS bf16x8*)(vb + 32 * VROW + 32 * ks);
                const bf16x8 pb = __builtin_bit_cast(bf16x8, pw[ks]);
                o0 = __builtin_amdgcn_mfma_f32_32x32x16_bf16(v0, pb, o0, 0, 0, 0);
                o1 = __builtin_amdgcn_mfma_f32_32x32x16_bf16(v1, pb, o1, 0, 0, 0);
            }
        }
        if (t + 1 < NT) AT_WRITE((t + 1) & 1);
        __syncthreads();
    }
#undef AT_LOAD
#undef AT_WRITE
    const float ltot = lsum + __shfl_xor(lsum, 32), inv = 1.0f / ltot;
    const int b = bh >> 3, hd = bh & 7;
    bf16_t* dst = (bf16_t*)(ws + WS_CAT) + ((size_t)b * 4096 + row0 + q) * 1024 + 512 + hd * 64;
#pragma unroll
    for (int g = 0; g < 4; ++g) {
        u32x2 w; w.x = cvtpk(o0[4 * g] * inv, o0[4 * g + 1] * inv); w.y = cvtpk(o0[4 * g + 2] * inv, o0[4 * g + 3] * inv); *(u32x2*)(dst + 8 * g + 4 * H) = w;
        w.x = cvtpk(o1[4 * g] * inv, o1[4 * g + 1] * inv); w.y = cvtpk(o1[4 * g + 2] * inv, o1[4 * g + 3] * inv); *(u32x2*)(dst + 32 + 8 * g + 4 * H) = w;
    }
}
__device__ __forceinline__ void phase2(const Params& p, LAS unsigned char* lds) {
    for (int u = blockIdx.x; u < 512; u += gridDim.x) {
        const int bh = u >> 3, pr = u & 7;
        attn_unit(p, lds, bh, 15 - pr);
        attn_unit(p, lds, bh, pr);
    }
}

__device__ __forceinline__ void phase3(const Params& p, LAS unsigned char* lds) {
    const int tid = threadIdx.x, lane = tid & 63, wid = __builtin_amdgcn_readfirstlane(tid >> 6), wr = wid >> 2, wc = wid & 3, fr = lane & 15, fq = lane >> 4;
    unsigned char* ws = p.ws;
    const float* x = (const float*)p.in[0]; const float* mod = (const float*)(ws + WS_MOD); float* sq1 = (float*)(ws + WS_SSQ1);
    for (int u = blockIdx.x; u < 512; u += gridDim.x) {
        const int pm = u >> 2, pn = u & 3;
        const bf16_t* ap[4]; const bf16_t* bp[4];
        stage_ptrs_dense<4>((const bf16_t*)(ws + WS_CAT), 1024, pm * 256, ap); stage_ptrs_dense<4>((const bf16_t*)(ws + WS_WOUT), 1024, pn * 256, bp);
        f32x4 acc[8][4];
#pragma unroll
        for (int m = 0; m < 8; ++m)
#pragma unroll
            for (int n = 0; n < 4; ++n) acc[m][n] = (f32x4){0.f, 0.f, 0.f, 0.f};
        gemm_block<8, 4, true>(lds, ap, bp, 16, acc);
        const int rowb = pm * 256 + wr * 128 + fr, b = (pm * 256) >> 12, colb = pn * 256 + wc * 64 + fq * 4;
        f32x4 ga[4];
#pragma unroll
        for (int n = 0; n < 4; ++n) ga[n] = *(const f32x4*)(mod + b * 6144 + 2048 + colb + n * 16);
#pragma unroll
        for (int m = 0; m < 8; ++m) { const size_t row = rowb + m * 16; float s = 0.f;
#pragma unroll
            for (int n = 0; n < 4; ++n) { const f32x4 xv = *(const f32x4*)(x + row * DM + colb + n * 16); const f32x4 v = xv + ga[n] * acc[m][n];
                *(f32x4*)(p.out + row * DM + colb + n * 16) = v; s += (v.x * v.x + v.y * v.y) + (v.z * v.z + v.w * v.w); }
            s += __shfl_xor(s, 16); s += __shfl_xor(s, 32);
            if (fq == 0) sq1[row * 16 + pn * 4 + wc] = s; }
    }
}

constexpr int RROW = 2064;
__device__ __forceinline__ void phase3b(const Params& p, LAS unsigned char* lds) {
    const int tid = threadIdx.x, lane = tid & 63, wave = __builtin_amdgcn_readfirstlane(tid >> 6), fr = lane & 15, fq = lane >> 4;
    unsigned char* ws = p.ws;
    const float* nf = (const float*)p.in[18]; const float* mod = (const float*)(ws + WS_MOD); const float* sq1 = (const float*)(ws + WS_SSQ1);
    const float* bg = (const float*)p.in[20]; const float* be = (const float*)p.in[22];
    bf16_t* h2 = (bf16_t*)(ws + WS_H); const bf16_t* wrh = (const bf16_t*)(ws + WS_WR); const bf16_t* wrl = wrh + 48 * 1024;
    LAS unsigned char* Ahi = lds; LAS unsigned char* Alo = lds + 32 * RROW; LAS float* lg = (LAS float*)(lds + 64 * RROW);
    unsigned* ctl = (unsigned*)(ws + WS_CTL); int* lists = (int*)(ws + WS_LIST); float* tokw = (float*)(ws + WS_TOKW);
    for (int tile = blockIdx.x; tile < MT / 32; tile += gridDim.x) {
        const int r0 = tile * 32, b = r0 >> 12;
        f32x4 gm[4], sh[4];
#pragma unroll
        for (int j = 0; j < 4; ++j) { const int col = 4 * lane + 256 * j; const f32x4 g = *(const f32x4*)(nf + col), s = *(const f32x4*)(mod + b * 6144 + 4096 + col);
            gm[j] = g * (s + 1.0f); sh[j] = *(const f32x4*)(mod + b * 6144 + 3072 + col); }
#pragma unroll
        for (int rr = 0; rr < 4; ++rr) {
            const int lr = wave * 4 + rr; const size_t row = r0 + lr;
            float ss = 0.f;
#pragma unroll
            for (int k = 0; k < 4; ++k) { const f32x4 s4 = *(const f32x4*)(sq1 + row * 16 + 4 * k); ss += (s4.x + s4.y) + (s4.z + s4.w); }
            const float rstd = 1.0f / sqrtf(ss * (1.0f / DM) + EPS);
#pragma unroll
            for (int j = 0; j < 4; ++j) { const int col = 4 * lane + 256 * j; const f32x4 xv = *(const f32x4*)(p.out + row * DM + col);
                const f32x4 o = xv * rstd * gm[j] + sh[j];
                u32x2 w; w.x = cvtpk(o.x, o.y); w.y = cvtpk(o.z, o.w);
                *(u32x2*)(h2 + row * DM + col) = w; *(LAS u32x2*)(Ahi + lr * RROW + col * 2) = w;
                const float lx = o.x - bf2f((unsigned short)(w.x & 0xffff)), ly = o.y - bf2f((unsigned short)(w.x >> 16)), lz = o.z - bf2f((unsigned short)(w.y & 0xffff)), lw = o.w - bf2f((unsigned short)(w.y >> 16));
                u32x2 wl; wl.x = cvtpk(lx, ly); wl.y = cvtpk(lz, lw); *(LAS u32x2*)(Alo + lr * RROW + col * 2) = wl; }
        }
        __syncthreads();
        if (wave < 6) {
            const int mt = wave / 3, nt = wave % 3;
            f32x4 acc = {0.f, 0.f, 0.f, 0.f};
            const LAS unsigned char* ah = Ahi + (mt * 16 + fr) * RROW + fq * 16; const LAS unsigned char* al = Alo + (mt * 16 + fr) * RROW + fq * 16;
            const bf16_t* bh = wrh + (size_t)(nt * 16 + fr) * 1024 + fq * 8; const bf16_t* bl = wrl + (size_t)(nt * 16 + fr) * 1024 + fq * 8;
#pragma unroll 4
            for (int kk = 0; kk < 32; ++kk) {
                const bf16x8 a_h = *(const LAS bf16x8*)(ah + kk * 64), a_l = *(const LAS bf16x8*)(al + kk * 64);
                const bf16x8 b_h = *(const bf16x8*)(bh + kk * 32), b_l = *(const bf16x8*)(bl + kk * 32);
                acc = __builtin_amdgcn_mfma_f32_16x16x32_bf16(a_h, b_h, acc, 0, 0, 0);
                acc = __builtin_amdgcn_mfma_f32_16x16x32_bf16(a_l, b_h, acc, 0, 0, 0);
                acc = __builtin_amdgcn_mfma_f32_16x16x32_bf16(a_h, b_l, acc, 0, 0, 0);
            }
#pragma unroll
            for (int j = 0; j < 4; ++j) lg[(mt * 16 + fq * 4 + j) * 48 + nt * 16 + fr] = acc[j];
        }
        __syncthreads();
        if (tid < 32) {
            const LAS float* l = lg + tid * 48; const int tok = r0 + tid;
            float gl[4]; int gi = 0; float gmx;
#pragma unroll
            for (int i = 0; i < 4; ++i) gl[i] = l[i] + bg[i];
            gmx = gl[0];
#pragma unroll
            for (int i = 1; i < 4; ++i) if (gl[i] > gmx) { gmx = gl[i]; gi = i; }
            float gs = 0.f;
#pragma unroll
            for (int i = 0; i < 4; ++i) gs += __expf(gl[i] - gmx);
            const float gtop = 1.0f / gs;
            float el[8];
#pragma unroll
            for (int i = 0; i < 8; ++i) el[i] = l[4 + gi * 8 + i] + be[gi * 8 + i];
            int e1 = 0; float m1 = el[0];
#pragma unroll
            for (int i = 1; i < 8; ++i) if (el[i] > m1) { m1 = el[i]; e1 = i; }
            int e2 = -1; float m2 = -INFINITY;
#pragma unroll
            for (int i = 0; i < 8; ++i) if (i != e1 && el[i] > m2) { m2 = el[i]; e2 = i; }
            const float p2 = __expf(m2 - m1);
            const float w1 = gtop / (1.0f + p2), w2 = gtop * p2 / (1.0f + p2);
            const int l1 = (gi * 8 + e1) * 2, l2 = (gi * 8 + e2) * 2 + 1;
            const unsigned p1 = atomicAdd(ctl + CW_CNT + 64 * l1, 1u), pp2 = atomicAdd(ctl + CW_CNT + 64 * l2, 1u);
            lists[(size_t)l1 * MT + p1] = tok; lists[(size_t)l2 * MT + pp2] = tok;
            tokw[tok * 2] = w1; tokw[tok * 2 + 1] = w2;
        }
        __syncthreads();
    }
}

__device__ __forceinline__ bool p4_find(const unsigned* cnts, int u, int per_tile, int& l, int& rt, int& ct, int& cnt) {
    for (int i = 0; i < 64; ++i) { const int c = (int)cnts[i]; const int n = ((c + 255) >> 8) * per_tile; if (u < n) { l = i; rt = u / per_tile; ct = u % per_tile; cnt = c; return true; } u -= n; }
    return false;
}
__device__ __forceinline__ void phase4a(const Params& p, LAS unsigned char* lds, LAS unsigned* cnts) {
    const int tid = threadIdx.x, lane = tid & 63, wid = __builtin_amdgcn_readfirstlane(tid >> 6), wr = wid >> 2, wc = wid & 3, fr = lane & 15, fq = lane >> 4;
    unsigned char* ws = p.ws;
    const int* lists = (const int*)(ws + WS_LIST); const float* tokw = (const float*)(ws + WS_TOKW);
    const bf16_t* h2 = (const bf16_t*)(ws + WS_H);
    for (int u = blockIdx.x;; u += gridDim.x) {
        int l, rt, ct, cnt;
        if (!p4_find((const unsigned*)cnts, u, 2, l, rt, ct, cnt)) break;
        const int e = l >> 1, slot = l & 1;
        const int* lst = lists + (size_t)l * MT + rt * 256; const int nrow = cnt - rt * 256;
        const bf16_t* ap[4]; const bf16_t* bp[4];
#pragma unroll
        for (int i = 0; i < 4; ++i) { int R, C; stage_rc2((tid >> 6) * 1024 + i * 8192 + lane * 16, R, C); const int tok = lst[R < nrow ? R : 0]; ap[i] = h2 + (size_t)tok * 1024 + C; }
        stage_ptrs_dense<4>((const bf16_t*)(ws + WS_WGU) + (size_t)e * 512 * 1024, 1024, ct * 256, bp);
        f32x4 acc[8][4];
#pragma unroll
        for (int m = 0; m < 8; ++m)
#pragma unroll
            for (int n = 0; n < 4; ++n) acc[m][n] = (f32x4){0.f, 0.f, 0.f, 0.f};
        gemm_block<8, 4, true>(lds, ap, bp, 16, acc);
        bf16_t* ab = (bf16_t*)(ws + WS_ABUF) + (size_t)slot * MT * 256;
#pragma unroll
        for (int m = 0; m < 8; ++m) { const int R = wr * 128 + m * 16 + fr;
            if (R < nrow) { const int tok = lst[R]; const float w = tokw[tok * 2 + slot];
#pragma unroll
                for (int h = 0; h < 2; ++h) { const f32x4 g = acc[m][2 * h], uu = acc[m][2 * h + 1]; const int ch = ct * 128 + wc * 32 + h * 16 + fq * 4;
                    u32x2 o; o.x = cvtpk(siluf_(g.x) * uu.x * w, siluf_(g.y) * uu.y * w); o.y = cvtpk(siluf_(g.z) * uu.z * w, siluf_(g.w) * uu.w * w);
                    *(u32x2*)(ab + (size_t)tok * 256 + ch) = o; } } }
    }
}
__device__ __forceinline__ void phase4b(const Params& p, LAS unsigned char* lds, LAS unsigned* cnts, int slot) {
    const int tid = threadIdx.x, lane = tid & 63, wid = __builtin_amdgcn_readfirstlane(tid >> 6), wr = wid >> 2, wc = wid & 3, fr = lane & 15, fq = lane >> 4;
    unsigned char* ws = p.ws;
    const int* lists = (const int*)(ws + WS_LIST); const float* mod = (const float*)(ws + WS_MOD);
    const bf16_t* ab = (const bf16_t*)(ws + WS_ABUF) + (size_t)slot * MT * 256;
    for (int u = blockIdx.x;; u += gridDim.x) {
        int l = -1, rt = 0, ct = 0, cnt = 0; { int uu = u; bool found = false;
            for (int i = 0; i < 32; ++i) { const int c = (int)cnts[2 * i + slot]; const int n = ((c + 127) >> 7) * 4; if (uu < n) { l = 2 * i + slot; rt = uu >> 2; ct = uu & 3; cnt = c; found = true; break; } uu -= n; }
            if (!found) break; }
        const int e = l >> 1;
        const int* lst = lists + (size_t)l * MT + rt * 128; const int nrow = cnt - rt * 128;
        const bf16_t* ap[2]; const bf16_t* bp[4];
#pragma unroll
        for (int i = 0; i < 2; ++i) { int R, C; stage_rc2((tid >> 6) * 1024 + i * 8192 + lane * 16, R, C); const int tok = lst[R < nrow ? R : 0]; ap[i] = ab + (size_t)tok * 256 + C; }
        stage_ptrs_dense<4>((const bf16_t*)(ws + WS_WD) + (size_t)e * 1024 * 256, 256, ct * 256, bp);
        f32x4 acc[4][4];
#pragma unroll
        for (int m = 0; m < 4; ++m)
#pragma unroll
            for (int n = 0; n < 4; ++n) acc[m][n] = (f32x4){0.f, 0.f, 0.f, 0.f};
        gemm_block<4, 4, true>(lds, ap, bp, 4, acc);
        const int colb = ct * 256 + wc * 64 + fq * 4;
#pragma unroll
        for (int m = 0; m < 4; ++m) { const int R = wr * 64 + m * 16 + fr;
            if (R < nrow) { const int tok = lst[R]; const int b = tok >> 12; float* orow = p.out + (size_t)tok * DM;
#pragma unroll
                for (int n = 0; n < 4; ++n) { const int col = colb + n * 16; const f32x4 gf = *(const f32x4*)(mod + b * 6144 + 5120 + col);
                    const f32x4 o = *(const f32x4*)(orow + col) + gf * acc[m][n]; *(f32x4*)(orow + col) = o; } } }
    }
}

__global__ void __launch_bounds__(512, 2) hybrid_block_fwd(Params p) {
    extern __shared__ __attribute__((aligned(16))) unsigned char lds_raw[];
    LAS unsigned char* lds = (LAS unsigned char*)lds_raw;
    volatile LAS unsigned* MISC = (volatile LAS unsigned*)(lds + MISC_OFF);
    LAS unsigned* cnts = (LAS unsigned*)(lds + MISC_OFF + 256);
    const int tid = threadIdx.x;
    if (tid < 16) MISC[tid] = 0u;
    __syncthreads();
    unsigned* ctl = (unsigned*)(p.ws + WS_CTL);
    const bool single = (p.ph_hi - p.ph_lo) > 1;
    XcdBarrier bar; bar.bar = ctl + CW_BAR; bar.x = 0; bar.st = nullptr;
    if (single) bar = xcd_barrier_post(ctl + CW_BAR, MISC + 8);
#ifndef PH_MASK
#define PH_MASK 0x3ff
#endif
#define IN(k) (((PH_MASK >> (k)) & 1) && p.ph_lo <= (k) && (k) < p.ph_hi)
#define SEAM(k) do { if (IN(k) && IN((k) + 1)) xcd_barrier(bar); } while (0)
    if (IN(0)) { phase0(p, lds); } SEAM(0);
    if (IN(1)) { phase1a(p); } SEAM(1);
    if (IN(2)) { phase1b(p, lds); } SEAM(2);
    if (IN(3)) { phase1c(p, lds); } SEAM(3);
    if (IN(4)) { phase2(p, lds); } SEAM(4);
    if (IN(5)) { phase3(p, lds); } SEAM(5);
    if (IN(6)) { phase3b(p, lds); } SEAM(6);
    if (IN(7) || IN(8) || IN(9)) {
        if (tid < 64) cnts[tid] = __hip_atomic_load(ctl + CW_CNT + 64 * tid, __ATOMIC_RELAXED, __HIP_MEMORY_SCOPE_AGENT);
        __syncthreads();
    }
    if (IN(7)) { phase4a(p, lds, cnts); } SEAM(7);
    if (IN(8)) { phase4b(p, lds, cnts, 0); } SEAM(8);
    if (IN(9)) { phase4b(p, lds, cnts, 1); }
#undef IN
#undef SEAM
}

extern "C" void kernel_launch(void* const* d_in, const int* in_sizes, int n_in, void* d_out, int out_size, void* d_ws, size_t ws_size, hipStream_t stream) {
    static int grid = 0;
    if (grid == 0) {
        if (n_in != 26 || out_size != MT * DM || ws_size < WS_END) { fprintf(stderr, "kernel_launch: unexpected problem (n_in %d out %d ws %zu)\n", n_in, out_size, ws_size); grid = -1; return; }
        int dev = 0, cus = 0, per_cu = 0;
        hipGetDevice(&dev); hipDeviceGetAttribute(&cus, hipDeviceAttributeMultiprocessorCount, dev);
        hipFuncSetAttribute((const void*)hybrid_block_fwd, hipFuncAttributeMaxDynamicSharedMemorySize, LDS_BYTES);
        hipOccupancyMaxActiveBlocksPerMultiprocessor(&per_cu, (const void*)hybrid_block_fwd, 512, LDS_BYTES);
        (void)hipGetLastError();
        if (per_cu < 1) { fprintf(stderr, "kernel_launch: occupancy query says %d blocks/CU\n", per_cu); per_cu = 1; }
        grid = cus;
    }
    if (grid < 0) return;
    hipMemsetAsync((char*)d_ws + WS_CTL, 0, CTL_BYTES, stream);
    Params prm{};
    for (int i = 0; i < 26; ++i) prm.in[i] = d_in[i];
    prm.out = (float*)d_out; prm.ws = (unsigned char*)d_ws;
#if N_LAUNCH_SPLIT
    for (int ph = 0; ph <= DBG_LAST_PHASE; ++ph) { prm.ph_lo = ph; prm.ph_hi = ph + 1; hipLaunchKernelGGL(hybrid_block_fwd, dim3(grid), dim3(512), LDS_BYTES, stream, prm); }
#else
    prm.ph_lo = 0; prm.ph_hi = DBG_LAST_PHASE + 1;
    hipLaunchKernelGGL(hybrid_block_fwd, dim3(grid), dim3(512), LDS_BYTES, stream, prm);
#endif
}
```

```cpp
#include <hip/hip_runtime.h>
#include <cstdio>
#include <cstdint>
#include <utility>

#ifndef N_LAUNCH_SPLIT
#define N_LAUNCH_SPLIT 0
#endif
#ifndef DBG_LAST_PHASE
#define DBG_LAST_PHASE 8
#endif

#define LAS __attribute__((address_space(3)))
#define GAS __attribute__((address_space(1)))
typedef unsigned short bf16_t;
typedef short bf16x8 __attribute__((ext_vector_type(8)));
typedef float f32x4 __attribute__((ext_vector_type(4)));
typedef float f32x2 __attribute__((ext_vector_type(2)));
typedef float f32x16 __attribute__((ext_vector_type(16)));
typedef unsigned u32x4 __attribute__((ext_vector_type(4)));
typedef unsigned u32x2 __attribute__((ext_vector_type(2)));
typedef __bf16 bf16x2_t __attribute__((ext_vector_type(2)));

constexpr int NB = 8, SEQ = 4096, DM = 1024, MT = NB * SEQ;
constexpr int NHEAD = 8, DQK = 96, DV = 64;
constexpr int NEXP = 32;
constexpr float EPS = 1e-6f;
constexpr float QSCALE = 0.14724444602590306f;
constexpr int NPH = 9;

constexpr size_t MiB = 1u << 20;
constexpr size_t WS_CTL = 0, CTL_BYTES = 1 * MiB;
constexpr size_t WS_MOD = 1 * MiB;
constexpr size_t WS_ROPE = 2 * MiB;
constexpr size_t WS_WIN = 6 * MiB;
constexpr size_t WS_WQ = 9 * MiB;
constexpr size_t WS_WKV = 9 * MiB + 512 * 1024;
constexpr size_t WS_WR = 9 * MiB + 768 * 1024;
constexpr size_t WS_WOUT = 10 * MiB;
constexpr size_t WS_WGU = 12 * MiB;
constexpr size_t WS_WD = 44 * MiB;
constexpr size_t WS_SSQQ = 60 * MiB;
constexpr size_t WS_SSQKV = 60 * MiB + 512 * 1024;
constexpr size_t WS_SSQKR = 60 * MiB + 768 * 1024;
constexpr size_t WS_SSQ1 = 61 * MiB;
constexpr size_t WS_TOKW = 63 * MiB;
constexpr size_t WS_KROPE = 64 * MiB;
constexpr size_t WS_CQ = 68 * MiB;
constexpr size_t WS_CKV = 84 * MiB;
constexpr size_t WS_LIST = 92 * MiB;
constexpr size_t WS_H = 100 * MiB;
constexpr size_t WS_U = 164 * MiB;
constexpr size_t WS_Q = 196 * MiB;
constexpr size_t WS_K = 244 * MiB;
constexpr size_t WS_VT = 292 * MiB;
constexpr size_t WS_CAT = 324 * MiB;
constexpr size_t WS_ABUF = 388 * MiB;
constexpr size_t WS_BLIST = 420 * MiB;
constexpr size_t WS_END = 435 * MiB;
constexpr int CW_BAR = 4096;
constexpr int CW_CNT = 16384;

constexpr int SCR_BYTES = 155648;
constexpr int MISC_OFF = SCR_BYTES;
constexpr int LDS_BYTES = SCR_BYTES + 1024;

__device__ __forceinline__ unsigned cvtpk(float lo, float hi) { f32x2 v = {lo, hi}; bf16x2_t b = __builtin_convertvector(v, bf16x2_t); return __builtin_bit_cast(unsigned, b); }
__device__ __forceinline__ float bf2f(unsigned short h) { return __builtin_bit_cast(float, (unsigned)h << 16); }
__device__ __forceinline__ unsigned short f2bf(float f) { return (unsigned short)(cvtpk(f, 0.f) & 0xffffu); }
__device__ __forceinline__ float sigmoidf_(float x) { return 1.0f / (1.0f + __expf(-x)); }
__device__ __forceinline__ float siluf_(float x) { return x / (1.0f + __expf(-x)); }
__device__ __forceinline__ float wave_sum(float v) {
#pragma unroll
    for (int o = 1; o < 64; o <<= 1) v += __shfl_xor(v, o);
    return v;
}

#define XB_TMO      128
#define XB_XCNT(j)  (256  + 64 * (j))
#define XB_XSUB(j)  (1280 + 64 * (j))
#define XB_XGEN(j)  (2304 + 64 * (j))
#define XB_TOP      3328
#define XB_TOPGEN   3392
#define XCD_BAR_WORDS 3456
#define XB_SPIN_CAP (1u << 20)
__device__ __forceinline__ unsigned xb_ld(unsigned* p)              { return __hip_atomic_load(p, __ATOMIC_RELAXED, __HIP_MEMORY_SCOPE_AGENT); }
__device__ __forceinline__ unsigned xb_add(unsigned* p, unsigned v) { return __hip_atomic_fetch_add(p, v, __ATOMIC_RELAXED, __HIP_MEMORY_SCOPE_AGENT); }
__device__ __forceinline__ unsigned xb_xcc_id() { return (unsigned)__builtin_amdgcn_s_getreg((3 << 11) | 20) & 0xFu; }
#define XB_SPIN(cond, bar) do { unsigned _sp = 0; while (cond) { __builtin_amdgcn_s_sleep(1); \
    if ((++_sp & 255u) == 0u) { if (xb_ld(&(bar)[XB_TMO])) break; if (_sp > XB_SPIN_CAP) { atomicAdd(&(bar)[XB_TMO], 1u); break; } } } } while (0)
struct XcdBarrier { unsigned* bar; unsigned x; volatile LAS unsigned* st; };
__device__ __forceinline__ XcdBarrier xcd_barrier_post(unsigned* bar, volatile LAS unsigned* st) {
    XcdBarrier b; b.bar = bar; b.x = xb_xcc_id(); b.st = st;
    if (threadIdx.x == 0) (void)xb_add(&bar[XB_XCNT(b.x)], 1u);
    return b;
}
__device__ __forceinline__ void xcd_barrier_complete(unsigned* bar, unsigned x, unsigned& nloc, unsigned& nx) {
    const unsigned G = gridDim.x * gridDim.y * gridDim.z;
    unsigned sum, cnt, mine, sp = 0u;
    for (;;) {
        sum = 0u; cnt = 0u; mine = 0u;
#pragma unroll
        for (unsigned j = 0; j < 16; ++j) { const unsigned c = xb_ld(&bar[XB_XCNT(j)]); sum += c; cnt += (c > 0u) ? 1u : 0u; mine = (j == x) ? c : mine; }
        if (sum == G) break;
        __builtin_amdgcn_s_sleep(1);
        if ((++sp & 255u) == 0u) { if (xb_ld(&bar[XB_TMO])) break; if (sp > XB_SPIN_CAP) { atomicAdd(&bar[XB_TMO], 1u); break; } }
    }
    nloc = mine > 0u ? mine : 1u; nx = cnt > 0u ? cnt : 1u;
}
__device__ __forceinline__ void xcd_barrier(const XcdBarrier& b) {
    asm volatile("s_waitcnt vmcnt(0)" ::: "memory");
    __syncthreads();
    if (threadIdx.x == 0) {
        unsigned* bar = b.bar;
        __builtin_amdgcn_s_waitcnt(0);
        unsigned nloc = b.st[0], nx = b.st[1];
        if (nloc == 0u) { xcd_barrier_complete(bar, b.x, nloc, nx); b.st[0] = nloc; b.st[1] = nx; }
        const unsigned old = xb_add(&bar[XB_XSUB(b.x)], 1u);
        const unsigned gen = old / nloc;
        if (old + 1u == (gen + 1u) * nloc) {
            __builtin_amdgcn_fence(__ATOMIC_RELEASE, "agent");
            asm volatile("s_waitcnt vmcnt(0)" ::: "memory");
            const unsigned og = xb_add(&bar[XB_TOP], 1u);
            const unsigned tg = og / nx;
            if (og + 1u == (tg + 1u) * nx) xb_add(&bar[XB_TOPGEN], 1u);
            else XB_SPIN(xb_ld(&bar[XB_TOPGEN]) == tg, bar);
            __builtin_amdgcn_fence(__ATOMIC_ACQUIRE, "agent");
            xb_add(&bar[XB_XGEN(b.x)], 1u);
            asm volatile("s_waitcnt vmcnt(0)" ::: "memory");
        } else {
            XB_SPIN(xb_ld(&bar[XB_XGEN(b.x)]) == gen, bar);
            __builtin_amdgcn_fence(__ATOMIC_ACQUIRE, "agent");
            asm volatile("s_waitcnt vmcnt(0)" ::: "memory");
        }
    }
    __syncthreads();
}

__device__ __forceinline__ int lds_byte2(int r, int c) { const int st = (r >> 4) * 2 + (c >> 5), ob = (r & 15) * 64 + (c & 31) * 2; return st * 1024 + (ob ^ (((ob >> 9) & 1) << 5)); }
__device__ __forceinline__ void stage_rc2(int b, int& R, int& C) { const int st = b >> 10, sb = b & 1023, swz = sb ^ (((sb >> 9) & 1) << 5); R = (st >> 1) * 16 + swz / 64; C = (st & 1) * 32 + (swz % 64) / 2; }

template <int MI, int NI, bool TRANS>
__device__ __forceinline__ void gemm_block(LAS unsigned char* lds, const bf16_t* const (&ap)[MI / 2], const bf16_t* const (&bp)[NI], int nkt, f32x4 (&acc)[MI][NI]) {
    constexpr int BM = 32 * MI, BN = 64 * NI, TA = BM * 128, TB = BN * 128, STG = TA + TB, GLA = MI / 2, GLB = NI;
    static_assert(2 * STG <= SCR_BYTES, "LDS");
    const int tid = threadIdx.x, lane = tid & 63, wid = __builtin_amdgcn_readfirstlane(tid >> 6), wr = wid >> 2, wc = wid & 3, fr = lane & 15, fq = lane >> 4;
    const int aoff = lds_byte2(wr * (MI * 16) + fr, fq * 8), boff = TA + lds_byte2(wc * (NI * 16) + fr, fq * 8);
#define GB_STAGE(buf, kt) do { \
        _Pragma("unroll") for (int i_ = 0; i_ < GLA; ++i_) __builtin_amdgcn_global_load_lds((const unsigned*)(ap[i_] + (kt) * 64), (LAS unsigned*)(lds + (buf) * STG + wid * 1024 + i_ * 8192), 16, 0, 0); \
        _Pragma("unroll") for (int i_ = 0; i_ < GLB; ++i_) __builtin_amdgcn_global_load_lds((const unsigned*)(bp[i_] + (kt) * 64), (LAS unsigned*)(lds + (buf) * STG + TA + wid * 1024 + i_ * 8192), 16, 0, 0); } while (0)
    GB_STAGE(0, 0);
    asm volatile("s_waitcnt vmcnt(0)" ::: "memory"); __syncthreads();
    for (int t = 0; t < nkt; ++t) {
        const int cur = t & 1;
        if (t + 1 < nkt) GB_STAGE(cur ^ 1, t + 1);
        const LAS unsigned char* sb = lds + cur * STG;
#pragma unroll
        for (int ks = 0; ks < 2; ++ks) {
            bf16x8 At[MI], Bf[NI];
#pragma unroll
            for (int m = 0; m < MI; ++m) At[m] = *(const LAS bf16x8*)(sb + aoff + m * 2048 + ks * 1024);
#pragma unroll
            for (int n = 0; n < NI; ++n) Bf[n] = *(const LAS bf16x8*)(sb + boff + n * 2048 + ks * 1024);
#pragma unroll
            for (int m = 0; m < MI; ++m)
#pragma unroll
                for (int n = 0; n < NI; ++n)
                    acc[m][n] = TRANS ? __builtin_amdgcn_mfma_f32_16x16x32_bf16(Bf[n], At[m], acc[m][n], 0, 0, 0)
                                      : __builtin_amdgcn_mfma_f32_16x16x32_bf16(At[m], Bf[n], acc[m][n], 0, 0, 0);
        }
        asm volatile("s_waitcnt vmcnt(0)" ::: "memory"); __syncthreads();
    }
#undef GB_STAGE
}
template <int MI, int NI, bool ARES>
__device__ __forceinline__ void gemm_stage(LAS unsigned char* lds, int abytes, const bf16_t* const (&ap)[MI / 2], const bf16_t* const (&bp)[NI], int buf, int kt) {
    constexpr int TA = MI * 32 * 128, TB = NI * 64 * 128, STG = ARES ? TB : TA + TB;
    const int wid = __builtin_amdgcn_readfirstlane(threadIdx.x >> 6);
    LAS unsigned char* base = lds + (ARES ? abytes : 0) + buf * STG + wid * 1024;
    if (!ARES) {
#pragma unroll
        for (int i = 0; i < MI / 2; ++i) __builtin_amdgcn_global_load_lds((const unsigned*)(ap[i] + kt * 64), (LAS unsigned*)(base + i * 8192), 16, 0, 0);
    }
#pragma unroll
    for (int i = 0; i < NI; ++i) __builtin_amdgcn_global_load_lds((const unsigned*)(bp[i] + kt * 64), (LAS unsigned*)(base + (ARES ? 0 : TA) + i * 8192), 16, 0, 0);
}
template <int MI>
__device__ __forceinline__ void gemm_load_ares(LAS unsigned char* lds, const bf16_t* const (&ap)[MI / 2], int nkt) {
    constexpr int TA = MI * 32 * 128;
    const int wid = __builtin_amdgcn_readfirstlane(threadIdx.x >> 6);
    for (int kt = 0; kt < nkt; ++kt) {
#pragma unroll
        for (int i = 0; i < MI / 2; ++i) __builtin_amdgcn_global_load_lds((const unsigned*)(ap[i] + kt * 64), (LAS unsigned*)(lds + kt * TA + wid * 1024 + i * 8192), 16, 0, 0);
    }
}
template <int MI, int NI, bool TRANS, bool ARES>
__device__ __forceinline__ void gemm_main(LAS unsigned char* lds, int abytes, const bf16_t* const (&ap)[MI / 2], const bf16_t* const (&bp)[NI], int nkt, f32x4 (&acc)[MI][NI]) {
    constexpr int TA = MI * 32 * 128, TB = NI * 64 * 128, STG = ARES ? TB : TA + TB;
    const int tid = threadIdx.x, lane = tid & 63, wid = __builtin_amdgcn_readfirstlane(tid >> 6), wr = wid >> 2, wc = wid & 3, fr = lane & 15, fq = lane >> 4;
    const int aoff = lds_byte2(wr * (MI * 16) + fr, fq * 8), boff = (ARES ? abytes : TA) + lds_byte2(wc * (NI * 16) + fr, fq * 8);
    for (int t = 0; t < nkt; ++t) {
        const int cur = t & 1;
        asm volatile("s_waitcnt vmcnt(0)" ::: "memory"); __syncthreads();
        if (t + 1 < nkt) gemm_stage<MI, NI, ARES>(lds, abytes, ap, bp, cur ^ 1, t + 1);
        const LAS unsigned char* sa = ARES ? lds + t * TA : lds + cur * STG;
        const LAS unsigned char* sb = lds + cur * STG;
#pragma unroll
        for (int ks = 0; ks < 2; ++ks) {
            bf16x8 At[MI], Bf[NI];
#pragma unroll
            for (int m = 0; m < MI; ++m) At[m] = *(const LAS bf16x8*)(sa + aoff + m * 2048 + ks * 1024);
#pragma unroll
            for (int n = 0; n < NI; ++n) Bf[n] = *(const LAS bf16x8*)(sb + boff + n * 2048 + ks * 1024);
#pragma unroll
            for (int m = 0; m < MI; ++m)
#pragma unroll
                for (int n = 0; n < NI; ++n)
                    acc[m][n] = TRANS ? __builtin_amdgcn_mfma_f32_16x16x32_bf16(Bf[n], At[m], acc[m][n], 0, 0, 0)
                                      : __builtin_amdgcn_mfma_f32_16x16x32_bf16(At[m], Bf[n], acc[m][n], 0, 0, 0);
        }
    }
    if (nkt & 1) __syncthreads();
}
template <int GL>
__device__ __forceinline__ void stage_ptrs_dense(const bf16_t* base, size_t ld, int r0, const bf16_t* (&p)[GL]) {
    const int tid = threadIdx.x, lane = tid & 63, wid = tid >> 6;
#pragma unroll
    for (int i = 0; i < GL; ++i) { int R, C; stage_rc2(wid * 1024 + i * 8192 + lane * 16, R, C); p[i] = base + (size_t)(r0 + R) * ld + C; }
}

struct Params {
    const void* in[26];
    float* out;
    unsigned char* ws;
    int ph_lo, ph_hi;
};

__device__ const float INVF[16] = {1.000000000e+00f, 5.623413324e-01f, 3.162277639e-01f, 1.778279394e-01f, 1.000000015e-01f, 5.623413250e-02f, 3.162277490e-02f, 1.778279431e-02f,
                                   9.999999776e-03f, 5.623413250e-03f, 3.162277630e-03f, 1.778279431e-03f, 1.000000047e-03f, 5.623413017e-04f, 3.162277571e-04f, 1.778279402e-04f};

__device__ __forceinline__ void tr_item(const float* srcp, int ldw, const float* kscale, bf16_t* WT, int Kd, int k0, int n0, LAS float* scr, int lane) {
#pragma unroll 8
    for (int i = 0; i < 32; ++i) { const int kk = 2 * i + (lane >> 5); float v = 0.f; if (srcp) { v = srcp[(size_t)(k0 + kk) * ldw]; if (kscale) v *= kscale[k0 + kk]; } scr[kk * 33 + (lane & 31)] = v; }
    asm volatile("s_waitcnt lgkmcnt(0)" ::: "memory");
    const int c = lane & 7;
#pragma unroll
    for (int j = 0; j < 4; ++j) { const int n = (lane >> 3) + 8 * j; const LAS float* s = scr + (8 * c) * 33 + n;
        u32x4 o; o.x = cvtpk(s[0 * 33], s[1 * 33]); o.y = cvtpk(s[2 * 33], s[3 * 33]); o.z = cvtpk(s[4 * 33], s[5 * 33]); o.w = cvtpk(s[6 * 33], s[7 * 33]);
        *(u32x4*)(WT + (size_t)(n0 + n) * Kd + k0 + 8 * c) = o; }
    asm volatile("s_waitcnt lgkmcnt(0)" ::: "memory");
}

__device__ __forceinline__ void phase0(const Params& p, LAS unsigned char* lds) {
    const int tid = threadIdx.x, lane = tid & 63, wave = __builtin_amdgcn_readfirstlane(tid >> 6);
    const int G = gridDim.x, bid = blockIdx.x;
    unsigned char* ws = p.ws;
    if (bid < 192) {
        const float* c = (const float*)p.in[1]; const float* w_ada = (const float*)p.in[3]; const float* b_ada = (const float*)p.in[4];
        LAS float* sc = (LAS float*)lds;
        LAS float* red = (LAS float*)(lds + 32768);
        for (int i = tid; i < 8192; i += 512) sc[i] = siluf_(c[i]);
        __syncthreads();
        const int col = tid & 31, ks = tid >> 5, n0 = bid * 32;
        float a[8] = {0, 0, 0, 0, 0, 0, 0, 0};
#pragma unroll 8
        for (int i = 0; i < 64; ++i) { const int k = ks * 64 + i; const float w = w_ada[(size_t)k * 6144 + n0 + col];
#pragma unroll
            for (int b = 0; b < 8; ++b) a[b] += sc[b * 1024 + k] * w; }
#pragma unroll
        for (int b = 0; b < 8; ++b) red[(ks * 32 + col) * 8 + b] = a[b];
        __syncthreads();
        if (tid < 256) { const int cc = tid & 31, b = tid >> 5; float s = 0.f;
#pragma unroll
            for (int k2 = 0; k2 < 16; ++k2) s += red[(k2 * 32 + cc) * 8 + b];
            ((float*)(ws + WS_MOD))[b * 6144 + n0 + cc] = s + b_ada[n0 + cc]; }
        __syncthreads();
    }
    {
        const int* pos = (const int*)p.in[2]; f32x2* rt = (f32x2*)(ws + WS_ROPE);
        for (int e = bid * 512 + tid; e < MT * 16; e += G * 512) {
            const int tok = e >> 4, i = e & 15;
            const float a32 = (float)pos[tok] * INVF[i];
            const double rev = (double)a32 * 0.15915494309189535;
            const float fr = (float)(rev - __builtin_rint(rev));
            rt[e] = (f32x2){__builtin_amdgcn_cosf(fr), __builtin_amdgcn_sinf(fr)};
        }
    }
    {
        LAS unsigned* scr = (LAS unsigned*)(lds + 65536) + wave * 2112;
        const int gw = bid * 8 + wave, NGW = G * 8;
        const float* w_in = (const float*)p.in[6]; const float* qan = (const float*)p.in[11]; const float* w_qb = (const float*)p.in[12];
        const float* kvan = (const float*)p.in[13]; const float* w_kvb = (const float*)p.in[14]; const float* w_out = (const float*)p.in[17];
        const float* w_group = (const float*)p.in[19]; const float* w_expert = (const float*)p.in[21];
        const float* w_gate = (const float*)p.in[23]; const float* w_up = (const float*)p.in[24]; const float* w_down = (const float*)p.in[25];
        constexpr int I0 = 16 * 24, I1 = 4 * 16, I2 = 2 * 16, I3 = 16 * 16, I4 = 32 * 128, I5 = 32 * 64, I6 = 16 * 2;
        constexpr int NIT = I0 + I1 + I2 + I3 + I4 + I5 + I6;
        const int c4 = lane & 15, kp = lane >> 4;
        for (int it = gw; it < NIT; it += NGW) {
            int r = it;
            if (r >= NIT - I6) {
                r -= NIT - I6;
                LAS float* fscr = (LAS float*)scr; const int nl = lane & 31;
                const int kb = r >> 1, nb = r & 1, n0 = nb * 32, np = n0 + nl, k0 = kb * 64;
                const float* srcp = nullptr; int ldw = 0;
                if (np < 4) { srcp = w_group + np; ldw = 4; } else if (np < 36) { srcp = w_expert + (np - 4); ldw = 32; }
#pragma unroll 8
                for (int i = 0; i < 32; ++i) { const int kk = 2 * i + (lane >> 5); fscr[kk * 33 + nl] = srcp ? srcp[(size_t)(k0 + kk) * ldw] : 0.f; }
                asm volatile("s_waitcnt lgkmcnt(0)" ::: "memory");
                const int c = lane & 7;
#pragma unroll
                for (int j = 0; j < 4; ++j) { const int n = (lane >> 3) + 8 * j; const LAS float* sp = fscr + (8 * c) * 33 + n;
                    float v[8], l[8];
#pragma unroll
                    for (int q = 0; q < 8; ++q) { v[q] = sp[q * 33]; l[q] = v[q] - bf2f(f2bf(v[q])); }
                    if (n0 + n < 48) {
                        u32x4 o; o.x = cvtpk(v[0], v[1]); o.y = cvtpk(v[2], v[3]); o.z = cvtpk(v[4], v[5]); o.w = cvtpk(v[6], v[7]);
                        *(u32x4*)((bf16_t*)(ws + WS_WR) + (size_t)(n0 + n) * 1024 + k0 + 8 * c) = o;
                        u32x4 o2; o2.x = cvtpk(l[0], l[1]); o2.y = cvtpk(l[2], l[3]); o2.z = cvtpk(l[4], l[5]); o2.w = cvtpk(l[6], l[7]);
                        *(u32x4*)((bf16_t*)(ws + WS_WR) + 48 * 1024 + (size_t)(n0 + n) * 1024 + k0 + 8 * c) = o2; } }
                asm volatile("s_waitcnt lgkmcnt(0)" ::: "memory");
                continue;
            }
            const float* srcp; int ldw, Kd, k0, n0; const float* ksc = nullptr; bf16_t* WT;
            if (r < I0) {
                const int kb = r / 24, nb = r % 24; n0 = nb * 64; k0 = kb * 64; const int np = n0 + 4 * c4;
                const int pn = np >> 8, wc = (np >> 6) & 3, n = (np >> 4) & 3, f = np & 15; int src;
                if (pn < 4) { const int ch = pn * 128 + wc * 32 + (n >> 1) * 16 + f; src = (n & 1) ? 512 + ch : ch; }
                else if (pn == 4) src = np;
                else { const int j = np - 1280; src = (j < 160) ? 1280 + j : -1; }
                srcp = src >= 0 ? w_in + src : nullptr; ldw = 1440; Kd = 1024; WT = (bf16_t*)(ws + WS_WIN);
            } else if ((r -= I0) < I1) {
                const int kb = r / 16, nb = r % 16; n0 = nb * 64; k0 = kb * 64; const int np = n0 + 4 * c4, hd = np >> 7, j = np & 127;
                srcp = j < 96 ? w_qb + hd * 96 + j : nullptr; ldw = 768; Kd = 256; ksc = qan; WT = (bf16_t*)(ws + WS_WQ);
            } else if ((r -= I1) < I2) {
                const int kb = r / 16, nb = r % 16; n0 = nb * 64; k0 = kb * 64;
                srcp = w_kvb + n0 + 4 * c4; ldw = 1024; Kd = 128; ksc = kvan; WT = (bf16_t*)(ws + WS_WKV);
            } else if ((r -= I2) < I3) {
                const int kb = r / 16, nb = r % 16; n0 = nb * 64; k0 = kb * 64;
                srcp = w_out + n0 + 4 * c4; ldw = 1024; Kd = 1024; WT = (bf16_t*)(ws + WS_WOUT);
            } else if ((r -= I3) < I4) {
                const int e = r >> 7, q = r & 127, kb = q / 8, nb = q % 8; n0 = nb * 64; k0 = kb * 64; const int np = n0 + 4 * c4;
                const int ct = np >> 8, wc = (np >> 6) & 3, n = (np >> 4) & 3, f = np & 15, ch = ct * 128 + wc * 32 + (n >> 1) * 16 + f;
                srcp = ((n & 1) ? w_up : w_gate) + (size_t)e * 1024 * 256 + ch; ldw = 256; Kd = 1024; WT = (bf16_t*)(ws + WS_WGU) + (size_t)e * 512 * 1024;
            } else {
                r -= I4; const int e = r >> 6, q = r & 63, kb = q / 16, nb = q % 16; n0 = nb * 64; k0 = kb * 64;
                srcp = w_down + (size_t)e * 256 * 1024 + n0 + 4 * c4; ldw = 1024; Kd = 256; WT = (bf16_t*)(ws + WS_WD) + (size_t)e * 1024 * 256;
            }
            f32x4 v0[8], v1[8];
#pragma unroll
            for (int i = 0; i < 8; ++i) { const int k = k0 + 8 * i + 2 * kp;
                if (srcp) { v0[i] = *(const f32x4*)(srcp + (size_t)k * ldw); v1[i] = *(const f32x4*)(srcp + (size_t)(k + 1) * ldw); }
                else { v0[i] = (f32x4){0.f, 0.f, 0.f, 0.f}; v1[i] = v0[i]; } }
#pragma unroll
            for (int i = 0; i < 8; ++i) { const int k = k0 + 8 * i + 2 * kp; f32x4 a = v0[i], b = v1[i];
                if (ksc) { a = a * ksc[k]; b = b * ksc[k + 1]; }
                LAS unsigned* d = scr + (4 * c4) * 33 + 4 * i + kp;
                d[0] = cvtpk(a.x, b.x); d[33] = cvtpk(a.y, b.y); d[66] = cvtpk(a.z, b.z); d[99] = cvtpk(a.w, b.w); }
            asm volatile("s_waitcnt lgkmcnt(0)" ::: "memory");
            const int c = lane & 7;
#pragma unroll
            for (int j = 0; j < 8; ++j) { const int n = (lane >> 3) + 8 * j; const LAS unsigned* sp = scr + n * 33 + 4 * c;
                u32x4 o; o.x = sp[0]; o.y = sp[1]; o.z = sp[2]; o.w = sp[3];
                *(u32x4*)(WT + (size_t)(n0 + n) * Kd + k0 + 8 * c) = o; }
            asm volatile("s_waitcnt lgkmcnt(0)" ::: "memory");
        }
    }
}

__device__ __forceinline__ void phase1a(const Params& p) {
    const int tid = threadIdx.x, lane = tid & 63, wave = tid >> 6;
    const int gw = blockIdx.x * 8 + wave, NGW = gridDim.x * 8;
    const float* x = (const float*)p.in[0]; const float* nm = (const float*)p.in[5]; const float* mod = (const float*)(p.ws + WS_MOD);
    bf16_t* h = (bf16_t*)(p.ws + WS_H);
    for (int grp = gw; grp < MT / 16; grp += NGW) {
        const int r0 = grp * 16, b = r0 >> 12;
        f32x4 gm[4], sh[4];
#pragma unroll
        for (int j = 0; j < 4; ++j) { const int col = 4 * lane + 256 * j; const f32x4 g = *(const f32x4*)(nm + col), s = *(const f32x4*)(mod + b * 6144 + 1024 + col);
            gm[j] = g * (s + 1.0f); sh[j] = *(const f32x4*)(mod + b * 6144 + col); }
        for (int rr = 0; rr < 16; ++rr) {
            const float* xr = x + (size_t)(r0 + rr) * DM; f32x4 v[4]; float s = 0.f;
#pragma unroll
            for (int j = 0; j < 4; ++j) { v[j] = *(const f32x4*)(xr + 4 * lane + 256 * j); s += (v[j].x * v[j].x + v[j].y * v[j].y) + (v[j].z * v[j].z + v[j].w * v[j].w); }
            const float rstd = 1.0f / sqrtf(wave_sum(s) * (1.0f / DM) + EPS);
            bf16_t* hr = h + (size_t)(r0 + rr) * DM;
#pragma unroll
            for (int j = 0; j < 4; ++j) { const f32x4 o = v[j] * rstd * gm[j] + sh[j]; u32x2 w; w.x = cvtpk(o.x, o.y); w.y = cvtpk(o.z, o.w); *(u32x2*)(hr + 4 * lane + 256 * j) = w; }
        }
    }
}

__device__ __forceinline__ void phase1b(const Params& p, LAS unsigned char* lds) {
    const int tid = threadIdx.x, lane = tid & 63, wid = __builtin_amdgcn_readfirstlane(tid >> 6), wr = wid >> 2, wc = wid & 3, fr = lane & 15, fq = lane >> 4;
    unsigned char* ws = p.ws;
    const bf16_t* h = (const bf16_t*)(ws + WS_H); const bf16_t* win = (const bf16_t*)(ws + WS_WIN);
    for (int u = blockIdx.x; u < 128 * 6; u += gridDim.x) {
        const int pm = u / 6, pn = u % 6;
        const bf16_t* ap[4]; const bf16_t* bp[4];
        stage_ptrs_dense<4>(h, 1024, pm * 256, ap); stage_ptrs_dense<4>(win, 1024, pn * 256, bp);
        f32x4 acc[8][4];
#pragma unroll
        for (int m = 0; m < 8; ++m)
#pragma unroll
            for (int n = 0; n < 4; ++n) acc[m][n] = (f32x4){0.f, 0.f, 0.f, 0.f};
        gemm_block<8, 4, true>(lds, ap, bp, 16, acc);
        const int rowb = pm * 256 + wr * 128 + fr;
        if (pn < 4) {
            bf16_t* ub = (bf16_t*)(ws + WS_U);
#pragma unroll
            for (int m = 0; m < 8; ++m) { const size_t row = rowb + m * 16;
#pragma unroll
                for (int h2 = 0; h2 < 2; ++h2) { const f32x4 v = acc[m][2 * h2], g = acc[m][2 * h2 + 1];
                    const int ch = pn * 128 + wc * 32 + h2 * 16 + fq * 4;
                    u32x2 w; w.x = cvtpk(v.x * sigmoidf_(g.x), v.y * sigmoidf_(g.y)); w.y = cvtpk(v.z * sigmoidf_(g.z), v.w * sigmoidf_(g.w));
                    *(u32x2*)(ub + row * 512 + ch) = w; } }
        } else if (pn == 4) {
            bf16_t* cq = (bf16_t*)(ws + WS_CQ); float* sq = (float*)(ws + WS_SSQQ);
#pragma unroll
            for (int m = 0; m < 8; ++m) { const size_t row = rowb + m * 16; float s = 0.f;
#pragma unroll
                for (int n = 0; n < 4; ++n) { const f32x4 v = acc[m][n]; s += (v.x * v.x + v.y * v.y) + (v.z * v.z + v.w * v.w);
                    u32x2 w; w.x = cvtpk(v.x, v.y); w.y = cvtpk(v.z, v.w); *(u32x2*)(cq + row * 256 + wc * 64 + n * 16 + fq * 4) = w; }
                s += __shfl_xor(s, 16); s += __shfl_xor(s, 32);
                if (fq == 0) sq[row * 4 + wc] = s; }
        } else {
            if (wc < 2) {
                bf16_t* ckv = (bf16_t*)(ws + WS_CKV); float* sq = (float*)(ws + WS_SSQKV);
#pragma unroll
                for (int m = 0; m < 8; ++m) { const size_t row = rowb + m * 16; float s = 0.f;
#pragma unroll
                    for (int n = 0; n < 4; ++n) { const f32x4 v = acc[m][n]; s += (v.x * v.x + v.y * v.y) + (v.z * v.z + v.w * v.w);
                        u32x2 w; w.x = cvtpk(v.x, v.y); w.y = cvtpk(v.z, v.w); *(u32x2*)(ckv + row * 128 + wc * 64 + n * 16 + fq * 4) = w; }
                    s += __shfl_xor(s, 16); s += __shfl_xor(s, 32);
                    if (fq == 0) sq[row * 2 + wc] = s; }
            } else if (wc == 2) {
                float* kr = (float*)(ws + WS_KROPE); float* sq = (float*)(ws + WS_SSQKR);
#pragma unroll
                for (int m = 0; m < 8; ++m) { const size_t row = rowb + m * 16; float s = 0.f;
#pragma unroll
                    for (int n = 0; n < 2; ++n) { const f32x4 v = acc[m][n]; s += (v.x * v.x + v.y * v.y) + (v.z * v.z + v.w * v.w);
                        *(f32x4*)(kr + row * 32 + n * 16 + fq * 4) = v; }
                    s += __shfl_xor(s, 16); s += __shfl_xor(s, 32);
                    if (fq == 0) sq[row] = s; }
            }
        }
    }
}

constexpr int EPI_SCR = 131072;
__device__ __forceinline__ void q_item(const Params& p, LAS unsigned char* lds, int pm) {
    const int tid = threadIdx.x, lane = tid & 63, wid = __builtin_amdgcn_readfirstlane(tid >> 6), wr = wid >> 2, wc = wid & 3, fr = lane & 15, fq = lane >> 4;
    unsigned char* ws = p.ws;
    const bf16_t* ap[2]; const bf16_t* bp[4];
    stage_ptrs_dense<2>((const bf16_t*)(ws + WS_CQ), 256, pm * 128, ap);
    stage_ptrs_dense<4>((const bf16_t*)(ws + WS_WQ), 256, 0, bp);
    __syncthreads();
    gemm_load_ares<4>(lds, ap, 4);
    gemm_stage<4, 4, true>(lds, 65536, ap, bp, 0, 0);
    const float* sq = (const float*)(ws + WS_SSQQ); const float* qn = (const float*)p.in[15];
    LAS float* part = (LAS float*)(lds + EPI_SCR);
    const int rowb = pm * 128 + wr * 64 + fr;
    float rq[4];
#pragma unroll
    for (int m = 0; m < 4; ++m) { const f32x4 s4 = *(const f32x4*)(sq + (size_t)(rowb + m * 16) * 4); rq[m] = 1.0f / sqrtf(((s4.x + s4.y) + (s4.z + s4.w)) * (1.0f / 256.0f) + EPS); }
    bf16_t* qb = (bf16_t*)(ws + WS_Q); const f32x2* rope = (const f32x2*)(ws + WS_ROPE);
#pragma unroll 1
    for (int pn = 0; pn < 4; ++pn) {
        f32x4 acc[4][4];
#pragma unroll
        for (int m = 0; m < 4; ++m)
#pragma unroll
            for (int n = 0; n < 4; ++n) acc[m][n] = (f32x4){0.f, 0.f, 0.f, 0.f};
        gemm_main<4, 4, true, true>(lds, 65536, ap, bp, 4, acc);
        if (pn < 3) {
#pragma unroll
            for (int i = 0; i < 4; ++i) bp[i] += 256 * 256;
            gemm_stage<4, 4, true>(lds, 65536, ap, bp, 0, 0);
        }
        const int nval = (wc & 1) ? 2 : 4;
#pragma unroll
        for (int m = 0; m < 4; ++m) { float s = 0.f;
#pragma unroll
            for (int n = 0; n < 4; ++n) { acc[m][n] = acc[m][n] * rq[m]; if (n < nval) { const f32x4 v = acc[m][n]; s += (v.x * v.x + v.y * v.y) + (v.z * v.z + v.w * v.w); } }
            s += __shfl_xor(s, 16); s += __shfl_xor(s, 32);
            if (fq == 0) part[wid * 64 + m * 16 + fr] = s; }
        __syncthreads();
        const int hd = pn * 2 + (wc >> 1);
#pragma unroll
        for (int m = 0; m < 4; ++m) {
            const float tot = part[wid * 64 + m * 16 + fr] + part[(wid ^ 1) * 64 + m * 16 + fr];
            const float rh = 1.0f / sqrtf(tot * (1.0f / 96.0f) + EPS) * QSCALE;
            const int tok = rowb + m * 16, b = tok >> 12, s = tok & 4095;
            bf16_t* dst = qb + ((size_t)(b * 8 + hd) * 4096 + s) * 96;
            if ((wc & 1) == 0) {
#pragma unroll
                for (int n = 0; n < 4; ++n) { const int j = n * 16 + fq * 4; const f32x4 g = *(const f32x4*)(qn + j); const f32x4 v = acc[m][n] * rh * g;
                    u32x2 w; w.x = cvtpk(v.x, v.y); w.y = cvtpk(v.z, v.w); *(u32x2*)(dst + j) = w; }
            } else {
                const int i0 = fq * 4; const f32x4 g1 = *(const f32x4*)(qn + 64 + i0), g2 = *(const f32x4*)(qn + 80 + i0);
                const f32x4 x1 = acc[m][0] * rh * g1, x2 = acc[m][1] * rh * g2;
                const f32x4 cs01 = *(const f32x4*)(rope + (size_t)tok * 16 + i0), cs23 = *(const f32x4*)(rope + (size_t)tok * 16 + i0 + 2);
                f32x4 o1, o2;
                o1.x = x1.x * cs01.x - x2.x * cs01.y; o2.x = x1.x * cs01.y + x2.x * cs01.x;
                o1.y = x1.y * cs01.z - x2.y * cs01.w; o2.y = x1.y * cs01.w + x2.y * cs01.z;
                o1.z = x1.z * cs23.x - x2.z * cs23.y; o2.z = x1.z * cs23.y + x2.z * cs23.x;
                o1.w = x1.w * cs23.z - x2.w * cs23.w; o2.w = x1.w * cs23.w + x2.w * cs23.z;
                u32x2 w; w.x = cvtpk(o1.x, o1.y); w.y = cvtpk(o1.z, o1.w); *(u32x2*)(dst + 64 + i0) = w;
                w.x = cvtpk(o2.x, o2.y); w.y = cvtpk(o2.z, o2.w); *(u32x2*)(dst + 80 + i0) = w;
            }
        }
        __syncthreads();
    }
}

__device__ __forceinline__ void kv_item(const Params& p, LAS unsigned char* lds, int pm) {
    const int tid = threadIdx.x, lane = tid & 63, wid = __builtin_amdgcn_readfirstlane(tid >> 6), wr = wid >> 2, wc = wid & 3, fr = lane & 15, fq = lane >> 4;
    unsigned char* ws = p.ws;
    const bf16_t* ap[2]; const bf16_t* bp[4];
    stage_ptrs_dense<2>((const bf16_t*)(ws + WS_CKV), 128, pm * 128, ap);
    stage_ptrs_dense<4>((const bf16_t*)(ws + WS_WKV), 128, 0, bp);
    __syncthreads();
    gemm_load_ares<4>(lds, ap, 2);
    gemm_stage<4, 4, true>(lds, 32768, ap, bp, 0, 0);
    const float* sqkv = (const float*)(ws + WS_SSQKV); const float* sqkr = (const float*)(ws + WS_SSQKR); const float* kn = (const float*)p.in[16];
    const float* krp = (const float*)(ws + WS_KROPE); const f32x2* rope = (const f32x2*)(ws + WS_ROPE);
    const int rowb = pm * 128 + wr * 64 + fq * 4;
    float g[4];
#pragma unroll
    for (int n = 0; n < 4; ++n) g[n] = kn[n * 16 + fr];
    const float g1 = kn[64 + fr], g2 = kn[80 + fr];
#pragma unroll 1
    for (int pn = 0; pn < 4; ++pn) {
        f32x4 acc[4][4];
#pragma unroll
        for (int m = 0; m < 4; ++m)
#pragma unroll
            for (int n = 0; n < 4; ++n) acc[m][n] = (f32x4){0.f, 0.f, 0.f, 0.f};
        gemm_main<4, 4, false, true>(lds, 32768, ap, bp, 2, acc);
        if (pn < 3) {
#pragma unroll
            for (int i = 0; i < 4; ++i) bp[i] += 256 * 128;
            gemm_stage<4, 4, true>(lds, 32768, ap, bp, 0, 0);
        }
        const int hd = pn * 2 + (wc >> 1);
        const int bb = (pm * 128) >> 12, sb = rowb & 4095;
        const float* sqkv_p = sqkv + (size_t)rowb * 2;
        if ((wc & 1) == 0) {
            const float* sqkr_p = sqkr + rowb; const float* krp_p = krp + (size_t)rowb * 32 + fr; const f32x2* rope_p = rope + (size_t)rowb * 16 + fr;
            bf16_t* dst_p = (bf16_t*)(ws + WS_K) + ((size_t)(bb * 8 + hd) * 4096 + sb) * 96 + fr;
#pragma unroll
            for (int m = 0; m < 4; ++m) {
#pragma unroll
                for (int j = 0; j < 4; ++j) {
                    const int o = m * 16 + j;
                    const f32x2 s2 = *(const f32x2*)(sqkv_p + o * 2);
                    const float rkv = 1.0f / sqrtf((s2.x + s2.y) * (1.0f / 128.0f) + EPS);
                    float v[4], ss = 0.f;
#pragma unroll
                    for (int n = 0; n < 4; ++n) { v[n] = acc[m][n][j] * rkv; ss += v[n] * v[n]; }
                    ss += __shfl_xor(ss, 1); ss += __shfl_xor(ss, 2); ss += __shfl_xor(ss, 4); ss += __shfl_xor(ss, 8);
                    const float rk = 1.0f / sqrtf((ss + sqkr_p[o]) * (1.0f / 96.0f) + EPS);
                    bf16_t* dst = dst_p + o * 96;
#pragma unroll
                    for (int n = 0; n < 4; ++n) dst[n * 16] = f2bf(v[n] * rk * g[n]);
                    const float x1 = krp_p[o * 32] * rk * g1, x2 = krp_p[o * 32 + 16] * rk * g2;
                    const f32x2 cs = rope_p[o * 16];
                    dst[64] = f2bf(x1 * cs.x - x2 * cs.y); dst[80] = f2bf(x1 * cs.y + x2 * cs.x);
                }
            }
        } else {
            bf16_t* vt_p = (bf16_t*)(ws + WS_VT) + ((size_t)(bb * 8 + hd) * 64 + fr) * 4096 + sb;
#pragma unroll
            for (int m = 0; m < 4; ++m) {
                float rkv[4];
#pragma unroll
                for (int j = 0; j < 4; ++j) { const f32x2 s2 = *(const f32x2*)(sqkv_p + (m * 16 + j) * 2); rkv[j] = 1.0f / sqrtf((s2.x + s2.y) * (1.0f / 128.0f) + EPS); }
#pragma unroll
                for (int n = 0; n < 4; ++n) { const f32x4 a = acc[m][n];
                    u32x2 w; w.x = cvtpk(a.x * rkv[0], a.y * rkv[1]); w.y = cvtpk(a.z * rkv[2], a.w * rkv[3]);
                    *(u32x2*)(vt_p + (size_t)(n * 16) * 4096 + m * 16) = w; }
            }
        }
    }
}

template <int R> __device__ __forceinline__ void conv_row(float (&o)[32], const float (&w)[31], float x) {
    constexpr int T0 = R > 30 ? R - 30 : 0, T1 = R < 31 ? R : 31;
#pragma unroll
    for (int t = T0; t <= T1; ++t) o[t] += w[R - t] * x;
}
template <int... R> __device__ __forceinline__ void conv_rows(float (&o)[32], const float (&w)[31], const float (&x)[62], std::integer_sequence<int, R...>) { (conv_row<R>(o, w, x[R]), ...); }
__device__ __forceinline__ void conv_unit(const Params& p, LAS unsigned char* lds, int cu) {
    const int tid = threadIdx.x, lane = tid & 63, wave = tid >> 6;
    const int b = cu >> 7, s0 = (cu & 127) * 32, c = tid;
    const bf16_t* ub = (const bf16_t*)(p.ws + WS_U) + ((size_t)b * 4096) * 512 + c;
    const float* cw = (const float*)p.in[7]; const float* cb = (const float*)p.in[8]; const float* lg = (const float*)p.in[9]; const float* lb = (const float*)p.in[10];
    float w[31];
#pragma unroll
    for (int j = 0; j < 31; ++j) w[j] = cw[j * 512 + c];
    float xin[62];
#pragma unroll
    for (int r = 0; r < 62; ++r) { const int s = s0 - 30 + r; xin[r] = bf2f(ub[(size_t)(s < 0 ? 0 : s) * 512]); }
    if (s0 == 0) {
#pragma unroll
        for (int r = 0; r < 30; ++r) xin[r] = 0.f;
    }
    float o[32];
    { const float bias = cb[c];
#pragma unroll
      for (int t = 0; t < 32; ++t) o[t] = bias; }
    conv_rows(o, w, xin, std::make_integer_sequence<int, 62>{});
    float s1, s2;
    {
        const bool b5 = lane & 32, b4 = lane & 16, b3 = lane & 8, b2 = lane & 4, b1 = lane & 2;
        float a16[16], q16[16];
#pragma unroll
        for (int i = 0; i < 16; ++i) { const float lo = o[i], hi = o[16 + i]; const float snd = b5 ? lo : hi, kp = b5 ? hi : lo; a16[i] = kp + __shfl_xor(snd, 32);
            const float lq = lo * lo, hq = hi * hi; const float snq = b5 ? lq : hq, kq = b5 ? hq : lq; q16[i] = kq + __shfl_xor(snq, 32); }
        float a8[8], q8[8];
#pragma unroll
        for (int i = 0; i < 8; ++i) { a8[i] = (b4 ? a16[8 + i] : a16[i]) + __shfl_xor(b4 ? a16[i] : a16[8 + i], 16); q8[i] = (b4 ? q16[8 + i] : q16[i]) + __shfl_xor(b4 ? q16[i] : q16[8 + i], 16); }
        float a4[4], q4[4];
#pragma unroll
        for (int i = 0; i < 4; ++i) { a4[i] = (b3 ? a8[4 + i] : a8[i]) + __shfl_xor(b3 ? a8[i] : a8[4 + i], 8); q4[i] = (b3 ? q8[4 + i] : q8[i]) + __shfl_xor(b3 ? q8[i] : q8[4 + i], 8); }
        float a2[2], q2[2];
#pragma unroll
        for (int i = 0; i < 2; ++i) { a2[i] = (b2 ? a4[2 + i] : a4[i]) + __shfl_xor(b2 ? a4[i] : a4[2 + i], 4); q2[i] = (b2 ? q4[2 + i] : q4[i]) + __shfl_xor(b2 ? q4[i] : q4[2 + i], 4); }
        s1 = (b1 ? a2[1] : a2[0]) + __shfl_xor(b1 ? a2[0] : a2[1], 2); s2 = (b1 ? q2[1] : q2[0]) + __shfl_xor(b1 ? q2[0] : q2[1], 2);
        s1 += __shfl_xor(s1, 1); s2 += __shfl_xor(s2, 1);
    }
    LAS float* red = (LAS float*)(lds + EPI_SCR);
    LAS float* stat = (LAS float*)(lds + EPI_SCR + 2048);
    if ((lane & 1) == 0) { red[(wave * 32 + (lane >> 1)) * 2] = s1; red[(wave * 32 + (lane >> 1)) * 2 + 1] = s2; }
    __syncthreads();
    if (tid < 32) { float t1 = 0.f, t2 = 0.f;
#pragma unroll
        for (int k = 0; k < 8; ++k) { t1 += red[(k * 32 + tid) * 2]; t2 += red[(k * 32 + tid) * 2 + 1]; }
        const float mean = t1 * (1.0f / 512.0f); float var = t2 * (1.0f / 512.0f) - mean * mean; var = var < 0.f ? 0.f : var;
        stat[tid * 2] = mean; stat[tid * 2 + 1] = 1.0f / sqrtf(var + EPS); }
    __syncthreads();
    const float g = lg[c], bb = lb[c];
    bf16_t* cat = (bf16_t*)(p.ws + WS_CAT) + ((size_t)b * 4096 + s0) * 1024 + c;
#pragma unroll
    for (int t = 0; t < 32; ++t) { const float y = (o[t] - stat[t * 2]) * stat[t * 2 + 1] * g + bb; cat[(size_t)t * 1024] = f2bf(siluf_(y)); }
    __syncthreads();
}

__device__ __forceinline__ void phase1c(const Params& p, LAS unsigned char* lds) {
#ifndef SUBREP
#define SUBREP -1
#endif
#pragma unroll 1
    for (int r_ = 0; r_ < (SUBREP == 0 ? 2 : 1); ++r_)
    for (int u = blockIdx.x; u < 256; u += gridDim.x) q_item(p, lds, u);
#pragma unroll 1
    for (int r_ = 0; r_ < (SUBREP == 1 ? 2 : 1); ++r_)
    for (int u = blockIdx.x; u < 256; u += gridDim.x) kv_item(p, lds, u);
    __syncthreads();
#pragma unroll 1
    for (int r_ = 0; r_ < (SUBREP == 2 ? 2 : 1); ++r_)
    for (int u = blockIdx.x; u < 1024; u += gridDim.x) conv_unit(p, lds, u);
}

__device__ __forceinline__ int swap23(int r) { return (r & ~12) | ((r & 4) << 1) | ((r & 8) >> 1); }
constexpr int KROW = 208, VROW = 144, KBUF = 64 * KROW, VBUF = 64 * VROW, ABUF = KBUF + VBUF;
__device__ __forceinline__ void attn_unit(const Params& p, LAS unsigned char* lds, int bh, int qblk) {
    const int tid = threadIdx.x, lane = tid & 63, wid = __builtin_amdgcn_readfirstlane(tid >> 6), q = lane & 31, H = lane >> 5;
    unsigned char* ws = p.ws;
    const bf16_t* qg = (const bf16_t*)(ws + WS_Q) + (size_t)bh * 4096 * 96;
    const bf16_t* kg = (const bf16_t*)(ws + WS_K) + (size_t)bh * 4096 * 96;
    const bf16_t* vg = (const bf16_t*)(ws + WS_VT) + (size_t)bh * 64 * 4096;
    const int row0 = qblk * 256 + wid * 32, mychunk = 4 * qblk + (wid >> 1), NT = 4 * qblk + 4;
    bf16x8 qf[6];
#pragma unroll
    for (int s = 0; s < 6; ++s) qf[s] = *(const bf16x8*)(qg + (size_t)(row0 + q) * 96 + 16 * s + 8 * H);
    const int kr0 = tid / 12, kc0 = tid % 12, kr1 = (tid + 512) / 12, kc1 = (tid + 512) % 12, vd = tid >> 3, vc = tid & 7;
    const bool k1 = tid < 256;
    const bf16_t* ksrc0 = kg + (size_t)kr0 * 96 + kc0 * 8; const bf16_t* ksrc1 = kg + (size_t)kr1 * 96 + kc1 * 8; const bf16_t* vsrc = vg + (size_t)vd * 4096 + vc * 8;
    const int kdst0 = kr0 * KROW + kc0 * 16, kdst1 = kr1 * KROW + kc1 * 16, vdst = KBUF + vd * VROW + vc * 16;
    u32x4 rk0, rk1 = (u32x4){0, 0, 0, 0}, rv;
#define AT_LOAD(t) do { rk0 = *(const u32x4*)(ksrc0 + (size_t)(t) * 64 * 96); if (k1) rk1 = *(const u32x4*)(ksrc1 + (size_t)(t) * 64 * 96); rv = *(const u32x4*)(vsrc + (t) * 64); } while (0)
#define AT_WRITE(buf) do { LAS unsigned char* b_ = lds + (buf) * ABUF; *(LAS u32x4*)(b_ + kdst0) = rk0; if (k1) *(LAS u32x4*)(b_ + kdst1) = rk1; *(LAS u32x4*)(b_ + vdst) = rv; } while (0)
    AT_LOAD(0); AT_WRITE(0);
    __syncthreads();
    f32x16 o0 = {0}, o1 = {0};
    float mrun = -INFINITY, lsum = 0.f;
    const int koff = swap23(q) * KROW + 16 * H, voff = KBUF + q * VROW + 16 * H;
    for (int t = 0; t < NT; ++t) {
        if (t + 1 < NT) AT_LOAD(t + 1);
        if (t <= mychunk) {
            const LAS unsigned char* kb = lds + (t & 1) * ABUF + koff; const LAS unsigned char* vb = lds + (t & 1) * ABUF + voff;
            f32x16 s0 = {0}, s1 = {0};
#pragma unroll
            for (int s = 0; s < 6; ++s) {
                const bf16x8 a0 = *(const LAS bf16x8*)(kb + 32 * s), a1 = *(const LAS bf16x8*)(kb + 32 * KROW + 32 * s);
                s0 = __builtin_amdgcn_mfma_f32_32x32x16_bf16(a0, qf[s], s0, 0, 0, 0);
                s1 = __builtin_amdgcn_mfma_f32_32x32x16_bf16(a1, qf[s], s1, 0, 0, 0);
            }
            float mloc = s0[0];
#pragma unroll
            for (int r = 1; r < 16; ++r) mloc = fmaxf(mloc, s0[r]);
#pragma unroll
            for (int r = 0; r < 16; ++r) mloc = fmaxf(mloc, s1[r]);
            mloc = fmaxf(mloc, __shfl_xor(mloc, 32));
            const float mnew = fmaxf(mrun, mloc);
            const float alpha = __builtin_amdgcn_exp2f(mrun - mnew);
            mrun = mnew;
            float ps = 0.f;
#pragma unroll
            for (int r = 0; r < 16; ++r) { s0[r] = __builtin_amdgcn_exp2f(s0[r] - mnew); s1[r] = __builtin_amdgcn_exp2f(s1[r] - mnew); ps += s0[r] + s1[r]; }
            lsum = lsum * alpha + ps;
#pragma unroll
            for (int r = 0; r < 16; ++r) { o0[r] *= alpha; o1[r] *= alpha; }
            u32x4 pw[4];
            pw[0] = (u32x4){cvtpk(s0[0], s0[1]), cvtpk(s0[2], s0[3]), cvtpk(s0[4], s0[5]), cvtpk(s0[6], s0[7])};
            pw[1] = (u32x4){cvtpk(s0[8], s0[9]), cvtpk(s0[10], s0[11]), cvtpk(s0[12], s0[13]), cvtpk(s0[14], s0[15])};
            pw[2] = (u32x4){cvtpk(s1[0], s1[1]), cvtpk(s1[2], s1[3]), cvtpk(s1[4], s1[5]), cvtpk(s1[6], s1[7])};
            pw[3] = (u32x4){cvtpk(s1[8], s1[9]), cvtpk(s1[10], s1[11]), cvtpk(s1[12], s1[13]), cvtpk(s1[14], s1[15])};
#pragma unroll
            for (int ks = 0; ks < 4; ++ks) {
                const bf16x8 v0 = *(const LAS bf16x8*)(vb + 32 * ks), v1 = *(const LAS bf16x8*)(vb + 32 * VROW + 32 * ks);
                const bf16x8 pb = __builtin_bit_cast(bf16x8, pw[ks]);
                o0 = __builtin_amdgcn_mfma_f32_32x32x16_bf16(v0, pb, o0, 0, 0, 0);
                o1 = __builtin_amdgcn_mfma_f32_32x32x16_bf16(v1, pb, o1, 0, 0, 0);
            }
        }
        if (t + 1 < NT) AT_WRITE((t + 1) & 1);
        __syncthreads();
    }
#undef AT_LOAD
#undef AT_WRITE
    const float ltot = lsum + __shfl_xor(lsum, 32), inv = 1.0f / ltot;
    const int b = bh >> 3, hd = bh & 7;
    bf16_t* dst = (bf16_t*)(ws + WS_CAT) + ((size_t)b * 4096 + row0 + q) * 1024 + 512 + hd * 64;
#pragma unroll
    for (int g = 0; g < 4; ++g) {
        u32x2 w; w.x = cvtpk(o0[4 * g] * inv, o0[4 * g + 1] * inv); w.y = cvtpk(o0[4 * g + 2] * inv, o0[4 * g + 3] * inv); *(u32x2*)(dst + 8 * g + 4 * H) = w;
        w.x = cvtpk(o1[4 * g] * inv, o1[4 * g + 1] * inv); w.y = cvtpk(o1[4 * g + 2] * inv, o1[4 * g + 3] * inv); *(u32x2*)(dst + 32 + 8 * g + 4 * H) = w;
    }
}
__device__ __forceinline__ void phase2(const Params& p, LAS unsigned char* lds) {
    for (int u = blockIdx.x; u < 512; u += gridDim.x) {
        const int bh = u >> 3, pr = u & 7;
        attn_unit(p, lds, bh, 15 - pr);
        attn_unit(p, lds, bh, pr);
    }
}

__device__ __forceinline__ void phase3(const Params& p, LAS unsigned char* lds) {
    const int tid = threadIdx.x, lane = tid & 63, wid = __builtin_amdgcn_readfirstlane(tid >> 6), wr = wid >> 2, wc = wid & 3, fr = lane & 15, fq = lane >> 4;
    unsigned char* ws = p.ws;
    const float* x = (const float*)p.in[0]; const float* mod = (const float*)(ws + WS_MOD); float* sq1 = (float*)(ws + WS_SSQ1);
    for (int u = blockIdx.x; u < 512; u += gridDim.x) {
        const int pm = u >> 2, pn = u & 3;
        const bf16_t* ap[4]; const bf16_t* bp[4];
        stage_ptrs_dense<4>((const bf16_t*)(ws + WS_CAT), 1024, pm * 256, ap); stage_ptrs_dense<4>((const bf16_t*)(ws + WS_WOUT), 1024, pn * 256, bp);
        f32x4 acc[8][4];
#pragma unroll
        for (int m = 0; m < 8; ++m)
#pragma unroll
            for (int n = 0; n < 4; ++n) acc[m][n] = (f32x4){0.f, 0.f, 0.f, 0.f};
        gemm_block<8, 4, true>(lds, ap, bp, 16, acc);
        const int rowb = pm * 256 + wr * 128 + fr, b = (pm * 256) >> 12, colb = pn * 256 + wc * 64 + fq * 4;
        f32x4 ga[4];
#pragma unroll
        for (int n = 0; n < 4; ++n) ga[n] = *(const f32x4*)(mod + b * 6144 + 2048 + colb + n * 16);
#pragma unroll
        for (int m = 0; m < 8; ++m) { const size_t row = rowb + m * 16; float s = 0.f;
#pragma unroll
            for (int n = 0; n < 4; ++n) { const f32x4 xv = *(const f32x4*)(x + row * DM + colb + n * 16); const f32x4 v = xv + ga[n] * acc[m][n];
                *(f32x4*)(p.out + row * DM + colb + n * 16) = v; s += (v.x * v.x + v.y * v.y) + (v.z * v.z + v.w * v.w); }
            s += __shfl_xor(s, 16); s += __shfl_xor(s, 32);
            if (fq == 0) sq1[row * 16 + pn * 4 + wc] = s; }
    }
}

constexpr int RROW = 2064;
__device__ __forceinline__ void phase3b(const Params& p, LAS unsigned char* lds, bool dry) {
    const int tid = threadIdx.x, lane = tid & 63, wave = __builtin_amdgcn_readfirstlane(tid >> 6), fr = lane & 15, fq = lane >> 4;
    unsigned char* ws = p.ws;
    const float* nf = (const float*)p.in[18]; const float* mod = (const float*)(ws + WS_MOD); const float* sq1 = (const float*)(ws + WS_SSQ1);
    const float* bg = (const float*)p.in[20]; const float* be = (const float*)p.in[22];
    bf16_t* h2 = (bf16_t*)(ws + WS_H); const bf16_t* wrh = (const bf16_t*)(ws + WS_WR); const bf16_t* wrl = wrh + 48 * 1024;
    LAS unsigned char* Ahi = lds; LAS unsigned char* Alo = lds + 32 * RROW; LAS float* lg = (LAS float*)(lds + 64 * RROW);
    unsigned* ctl = (unsigned*)(ws + WS_CTL); int* lists = (int*)(ws + WS_LIST); int* blists = (int*)(ws + WS_BLIST); float* tokw = (float*)(ws + WS_TOKW);
    for (int tile = blockIdx.x; tile < MT / 32; tile += gridDim.x) {
        const int r0 = tile * 32, b = r0 >> 12;
        f32x4 gm[4], sh[4];
#pragma unroll
        for (int j = 0; j < 4; ++j) { const int col = 4 * lane + 256 * j; const f32x4 g = *(const f32x4*)(nf + col), s = *(const f32x4*)(mod + b * 6144 + 4096 + col);
            gm[j] = g * (s + 1.0f); sh[j] = *(const f32x4*)(mod + b * 6144 + 3072 + col); }
#pragma unroll
        for (int rr = 0; rr < 4; ++rr) {
            const int lr = wave * 4 + rr; const size_t row = r0 + lr;
            float ss = 0.f;
#pragma unroll
            for (int k = 0; k < 4; ++k) { const f32x4 s4 = *(const f32x4*)(sq1 + row * 16 + 4 * k); ss += (s4.x + s4.y) + (s4.z + s4.w); }
            const float rstd = 1.0f / sqrtf(ss * (1.0f / DM) + EPS);
#pragma unroll
            for (int j = 0; j < 4; ++j) { const int col = 4 * lane + 256 * j; const f32x4 xv = *(const f32x4*)(p.out + row * DM + col);
                const f32x4 o = xv * rstd * gm[j] + sh[j];
                u32x2 w; w.x = cvtpk(o.x, o.y); w.y = cvtpk(o.z, o.w);
                *(u32x2*)(h2 + row * DM + col) = w; *(LAS u32x2*)(Ahi + lr * RROW + col * 2) = w;
                const float lx = o.x - bf2f((unsigned short)(w.x & 0xffff)), ly = o.y - bf2f((unsigned short)(w.x >> 16)), lz = o.z - bf2f((unsigned short)(w.y & 0xffff)), lw = o.w - bf2f((unsigned short)(w.y >> 16));
                u32x2 wl; wl.x = cvtpk(lx, ly); wl.y = cvtpk(lz, lw); *(LAS u32x2*)(Alo + lr * RROW + col * 2) = wl; }
        }
        __syncthreads();
        if (wave < 6) {
            const int mt = wave / 3, nt = wave % 3;
            f32x4 acc = {0.f, 0.f, 0.f, 0.f};
            const LAS unsigned char* ah = Ahi + (mt * 16 + fr) * RROW + fq * 16; const LAS unsigned char* al = Alo + (mt * 16 + fr) * RROW + fq * 16;
            const bf16_t* bh = wrh + (size_t)(nt * 16 + fr) * 1024 + fq * 8; const bf16_t* bl = wrl + (size_t)(nt * 16 + fr) * 1024 + fq * 8;
#pragma unroll 4
            for (int kk = 0; kk < 32; ++kk) {
                const bf16x8 a_h = *(const LAS bf16x8*)(ah + kk * 64), a_l = *(const LAS bf16x8*)(al + kk * 64);
                const bf16x8 b_h = *(const bf16x8*)(bh + kk * 32), b_l = *(const bf16x8*)(bl + kk * 32);
                acc = __builtin_amdgcn_mfma_f32_16x16x32_bf16(a_h, b_h, acc, 0, 0, 0);
                acc = __builtin_amdgcn_mfma_f32_16x16x32_bf16(a_l, b_h, acc, 0, 0, 0);
                acc = __builtin_amdgcn_mfma_f32_16x16x32_bf16(a_h, b_l, acc, 0, 0, 0);
            }
#pragma unroll
            for (int j = 0; j < 4; ++j) lg[(mt * 16 + fq * 4 + j) * 48 + nt * 16 + fr] = acc[j];
        }
        __syncthreads();
        if (tid < 32 && !dry) {
            const LAS float* l = lg + tid * 48; const int tok = r0 + tid;
            float gl[4]; int gi = 0; float gmx;
#pragma unroll
            for (int i = 0; i < 4; ++i) gl[i] = l[i] + bg[i];
            gmx = gl[0];
#pragma unroll
            for (int i = 1; i < 4; ++i) if (gl[i] > gmx) { gmx = gl[i]; gi = i; }
            float gs = 0.f;
#pragma unroll
            for (int i = 0; i < 4; ++i) gs += __expf(gl[i] - gmx);
            const float gtop = 1.0f / gs;
            float el[8];
#pragma unroll
            for (int i = 0; i < 8; ++i) el[i] = l[4 + gi * 8 + i] + be[gi * 8 + i];
            int e1 = 0; float m1 = el[0];
#pragma unroll
            for (int i = 1; i < 8; ++i) if (el[i] > m1) { m1 = el[i]; e1 = i; }
            int e2 = -1; float m2 = -INFINITY;
#pragma unroll
            for (int i = 0; i < 8; ++i) if (i != e1 && el[i] > m2) { m2 = el[i]; e2 = i; }
            const float p2 = __expf(m2 - m1);
            const float w1 = gtop / (1.0f + p2), w2 = gtop * p2 / (1.0f + p2);
            const int lo = e1 < e2 ? e1 : e2, hi = e1 < e2 ? e2 : e1;
            const float wlo = e1 < e2 ? w1 : w2, whi = e1 < e2 ? w2 : w1;
            const int bk = gi * 28 + lo * 8 - ((lo * (lo + 1)) >> 1) + (hi - lo - 1);
            const int El = gi * 8 + lo, Eh = gi * 8 + hi;
            const unsigned p1 = atomicAdd(ctl + CW_CNT + 64 * El, 1u), pp2 = atomicAdd(ctl + CW_CNT + 64 * Eh, 1u), p3 = atomicAdd(ctl + CW_CNT + 64 * (32 + bk), 1u);
            lists[(size_t)El * MT + p1] = tok * 2; lists[(size_t)Eh * MT + pp2] = tok * 2 + 1;
            blists[(size_t)bk * MT + p3] = tok;
            tokw[tok * 2] = wlo; tokw[tok * 2 + 1] = whi;
        }
        __syncthreads();
    }
}

__device__ __forceinline__ void phase4a(const Params& p, LAS unsigned char* lds, const LAS unsigned* cnts) {
    const int tid = threadIdx.x, lane = tid & 63, wid = __builtin_amdgcn_readfirstlane(tid >> 6), wr = wid >> 2, wc = wid & 3, fr = lane & 15, fq = lane >> 4;
    unsigned char* ws = p.ws;
    const int* lists = (const int*)(ws + WS_LIST); const float* tokw = (const float*)(ws + WS_TOKW);
    const bf16_t* h2 = (const bf16_t*)(ws + WS_H);
    for (int u = blockIdx.x;; u += gridDim.x) {
        int e = -1, rt = 0, ct = 0, cnt = 0; { int uu = u;
            for (int i = 0; i < 32; ++i) { const int c = (int)cnts[i]; const int n = ((c + 255) >> 8) * 2; if (uu < n) { e = i; rt = uu >> 1; ct = uu & 1; cnt = c; break; } uu -= n; } }
        if (e < 0) break;
        const int* lst = lists + (size_t)e * MT + rt * 256; const int nrow = cnt - rt * 256;
        const bf16_t* ap[4]; const bf16_t* bp[4];
#pragma unroll
        for (int i = 0; i < 4; ++i) { int R, C; stage_rc2((tid >> 6) * 1024 + i * 8192 + lane * 16, R, C); const int tok = lst[R < nrow ? R : 0] >> 1; ap[i] = h2 + (size_t)tok * 1024 + C; }
        stage_ptrs_dense<4>((const bf16_t*)(ws + WS_WGU) + (size_t)e * 512 * 1024, 1024, ct * 256, bp);
        f32x4 acc[8][4];
#pragma unroll
        for (int m = 0; m < 8; ++m)
#pragma unroll
            for (int n = 0; n < 4; ++n) acc[m][n] = (f32x4){0.f, 0.f, 0.f, 0.f};
        gemm_block<8, 4, true>(lds, ap, bp, 16, acc);
        bf16_t* ab = (bf16_t*)(ws + WS_ABUF);
#pragma unroll
        for (int m = 0; m < 8; ++m) { const int R = wr * 128 + m * 16 + fr;
            if (R < nrow) { const int ent = lst[R]; const float w = tokw[ent];
#pragma unroll
                for (int h = 0; h < 2; ++h) { const f32x4 g = acc[m][2 * h], uu = acc[m][2 * h + 1]; const int ch = ct * 128 + wc * 32 + h * 16 + fq * 4;
                    u32x2 o; o.x = cvtpk(siluf_(g.x) * uu.x * w, siluf_(g.y) * uu.y * w); o.y = cvtpk(siluf_(g.z) * uu.z * w, siluf_(g.w) * uu.w * w);
                    *(u32x2*)(ab + (size_t)ent * 256 + ch) = o; } } }
    }
}
__device__ __forceinline__ void phase4b(const Params& p, LAS unsigned char* lds, const LAS unsigned* cnts) {
    const int tid = threadIdx.x, lane = tid & 63, wid = __builtin_amdgcn_readfirstlane(tid >> 6), wr = wid >> 2, wc = wid & 3, fr = lane & 15, fq = lane >> 4;
    unsigned char* ws = p.ws;
    const int* blists = (const int*)(ws + WS_BLIST); const float* mod = (const float*)(ws + WS_MOD);
    const bf16_t* ab = (const bf16_t*)(ws + WS_ABUF);
    for (int u = blockIdx.x;; u += gridDim.x) {
        int bk = -1, rt = 0, ct = 0, cnt = 0; { int uu = u;
            for (int i = 0; i < 112; ++i) { const int c = (int)cnts[32 + i]; const int n = ((c + 127) >> 7) * 4; if (uu < n) { bk = i; rt = uu >> 2; ct = uu & 3; cnt = c; break; } uu -= n; } }
        if (bk < 0) break;
        const int g = bk / 28; int pi = bk % 28, lo = 0; while (pi >= 7 - lo) { pi -= 7 - lo; ++lo; } const int hi = lo + 1 + pi;
        const int* lst = blists + (size_t)bk * MT + rt * 128; const int nrow = cnt - rt * 128;
        const bf16_t* ap[2]; const bf16_t* ap2[2]; const bf16_t* bp[4]; const bf16_t* bp2[4];
#pragma unroll
        for (int i = 0; i < 2; ++i) { int R, C; stage_rc2((tid >> 6) * 1024 + i * 8192 + lane * 16, R, C); const int tok = lst[R < nrow ? R : 0]; ap[i] = ab + (size_t)tok * 512 + C; ap2[i] = ap[i] + 256; }
        stage_ptrs_dense<4>((const bf16_t*)(ws + WS_WD) + (size_t)(g * 8 + lo) * 1024 * 256, 256, ct * 256, bp);
        stage_ptrs_dense<4>((const bf16_t*)(ws + WS_WD) + (size_t)(g * 8 + hi) * 1024 * 256, 256, ct * 256, bp2);
        f32x4 acc[4][4];
#pragma unroll
        for (int m = 0; m < 4; ++m)
#pragma unroll
            for (int n = 0; n < 4; ++n) acc[m][n] = (f32x4){0.f, 0.f, 0.f, 0.f};
        gemm_block<4, 4, true>(lds, ap, bp, 4, acc);
        gemm_block<4, 4, true>(lds, ap2, bp2, 4, acc);
        const int colb = ct * 256 + wc * 64 + fq * 4;
#pragma unroll
        for (int m = 0; m < 4; ++m) { const int R = wr * 64 + m * 16 + fr;
            if (R < nrow) { const int tok = lst[R]; const int b = tok >> 12; float* orow = p.out + (size_t)tok * DM;
#pragma unroll
                for (int n = 0; n < 4; ++n) { const int col = colb + n * 16; const f32x4 gf = *(const f32x4*)(mod + b * 6144 + 5120 + col);
                    const f32x4 o = *(const f32x4*)(orow + col) + gf * acc[m][n]; *(f32x4*)(orow + col) = o; } } }
    }
}

__global__ void __launch_bounds__(512, 2) hybrid_block_fwd(Params p) {
    extern __shared__ __attribute__((aligned(16))) unsigned char lds_raw[];
    LAS unsigned char* lds = (LAS unsigned char*)lds_raw;
    volatile LAS unsigned* MISC = (volatile LAS unsigned*)(lds + MISC_OFF);
    LAS unsigned* cnts = (LAS unsigned*)(lds + MISC_OFF + 256);
    const int tid = threadIdx.x;
    if (tid < 16) MISC[tid] = 0u;
    __syncthreads();
    unsigned* ctl = (unsigned*)(p.ws + WS_CTL);
    const bool single = (p.ph_hi - p.ph_lo) > 1;
    XcdBarrier bar; bar.bar = ctl + CW_BAR; bar.x = 0; bar.st = nullptr;
    if (single) bar = xcd_barrier_post(ctl + CW_BAR, MISC + 8);
#ifndef PH_MASK
#define PH_MASK 0x1ff
#endif
#define IN(k) (((PH_MASK >> (k)) & 1) && p.ph_lo <= (k) && (k) < p.ph_hi)
#define SEAM(k) do { if (IN(k) && IN((k) + 1)) xcd_barrier(bar); } while (0)
#ifndef REPEAT_PH
#define REPEAT_PH -1
#endif
#define NREP(k) ((REPEAT_PH == (k)) ? 2 : 1)
    if (IN(0)) { for (int r_ = 0; r_ < NREP(0); ++r_) phase0(p, lds); } SEAM(0);
    if (IN(1)) { for (int r_ = 0; r_ < NREP(1); ++r_) phase1a(p); } SEAM(1);
    if (IN(2)) { for (int r_ = 0; r_ < NREP(2); ++r_) phase1b(p, lds); } SEAM(2);
    if (IN(3)) { for (int r_ = 0; r_ < NREP(3); ++r_) phase1c(p, lds); } SEAM(3);
    if (IN(4)) { for (int r_ = 0; r_ < NREP(4); ++r_) phase2(p, lds); } SEAM(4);
    if (IN(5)) { for (int r_ = 0; r_ < NREP(5); ++r_) phase3(p, lds); } SEAM(5);
    if (IN(6)) { for (int r_ = 0; r_ < NREP(6); ++r_) phase3b(p, lds, r_ + 1 < NREP(6)); } SEAM(6);
    if (IN(7) || IN(8)) {
        if (tid < 144) cnts[tid] = __hip_atomic_load(ctl + CW_CNT + 64 * tid, __ATOMIC_RELAXED, __HIP_MEMORY_SCOPE_AGENT);
        __syncthreads();
    }
    if (IN(7)) { for (int r_ = 0; r_ < NREP(7); ++r_) phase4a(p, lds, cnts); } SEAM(7);
    if (IN(8)) { phase4b(p, lds, cnts); }
#undef IN
#undef SEAM
}

extern "C" void kernel_launch(void* const* d_in, const int* in_sizes, int n_in, void* d_out, int out_size, void* d_ws, size_t ws_size, hipStream_t stream) {
    static int grid = 0;
    if (grid == 0) {
        if (n_in != 26 || out_size != MT * DM || ws_size < WS_END) { fprintf(stderr, "kernel_launch: unexpected problem (n_in %d out %d ws %zu)\n", n_in, out_size, ws_size); grid = -1; return; }
        int dev = 0, cus = 0, per_cu = 0;
        hipGetDevice(&dev); hipDeviceGetAttribute(&cus, hipDeviceAttributeMultiprocessorCount, dev);
        hipFuncSetAttribute((const void*)hybrid_block_fwd, hipFuncAttributeMaxDynamicSharedMemorySize, LDS_BYTES);
        hipOccupancyMaxActiveBlocksPerMultiprocessor(&per_cu, (const void*)hybrid_block_fwd, 512, LDS_BYTES);
        (void)hipGetLastError();
        if (per_cu < 1) { fprintf(stderr, "kernel_launch: occupancy query says %d blocks/CU\n", per_cu); per_cu = 1; }
        grid = cus;
    }
    if (grid < 0) return;
    hipMemsetAsync((char*)d_ws + WS_CTL, 0, CTL_BYTES, stream);
    Params prm{};
    for (int i = 0; i < 26; ++i) prm.in[i] = d_in[i];
    prm.out = (float*)d_out; prm.ws = (unsigned char*)d_ws;
#if N_LAUNCH_SPLIT
    for (int ph = 0; ph <= DBG_LAST_PHASE; ++ph) { prm.ph_lo = ph; prm.ph_hi = ph + 1; hipLaunchKernelGGL(hybrid_block_fwd, dim3(grid), dim3(512), LDS_BYTES, stream, prm); }
#else
    prm.ph_lo = 0; prm.ph_hi = DBG_LAST_PHASE + 1;
    hipLaunchKernelGGL(hybrid_block_fwd, dim3(grid), dim3(512), LDS_BYTES, stream, prm);
#endif
}
```

```cpp
#include <hip/hip_runtime.h>
#include <cstdio>
#include <cstdint>
#include <utility>

#ifndef N_LAUNCH_SPLIT
#define N_LAUNCH_SPLIT 0
#endif
#ifndef DBG_LAST_PHASE
#define DBG_LAST_PHASE 8
#endif

#define LAS __attribute__((address_space(3)))
#define GAS __attribute__((address_space(1)))
typedef unsigned short bf16_t;
typedef short bf16x8 __attribute__((ext_vector_type(8)));
typedef float f32x4 __attribute__((ext_vector_type(4)));
typedef float f32x2 __attribute__((ext_vector_type(2)));
typedef float f32x16 __attribute__((ext_vector_type(16)));
typedef unsigned u32x4 __attribute__((ext_vector_type(4)));
typedef unsigned u32x2 __attribute__((ext_vector_type(2)));
typedef __bf16 bf16x2_t __attribute__((ext_vector_type(2)));

constexpr int NB = 8, SEQ = 4096, DM = 1024, MT = NB * SEQ;
constexpr int NHEAD = 8, DQK = 96, DV = 64;
constexpr int NEXP = 32;
constexpr float EPS = 1e-6f;
constexpr float QSCALE = 0.14724444602590306f;
constexpr int NPH = 9;

constexpr size_t MiB = 1u << 20;
constexpr size_t WS_CTL = 0, CTL_BYTES = 1 * MiB;
constexpr size_t WS_MOD = 1 * MiB;
constexpr size_t WS_ROPE = 2 * MiB;
constexpr size_t WS_WIN = 6 * MiB;
constexpr size_t WS_WQ = 9 * MiB;
constexpr size_t WS_WKV = 9 * MiB + 512 * 1024;
constexpr size_t WS_WR = 9 * MiB + 768 * 1024;
constexpr size_t WS_WOUT = 10 * MiB;
constexpr size_t WS_WGU = 12 * MiB;
constexpr size_t WS_WD = 44 * MiB;
constexpr size_t WS_SSQQ = 60 * MiB;
constexpr size_t WS_SSQKV = 60 * MiB + 512 * 1024;
constexpr size_t WS_SSQKR = 60 * MiB + 768 * 1024;
constexpr size_t WS_SSQ1 = 61 * MiB;
constexpr size_t WS_TOKW = 63 * MiB;
constexpr size_t WS_KROPE = 64 * MiB;
constexpr size_t WS_CQ = 68 * MiB;
constexpr size_t WS_CKV = 84 * MiB;
constexpr size_t WS_LIST = 92 * MiB;
constexpr size_t WS_H = 100 * MiB;
constexpr size_t WS_U = 164 * MiB;
constexpr size_t WS_Q = 196 * MiB;
constexpr size_t WS_K = 244 * MiB;
constexpr size_t WS_VT = 292 * MiB;
constexpr size_t WS_CAT = 324 * MiB;
constexpr size_t WS_ABUF = 388 * MiB;
constexpr size_t WS_BLIST = 420 * MiB;
constexpr size_t WS_END = 435 * MiB;
constexpr int CW_BAR = 4096;
constexpr int CW_CNT = 16384;

constexpr int SCR_BYTES = 155648;
constexpr int MISC_OFF = SCR_BYTES;
constexpr int LDS_BYTES = SCR_BYTES + 2048;

__device__ __forceinline__ unsigned cvtpk(float lo, float hi) { f32x2 v = {lo, hi}; bf16x2_t b = __builtin_convertvector(v, bf16x2_t); return __builtin_bit_cast(unsigned, b); }
__device__ __forceinline__ float bf2f(unsigned short h) { return __builtin_bit_cast(float, (unsigned)h << 16); }
__device__ __forceinline__ unsigned short f2bf(float f) { return (unsigned short)(cvtpk(f, 0.f) & 0xffffu); }
__device__ __forceinline__ float sigmoidf_(float x) { return __builtin_amdgcn_rcpf(1.0f + __expf(-x)); }
__device__ __forceinline__ float siluf_(float x) { return x * __builtin_amdgcn_rcpf(1.0f + __expf(-x)); }
__device__ __forceinline__ float wave_sum(float v) {
#pragma unroll
    for (int o = 1; o < 64; o <<= 1) v += __shfl_xor(v, o);
    return v;
}

__device__ __forceinline__ int vcu_id() { const int g = gridDim.x, b = blockIdx.x; return (g & 7) == 0 ? (b & 7) * (g >> 3) + (b >> 3) : b; }
#define XB_TMO      128
#define XB_XCNT(j)  (256  + 64 * (j))
#define XB_XSUB(j)  (1280 + 64 * (j))
#define XB_XGEN(j)  (2304 + 64 * (j))
#define XB_TOP      3328
#define XB_TOPGEN   3392
#define XCD_BAR_WORDS 3456
#define XB_SPIN_CAP (1u << 20)
__device__ __forceinline__ unsigned xb_ld(unsigned* p)              { return __hip_atomic_load(p, __ATOMIC_RELAXED, __HIP_MEMORY_SCOPE_AGENT); }
__device__ __forceinline__ unsigned xb_add(unsigned* p, unsigned v) { return __hip_atomic_fetch_add(p, v, __ATOMIC_RELAXED, __HIP_MEMORY_SCOPE_AGENT); }
__device__ __forceinline__ unsigned xb_xcc_id() { return (unsigned)__builtin_amdgcn_s_getreg((3 << 11) | 20) & 0xFu; }
#define XB_SPIN(cond, bar) do { unsigned _sp = 0; while (cond) { __builtin_amdgcn_s_sleep(1); \
    if ((++_sp & 255u) == 0u) { if (xb_ld(&(bar)[XB_TMO])) break; if (_sp > XB_SPIN_CAP) { atomicAdd(&(bar)[XB_TMO], 1u); break; } } } } while (0)
struct XcdBarrier { unsigned* bar; unsigned x; volatile LAS unsigned* st; };
__device__ __forceinline__ XcdBarrier xcd_barrier_post(unsigned* bar, volatile LAS unsigned* st) {
    XcdBarrier b; b.bar = bar; b.x = xb_xcc_id(); b.st = st;
    if (threadIdx.x == 0) (void)xb_add(&bar[XB_XCNT(b.x)], 1u);
    return b;
}
__device__ __forceinline__ void xcd_barrier_complete(unsigned* bar, unsigned x, unsigned& nloc, unsigned& nx) {
    const unsigned G = gridDim.x * gridDim.y * gridDim.z;
    unsigned sum, cnt, mine, sp = 0u;
    for (;;) {
        sum = 0u; cnt = 0u; mine = 0u;
#pragma unroll
        for (unsigned j = 0; j < 16; ++j) { const unsigned c = xb_ld(&bar[XB_XCNT(j)]); sum += c; cnt += (c > 0u) ? 1u : 0u; mine = (j == x) ? c : mine; }
        if (sum == G) break;
        __builtin_amdgcn_s_sleep(1);
        if ((++sp & 255u) == 0u) { if (xb_ld(&bar[XB_TMO])) break; if (sp > XB_SPIN_CAP) { atomicAdd(&bar[XB_TMO], 1u); break; } }
    }
    nloc = mine > 0u ? mine : 1u; nx = cnt > 0u ? cnt : 1u;
}
__device__ __forceinline__ void xcd_barrier(const XcdBarrier& b) {
    asm volatile("s_waitcnt vmcnt(0)" ::: "memory");
    __syncthreads();
    if (threadIdx.x == 0) {
        unsigned* bar = b.bar;
        __builtin_amdgcn_s_waitcnt(0);
        unsigned nloc = b.st[0], nx = b.st[1];
        if (nloc == 0u) { xcd_barrier_complete(bar, b.x, nloc, nx); b.st[0] = nloc; b.st[1] = nx; }
        const unsigned old = xb_add(&bar[XB_XSUB(b.x)], 1u);
        const unsigned gen = old / nloc;
        if (old + 1u == (gen + 1u) * nloc) {
            __builtin_amdgcn_fence(__ATOMIC_RELEASE, "agent");
            asm volatile("s_waitcnt vmcnt(0)" ::: "memory");
            const unsigned og = xb_add(&bar[XB_TOP], 1u);
            const unsigned tg = og / nx;
            if (og + 1u == (tg + 1u) * nx) xb_add(&bar[XB_TOPGEN], 1u);
            else XB_SPIN(xb_ld(&bar[XB_TOPGEN]) == tg, bar);
            __builtin_amdgcn_fence(__ATOMIC_ACQUIRE, "agent");
            xb_add(&bar[XB_XGEN(b.x)], 1u);
            asm volatile("s_waitcnt vmcnt(0)" ::: "memory");
        } else {
            XB_SPIN(xb_ld(&bar[XB_XGEN(b.x)]) == gen, bar);
            __builtin_amdgcn_fence(__ATOMIC_ACQUIRE, "agent");
            asm volatile("s_waitcnt vmcnt(0)" ::: "memory");
        }
    }
    __syncthreads();
}

__device__ __forceinline__ int lds_byte2(int r, int c) { const int st = (r >> 4) * 2 + (c >> 5), ob = (r & 15) * 64 + (c & 31) * 2; return st * 1024 + (ob ^ (((ob >> 9) & 1) << 5)); }
__device__ __forceinline__ void stage_rc2(int b, int& R, int& C) { const int st = b >> 10, sb = b & 1023, swz = sb ^ (((sb >> 9) & 1) << 5); R = (st >> 1) * 16 + swz / 64; C = (st & 1) * 32 + (swz % 64) / 2; }

template <int MI, int NI, bool TRANS>
__device__ __forceinline__ void gemm_block(LAS unsigned char* lds, const bf16_t* const (&ap)[MI / 2], const bf16_t* const (&bp)[NI], int nkt, f32x4 (&acc)[MI][NI]) {
    constexpr int BM = 32 * MI, BN = 64 * NI, TA = BM * 128, TB = BN * 128, STG = TA + TB, GLA = MI / 2, GLB = NI;
    static_assert(2 * STG <= SCR_BYTES, "LDS");
    const int tid = threadIdx.x, lane = tid & 63, wid = __builtin_amdgcn_readfirstlane(tid >> 6), wr = wid >> 2, wc = wid & 3, fr = lane & 15, fq = lane >> 4;
    const int aoff = lds_byte2(wr * (MI * 16) + fr, fq * 8), boff = TA + lds_byte2(wc * (NI * 16) + fr, fq * 8);
#define GB_STAGE(buf, kt) do { \
        _Pragma("unroll") for (int i_ = 0; i_ < GLA; ++i_) __builtin_amdgcn_global_load_lds((const unsigned*)(ap[i_] + (kt) * 64), (LAS unsigned*)(lds + (buf) * STG + wid * 1024 + i_ * 8192), 16, 0, 0); \
        _Pragma("unroll") for (int i_ = 0; i_ < GLB; ++i_) __builtin_amdgcn_global_load_lds((const unsigned*)(bp[i_] + (kt) * 64), (LAS unsigned*)(lds + (buf) * STG + TA + wid * 1024 + i_ * 8192), 16, 0, 0); } while (0)
    GB_STAGE(0, 0);
    asm volatile("s_waitcnt vmcnt(0)" ::: "memory"); __syncthreads();
    for (int t = 0; t < nkt; ++t) {
        const int cur = t & 1;
        if (t + 1 < nkt) GB_STAGE(cur ^ 1, t + 1);
        const LAS unsigned char* sb = lds + cur * STG;
#pragma unroll
        for (int ks = 0; ks < 2; ++ks) {
            bf16x8 At[MI], Bf[NI];
#pragma unroll
            for (int m = 0; m < MI; ++m) At[m] = *(const LAS bf16x8*)(sb + aoff + m * 2048 + ks * 1024);
#pragma unroll
            for (int n = 0; n < NI; ++n) Bf[n] = *(const LAS bf16x8*)(sb + boff + n * 2048 + ks * 1024);
#pragma unroll
            for (int m = 0; m < MI; ++m)
#pragma unroll
                for (int n = 0; n < NI; ++n)
                    acc[m][n] = TRANS ? __builtin_amdgcn_mfma_f32_16x16x32_bf16(Bf[n], At[m], acc[m][n], 0, 0, 0)
                                      : __builtin_amdgcn_mfma_f32_16x16x32_bf16(At[m], Bf[n], acc[m][n], 0, 0, 0);
        }
        asm volatile("s_waitcnt vmcnt(0)" ::: "memory"); __syncthreads();
    }
#undef GB_STAGE
}
template <int MI, int NI, bool ARES>
__device__ __forceinline__ void gemm_stage(LAS unsigned char* lds, int abytes, const bf16_t* const (&ap)[MI / 2], const bf16_t* const (&bp)[NI], int buf, int kt) {
    constexpr int TA = MI * 32 * 128, TB = NI * 64 * 128, STG = ARES ? TB : TA + TB;
    const int wid = __builtin_amdgcn_readfirstlane(threadIdx.x >> 6);
    LAS unsigned char* base = lds + (ARES ? abytes : 0) + buf * STG + wid * 1024;
    if (!ARES) {
#pragma unroll
        for (int i = 0; i < MI / 2; ++i) __builtin_amdgcn_global_load_lds((const unsigned*)(ap[i] + kt * 64), (LAS unsigned*)(base + i * 8192), 16, 0, 0);
    }
#pragma unroll
    for (int i = 0; i < NI; ++i) __builtin_amdgcn_global_load_lds((const unsigned*)(bp[i] + kt * 64), (LAS unsigned*)(base + (ARES ? 0 : TA) + i * 8192), 16, 0, 0);
}
template <int MI>
__device__ __forceinline__ void gemm_load_ares(LAS unsigned char* lds, const bf16_t* const (&ap)[MI / 2], int nkt) {
    constexpr int TA = MI * 32 * 128;
    const int wid = __builtin_amdgcn_readfirstlane(threadIdx.x >> 6);
    for (int kt = 0; kt < nkt; ++kt) {
#pragma unroll
        for (int i = 0; i < MI / 2; ++i) __builtin_amdgcn_global_load_lds((const unsigned*)(ap[i] + kt * 64), (LAS unsigned*)(lds + kt * TA + wid * 1024 + i * 8192), 16, 0, 0);
    }
}
template <int MI, int NI, bool TRANS, bool ARES>
__device__ __forceinline__ void gemm_main2(LAS unsigned char* lds, int abytes, const bf16_t* const (&ap)[MI / 2], const bf16_t* const (&bp)[NI], const bf16_t* const (&bq)[NI], int ksplit, int nkt, f32x4 (&acc)[MI][NI]) {
    constexpr int TA = MI * 32 * 128, TB = NI * 64 * 128, STG = ARES ? TB : TA + TB;
    const int tid = threadIdx.x, lane = tid & 63, wid = __builtin_amdgcn_readfirstlane(tid >> 6), wr = wid >> 2, wc = wid & 3, fr = lane & 15, fq = lane >> 4;
    const int aoff = lds_byte2(wr * (MI * 16) + fr, fq * 8), boff = (ARES ? abytes : TA) + lds_byte2(wc * (NI * 16) + fr, fq * 8);
#pragma unroll 1
    for (int t = 0; t < nkt; ++t) {
        const int cur = t & 1;
        asm volatile("s_waitcnt vmcnt(0)" ::: "memory"); __syncthreads();
        if (t + 1 < nkt) { if (t + 1 < ksplit) gemm_stage<MI, NI, ARES>(lds, abytes, ap, bp, cur ^ 1, t + 1); else gemm_stage<MI, NI, ARES>(lds, abytes, ap, bq, cur ^ 1, t + 1); }
        const LAS unsigned char* sa = ARES ? lds + t * TA : lds + cur * STG;
        const LAS unsigned char* sb = lds + cur * STG;
#pragma unroll
        for (int ks = 0; ks < 2; ++ks) {
            bf16x8 At[MI], Bf[NI];
#pragma unroll
            for (int m = 0; m < MI; ++m) At[m] = *(const LAS bf16x8*)(sa + aoff + m * 2048 + ks * 1024);
#pragma unroll
            for (int n = 0; n < NI; ++n) Bf[n] = *(const LAS bf16x8*)(sb + boff + n * 2048 + ks * 1024);
#pragma unroll
            for (int m = 0; m < MI; ++m)
#pragma unroll
                for (int n = 0; n < NI; ++n)
                    acc[m][n] = TRANS ? __builtin_amdgcn_mfma_f32_16x16x32_bf16(Bf[n], At[m], acc[m][n], 0, 0, 0)
                                      : __builtin_amdgcn_mfma_f32_16x16x32_bf16(At[m], Bf[n], acc[m][n], 0, 0, 0);
        }
    }
    if (nkt & 1) __syncthreads();
}
template <int MI, int NI, bool TRANS, bool ARES>
__device__ __forceinline__ void gemm_main(LAS unsigned char* lds, int abytes, const bf16_t* const (&ap)[MI / 2], const bf16_t* const (&bp)[NI], int nkt, f32x4 (&acc)[MI][NI]) {
    gemm_main2<MI, NI, TRANS, ARES>(lds, abytes, ap, bp, bp, nkt, nkt, acc);
}
template <int GL>
__device__ __forceinline__ void stage_ptrs_dense(const bf16_t* base, size_t ld, int r0, const bf16_t* (&p)[GL]) {
    const int tid = threadIdx.x, lane = tid & 63, wid = tid >> 6;
#pragma unroll
    for (int i = 0; i < GL; ++i) { int R, C; stage_rc2(wid * 1024 + i * 8192 + lane * 16, R, C); p[i] = base + (size_t)(r0 + R) * ld + C; }
}

struct Params {
    const void* in[26];
    float* out;
    unsigned char* ws;
    int ph_lo, ph_hi;
};
typedef const __attribute__((address_space(4))) Params* CP;
__device__ __forceinline__ CP get_params() { CP q = (CP)__builtin_amdgcn_kernarg_segment_ptr(); asm volatile("" : "+s"(q)); return q; }

__device__ const float INVF[16] = {1.000000000e+00f, 5.623413324e-01f, 3.162277639e-01f, 1.778279394e-01f, 1.000000015e-01f, 5.623413250e-02f, 3.162277490e-02f, 1.778279431e-02f,
                                   9.999999776e-03f, 5.623413250e-03f, 3.162277630e-03f, 1.778279431e-03f, 1.000000047e-03f, 5.623413017e-04f, 3.162277571e-04f, 1.778279402e-04f};

__device__ __forceinline__ void tr_item(const float* srcp, int ldw, const float* kscale, bf16_t* WT, int Kd, int k0, int n0, LAS float* scr, int lane) {
#pragma unroll 8
    for (int i = 0; i < 32; ++i) { const int kk = 2 * i + (lane >> 5); float v = 0.f; if (srcp) { v = srcp[(size_t)(k0 + kk) * ldw]; if (kscale) v *= kscale[k0 + kk]; } scr[kk * 33 + (lane & 31)] = v; }
    asm volatile("s_waitcnt lgkmcnt(0)" ::: "memory");
    const int c = lane & 7;
#pragma unroll
    for (int j = 0; j < 4; ++j) { const int n = (lane >> 3) + 8 * j; const LAS float* s = scr + (8 * c) * 33 + n;
        u32x4 o; o.x = cvtpk(s[0 * 33], s[1 * 33]); o.y = cvtpk(s[2 * 33], s[3 * 33]); o.z = cvtpk(s[4 * 33], s[5 * 33]); o.w = cvtpk(s[6 * 33], s[7 * 33]);
        *(u32x4*)(WT + (size_t)(n0 + n) * Kd + k0 + 8 * c) = o; }
    asm volatile("s_waitcnt lgkmcnt(0)" ::: "memory");
}

__device__ __forceinline__ void phase0(CP p, LAS unsigned char* lds) {
    const int tid = threadIdx.x, lane = tid & 63, wave = __builtin_amdgcn_readfirstlane(tid >> 6);
    const int G = gridDim.x, bid = blockIdx.x;
    unsigned char* ws = p->ws;
    if (bid < 192) {
        const float* c = (const float*)p->in[1]; const float* w_ada = (const float*)p->in[3]; const float* b_ada = (const float*)p->in[4];
        LAS float* sc = (LAS float*)lds;
        LAS float* red = (LAS float*)(lds + 32768);
        for (int i = tid; i < 8192; i += 512) sc[i] = siluf_(c[i]);
        __syncthreads();
        const int col = tid & 31, ks = tid >> 5, n0 = bid * 32;
        float a[8] = {0, 0, 0, 0, 0, 0, 0, 0};
#pragma unroll 8
        for (int i = 0; i < 64; ++i) { const int k = ks * 64 + i; const float w = w_ada[(size_t)k * 6144 + n0 + col];
#pragma unroll
            for (int b = 0; b < 8; ++b) a[b] += sc[b * 1024 + k] * w; }
#pragma unroll
        for (int b = 0; b < 8; ++b) red[(ks * 32 + col) * 8 + b] = a[b];
        __syncthreads();
        if (tid < 256) { const int cc = tid & 31, b = tid >> 5; float s = 0.f;
#pragma unroll
            for (int k2 = 0; k2 < 16; ++k2) s += red[(k2 * 32 + cc) * 8 + b];
            ((float*)(ws + WS_MOD))[b * 6144 + n0 + cc] = s + b_ada[n0 + cc]; }
        __syncthreads();
    }
    {
        const int* pos = (const int*)p->in[2]; f32x2* rt = (f32x2*)(ws + WS_ROPE);
        for (int e = bid * 512 + tid; e < MT * 16; e += G * 512) {
            const int tok = e >> 4, i = e & 15;
            const float a32 = (float)pos[tok] * INVF[i];
            const double rev = (double)a32 * 0.15915494309189535;
            const float fr = (float)(rev - __builtin_rint(rev));
            rt[e] = (f32x2){__builtin_amdgcn_cosf(fr), __builtin_amdgcn_sinf(fr)};
        }
    }
    {
        LAS unsigned* scr = (LAS unsigned*)(lds + 65536) + wave * 2112;
        const int gw = bid * 8 + wave, NGW = G * 8;
        const float* w_in = (const float*)p->in[6]; const float* qan = (const float*)p->in[11]; const float* w_qb = (const float*)p->in[12];
        const float* kvan = (const float*)p->in[13]; const float* w_kvb = (const float*)p->in[14]; const float* w_out = (const float*)p->in[17];
        const float* w_group = (const float*)p->in[19]; const float* w_expert = (const float*)p->in[21];
        const float* w_gate = (const float*)p->in[23]; const float* w_up = (const float*)p->in[24]; const float* w_down = (const float*)p->in[25];
        constexpr int I0 = 16 * 24, I1 = 4 * 16, I2 = 2 * 16, I3 = 16 * 16, I4 = 32 * 128, I5 = 32 * 64, I6 = 16 * 2;
        constexpr int NIT = I0 + I1 + I2 + I3 + I4 + I5 + I6;
        const int c4 = lane & 15, kp = lane >> 4;
        for (int it = gw; it < NIT; it += NGW) {
            int r = it;
            if (r >= NIT - I6) {
                r -= NIT - I6;
                LAS float* fscr = (LAS float*)scr; const int nl = lane & 31;
                const int kb = r >> 1, nb = r & 1, n0 = nb * 32, np = n0 + nl, k0 = kb * 64;
                const float* srcp = nullptr; int ldw = 0;
                if (np < 4) { srcp = w_group + np; ldw = 4; } else if (np < 36) { srcp = w_expert + (np - 4); ldw = 32; }
#pragma unroll 8
                for (int i = 0; i < 32; ++i) { const int kk = 2 * i + (lane >> 5); fscr[kk * 33 + nl] = srcp ? srcp[(size_t)(k0 + kk) * ldw] : 0.f; }
                asm volatile("s_waitcnt lgkmcnt(0)" ::: "memory");
                const int c = lane & 7;
#pragma unroll
                for (int j = 0; j < 4; ++j) { const int n = (lane >> 3) + 8 * j; const LAS float* sp = fscr + (8 * c) * 33 + n;
                    float v[8], l[8];
#pragma unroll
                    for (int q = 0; q < 8; ++q) { v[q] = sp[q * 33]; l[q] = v[q] - bf2f(f2bf(v[q])); }
                    if (n0 + n < 48) {
                        u32x4 o; o.x = cvtpk(v[0], v[1]); o.y = cvtpk(v[2], v[3]); o.z = cvtpk(v[4], v[5]); o.w = cvtpk(v[6], v[7]);
                        *(u32x4*)((bf16_t*)(ws + WS_WR) + (size_t)(n0 + n) * 1024 + k0 + 8 * c) = o;
                        u32x4 o2; o2.x = cvtpk(l[0], l[1]); o2.y = cvtpk(l[2], l[3]); o2.z = cvtpk(l[4], l[5]); o2.w = cvtpk(l[6], l[7]);
                        *(u32x4*)((bf16_t*)(ws + WS_WR) + 48 * 1024 + (size_t)(n0 + n) * 1024 + k0 + 8 * c) = o2; } }
                asm volatile("s_waitcnt lgkmcnt(0)" ::: "memory");
                continue;
            }
            const float* srcp; int ldw, Kd, k0, n0; const float* ksc = nullptr; bf16_t* WT;
            if (r < I0) {
                const int kb = r / 24, nb = r % 24; n0 = nb * 64; k0 = kb * 64; const int np = n0 + 4 * c4;
                const int pn = np >> 8, wc = (np >> 6) & 3, n = (np >> 4) & 3, f = np & 15; int src;
                if (pn < 4) { const int ch = pn * 128 + wc * 32 + (n >> 1) * 16 + f; src = (n & 1) ? 512 + ch : ch; }
                else if (pn == 4) src = np;
                else { const int j = np - 1280; src = (j < 160) ? 1280 + j : -1; }
                srcp = src >= 0 ? w_in + src : nullptr; ldw = 1440; Kd = 1024; WT = (bf16_t*)(ws + WS_WIN);
            } else if ((r -= I0) < I1) {
                const int kb = r / 16, nb = r % 16; n0 = nb * 64; k0 = kb * 64; const int np = n0 + 4 * c4, hd = np >> 7, j = np & 127;
                srcp = j < 96 ? w_qb + hd * 96 + j : nullptr; ldw = 768; Kd = 256; ksc = qan; WT = (bf16_t*)(ws + WS_WQ);
            } else if ((r -= I1) < I2) {
                const int kb = r / 16, nb = r % 16; n0 = nb * 64; k0 = kb * 64;
                srcp = w_kvb + n0 + 4 * c4; ldw = 1024; Kd = 128; ksc = kvan; WT = (bf16_t*)(ws + WS_WKV);
            } else if ((r -= I2) < I3) {
                const int kb = r / 16, nb = r % 16; n0 = nb * 64; k0 = kb * 64;
                srcp = w_out + n0 + 4 * c4; ldw = 1024; Kd = 1024; WT = (bf16_t*)(ws + WS_WOUT);
            } else if ((r -= I3) < I4) {
                const int e = r >> 7, q = r & 127, kb = q / 8, nb = q % 8; n0 = nb * 64; k0 = kb * 64; const int np = n0 + 4 * c4;
                const int ct = np >> 8, wc = (np >> 6) & 3, n = (np >> 4) & 3, f = np & 15, ch = ct * 128 + wc * 32 + (n >> 1) * 16 + f;
                srcp = ((n & 1) ? w_up : w_gate) + (size_t)e * 1024 * 256 + ch; ldw = 256; Kd = 1024; WT = (bf16_t*)(ws + WS_WGU) + (size_t)e * 512 * 1024;
            } else {
                r -= I4; const int e = r >> 6, q = r & 63, kb = q / 16, nb = q % 16; n0 = nb * 64; k0 = kb * 64;
                srcp = w_down + (size_t)e * 256 * 1024 + n0 + 4 * c4; ldw = 1024; Kd = 256; WT = (bf16_t*)(ws + WS_WD) + (size_t)e * 1024 * 256;
            }
            f32x4 v0[8], v1[8];
#pragma unroll
            for (int i = 0; i < 8; ++i) { const int k = k0 + 8 * i + 2 * kp;
                if (srcp) { v0[i] = *(const f32x4*)(srcp + (size_t)k * ldw); v1[i] = *(const f32x4*)(srcp + (size_t)(k + 1) * ldw); }
                else { v0[i] = (f32x4){0.f, 0.f, 0.f, 0.f}; v1[i] = v0[i]; } }
#pragma unroll
            for (int i = 0; i < 8; ++i) { const int k = k0 + 8 * i + 2 * kp; f32x4 a = v0[i], b = v1[i];
                if (ksc) { a = a * ksc[k]; b = b * ksc[k + 1]; }
                LAS unsigned* d = scr + (4 * c4) * 33 + 4 * i + kp;
                d[0] = cvtpk(a.x, b.x); d[33] = cvtpk(a.y, b.y); d[66] = cvtpk(a.z, b.z); d[99] = cvtpk(a.w, b.w); }
            asm volatile("s_waitcnt lgkmcnt(0)" ::: "memory");
            const int c = lane & 7;
#pragma unroll
            for (int j = 0; j < 8; ++j) { const int n = (lane >> 3) + 8 * j; const LAS unsigned* sp = scr + n * 33 + 4 * c;
                u32x4 o; o.x = sp[0]; o.y = sp[1]; o.z = sp[2]; o.w = sp[3];
                *(u32x4*)(WT + (size_t)(n0 + n) * Kd + k0 + 8 * c) = o; }
            asm volatile("s_waitcnt lgkmcnt(0)" ::: "memory");
        }
    }
}

__device__ __forceinline__ void phase1a(CP p) {
    const int tid = threadIdx.x, lane = tid & 63, wave = tid >> 6;
    const int gw = blockIdx.x * 8 + wave, NGW = gridDim.x * 8;
    const float* x = (const float*)p->in[0]; const float* nm = (const float*)p->in[5]; const float* mod = (const float*)(p->ws + WS_MOD);
    bf16_t* h = (bf16_t*)(p->ws + WS_H);
    for (int grp = gw; grp < MT / 16; grp += NGW) {
        const int r0 = grp * 16, b = r0 >> 12;
        f32x4 gm[4], sh[4];
#pragma unroll
        for (int j = 0; j < 4; ++j) { const int col = 4 * lane + 256 * j; const f32x4 g = *(const f32x4*)(nm + col), s = *(const f32x4*)(mod + b * 6144 + 1024 + col);
            gm[j] = g * (s + 1.0f); sh[j] = *(const f32x4*)(mod + b * 6144 + col); }
#pragma unroll 1
        for (int rb = 0; rb < 16; rb += 4) {
            f32x4 v[4][4];
#pragma unroll
            for (int rr = 0; rr < 4; ++rr) { const float* xr = x + (size_t)(r0 + rb + rr) * DM;
#pragma unroll
                for (int j = 0; j < 4; ++j) v[rr][j] = *(const f32x4*)(xr + 4 * lane + 256 * j); }
#pragma unroll
            for (int rr = 0; rr < 4; ++rr) { float s = 0.f;
#pragma unroll
                for (int j = 0; j < 4; ++j) s += (v[rr][j].x * v[rr][j].x + v[rr][j].y * v[rr][j].y) + (v[rr][j].z * v[rr][j].z + v[rr][j].w * v[rr][j].w);
                const float rstd = __builtin_amdgcn_rsqf(wave_sum(s) * (1.0f / DM) + EPS);
                bf16_t* hr = h + (size_t)(r0 + rb + rr) * DM;
#pragma unroll
                for (int j = 0; j < 4; ++j) { const f32x4 o = v[rr][j] * rstd * gm[j] + sh[j]; u32x2 w; w.x = cvtpk(o.x, o.y); w.y = cvtpk(o.z, o.w); *(u32x2*)(hr + 4 * lane + 256 * j) = w; } }
        }
    }
}

__device__ __forceinline__ void phase1b(CP p, LAS unsigned char* lds) {
    const int tid = threadIdx.x, lane = tid & 63, wid = __builtin_amdgcn_readfirstlane(tid >> 6), wr = wid >> 2, wc = wid & 3, fr = lane & 15, fq = lane >> 4;
    unsigned char* ws = p->ws;
    const bf16_t* h = (const bf16_t*)(ws + WS_H); const bf16_t* win = (const bf16_t*)(ws + WS_WIN);
    for (int u = vcu_id(); u < 128 * 6; u += gridDim.x) {
        const int pm = u / 6, pn = u % 6;
        const bf16_t* ap[4]; const bf16_t* bp[4];
        stage_ptrs_dense<4>(h, 1024, pm * 256, ap); stage_ptrs_dense<4>(win, 1024, pn * 256, bp);
        f32x4 acc[8][4];
#pragma unroll
        for (int m = 0; m < 8; ++m)
#pragma unroll
            for (int n = 0; n < 4; ++n) acc[m][n] = (f32x4){0.f, 0.f, 0.f, 0.f};
        gemm_block<8, 4, true>(lds, ap, bp, 16, acc);
        const int rowb = pm * 256 + wr * 128 + fr;
        if (pn < 4) {
            bf16_t* ub = (bf16_t*)(ws + WS_U);
#pragma unroll
            for (int m = 0; m < 8; ++m) { const size_t row = rowb + m * 16;
#pragma unroll
                for (int h2 = 0; h2 < 2; ++h2) { const f32x4 v = acc[m][2 * h2], g = acc[m][2 * h2 + 1];
                    const int ch = pn * 128 + wc * 32 + h2 * 16 + fq * 4;
                    u32x2 w; w.x = cvtpk(v.x * sigmoidf_(g.x), v.y * sigmoidf_(g.y)); w.y = cvtpk(v.z * sigmoidf_(g.z), v.w * sigmoidf_(g.w));
                    *(u32x2*)(ub + row * 512 + ch) = w; } }
        } else if (pn == 4) {
            bf16_t* cq = (bf16_t*)(ws + WS_CQ); float* sq = (float*)(ws + WS_SSQQ);
#pragma unroll
            for (int m = 0; m < 8; ++m) { const size_t row = rowb + m * 16; float s = 0.f;
#pragma unroll
                for (int n = 0; n < 4; ++n) { const f32x4 v = acc[m][n]; s += (v.x * v.x + v.y * v.y) + (v.z * v.z + v.w * v.w);
                    u32x2 w; w.x = cvtpk(v.x, v.y); w.y = cvtpk(v.z, v.w); *(u32x2*)(cq + row * 256 + wc * 64 + n * 16 + fq * 4) = w; }
                s += __shfl_xor(s, 16); s += __shfl_xor(s, 32);
                if (fq == 0) sq[row * 4 + wc] = s; }
        } else {
            if (wc < 2) {
                bf16_t* ckv = (bf16_t*)(ws + WS_CKV); float* sq = (float*)(ws + WS_SSQKV);
#pragma unroll
                for (int m = 0; m < 8; ++m) { const size_t row = rowb + m * 16; float s = 0.f;
#pragma unroll
                    for (int n = 0; n < 4; ++n) { const f32x4 v = acc[m][n]; s += (v.x * v.x + v.y * v.y) + (v.z * v.z + v.w * v.w);
                        u32x2 w; w.x = cvtpk(v.x, v.y); w.y = cvtpk(v.z, v.w); *(u32x2*)(ckv + row * 128 + wc * 64 + n * 16 + fq * 4) = w; }
                    s += __shfl_xor(s, 16); s += __shfl_xor(s, 32);
                    if (fq == 0) sq[row * 2 + wc] = s; }
            } else if (wc == 2) {
                float* kr = (float*)(ws + WS_KROPE); float* sq = (float*)(ws + WS_SSQKR);
#pragma unroll
                for (int m = 0; m < 8; ++m) { const size_t row = rowb + m * 16; float s = 0.f;
#pragma unroll
                    for (int n = 0; n < 2; ++n) { const f32x4 v = acc[m][n]; s += (v.x * v.x + v.y * v.y) + (v.z * v.z + v.w * v.w);
                        *(f32x4*)(kr + row * 32 + n * 16 + fq * 4) = v; }
                    s += __shfl_xor(s, 16); s += __shfl_xor(s, 32);
                    if (fq == 0) sq[row] = s; }
            }
        }
    }
}

constexpr int EPI_SCR = 131072;
__device__ __forceinline__ void q_item(CP p, LAS unsigned char* lds, int pm) {
    const int tid = threadIdx.x, lane = tid & 63, wid = __builtin_amdgcn_readfirstlane(tid >> 6), wr = wid >> 2, wc = wid & 3, fr = lane & 15, fq = lane >> 4;
    unsigned char* ws = p->ws;
    const bf16_t* ap[2]; const bf16_t* bp[4];
    stage_ptrs_dense<2>((const bf16_t*)(ws + WS_CQ), 256, pm * 128, ap);
    stage_ptrs_dense<4>((const bf16_t*)(ws + WS_WQ), 256, 0, bp);
    __syncthreads();
    gemm_load_ares<4>(lds, ap, 4);
    gemm_stage<4, 4, true>(lds, 65536, ap, bp, 0, 0);
    const float* sq = (const float*)(ws + WS_SSQQ); const float* qn = (const float*)p->in[15];
    LAS float* part = (LAS float*)(lds + EPI_SCR);
    const int rowb = pm * 128 + wr * 64 + fr;
    float rq[4];
#pragma unroll
    for (int m = 0; m < 4; ++m) { const f32x4 s4 = *(const f32x4*)(sq + (size_t)(rowb + m * 16) * 4); rq[m] = 1.0f / sqrtf(((s4.x + s4.y) + (s4.z + s4.w)) * (1.0f / 256.0f) + EPS); }
    bf16_t* qb = (bf16_t*)(ws + WS_Q); const f32x2* rope = (const f32x2*)(ws + WS_ROPE);
    const int i0 = fq * 4;
    f32x4 gq[4], cs01[4], cs23[4];
    if ((wc & 1) == 0) {
#pragma unroll
        for (int n = 0; n < 4; ++n) gq[n] = *(const f32x4*)(qn + n * 16 + i0);
#pragma unroll
        for (int m = 0; m < 4; ++m) { cs01[m] = (f32x4){0.f, 0.f, 0.f, 0.f}; cs23[m] = cs01[m]; }
    } else {
        gq[0] = *(const f32x4*)(qn + 64 + i0); gq[1] = *(const f32x4*)(qn + 80 + i0); gq[2] = gq[0]; gq[3] = gq[1];
#pragma unroll
        for (int m = 0; m < 4; ++m) { const size_t tok = rowb + m * 16; cs01[m] = *(const f32x4*)(rope + tok * 16 + i0); cs23[m] = *(const f32x4*)(rope + tok * 16 + i0 + 2); }
    }
    const int bb = (pm * 128) >> 12, sb = rowb & 4095;
#pragma unroll 1
    for (int pn = 0; pn < 4; ++pn) {
        f32x4 acc[4][4];
#pragma unroll
        for (int m = 0; m < 4; ++m)
#pragma unroll
            for (int n = 0; n < 4; ++n) acc[m][n] = (f32x4){0.f, 0.f, 0.f, 0.f};
        gemm_main<4, 4, true, true>(lds, 65536, ap, bp, 4, acc);
        if (pn < 3) {
#pragma unroll
            for (int i = 0; i < 4; ++i) bp[i] += 256 * 256;
            gemm_stage<4, 4, true>(lds, 65536, ap, bp, 0, 0);
        }
        const int nval = (wc & 1) ? 2 : 4;
#pragma unroll
        for (int m = 0; m < 4; ++m) { float s = 0.f;
#pragma unroll
            for (int n = 0; n < 4; ++n) { acc[m][n] = acc[m][n] * rq[m]; if (n < nval) { const f32x4 v = acc[m][n]; s += (v.x * v.x + v.y * v.y) + (v.z * v.z + v.w * v.w); } }
            s += __shfl_xor(s, 16); s += __shfl_xor(s, 32);
            if (fq == 0) part[wid * 64 + m * 16 + fr] = s; }
        __syncthreads();
        const int hd = pn * 2 + (wc >> 1);
        bf16_t* dst0 = qb + ((size_t)(bb * 8 + hd) * 4096 + sb) * 96;
#pragma unroll
        for (int m = 0; m < 4; ++m) {
            const float tot = part[wid * 64 + m * 16 + fr] + part[(wid ^ 1) * 64 + m * 16 + fr];
            const float rh = __builtin_amdgcn_rsqf(tot * (1.0f / 96.0f) + EPS) * QSCALE;
            bf16_t* dst = dst0 + (m * 16) * 96;
            if ((wc & 1) == 0) {
#pragma unroll
                for (int n = 0; n < 4; ++n) { const int j = n * 16 + i0; const f32x4 v = acc[m][n] * rh * gq[n];
                    u32x2 w; w.x = cvtpk(v.x, v.y); w.y = cvtpk(v.z, v.w); *(u32x2*)(dst + j) = w; }
            } else {
                const f32x4 x1 = acc[m][0] * rh * gq[0], x2 = acc[m][1] * rh * gq[1];
                const f32x4 c01 = cs01[m], c23 = cs23[m];
                f32x4 o1, o2;
                o1.x = x1.x * c01.x - x2.x * c01.y; o2.x = x1.x * c01.y + x2.x * c01.x;
                o1.y = x1.y * c01.z - x2.y * c01.w; o2.y = x1.y * c01.w + x2.y * c01.z;
                o1.z = x1.z * c23.x - x2.z * c23.y; o2.z = x1.z * c23.y + x2.z * c23.x;
                o1.w = x1.w * c23.z - x2.w * c23.w; o2.w = x1.w * c23.w + x2.w * c23.z;
                u32x2 w; w.x = cvtpk(o1.x, o1.y); w.y = cvtpk(o1.z, o1.w); *(u32x2*)(dst + 64 + i0) = w;
                w.x = cvtpk(o2.x, o2.y); w.y = cvtpk(o2.z, o2.w); *(u32x2*)(dst + 80 + i0) = w;
            }
        }
        __syncthreads();
    }
}

constexpr int KV_SCR = 98304;
__device__ __forceinline__ void kv_item(CP p, LAS unsigned char* lds, int pm) {
    const int tid = threadIdx.x, lane = tid & 63, wid = __builtin_amdgcn_readfirstlane(tid >> 6), wr = wid >> 2, wc = wid & 3, fr = lane & 15, fq = lane >> 4;
    unsigned char* ws = p->ws;
    const bf16_t* ap[2]; const bf16_t* bp[4];
    stage_ptrs_dense<2>((const bf16_t*)(ws + WS_CKV), 128, pm * 128, ap);
    stage_ptrs_dense<4>((const bf16_t*)(ws + WS_WKV), 128, 0, bp);
    __syncthreads();
    gemm_load_ares<4>(lds, ap, 2);
    gemm_stage<4, 4, true>(lds, 32768, ap, bp, 0, 0);
    LAS float* kr_l = (LAS float*)(lds + KV_SCR); LAS float* rp_l = kr_l + 128 * 33; LAS float* rkv_l = rp_l + 128 * 34; LAS float* skr_l = rkv_l + 128;
    {
        const float* krp = (const float*)(ws + WS_KROPE) + (size_t)pm * 128 * 32; const float* rope = (const float*)(ws + WS_ROPE) + (size_t)pm * 128 * 32;
        f32x4 a[2], b[2];
#pragma unroll
        for (int k = 0; k < 2; ++k) { const int idx = tid + 512 * k; a[k] = *(const f32x4*)(krp + idx * 4); b[k] = *(const f32x4*)(rope + idx * 4); }
        float rk = 0.f, sk = 0.f;
        if (tid < 128) { const f32x2 s2 = *(const f32x2*)((const float*)(ws + WS_SSQKV) + (size_t)(pm * 128 + tid) * 2); rk = __builtin_amdgcn_rsqf((s2.x + s2.y) * (1.0f / 128.0f) + EPS); sk = ((const float*)(ws + WS_SSQKR))[pm * 128 + tid]; }
#pragma unroll
        for (int k = 0; k < 2; ++k) { const int idx = tid + 512 * k, row = idx >> 3, c4 = (idx & 7) * 4;
            LAS float* d = kr_l + row * 33 + c4; d[0] = a[k].x; d[1] = a[k].y; d[2] = a[k].z; d[3] = a[k].w;
            LAS float* e = rp_l + row * 34 + c4; e[0] = b[k].x; e[1] = b[k].y; e[2] = b[k].z; e[3] = b[k].w; }
        if (tid < 128) { rkv_l[tid] = rk; skr_l[tid] = sk; }
    }
    const float* kn = (const float*)p->in[16];
    const int rowl = wr * 64 + fq * 4, rowb = pm * 128 + rowl;
    float g[4];
#pragma unroll
    for (int n = 0; n < 4; ++n) g[n] = kn[n * 16 + fr];
    const float g1 = kn[64 + fr], g2 = kn[80 + fr];
    const int bb = (pm * 128) >> 12, sb = rowb & 4095;
#pragma unroll 1
    for (int pn = 0; pn < 4; ++pn) {
        f32x4 acc[4][4];
#pragma unroll
        for (int m = 0; m < 4; ++m)
#pragma unroll
            for (int n = 0; n < 4; ++n) acc[m][n] = (f32x4){0.f, 0.f, 0.f, 0.f};
        gemm_main<4, 4, false, true>(lds, 32768, ap, bp, 2, acc);
        if (pn < 3) {
#pragma unroll
            for (int i = 0; i < 4; ++i) bp[i] += 256 * 128;
            gemm_stage<4, 4, true>(lds, 32768, ap, bp, 0, 0);
        }
        const int hd = pn * 2 + (wc >> 1);
        if ((wc & 1) == 0) {
            bf16_t* dst_p = (bf16_t*)(ws + WS_K) + ((size_t)(bb * 8 + hd) * 4096 + sb) * 96 + fr;
#pragma unroll
            for (int m = 0; m < 4; ++m) {
#pragma unroll
                for (int j = 0; j < 4; ++j) {
                    const int o = m * 16 + j, rl = rowl + o;
                    const float rkv = rkv_l[rl];
                    float v[4], ss = 0.f;
#pragma unroll
                    for (int n = 0; n < 4; ++n) { v[n] = acc[m][n][j] * rkv; ss += v[n] * v[n]; }
                    ss += __shfl_xor(ss, 1); ss += __shfl_xor(ss, 2); ss += __shfl_xor(ss, 4); ss += __shfl_xor(ss, 8);
                    const float rk = __builtin_amdgcn_rsqf((ss + skr_l[rl]) * (1.0f / 96.0f) + EPS);
                    bf16_t* dst = dst_p + o * 96;
#pragma unroll
                    for (int n = 0; n < 4; ++n) dst[n * 16] = f2bf(v[n] * rk * g[n]);
                    const float x1 = kr_l[rl * 33 + fr] * rk * g1, x2 = kr_l[rl * 33 + 16 + fr] * rk * g2;
                    const float cs_c = rp_l[rl * 34 + 2 * fr], cs_s = rp_l[rl * 34 + 2 * fr + 1];
                    dst[64] = f2bf(x1 * cs_c - x2 * cs_s); dst[80] = f2bf(x1 * cs_s + x2 * cs_c);
                }
            }
        } else {
            bf16_t* vt_p = (bf16_t*)(ws + WS_VT) + ((size_t)(bb * 8 + hd) * 64 + fr) * 4096 + sb;
#pragma unroll
            for (int m = 0; m < 4; ++m) {
                float rkv[4];
#pragma unroll
                for (int j = 0; j < 4; ++j) rkv[j] = rkv_l[rowl + m * 16 + j];
#pragma unroll
                for (int n = 0; n < 4; ++n) { const f32x4 a = acc[m][n];
                    u32x2 w; w.x = cvtpk(a.x * rkv[0], a.y * rkv[1]); w.y = cvtpk(a.z * rkv[2], a.w * rkv[3]);
                    *(u32x2*)(vt_p + (size_t)(n * 16) * 4096 + m * 16) = w; }
            }
        }
    }
}

template <int R> __device__ __forceinline__ void conv_row(float (&o)[64], const float (&w)[31], float x) {
    constexpr int T0 = R > 30 ? R - 30 : 0, T1 = R < 63 ? R : 63;
#pragma unroll
    for (int t = T0; t <= T1; ++t) o[t] += w[R - t] * x;
}
template <int... R> __device__ __forceinline__ void conv_rows(float (&o)[64], const float (&w)[31], const float (&x)[94], std::integer_sequence<int, R...>) { (conv_row<R>(o, w, x[R]), ...); }
__device__ __forceinline__ void conv_unit(CP p, LAS unsigned char* lds, int cu) {
    const int tid = threadIdx.x, lane = tid & 63, wave = tid >> 6;
    const int b = cu >> 6, s0 = (cu & 63) * 64, c = tid;
    const bf16_t* ub = (const bf16_t*)(p->ws + WS_U) + ((size_t)b * 4096) * 512 + c;
    const float* cw = (const float*)p->in[7]; const float* cb = (const float*)p->in[8]; const float* lg = (const float*)p->in[9]; const float* lb = (const float*)p->in[10];
    float w[31];
#pragma unroll
    for (int j = 0; j < 31; ++j) w[j] = cw[j * 512 + c];
    float xin[94];
#pragma unroll
    for (int r = 0; r < 94; ++r) { const int s = s0 - 30 + r; xin[r] = bf2f(ub[(size_t)(s < 0 ? 0 : s) * 512]); }
    if (s0 == 0) {
#pragma unroll
        for (int r = 0; r < 30; ++r) xin[r] = 0.f;
    }
    float o[64];
    { const float bias = cb[c];
#pragma unroll
      for (int t = 0; t < 64; ++t) o[t] = bias; }
    conv_rows(o, w, xin, std::make_integer_sequence<int, 94>{});
    float s1, s2;
    {
        const bool b5 = lane & 32, b4 = lane & 16, b3 = lane & 8, b2 = lane & 4, b1 = lane & 2, b0 = lane & 1;
#define CONV_BFLY(RES, SQ) do { float a32[32]; \
        _Pragma("unroll") for (int i = 0; i < 32; ++i) { const float lo = SQ ? o[i] * o[i] : o[i], hi = SQ ? o[32 + i] * o[32 + i] : o[32 + i]; a32[i] = (b5 ? hi : lo) + __shfl_xor(b5 ? lo : hi, 32); } \
        float a16[16]; _Pragma("unroll") for (int i = 0; i < 16; ++i) a16[i] = (b4 ? a32[16 + i] : a32[i]) + __shfl_xor(b4 ? a32[i] : a32[16 + i], 16); \
        float a8[8]; _Pragma("unroll") for (int i = 0; i < 8; ++i) a8[i] = (b3 ? a16[8 + i] : a16[i]) + __shfl_xor(b3 ? a16[i] : a16[8 + i], 8); \
        float a4[4]; _Pragma("unroll") for (int i = 0; i < 4; ++i) a4[i] = (b2 ? a8[4 + i] : a8[i]) + __shfl_xor(b2 ? a8[i] : a8[4 + i], 4); \
        float a2[2]; _Pragma("unroll") for (int i = 0; i < 2; ++i) a2[i] = (b1 ? a4[2 + i] : a4[i]) + __shfl_xor(b1 ? a4[i] : a4[2 + i], 2); \
        RES = (b0 ? a2[1] : a2[0]) + __shfl_xor(b0 ? a2[0] : a2[1], 1); } while (0)
        CONV_BFLY(s1, false);
        asm volatile("" : "+v"(s1));
        CONV_BFLY(s2, true);
#undef CONV_BFLY
    }
    LAS float* red = (LAS float*)(lds + EPI_SCR);
    LAS float* stat = (LAS float*)(lds + EPI_SCR + 4096);
    red[(wave * 64 + lane) * 2] = s1; red[(wave * 64 + lane) * 2 + 1] = s2;
    __syncthreads();
    if (tid < 64) { float t1 = 0.f, t2 = 0.f;
#pragma unroll
        for (int k = 0; k < 8; ++k) { t1 += red[(k * 64 + tid) * 2]; t2 += red[(k * 64 + tid) * 2 + 1]; }
        const float mean = t1 * (1.0f / 512.0f); float var = t2 * (1.0f / 512.0f) - mean * mean; var = var < 0.f ? 0.f : var;
        stat[tid * 2] = mean; stat[tid * 2 + 1] = __builtin_amdgcn_rsqf(var + EPS); }
    __syncthreads();
    const float g = lg[c], bb = lb[c];
    bf16_t* cat = (bf16_t*)(p->ws + WS_CAT) + ((size_t)b * 4096 + s0) * 1024 + c;
#pragma unroll
    for (int t = 0; t < 64; ++t) { const float y = (o[t] - stat[t * 2]) * stat[t * 2 + 1] * g + bb; cat[(size_t)t * 1024] = f2bf(y * __builtin_amdgcn_rcpf(1.0f + __expf(-y))); }
    __syncthreads();
}

__device__ __forceinline__ void phase1c(CP p, LAS unsigned char* lds) {
#ifndef SUBREP
#define SUBREP -1
#endif
#pragma unroll 1
    for (int r_ = 0; r_ < (SUBREP == 0 ? 2 : 1); ++r_)
    for (int u = blockIdx.x; u < 256; u += gridDim.x) q_item(p, lds, u);
#pragma unroll 1
    for (int r_ = 0; r_ < (SUBREP == 1 ? 2 : 1); ++r_)
    for (int u = blockIdx.x; u < 256; u += gridDim.x) kv_item(p, lds, u);
    __syncthreads();
#pragma unroll 1
    for (int r_ = 0; r_ < (SUBREP == 2 ? 2 : 1); ++r_)
    for (int u = blockIdx.x; u < 512; u += gridDim.x) conv_unit(p, lds, u);
}

__device__ __forceinline__ int swap23(int r) { return (r & ~12) | ((r & 4) << 1) | ((r & 8) >> 1); }
constexpr int KROW = 208, VROW = 144, KBUF = 64 * KROW, VBUF = 64 * VROW, ABUF = KBUF + VBUF;
__device__ __forceinline__ void attn_unit(CP p, LAS unsigned char* lds, int bh, int qblk) {
    const int tid = threadIdx.x, lane = tid & 63, wid = __builtin_amdgcn_readfirstlane(tid >> 6), q = lane & 31, H = lane >> 5;
    unsigned char* ws = p->ws;
    const bf16_t* qg = (const bf16_t*)(ws + WS_Q) + (size_t)bh * 4096 * 96;
    const bf16_t* kg = (const bf16_t*)(ws + WS_K) + (size_t)bh * 4096 * 96;
    const bf16_t* vg = (const bf16_t*)(ws + WS_VT) + (size_t)bh * 64 * 4096;
    const int row0 = qblk * 256 + wid * 32, mychunk = 4 * qblk + (wid >> 1), NT = 4 * qblk + 4;
    bf16x8 qf[6];
#pragma unroll
    for (int s = 0; s < 6; ++s) qf[s] = *(const bf16x8*)(qg + (size_t)(row0 + q) * 96 + 16 * s + 8 * H);
    const int kr0 = tid / 12, kc0 = tid % 12, kr1 = (tid + 512) / 12, kc1 = (tid + 512) % 12, vd = tid >> 3, vc = tid & 7;
    const bool k1 = tid < 256;
    const bf16_t* ksrc0 = kg + (size_t)kr0 * 96 + kc0 * 8; const bf16_t* ksrc1 = kg + (size_t)kr1 * 96 + kc1 * 8; const bf16_t* vsrc = vg + (size_t)vd * 4096 + vc * 8;
    const int kdst0 = kr0 * KROW + kc0 * 16, kdst1 = kr1 * KROW + kc1 * 16, vdst = KBUF + vd * VROW + vc * 16;
    u32x4 rk0, rk1 = (u32x4){0, 0, 0, 0}, rv;
#define AT_LOAD(t) do { rk0 = *(const u32x4*)(ksrc0 + (size_t)(t) * 64 * 96); if (k1) rk1 = *(const u32x4*)(ksrc1 + (size_t)(t) * 64 * 96); rv = *(const u32x4*)(vsrc + (t) * 64); } while (0)
#define AT_WRITE(buf) do { LAS unsigned char* b_ = lds + (buf) * ABUF; *(LAS u32x4*)(b_ + kdst0) = rk0; if (k1) *(LAS u32x4*)(b_ + kdst1) = rk1; *(LAS u32x4*)(b_ + vdst) = rv; } while (0)
    AT_LOAD(0); AT_WRITE(0);
    __syncthreads();
    f32x16 o0 = {0}, o1 = {0};
    float mrun = -INFINITY, lsum = 0.f;
    const int koff = swap23(q) * KROW + 16 * H, voff = KBUF + q * VROW + 16 * H;
    for (int t = 0; t < NT; ++t) {
        if (t + 1 < NT) AT_LOAD(t + 1);
        if (t <= mychunk) {
            const LAS unsigned char* kb = lds + (t & 1) * ABUF + koff; const LAS unsigned char* vb = lds + (t & 1) * ABUF + voff;
            f32x16 s0 = {0}, s1 = {0};
#pragma unroll
            for (int s = 0; s < 6; ++s) {
                const bf16x8 a0 = *(const LAS bf16x8*)(kb + 32 * s), a1 = *(const LAS bf16x8*)(kb + 32 * KROW + 32 * s);
                s0 = __builtin_amdgcn_mfma_f32_32x32x16_bf16(a0, qf[s], s0, 0, 0, 0);
                s1 = __builtin_amdgcn_mfma_f32_32x32x16_bf16(a1, qf[s], s1, 0, 0, 0);
            }
            float mloc = s0[0];
#pragma unroll
            for (int r = 1; r < 16; ++r) mloc = fmaxf(mloc, s0[r]);
#pragma unroll
            for (int r = 0; r < 16; ++r) mloc = fmaxf(mloc, s1[r]);
            mloc = fmaxf(mloc, __shfl_xor(mloc, 32));
            const float mnew = fmaxf(mrun, mloc);
            const float alpha = __builtin_amdgcn_exp2f(mrun - mnew);
            mrun = mnew;
            float ps = 0.f;
#pragma unroll
            for (int r = 0; r < 16; ++r) { s0[r] = __builtin_amdgcn_exp2f(s0[r] - mnew); s1[r] = __builtin_amdgcn_exp2f(s1[r] - mnew); ps += s0[r] + s1[r]; }
            lsum = lsum * alpha + ps;
#pragma unroll
            for (int r = 0; r < 16; ++r) { o0[r] *= alpha; o1[r] *= alpha; }
            u32x4 pw[4];
            pw[0] = (u32x4){cvtpk(s0[0], s0[1]), cvtpk(s0[2], s0[3]), cvtpk(s0[4], s0[5]), cvtpk(s0[6], s0[7])};
            pw[1] = (u32x4){cvtpk(s0[8], s0[9]), cvtpk(s0[10], s0[11]), cvtpk(s0[12], s0[13]), cvtpk(s0[14], s0[15])};
            pw[2] = (u32x4){cvtpk(s1[0], s1[1]), cvtpk(s1[2], s1[3]), cvtpk(s1[4], s1[5]), cvtpk(s1[6], s1[7])};
            pw[3] = (u32x4){cvtpk(s1[8], s1[9]), cvtpk(s1[10], s1[11]), cvtpk(s1[12], s1[13]), cvtpk(s1[14], s1[15])};
#pragma unroll
            for (int ks = 0; ks < 4; ++ks) {
                const bf16x8 v0 = *(const LAS bf16x8*)(vb + 32 * ks), v1 = *(const LAS bf16x8*)(vb + 32 * VROW + 32 * ks);
                const bf16x8 pb = __builtin_bit_cast(bf16x8, pw[ks]);
                o0 = __builtin_amdgcn_mfma_f32_32x32x16_bf16(v0, pb, o0, 0, 0, 0);
                o1 = __builtin_amdgcn_mfma_f32_32x32x16_bf16(v1, pb, o1, 0, 0, 0);
            }
        }
        if (t + 1 < NT) AT_WRITE((t + 1) & 1);
        __syncthreads();
    }
#undef AT_LOAD
#undef AT_WRITE
    const float ltot = lsum + __shfl_xor(lsum, 32), inv = 1.0f / ltot;
    const int b = bh >> 3, hd = bh & 7;
    bf16_t* dst = (bf16_t*)(ws + WS_CAT) + ((size_t)b * 4096 + row0 + q) * 1024 + 512 + hd * 64;
#pragma unroll
    for (int g = 0; g < 4; ++g) {
        u32x2 w; w.x = cvtpk(o0[4 * g] * inv, o0[4 * g + 1] * inv); w.y = cvtpk(o0[4 * g + 2] * inv, o0[4 * g + 3] * inv); *(u32x2*)(dst + 8 * g + 4 * H) = w;
        w.x = cvtpk(o1[4 * g] * inv, o1[4 * g + 1] * inv); w.y = cvtpk(o1[4 * g + 2] * inv, o1[4 * g + 3] * inv); *(u32x2*)(dst + 32 + 8 * g + 4 * H) = w;
    }
}
constexpr int AF_NS = 6, AF_KB = 64 * 192, AF_STG = AF_KB + 64 * 128;
__device__ __forceinline__ void attn_unit_fast(CP p, LAS unsigned char* lds, int bh, int qblk) {
    const int tid = threadIdx.x, lane = tid & 63, wid = __builtin_amdgcn_readfirstlane(tid >> 6), q = lane & 31, H = lane >> 5;
    unsigned char* ws = p->ws;
    const bf16_t* qg = (const bf16_t*)(ws + WS_Q) + (size_t)bh * 4096 * 96;
    const bf16_t* kg = (const bf16_t*)(ws + WS_K) + (size_t)bh * 4096 * 96;
    const bf16_t* vg = (const bf16_t*)(ws + WS_VT) + (size_t)bh * 64 * 4096;
    const int row0 = qblk * 256 + wid * 32, mychunk = 4 * qblk + (wid >> 1), NT = 4 * qblk + 4;
    int ks0, ks1, vs0;
    { int P = wid * 64 + lane, r = P / 12, c = (P % 12) ^ ((r >> 2) & 3); ks0 = r * 96 + c * 8;
      P = (8 + (wid & 3)) * 64 + lane; r = P / 12; c = (P % 12) ^ ((r >> 2) & 3); ks1 = r * 96 + c * 8;
      P = wid * 64 + lane; r = P >> 3; c = (P & 7) ^ ((r >> 1) & 7); vs0 = r * 4096 + c * 8; }
    const bool two = wid < 4;
#define AF_ISSUE(u) do { const int u_ = (u) < NT ? (u) : NT - 1; LAS unsigned char* st_ = lds + ((u) % AF_NS) * AF_STG; \
        __builtin_amdgcn_global_load_lds((const unsigned*)(kg + (size_t)u_ * 64 * 96 + ks0), (LAS unsigned*)(st_ + wid * 1024), 16, 0, 0); \
        if (two) __builtin_amdgcn_global_load_lds((const unsigned*)(kg + (size_t)u_ * 64 * 96 + ks1), (LAS unsigned*)(st_ + (8 + wid) * 1024), 16, 0, 0); \
        __builtin_amdgcn_global_load_lds((const unsigned*)(vg + u_ * 64 + vs0), (LAS unsigned*)(st_ + AF_KB + wid * 1024), 16, 0, 0); } while (0)
#define AF_WAITBAR() do { if (two) asm volatile("s_waitcnt vmcnt(6)" ::: "memory"); else asm volatile("s_waitcnt vmcnt(4)" ::: "memory"); \
        asm volatile("s_waitcnt lgkmcnt(0)" ::: "memory"); __builtin_amdgcn_s_barrier(); asm volatile("" ::: "memory"); } while (0)
    static_assert(AF_NS == 6, "vmcnt immediates above are (AF_NS - 4) * pieces per tile");
    const int pr = swap23(q), kx = (pr >> 2) & 3;
    const int kbe = pr * 192 + 16 * ((H ^ (kx & 1)) + 2 * (kx >> 1)), kbo = pr * 192 + 16 * ((H ^ (kx & 1)) + 2 * (1 ^ (kx >> 1)));
    const int vx = (q >> 1) & 7, vbase = AF_KB + q * 128 + 16 * (H ^ (vx & 1)), vxx = (vx >> 1) * 32;
    bf16x8 qf[6];
#pragma unroll
    for (int s = 0; s < 6; ++s) qf[s] = *(const bf16x8*)(qg + (size_t)(row0 + q) * 96 + 16 * s + 8 * H);
#define AF_QK(S0, S1, u) do { const LAS unsigned char* kb_ = lds + ((u) % AF_NS) * AF_STG; \
        { const bf16x8 a0_ = *(const LAS bf16x8*)(kb_ + kbe), a1_ = *(const LAS bf16x8*)(kb_ + kbe + 32 * 192); \
          S0 = __builtin_amdgcn_mfma_f32_32x32x16_bf16(a0_, qf[0], (f32x16){0.f, 0.f, 0.f, 0.f, 0.f, 0.f, 0.f, 0.f, 0.f, 0.f, 0.f, 0.f, 0.f, 0.f, 0.f, 0.f}, 0, 0, 0); \
          S1 = __builtin_amdgcn_mfma_f32_32x32x16_bf16(a1_, qf[0], (f32x16){0.f, 0.f, 0.f, 0.f, 0.f, 0.f, 0.f, 0.f, 0.f, 0.f, 0.f, 0.f, 0.f, 0.f, 0.f, 0.f}, 0, 0, 0); } \
        _Pragma("unroll") for (int s_ = 1; s_ < 6; ++s_) { const int o_ = ((s_ & 1) ? kbo : kbe) + 64 * (s_ >> 1); \
            const bf16x8 a0_ = *(const LAS bf16x8*)(kb_ + o_), a1_ = *(const LAS bf16x8*)(kb_ + o_ + 32 * 192); \
            S0 = __builtin_amdgcn_mfma_f32_32x32x16_bf16(a0_, qf[s_], S0, 0, 0, 0); \
            S1 = __builtin_amdgcn_mfma_f32_32x32x16_bf16(a1_, qf[s_], S1, 0, 0, 0); } } while (0)
    asm volatile("s_waitcnt vmcnt(0) lgkmcnt(0)" ::: "memory"); __builtin_amdgcn_s_barrier(); asm volatile("" ::: "memory");
    AF_ISSUE(0); AF_ISSUE(1); AF_ISSUE(2); AF_ISSUE(3);
    AF_WAITBAR();
    f32x16 o0 = {0}, o1 = {0}, c0, c1;
    float lsum = 0.f;
    AF_QK(c0, c1, 0);
    for (int t = 0; t < NT; ++t) {
        AF_ISSUE(t + AF_NS - 2);
        if (t <= mychunk) {
            f32x16 n0, n1;
            AF_QK(n0, n1, t + 1);
            float ps = 0.f;
#pragma unroll
            for (int r = 0; r < 16; ++r) { c0[r] = __builtin_amdgcn_exp2f(c0[r]); c1[r] = __builtin_amdgcn_exp2f(c1[r]); ps += c0[r] + c1[r]; }
            lsum += ps;
            u32x4 pw[4];
            pw[0] = (u32x4){cvtpk(c0[0], c0[1]), cvtpk(c0[2], c0[3]), cvtpk(c0[4], c0[5]), cvtpk(c0[6], c0[7])};
            pw[1] = (u32x4){cvtpk(c0[8], c0[9]), cvtpk(c0[10], c0[11]), cvtpk(c0[12], c0[13]), cvtpk(c0[14], c0[15])};
            pw[2] = (u32x4){cvtpk(c1[0], c1[1]), cvtpk(c1[2], c1[3]), cvtpk(c1[4], c1[5]), cvtpk(c1[6], c1[7])};
            pw[3] = (u32x4){cvtpk(c1[8], c1[9]), cvtpk(c1[10], c1[11]), cvtpk(c1[12], c1[13]), cvtpk(c1[14], c1[15])};
            const LAS unsigned char* vb = lds + (t % AF_NS) * AF_STG + vbase;
#pragma unroll
            for (int ks = 0; ks < 4; ++ks) {
                const int vo = (ks * 32) ^ vxx;
                const bf16x8 v0 = *(const LAS bf16x8*)(vb + vo), v1 = *(const LAS bf16x8*)(vb + vo + 32 * 128);
                const bf16x8 pb = __builtin_bit_cast(bf16x8, pw[ks]);
                o0 = __builtin_amdgcn_mfma_f32_32x32x16_bf16(v0, pb, o0, 0, 0, 0);
                o1 = __builtin_amdgcn_mfma_f32_32x32x16_bf16(v1, pb, o1, 0, 0, 0);
            }
            c0 = n0; c1 = n1;
        }
        AF_WAITBAR();
    }
#undef AF_ISSUE
#undef AF_WAITBAR
#undef AF_QK
    const float ltot = lsum + __shfl_xor(lsum, 32), inv = 1.0f / ltot;
    const int b = bh >> 3, hd = bh & 7;
    bf16_t* dst = (bf16_t*)(ws + WS_CAT) + ((size_t)b * 4096 + row0 + q) * 1024 + 512 + hd * 64;
#pragma unroll
    for (int g = 0; g < 4; ++g) {
        u32x2 w; w.x = cvtpk(o0[4 * g] * inv, o0[4 * g + 1] * inv); w.y = cvtpk(o0[4 * g + 2] * inv, o0[4 * g + 3] * inv); *(u32x2*)(dst + 8 * g + 4 * H) = w;
        w.x = cvtpk(o1[4 * g] * inv, o1[4 * g + 1] * inv); w.y = cvtpk(o1[4 * g + 2] * inv, o1[4 * g + 3] * inv); *(u32x2*)(dst + 32 + 8 * g + 4 * H) = w;
    }
}
__device__ __forceinline__ void phase2(CP p, LAS unsigned char* lds) {
    const int lane = threadIdx.x & 63;
    const float* qn = (const float*)p->in[15]; const float* kn = (const float*)p->in[16];
    float mq = 0.f, mk = 0.f;
    for (int j = lane; j < 96; j += 64) { mq = fmaxf(mq, fabsf(qn[j])); mk = fmaxf(mk, fabsf(kn[j])); }
#pragma unroll
    for (int o = 1; o < 64; o <<= 1) { mq = fmaxf(mq, __shfl_xor(mq, o)); mk = fmaxf(mk, __shfl_xor(mk, o)); }
    const float bound = 96.0f * mq * mk * QSCALE * 1.01f;
    if (bound <= 40.0f) {
        for (int u = vcu_id(); u < 512; u += gridDim.x) { const int bh = u >> 3, pr = u & 7; attn_unit_fast(p, lds, bh, 15 - pr); attn_unit_fast(p, lds, bh, pr); }
    } else {
        for (int u = vcu_id(); u < 512; u += gridDim.x) { const int bh = u >> 3, pr = u & 7; attn_unit(p, lds, bh, 15 - pr); attn_unit(p, lds, bh, pr); }
    }
    asm volatile("s_waitcnt vmcnt(0)" ::: "memory"); __syncthreads();
}

__device__ __forceinline__ void phase3(CP p, LAS unsigned char* lds) {
    const int tid = threadIdx.x, lane = tid & 63, wid = __builtin_amdgcn_readfirstlane(tid >> 6), wr = wid >> 2, wc = wid & 3, fr = lane & 15, fq = lane >> 4;
    unsigned char* ws = p->ws;
    const float* x = (const float*)p->in[0]; const float* mod = (const float*)(ws + WS_MOD); float* sq1 = (float*)(ws + WS_SSQ1);
    for (int u = vcu_id(); u < 512; u += gridDim.x) {
        const int pm = u >> 2, pn = u & 3;
        const bf16_t* ap[4]; const bf16_t* bp[4];
        stage_ptrs_dense<4>((const bf16_t*)(ws + WS_CAT), 1024, pm * 256, ap); stage_ptrs_dense<4>((const bf16_t*)(ws + WS_WOUT), 1024, pn * 256, bp);
        f32x4 acc[8][4];
#pragma unroll
        for (int m = 0; m < 8; ++m)
#pragma unroll
            for (int n = 0; n < 4; ++n) acc[m][n] = (f32x4){0.f, 0.f, 0.f, 0.f};
        gemm_block<8, 4, true>(lds, ap, bp, 16, acc);
        const int rowb = pm * 256 + wr * 128 + fr, b = (pm * 256) >> 12, colb = pn * 256 + wc * 64 + fq * 4;
        f32x4 ga[4];
#pragma unroll
        for (int n = 0; n < 4; ++n) ga[n] = *(const f32x4*)(mod + b * 6144 + 2048 + colb + n * 16);
#pragma unroll
        for (int mb = 0; mb < 8; mb += 4) {
            f32x4 xv[4][4];
#pragma unroll
            for (int m = 0; m < 4; ++m)
#pragma unroll
                for (int n = 0; n < 4; ++n) xv[m][n] = *(const f32x4*)(x + (size_t)(rowb + (mb + m) * 16) * DM + colb + n * 16);
#pragma unroll
            for (int m = 0; m < 4; ++m) { const size_t row = rowb + (mb + m) * 16; float s = 0.f;
#pragma unroll
                for (int n = 0; n < 4; ++n) { const f32x4 v = xv[m][n] + ga[n] * acc[mb + m][n];
                    *(f32x4*)(p->out + row * DM + colb + n * 16) = v; s += (v.x * v.x + v.y * v.y) + (v.z * v.z + v.w * v.w); }
                s += __shfl_xor(s, 16); s += __shfl_xor(s, 32);
                if (fq == 0) sq1[row * 16 + pn * 4 + wc] = s; }
        }
    }
}

constexpr int RROW = 2064;
__device__ __forceinline__ void phase3b(CP p, LAS unsigned char* lds, bool dry) {
    const int tid = threadIdx.x, lane = tid & 63, wave = __builtin_amdgcn_readfirstlane(tid >> 6), fr = lane & 15, fq = lane >> 4;
    unsigned char* ws = p->ws;
    const float* nf = (const float*)p->in[18]; const float* mod = (const float*)(ws + WS_MOD); const float* sq1 = (const float*)(ws + WS_SSQ1);
    const float* bg = (const float*)p->in[20]; const float* be = (const float*)p->in[22];
    bf16_t* h2 = (bf16_t*)(ws + WS_H); const bf16_t* wrh = (const bf16_t*)(ws + WS_WR); const bf16_t* wrl = wrh + 48 * 1024;
    LAS unsigned char* Ahi = lds; LAS unsigned char* Alo = lds + 32 * RROW; LAS float* part = (LAS float*)lds; LAS float* lg = (LAS float*)(lds + 8 * 32 * 48 * 4);
    unsigned* ctl = (unsigned*)(ws + WS_CTL); int* lists = (int*)(ws + WS_LIST); int* blists = (int*)(ws + WS_BLIST); float* tokw = (float*)(ws + WS_TOKW);
    bf16x8 Bh[3][4], Bl[3][4];
#pragma unroll
    for (int nt = 0; nt < 3; ++nt)
#pragma unroll
        for (int kk = 0; kk < 4; ++kk) { const size_t o = (size_t)(nt * 16 + fr) * 1024 + wave * 128 + kk * 32 + fq * 8; Bh[nt][kk] = *(const bf16x8*)(wrh + o); Bl[nt][kk] = *(const bf16x8*)(wrl + o); }
#pragma unroll 1
    for (int tile = blockIdx.x; tile < MT / 32; tile += gridDim.x) {
        const int r0 = tile * 32, b = r0 >> 12;
        {
            f32x4 gm[4], sh[4];
#pragma unroll
            for (int j = 0; j < 4; ++j) { const int col = 4 * lane + 256 * j; const f32x4 g = *(const f32x4*)(nf + col), s = *(const f32x4*)(mod + b * 6144 + 4096 + col);
                gm[j] = g * (s + 1.0f); sh[j] = *(const f32x4*)(mod + b * 6144 + 3072 + col); }
#pragma unroll
            for (int rb = 0; rb < 4; rb += 2) {
                f32x4 xr[2][4]; float rs[2];
#pragma unroll
                for (int rr = 0; rr < 2; ++rr) { const size_t row = r0 + wave * 4 + rb + rr; float ss = 0.f;
#pragma unroll
                    for (int k = 0; k < 4; ++k) { const f32x4 s4 = *(const f32x4*)(sq1 + row * 16 + 4 * k); ss += (s4.x + s4.y) + (s4.z + s4.w); }
                    rs[rr] = ss;
#pragma unroll
                    for (int j = 0; j < 4; ++j) xr[rr][j] = *(const f32x4*)(p->out + row * DM + 4 * lane + 256 * j); }
#pragma unroll
                for (int rr = 0; rr < 2; ++rr) {
                    const int lr = wave * 4 + rb + rr; const size_t row = r0 + lr;
                    const float rstd = __builtin_amdgcn_rsqf(rs[rr] * (1.0f / DM) + EPS);
#pragma unroll
                    for (int j = 0; j < 4; ++j) { const int col = 4 * lane + 256 * j; const f32x4 xv = xr[rr][j];
                        const f32x4 o = xv * rstd * gm[j] + sh[j];
                        u32x2 w; w.x = cvtpk(o.x, o.y); w.y = cvtpk(o.z, o.w);
                        *(u32x2*)(h2 + row * DM + col) = w; *(LAS u32x2*)(Ahi + lr * RROW + col * 2) = w;
                        const float lx = o.x - __builtin_bit_cast(float, w.x << 16), ly = o.y - __builtin_bit_cast(float, w.x & 0xffff0000u), lz = o.z - __builtin_bit_cast(float, w.y << 16), lw = o.w - __builtin_bit_cast(float, w.y & 0xffff0000u);
                        u32x2 wl; wl.x = cvtpk(lx, ly); wl.y = cvtpk(lz, lw); *(LAS u32x2*)(Alo + lr * RROW + col * 2) = wl; }
                }
            }
        }
        __syncthreads();
        f32x4 P[2][3];
#pragma unroll
        for (int mt = 0; mt < 2; ++mt)
#pragma unroll
            for (int nt = 0; nt < 3; ++nt) P[mt][nt] = (f32x4){0.f, 0.f, 0.f, 0.f};
#pragma unroll
        for (int mt = 0; mt < 2; ++mt)
#pragma unroll
            for (int kk = 0; kk < 4; ++kk) {
                const int ao = (mt * 16 + fr) * RROW + (wave * 128 + kk * 32 + fq * 8) * 2;
                const bf16x8 a_h = *(const LAS bf16x8*)(Ahi + ao), a_l = *(const LAS bf16x8*)(Alo + ao);
#pragma unroll
                for (int nt = 0; nt < 3; ++nt) {
                    P[mt][nt] = __builtin_amdgcn_mfma_f32_16x16x32_bf16(a_h, Bh[nt][kk], P[mt][nt], 0, 0, 0);
                    P[mt][nt] = __builtin_amdgcn_mfma_f32_16x16x32_bf16(a_l, Bh[nt][kk], P[mt][nt], 0, 0, 0);
                    P[mt][nt] = __builtin_amdgcn_mfma_f32_16x16x32_bf16(a_h, Bl[nt][kk], P[mt][nt], 0, 0, 0);
                }
            }
        __syncthreads();
#pragma unroll
        for (int mt = 0; mt < 2; ++mt)
#pragma unroll
            for (int nt = 0; nt < 3; ++nt)
#pragma unroll
                for (int j = 0; j < 4; ++j) part[(wave * 32 + mt * 16 + fq * 4 + j) * 48 + nt * 16 + fr] = P[mt][nt][j];
        __syncthreads();
#pragma unroll
        for (int i = 0; i < 3; ++i) { const int idx = tid + 512 * i; float v = 0.f;
#pragma unroll
            for (int w8 = 0; w8 < 8; ++w8) v += part[w8 * 1536 + idx];
            lg[idx] = v; }
        __syncthreads();
        if (tid < 32 && !dry) {
            const LAS float* l = lg + tid * 48; const int tok = r0 + tid;
            float gl[4]; int gi = 0; float gmx;
#pragma unroll
            for (int i = 0; i < 4; ++i) gl[i] = l[i] + bg[i];
            gmx = gl[0];
#pragma unroll
            for (int i = 1; i < 4; ++i) if (gl[i] > gmx) { gmx = gl[i]; gi = i; }
            float gs = 0.f;
#pragma unroll
            for (int i = 0; i < 4; ++i) gs += __expf(gl[i] - gmx);
            const float gtop = 1.0f / gs;
            float el[8];
#pragma unroll
            for (int i = 0; i < 8; ++i) el[i] = l[4 + gi * 8 + i] + be[gi * 8 + i];
            int e1 = 0; float m1 = el[0];
#pragma unroll
            for (int i = 1; i < 8; ++i) if (el[i] > m1) { m1 = el[i]; e1 = i; }
            int e2 = -1; float m2 = -INFINITY;
#pragma unroll
            for (int i = 0; i < 8; ++i) if (i != e1 && el[i] > m2) { m2 = el[i]; e2 = i; }
            const float p2 = __expf(m2 - m1);
            const float w1 = gtop / (1.0f + p2), w2 = gtop * p2 / (1.0f + p2);
            const int lo = e1 < e2 ? e1 : e2, hi = e1 < e2 ? e2 : e1;
            const float wlo = e1 < e2 ? w1 : w2, whi = e1 < e2 ? w2 : w1;
            const int bk = gi * 28 + lo * 8 - ((lo * (lo + 1)) >> 1) + (hi - lo - 1);
            const int El = gi * 8 + lo, Eh = gi * 8 + hi;
            const unsigned p1 = atomicAdd(ctl + CW_CNT + 64 * El, 1u), pp2 = atomicAdd(ctl + CW_CNT + 64 * Eh, 1u), p3 = atomicAdd(ctl + CW_CNT + 64 * (32 + bk), 1u);
            lists[(size_t)El * MT + p1] = tok * 2; lists[(size_t)Eh * MT + pp2] = tok * 2 + 1;
            blists[(size_t)bk * MT + p3] = tok;
            tokw[tok * 2] = wlo; tokw[tok * 2 + 1] = whi;
        }
        __syncthreads();
    }
}

struct U4a { int e, rt, ct, cnt; };
__device__ __forceinline__ int prefix_find(const LAS unsigned* pre, int n, int u) {
    const int lane = threadIdx.x & 63; int res = -1;
    for (int b0 = 0; b0 < n; b0 += 64) { const int i = b0 + lane; const bool hit = i < n && (int)pre[i] <= u && u < (int)pre[i + 1];
        const unsigned long long m = __ballot(hit); if (m) { res = b0 + __builtin_ctzll(m); break; } }
    return res;
}
__device__ __forceinline__ bool p4a_find(const LAS unsigned* cnts, const LAS unsigned* pre, int u, U4a& r) {
    const int i = prefix_find(pre, 32, u); if (i < 0) return false;
    const int uu = u - (int)pre[i]; r.e = i; r.rt = uu >> 2; r.ct = uu & 3; r.cnt = (int)cnts[i]; return true;
}
__device__ __forceinline__ void p4a_ptrs(CP p, const U4a& u, const bf16_t* (&ap)[4], const bf16_t* (&bp)[2]) {
    const int tid = threadIdx.x, lane = tid & 63;
    const int* lst = (const int*)(p->ws + WS_LIST) + (size_t)u.e * MT + u.rt * 256; const int nrow = u.cnt - u.rt * 256;
    const bf16_t* h2 = (const bf16_t*)(p->ws + WS_H);
    int tok[4], C[4];
#pragma unroll
    for (int i = 0; i < 4; ++i) { int R; stage_rc2((tid >> 6) * 1024 + i * 8192 + lane * 16, R, C[i]); tok[i] = lst[R < nrow ? R : 0] >> 1; }
#pragma unroll
    for (int i = 0; i < 4; ++i) ap[i] = h2 + (size_t)tok[i] * 1024 + C[i];
    stage_ptrs_dense<2>((const bf16_t*)(p->ws + WS_WGU) + (size_t)u.e * 512 * 1024, 1024, u.ct * 128, bp);
}
__device__ __forceinline__ void phase4a(CP p, LAS unsigned char* lds, const LAS unsigned* cnts, const LAS unsigned* pre) {
    const int tid = threadIdx.x, lane = tid & 63, wid = __builtin_amdgcn_readfirstlane(tid >> 6), wr = wid >> 2, wc = wid & 3, fr = lane & 15, fq = lane >> 4;
    unsigned char* ws = p->ws;
    const float* tokw = (const float*)(ws + WS_TOKW); bf16_t* ab = (bf16_t*)(ws + WS_ABUF);
    int u = vcu_id(); U4a cur;
    if (!p4a_find(cnts, pre, u, cur)) return;
    const bf16_t* ap[4]; const bf16_t* bp[2];
    p4a_ptrs(p, cur, ap, bp);
    __syncthreads();
    gemm_stage<8, 2, false>(lds, 0, ap, bp, 0, 0);
    for (;;) {
        f32x4 acc[8][2];
#pragma unroll
        for (int m = 0; m < 8; ++m)
#pragma unroll
            for (int n = 0; n < 2; ++n) acc[m][n] = (f32x4){0.f, 0.f, 0.f, 0.f};
        gemm_main<8, 2, true, false>(lds, 0, ap, bp, 16, acc);
        U4a nxt; u += gridDim.x; const bool has_next = p4a_find(cnts, pre, u, nxt);
        if (has_next) { p4a_ptrs(p, nxt, ap, bp); gemm_stage<8, 2, false>(lds, 0, ap, bp, 0, 0); }
        const int* lst = (const int*)(ws + WS_LIST) + (size_t)cur.e * MT + cur.rt * 256; const int nrow = cur.cnt - cur.rt * 256;
        int ent[8]; float w[8];
#pragma unroll
        for (int m = 0; m < 8; ++m) { const int R = wr * 128 + m * 16 + fr; ent[m] = lst[R < nrow ? R : 0]; }
#pragma unroll
        for (int m = 0; m < 8; ++m) w[m] = tokw[ent[m]];
        const int ch = cur.ct * 64 + wc * 16 + fq * 4;
#pragma unroll
        for (int m = 0; m < 8; ++m) { const int R = wr * 128 + m * 16 + fr; const f32x4 g = acc[m][0], uu = acc[m][1]; const float wm = w[m];
            u32x2 o; o.x = cvtpk(g.x * __builtin_amdgcn_rcpf(1.0f + __expf(-g.x)) * uu.x * wm, g.y * __builtin_amdgcn_rcpf(1.0f + __expf(-g.y)) * uu.y * wm);
            o.y = cvtpk(g.z * __builtin_amdgcn_rcpf(1.0f + __expf(-g.z)) * uu.z * wm, g.w * __builtin_amdgcn_rcpf(1.0f + __expf(-g.w)) * uu.w * wm);
            if (R < nrow) *(u32x2*)(ab + (size_t)ent[m] * 256 + ch) = o; }
        if (!has_next) break;
        cur = nxt;
    }
    asm volatile("s_waitcnt vmcnt(0)" ::: "memory"); __syncthreads();
}
struct U4b { int bk, rt, ct, cnt; };
__device__ __forceinline__ bool p4b_find(const LAS unsigned* cnts, const LAS unsigned* pre, int u, U4b& r) {
    const int i = prefix_find(pre + 33, 112, u); if (i < 0) return false;
    const int uu = u - (int)pre[33 + i]; r.bk = i; r.rt = uu >> 2; r.ct = uu & 3; r.cnt = (int)cnts[32 + i]; return true;
}
__device__ __forceinline__ void p4b_ptrs(CP p, const U4b& u, const bf16_t* (&ap)[2], const bf16_t* (&bp)[4], const bf16_t* (&bq)[4]) {
    const int tid = threadIdx.x, lane = tid & 63;
    const int g = u.bk / 28; int pi = u.bk % 28, lo = 0; while (pi >= 7 - lo) { pi -= 7 - lo; ++lo; } const int hi = lo + 1 + pi;
    const int* lst = (const int*)(p->ws + WS_BLIST) + (size_t)u.bk * MT + u.rt * 128; const int nrow = u.cnt - u.rt * 128;
    const bf16_t* ab = (const bf16_t*)(p->ws + WS_ABUF);
#pragma unroll
    for (int i = 0; i < 2; ++i) { int R, C; stage_rc2((tid >> 6) * 1024 + i * 8192 + lane * 16, R, C); const int tok = lst[R < nrow ? R : 0]; ap[i] = ab + (size_t)tok * 512 + C; }
    stage_ptrs_dense<4>((const bf16_t*)(p->ws + WS_WD) + (size_t)(g * 8 + lo) * 1024 * 256, 256, u.ct * 256, bp);
    stage_ptrs_dense<4>((const bf16_t*)(p->ws + WS_WD) + (size_t)(g * 8 + hi) * 1024 * 256, 256, u.ct * 256, bq);
#pragma unroll
    for (int i = 0; i < 4; ++i) bq[i] -= 256;
}
__device__ __forceinline__ void phase4b(CP p, LAS unsigned char* lds, const LAS unsigned* cnts, const LAS unsigned* pre) {
    const int tid = threadIdx.x, lane = tid & 63, wid = __builtin_amdgcn_readfirstlane(tid >> 6), wr = wid >> 2, wc = wid & 3, fr = lane & 15, fq = lane >> 4;
    unsigned char* ws = p->ws;
    const float* mod = (const float*)(ws + WS_MOD); float* out = p->out;
    int u = vcu_id(); U4b cur;
    if (!p4b_find(cnts, pre, u, cur)) return;
    const bf16_t* ap[2]; const bf16_t* bp[4]; const bf16_t* bq[4];
    p4b_ptrs(p, cur, ap, bp, bq);
    int tok[4];
    { const int* lst = (const int*)(ws + WS_BLIST) + (size_t)cur.bk * MT + cur.rt * 128; const int nrow = cur.cnt - cur.rt * 128;
#pragma unroll
      for (int m = 0; m < 4; ++m) { const int R = wr * 64 + m * 16 + fr; tok[m] = lst[R < nrow ? R : 0]; } }
    __syncthreads();
    gemm_stage<4, 4, false>(lds, 0, ap, bp, 0, 0);
    for (;;) {
        const int colb = cur.ct * 256 + wc * 64 + fq * 4; const int nrow = cur.cnt - cur.rt * 128;
        f32x4 old[4][4];
#pragma unroll
        for (int m = 0; m < 4; ++m)
#pragma unroll
            for (int n = 0; n < 4; ++n) old[m][n] = *(const f32x4*)(out + (size_t)tok[m] * DM + colb + n * 16);
        f32x4 acc[4][4];
#pragma unroll
        for (int m = 0; m < 4; ++m)
#pragma unroll
            for (int n = 0; n < 4; ++n) acc[m][n] = (f32x4){0.f, 0.f, 0.f, 0.f};
        gemm_main2<4, 4, true, false>(lds, 0, ap, bp, bq, 4, 8, acc);
        U4b nxt; u += gridDim.x; const bool has_next = p4b_find(cnts, pre, u, nxt);
        int tokn[4] = {0, 0, 0, 0};
        if (has_next) { p4b_ptrs(p, nxt, ap, bp, bq); gemm_stage<4, 4, false>(lds, 0, ap, bp, 0, 0);
            const int* lst = (const int*)(ws + WS_BLIST) + (size_t)nxt.bk * MT + nxt.rt * 128; const int nr2 = nxt.cnt - nxt.rt * 128;
#pragma unroll
            for (int m = 0; m < 4; ++m) { const int R = wr * 64 + m * 16 + fr; tokn[m] = lst[R < nr2 ? R : 0]; } }
#pragma unroll
        for (int m = 0; m < 4; ++m) { const int R = wr * 64 + m * 16 + fr; const int b = tok[m] >> 12;
#pragma unroll
            for (int n = 0; n < 4; ++n) { const f32x4 gf = *(const f32x4*)(mod + b * 6144 + 5120 + colb + n * 16);
                const f32x4 o = old[m][n] + gf * acc[m][n]; if (R < nrow) *(f32x4*)(out + (size_t)tok[m] * DM + colb + n * 16) = o; } }
        if (!has_next) break;
        cur = nxt;
#pragma unroll
        for (int m = 0; m < 4; ++m) tok[m] = tokn[m];
    }
    asm volatile("s_waitcnt vmcnt(0)" ::: "memory"); __syncthreads();
}

__global__ void __launch_bounds__(512, 2) hybrid_block_fwd(Params p) {
    extern __shared__ __attribute__((aligned(16))) unsigned char lds_raw[];
    LAS unsigned char* lds = (LAS unsigned char*)lds_raw;
    volatile LAS unsigned* MISC = (volatile LAS unsigned*)(lds + MISC_OFF);
    LAS unsigned* cnts = (LAS unsigned*)(lds + MISC_OFF + 256);
    const int tid = threadIdx.x;
    if (tid < 16) MISC[tid] = 0u;
    __syncthreads();
    unsigned* ctl = (unsigned*)(p.ws + WS_CTL);
    const bool single = (p.ph_hi - p.ph_lo) > 1;
    XcdBarrier bar; bar.bar = ctl + CW_BAR; bar.x = 0; bar.st = nullptr;
    if (single) bar = xcd_barrier_post(ctl + CW_BAR, MISC + 8);
#ifndef PH_MASK
#define PH_MASK 0x1ff
#endif
#define IN(k) (((PH_MASK >> (k)) & 1) && p.ph_lo <= (k) && (k) < p.ph_hi)
#define SEAM(k) do { if (IN(k) && IN((k) + 1)) xcd_barrier(bar); } while (0)
#ifndef REPEAT_PH
#define REPEAT_PH -1
#endif
#define NREP(k) ((REPEAT_PH == (k)) ? 2 : 1)
    if (IN(0)) { for (int r_ = 0; r_ < NREP(0); ++r_) phase0(get_params(), lds); } SEAM(0);
    if (IN(1)) { for (int r_ = 0; r_ < NREP(1); ++r_) phase1a(get_params()); } SEAM(1);
    if (IN(2)) { for (int r_ = 0; r_ < NREP(2); ++r_) phase1b(get_params(), lds); } SEAM(2);
    if (IN(3)) { for (int r_ = 0; r_ < NREP(3); ++r_) phase1c(get_params(), lds); } SEAM(3);
    if (IN(4)) { for (int r_ = 0; r_ < NREP(4); ++r_) phase2(get_params(), lds); } SEAM(4);
    if (IN(5)) { for (int r_ = 0; r_ < NREP(5); ++r_) phase3(get_params(), lds); } SEAM(5);
    if (IN(6)) { for (int r_ = 0; r_ < NREP(6); ++r_) phase3b(get_params(), lds, r_ + 1 < NREP(6)); } SEAM(6);
    LAS unsigned* pre = (LAS unsigned*)(lds + MISC_OFF + 256 + 640);
    if (IN(7) || IN(8)) {
        if (tid < 144) cnts[tid] = __hip_atomic_load(ctl + CW_CNT + 64 * tid, __ATOMIC_RELAXED, __HIP_MEMORY_SCOPE_AGENT);
        __syncthreads();
        if (tid == 0) { unsigned a = 0; for (int i = 0; i < 32; ++i) { pre[i] = a; a += ((cnts[i] + 255u) >> 8) * 4u; } pre[32] = a;
                        a = 0; for (int i = 0; i < 112; ++i) { pre[33 + i] = a; a += ((cnts[32 + i] + 127u) >> 7) * 4u; } pre[33 + 112] = a; }
        __syncthreads();
    }
    if (IN(7)) { for (int r_ = 0; r_ < NREP(7); ++r_) phase4a(get_params(), lds, cnts, pre); } SEAM(7);
    if (IN(8)) { phase4b(get_params(), lds, cnts, pre); }
#undef IN
#undef SEAM
}

extern "C" void kernel_launch(void* const* d_in, const int* in_sizes, int n_in, void* d_out, int out_size, void* d_ws, size_t ws_size, hipStream_t stream) {
    static int grid = 0;
    if (grid == 0) {
        if (n_in != 26 || out_size != MT * DM || ws_size < WS_END) { fprintf(stderr, "kernel_launch: unexpected problem (n_in %d out %d ws %zu)\n", n_in, out_size, ws_size); grid = -1; return; }
        int dev = 0, cus = 0, per_cu = 0;
        hipGetDevice(&dev); hipDeviceGetAttribute(&cus, hipDeviceAttributeMultiprocessorCount, dev);
        hipFuncSetAttribute((const void*)hybrid_block_fwd, hipFuncAttributeMaxDynamicSharedMemorySize, LDS_BYTES);
        hipOccupancyMaxActiveBlocksPerMultiprocessor(&per_cu, (const void*)hybrid_block_fwd, 512, LDS_BYTES);
        (void)hipGetLastError();
        if (per_cu < 1) { fprintf(stderr, "kernel_launch: occupancy query says %d blocks/CU\n", per_cu); per_cu = 1; }
        grid = cus;
    }
    if (grid < 0) return;
    hipMemsetAsync((char*)d_ws + WS_CTL, 0, CTL_BYTES, stream);
    Params prm{};
    for (int i = 0; i < 26; ++i) prm.in[i] = d_in[i];
    prm.out = (float*)d_out; prm.ws = (unsigned char*)d_ws;
#if N_LAUNCH_SPLIT
    for (int ph = 0; ph <= DBG_LAST_PHASE; ++ph) { prm.ph_lo = ph; prm.ph_hi = ph + 1; hipLaunchKernelGGL(hybrid_block_fwd, dim3(grid), dim3(512), LDS_BYTES, stream, prm); }
#else
    prm.ph_lo = 0; prm.ph_hi = DBG_LAST_PHASE + 1;
    hipLaunchKernelGGL(hybrid_block_fwd, dim3(grid), dim3(512), LDS_BYTES, stream, prm);
#endif
}
```

```cpp
#include <hip/hip_runtime.h>
#include <cstdio>
#include <cstdint>
#include <utility>

#ifndef N_LAUNCH_SPLIT
#define N_LAUNCH_SPLIT 0
#endif
#ifndef DBG_LAST_PHASE
#define DBG_LAST_PHASE 8
#endif

#define LAS __attribute__((address_space(3)))
#define GAS __attribute__((address_space(1)))
typedef unsigned short bf16_t;
typedef short bf16x8 __attribute__((ext_vector_type(8)));
typedef float f32x4 __attribute__((ext_vector_type(4)));
typedef float f32x2 __attribute__((ext_vector_type(2)));
typedef float f32x16 __attribute__((ext_vector_type(16)));
typedef unsigned u32x4 __attribute__((ext_vector_type(4)));
typedef unsigned u32x2 __attribute__((ext_vector_type(2)));
typedef __bf16 bf16x2_t __attribute__((ext_vector_type(2)));

constexpr int NB = 8, SEQ = 4096, DM = 1024, MT = NB * SEQ;
constexpr int NHEAD = 8, DQK = 96, DV = 64;
constexpr int NEXP = 32;
constexpr float EPS = 1e-6f;
constexpr float QSCALE = 0.14724444602590306f;
constexpr int NPH = 9;

constexpr size_t MiB = 1u << 20;
constexpr size_t WS_CTL = 0, CTL_BYTES = 1 * MiB;
constexpr size_t WS_MOD = 1 * MiB;
constexpr size_t WS_ROPE = 2 * MiB;
constexpr size_t WS_WIN = 6 * MiB;
constexpr size_t WS_WQ = 9 * MiB;
constexpr size_t WS_WKV = 9 * MiB + 512 * 1024;
constexpr size_t WS_WR = 9 * MiB + 768 * 1024;
constexpr size_t WS_WOUT = 10 * MiB;
constexpr size_t WS_WGU = 12 * MiB;
constexpr size_t WS_WD = 44 * MiB;
constexpr size_t WS_SSQQ = 60 * MiB;
constexpr size_t WS_SSQKV = 60 * MiB + 512 * 1024;
constexpr size_t WS_SSQKR = 60 * MiB + 768 * 1024;
constexpr size_t WS_SSQ1 = 61 * MiB;
constexpr size_t WS_TOKW = 63 * MiB;
constexpr size_t WS_KROPE = 64 * MiB;
constexpr size_t WS_CQ = 68 * MiB;
constexpr size_t WS_CKV = 84 * MiB;
constexpr size_t WS_LIST = 92 * MiB;
constexpr size_t WS_H = 100 * MiB;
constexpr size_t WS_U = 164 * MiB;
constexpr size_t WS_Q = 196 * MiB;
constexpr size_t WS_K = 244 * MiB;
constexpr size_t WS_VT = 292 * MiB;
constexpr size_t WS_CAT = 324 * MiB;
constexpr size_t WS_ABUF = 388 * MiB;
constexpr size_t WS_BLIST = 420 * MiB;
constexpr size_t WS_END = 435 * MiB;
constexpr int CW_BAR = 4096;
constexpr int CW_CNT = 16384;

constexpr int SCR_BYTES = 155648;
constexpr int MISC_OFF = SCR_BYTES;
constexpr int LDS_BYTES = SCR_BYTES + 2048;

__device__ __forceinline__ unsigned cvtpk(float lo, float hi) { f32x2 v = {lo, hi}; bf16x2_t b = __builtin_convertvector(v, bf16x2_t); return __builtin_bit_cast(unsigned, b); }
__device__ __forceinline__ float bf2f(unsigned short h) { return __builtin_bit_cast(float, (unsigned)h << 16); }
__device__ __forceinline__ unsigned short f2bf(float f) { return (unsigned short)(cvtpk(f, 0.f) & 0xffffu); }
__device__ __forceinline__ float sigmoidf_(float x) { return __builtin_amdgcn_rcpf(1.0f + __expf(-x)); }
__device__ __forceinline__ float siluf_(float x) { return x * __builtin_amdgcn_rcpf(1.0f + __expf(-x)); }
__device__ __forceinline__ float wave_sum(float v) {
#pragma unroll
    for (int o = 1; o < 64; o <<= 1) v += __shfl_xor(v, o);
    return v;
}

__device__ __forceinline__ int vcu_id() { const int g = gridDim.x, b = blockIdx.x; return (g & 7) == 0 ? (b & 7) * (g >> 3) + (b >> 3) : b; }
#define XB_TMO      128
#define XB_XCNT(j)  (256  + 64 * (j))
#define XB_XSUB(j)  (1280 + 64 * (j))
#define XB_XGEN(j)  (2304 + 64 * (j))
#define XB_TOP      3328
#define XB_TOPGEN   3392
#define XCD_BAR_WORDS 3456
#define XB_SPIN_CAP (1u << 20)
__device__ __forceinline__ unsigned xb_ld(unsigned* p)              { return __hip_atomic_load(p, __ATOMIC_RELAXED, __HIP_MEMORY_SCOPE_AGENT); }
__device__ __forceinline__ unsigned xb_add(unsigned* p, unsigned v) { return __hip_atomic_fetch_add(p, v, __ATOMIC_RELAXED, __HIP_MEMORY_SCOPE_AGENT); }
__device__ __forceinline__ unsigned xb_xcc_id() { return (unsigned)__builtin_amdgcn_s_getreg((3 << 11) | 20) & 0xFu; }
#define XB_SPIN(cond, bar) do { unsigned _sp = 0; while (cond) { __builtin_amdgcn_s_sleep(1); \
    if ((++_sp & 255u) == 0u) { if (xb_ld(&(bar)[XB_TMO])) break; if (_sp > XB_SPIN_CAP) { atomicAdd(&(bar)[XB_TMO], 1u); break; } } } } while (0)
struct XcdBarrier { unsigned* bar; unsigned x; volatile LAS unsigned* st; };
__device__ __forceinline__ XcdBarrier xcd_barrier_post(unsigned* bar, volatile LAS unsigned* st) {
    XcdBarrier b; b.bar = bar; b.x = xb_xcc_id(); b.st = st;
    if (threadIdx.x == 0) (void)xb_add(&bar[XB_XCNT(b.x)], 1u);
    return b;
}
__device__ __forceinline__ void xcd_barrier_complete(unsigned* bar, unsigned x, unsigned& nloc, unsigned& nx) {
    const unsigned G = gridDim.x * gridDim.y * gridDim.z;
    unsigned sum, cnt, mine, sp = 0u;
    for (;;) {
        sum = 0u; cnt = 0u; mine = 0u;
#pragma unroll
        for (unsigned j = 0; j < 16; ++j) { const unsigned c = xb_ld(&bar[XB_XCNT(j)]); sum += c; cnt += (c > 0u) ? 1u : 0u; mine = (j == x) ? c : mine; }
        if (sum == G) break;
        __builtin_amdgcn_s_sleep(1);
        if ((++sp & 255u) == 0u) { if (xb_ld(&bar[XB_TMO])) break; if (sp > XB_SPIN_CAP) { atomicAdd(&bar[XB_TMO], 1u); break; } }
    }
    nloc = mine > 0u ? mine : 1u; nx = cnt > 0u ? cnt : 1u;
}
__device__ __forceinline__ void xcd_barrier(const XcdBarrier& b) {
    asm volatile("s_waitcnt vmcnt(0)" ::: "memory");
    __syncthreads();
    if (threadIdx.x == 0) {
        unsigned* bar = b.bar;
        __builtin_amdgcn_s_waitcnt(0);
        unsigned nloc = b.st[0], nx = b.st[1];
        if (nloc == 0u) { xcd_barrier_complete(bar, b.x, nloc, nx); b.st[0] = nloc; b.st[1] = nx; }
        const unsigned old = xb_add(&bar[XB_XSUB(b.x)], 1u);
        const unsigned gen = old / nloc;
        if (old + 1u == (gen + 1u) * nloc) {
            __builtin_amdgcn_fence(__ATOMIC_RELEASE, "agent");
            asm volatile("s_waitcnt vmcnt(0)" ::: "memory");
            const unsigned og = xb_add(&bar[XB_TOP], 1u);
            const unsigned tg = og / nx;
            if (og + 1u == (tg + 1u) * nx) xb_add(&bar[XB_TOPGEN], 1u);
            else XB_SPIN(xb_ld(&bar[XB_TOPGEN]) == tg, bar);
            __builtin_amdgcn_fence(__ATOMIC_ACQUIRE, "agent");
            xb_add(&bar[XB_XGEN(b.x)], 1u);
            asm volatile("s_waitcnt vmcnt(0)" ::: "memory");
        } else {
            XB_SPIN(xb_ld(&bar[XB_XGEN(b.x)]) == gen, bar);
            __builtin_amdgcn_fence(__ATOMIC_ACQUIRE, "agent");
            asm volatile("s_waitcnt vmcnt(0)" ::: "memory");
        }
    }
    __syncthreads();
}

__device__ __forceinline__ int lds_byte2(int r, int c) { const int st = (r >> 4) * 2 + (c >> 5), ob = (r & 15) * 64 + (c & 31) * 2; return st * 1024 + (ob ^ (((ob >> 9) & 1) << 5)); }
__device__ __forceinline__ void stage_rc2(int b, int& R, int& C) { const int st = b >> 10, sb = b & 1023, swz = sb ^ (((sb >> 9) & 1) << 5); R = (st >> 1) * 16 + swz / 64; C = (st & 1) * 32 + (swz % 64) / 2; }

template <int MI, int NI, bool TRANS>
__device__ __forceinline__ void gemm_block(LAS unsigned char* lds, const bf16_t* const (&ap)[MI / 2], const bf16_t* const (&bp)[NI], int nkt, f32x4 (&acc)[MI][NI]) {
    constexpr int BM = 32 * MI, BN = 64 * NI, TA = BM * 128, TB = BN * 128, STG = TA + TB, GLA = MI / 2, GLB = NI;
    static_assert(2 * STG <= SCR_BYTES, "LDS");
    const int tid = threadIdx.x, lane = tid & 63, wid = __builtin_amdgcn_readfirstlane(tid >> 6), wr = wid >> 2, wc = wid & 3, fr = lane & 15, fq = lane >> 4;
    const int aoff = lds_byte2(wr * (MI * 16) + fr, fq * 8), boff = TA + lds_byte2(wc * (NI * 16) + fr, fq * 8);
#define GB_STAGE(buf, kt) do { \
        _Pragma("unroll") for (int i_ = 0; i_ < GLA; ++i_) __builtin_amdgcn_global_load_lds((const unsigned*)(ap[i_] + (kt) * 64), (LAS unsigned*)(lds + (buf) * STG + wid * 1024 + i_ * 8192), 16, 0, 0); \
        _Pragma("unroll") for (int i_ = 0; i_ < GLB; ++i_) __builtin_amdgcn_global_load_lds((const unsigned*)(bp[i_] + (kt) * 64), (LAS unsigned*)(lds + (buf) * STG + TA + wid * 1024 + i_ * 8192), 16, 0, 0); } while (0)
    GB_STAGE(0, 0);
    asm volatile("s_waitcnt vmcnt(0)" ::: "memory"); __syncthreads();
    for (int t = 0; t < nkt; ++t) {
        const int cur = t & 1;
        if (t + 1 < nkt) GB_STAGE(cur ^ 1, t + 1);
        const LAS unsigned char* sb = lds + cur * STG;
#pragma unroll
        for (int ks = 0; ks < 2; ++ks) {
            bf16x8 At[MI], Bf[NI];
#pragma unroll
            for (int m = 0; m < MI; ++m) At[m] = *(const LAS bf16x8*)(sb + aoff + m * 2048 + ks * 1024);
#pragma unroll
            for (int n = 0; n < NI; ++n) Bf[n] = *(const LAS bf16x8*)(sb + boff + n * 2048 + ks * 1024);
#pragma unroll
            for (int m = 0; m < MI; ++m)
#pragma unroll
                for (int n = 0; n < NI; ++n)
                    acc[m][n] = TRANS ? __builtin_amdgcn_mfma_f32_16x16x32_bf16(Bf[n], At[m], acc[m][n], 0, 0, 0)
                                      : __builtin_amdgcn_mfma_f32_16x16x32_bf16(At[m], Bf[n], acc[m][n], 0, 0, 0);
        }
        asm volatile("s_waitcnt vmcnt(0)" ::: "memory"); __syncthreads();
    }
#undef GB_STAGE
}
template <int MI, int NI, bool ARES>
__device__ __forceinline__ void gemm_stage(LAS unsigned char* lds, int abytes, const bf16_t* const (&ap)[MI / 2], const bf16_t* const (&bp)[NI], int buf, int kt) {
    constexpr int TA = MI * 32 * 128, TB = NI * 64 * 128, STG = ARES ? TB : TA + TB;
    const int wid = __builtin_amdgcn_readfirstlane(threadIdx.x >> 6);
    LAS unsigned char* base = lds + (ARES ? abytes : 0) + buf * STG + wid * 1024;
    if (!ARES) {
#pragma unroll
        for (int i = 0; i < MI / 2; ++i) __builtin_amdgcn_global_load_lds((const unsigned*)(ap[i] + kt * 64), (LAS unsigned*)(base + i * 8192), 16, 0, 0);
    }
#pragma unroll
    for (int i = 0; i < NI; ++i) __builtin_amdgcn_global_load_lds((const unsigned*)(bp[i] + kt * 64), (LAS unsigned*)(base + (ARES ? 0 : TA) + i * 8192), 16, 0, 0);
}
template <int MI>
__device__ __forceinline__ void gemm_load_ares(LAS unsigned char* lds, const bf16_t* const (&ap)[MI / 2], int nkt) {
    constexpr int TA = MI * 32 * 128;
    const int wid = __builtin_amdgcn_readfirstlane(threadIdx.x >> 6);
    for (int kt = 0; kt < nkt; ++kt) {
#pragma unroll
        for (int i = 0; i < MI / 2; ++i) __builtin_amdgcn_global_load_lds((const unsigned*)(ap[i] + kt * 64), (LAS unsigned*)(lds + kt * TA + wid * 1024 + i * 8192), 16, 0, 0);
    }
}
template <int MI, int NI, bool TRANS, bool ARES>
__device__ __forceinline__ void gemm_main2(LAS unsigned char* lds, int abytes, const bf16_t* const (&ap)[MI / 2], const bf16_t* const (&bp)[NI], const bf16_t* const (&bq)[NI], int ksplit, int nkt, f32x4 (&acc)[MI][NI]) {
    constexpr int TA = MI * 32 * 128, TB = NI * 64 * 128, STG = ARES ? TB : TA + TB;
    const int tid = threadIdx.x, lane = tid & 63, wid = __builtin_amdgcn_readfirstlane(tid >> 6), wr = wid >> 2, wc = wid & 3, fr = lane & 15, fq = lane >> 4;
    const int aoff = lds_byte2(wr * (MI * 16) + fr, fq * 8), boff = (ARES ? abytes : TA) + lds_byte2(wc * (NI * 16) + fr, fq * 8);
#pragma unroll 1
    for (int t = 0; t < nkt; ++t) {
        const int cur = t & 1;
        asm volatile("s_waitcnt vmcnt(0)" ::: "memory"); __syncthreads();
        if (t + 1 < nkt) { if (t + 1 < ksplit) gemm_stage<MI, NI, ARES>(lds, abytes, ap, bp, cur ^ 1, t + 1); else gemm_stage<MI, NI, ARES>(lds, abytes, ap, bq, cur ^ 1, t + 1); }
        const LAS unsigned char* sa = ARES ? lds + t * TA : lds + cur * STG;
        const LAS unsigned char* sb = lds + cur * STG;
#pragma unroll
        for (int ks = 0; ks < 2; ++ks) {
            bf16x8 At[MI], Bf[NI];
#pragma unroll
            for (int m = 0; m < MI; ++m) At[m] = *(const LAS bf16x8*)(sa + aoff + m * 2048 + ks * 1024);
#pragma unroll
            for (int n = 0; n < NI; ++n) Bf[n] = *(const LAS bf16x8*)(sb + boff + n * 2048 + ks * 1024);
#pragma unroll
            for (int m = 0; m < MI; ++m)
#pragma unroll
                for (int n = 0; n < NI; ++n)
                    acc[m][n] = TRANS ? __builtin_amdgcn_mfma_f32_16x16x32_bf16(Bf[n], At[m], acc[m][n], 0, 0, 0)
                                      : __builtin_amdgcn_mfma_f32_16x16x32_bf16(At[m], Bf[n], acc[m][n], 0, 0, 0);
        }
    }
    if (nkt & 1) __syncthreads();
}
template <int MI, int NI, bool TRANS, bool ARES>
__device__ __forceinline__ void gemm_main(LAS unsigned char* lds, int abytes, const bf16_t* const (&ap)[MI / 2], const bf16_t* const (&bp)[NI], int nkt, f32x4 (&acc)[MI][NI]) {
    gemm_main2<MI, NI, TRANS, ARES>(lds, abytes, ap, bp, bp, nkt, nkt, acc);
}
template <int GL>
__device__ __forceinline__ void stage_ptrs_dense(const bf16_t* base, size_t ld, int r0, const bf16_t* (&p)[GL]) {
    const int tid = threadIdx.x, lane = tid & 63, wid = tid >> 6;
#pragma unroll
    for (int i = 0; i < GL; ++i) { int R, C; stage_rc2(wid * 1024 + i * 8192 + lane * 16, R, C); p[i] = base + (size_t)(r0 + R) * ld + C; }
}

struct Params {
    const void* in[26];
    float* out;
    unsigned char* ws;
    int ph_lo, ph_hi;
};
typedef const __attribute__((address_space(4))) Params* CP;
__device__ __forceinline__ CP get_params() { CP q = (CP)__builtin_amdgcn_kernarg_segment_ptr(); asm volatile("" : "+s"(q)); return q; }

__device__ const float INVF[16] = {1.000000000e+00f, 5.623413324e-01f, 3.162277639e-01f, 1.778279394e-01f, 1.000000015e-01f, 5.623413250e-02f, 3.162277490e-02f, 1.778279431e-02f,
                                   9.999999776e-03f, 5.623413250e-03f, 3.162277630e-03f, 1.778279431e-03f, 1.000000047e-03f, 5.623413017e-04f, 3.162277571e-04f, 1.778279402e-04f};

__device__ __forceinline__ void tr_item(const float* srcp, int ldw, const float* kscale, bf16_t* WT, int Kd, int k0, int n0, LAS float* scr, int lane) {
#pragma unroll 8
    for (int i = 0; i < 32; ++i) { const int kk = 2 * i + (lane >> 5); float v = 0.f; if (srcp) { v = srcp[(size_t)(k0 + kk) * ldw]; if (kscale) v *= kscale[k0 + kk]; } scr[kk * 33 + (lane & 31)] = v; }
    asm volatile("s_waitcnt lgkmcnt(0)" ::: "memory");
    const int c = lane & 7;
#pragma unroll
    for (int j = 0; j < 4; ++j) { const int n = (lane >> 3) + 8 * j; const LAS float* s = scr + (8 * c) * 33 + n;
        u32x4 o; o.x = cvtpk(s[0 * 33], s[1 * 33]); o.y = cvtpk(s[2 * 33], s[3 * 33]); o.z = cvtpk(s[4 * 33], s[5 * 33]); o.w = cvtpk(s[6 * 33], s[7 * 33]);
        *(u32x4*)(WT + (size_t)(n0 + n) * Kd + k0 + 8 * c) = o; }
    asm volatile("s_waitcnt lgkmcnt(0)" ::: "memory");
}

__device__ __forceinline__ void phase0(CP p, LAS unsigned char* lds) {
    const int tid = threadIdx.x, lane = tid & 63, wave = __builtin_amdgcn_readfirstlane(tid >> 6);
    const int G = gridDim.x, bid = blockIdx.x;
    unsigned char* ws = p->ws;
    if (bid < 192) {
        const float* c = (const float*)p->in[1]; const float* w_ada = (const float*)p->in[3]; const float* b_ada = (const float*)p->in[4];
        LAS float* sc = (LAS float*)lds;
        LAS float* red = (LAS float*)(lds + 32768);
        for (int i = tid; i < 8192; i += 512) sc[i] = siluf_(c[i]);
        __syncthreads();
        const int col = tid & 31, ks = tid >> 5, n0 = bid * 32;
        float a[8] = {0, 0, 0, 0, 0, 0, 0, 0};
#pragma unroll 8
        for (int i = 0; i < 64; ++i) { const int k = ks * 64 + i; const float w = w_ada[(size_t)k * 6144 + n0 + col];
#pragma unroll
            for (int b = 0; b < 8; ++b) a[b] += sc[b * 1024 + k] * w; }
#pragma unroll
        for (int b = 0; b < 8; ++b) red[(ks * 32 + col) * 8 + b] = a[b];
        __syncthreads();
        if (tid < 256) { const int cc = tid & 31, b = tid >> 5; float s = 0.f;
#pragma unroll
            for (int k2 = 0; k2 < 16; ++k2) s += red[(k2 * 32 + cc) * 8 + b];
            ((float*)(ws + WS_MOD))[b * 6144 + n0 + cc] = s + b_ada[n0 + cc]; }
        __syncthreads();
    }
    {
        const int* pos = (const int*)p->in[2]; f32x2* rt = (f32x2*)(ws + WS_ROPE);
        for (int e = bid * 512 + tid; e < MT * 16; e += G * 512) {
            const int tok = e >> 4, i = e & 15;
            const float a32 = (float)pos[tok] * INVF[i];
            const double rev = (double)a32 * 0.15915494309189535;
            const float fr = (float)(rev - __builtin_rint(rev));
            rt[e] = (f32x2){__builtin_amdgcn_cosf(fr), __builtin_amdgcn_sinf(fr)};
        }
    }
    {
        LAS unsigned* scr = (LAS unsigned*)(lds + 65536) + wave * 2112;
        const int gw = bid * 8 + wave, NGW = G * 8;
        const float* w_in = (const float*)p->in[6]; const float* qan = (const float*)p->in[11]; const float* w_qb = (const float*)p->in[12];
        const float* kvan = (const float*)p->in[13]; const float* w_kvb = (const float*)p->in[14]; const float* w_out = (const float*)p->in[17];
        const float* w_group = (const float*)p->in[19]; const float* w_expert = (const float*)p->in[21];
        const float* w_gate = (const float*)p->in[23]; const float* w_up = (const float*)p->in[24]; const float* w_down = (const float*)p->in[25];
        constexpr int I0 = 16 * 24, I1 = 4 * 16, I2 = 2 * 16, I3 = 16 * 16, I4 = 32 * 128, I5 = 32 * 64, I6 = 16 * 2;
        constexpr int NIT = I0 + I1 + I2 + I3 + I4 + I5 + I6;
        const int c4 = lane & 15, kp = lane >> 4;
        for (int it = gw; it < NIT; it += NGW) {
            int r = it;
            if (r >= NIT - I6) {
                r -= NIT - I6;
                LAS float* fscr = (LAS float*)scr; const int nl = lane & 31;
                const int kb = r >> 1, nb = r & 1, n0 = nb * 32, np = n0 + nl, k0 = kb * 64;
                const float* srcp = nullptr; int ldw = 0;
                if (np < 4) { srcp = w_group + np; ldw = 4; } else if (np < 36) { srcp = w_expert + (np - 4); ldw = 32; }
#pragma unroll 8
                for (int i = 0; i < 32; ++i) { const int kk = 2 * i + (lane >> 5); fscr[kk * 33 + nl] = srcp ? srcp[(size_t)(k0 + kk) * ldw] : 0.f; }
                asm volatile("s_waitcnt lgkmcnt(0)" ::: "memory");
                const int c = lane & 7;
#pragma unroll
                for (int j = 0; j < 4; ++j) { const int n = (lane >> 3) + 8 * j; const LAS float* sp = fscr + (8 * c) * 33 + n;
                    float v[8], l[8];
#pragma unroll
                    for (int q = 0; q < 8; ++q) { v[q] = sp[q * 33]; l[q] = v[q] - bf2f(f2bf(v[q])); }
                    if (n0 + n < 48) {
                        u32x4 o; o.x = cvtpk(v[0], v[1]); o.y = cvtpk(v[2], v[3]); o.z = cvtpk(v[4], v[5]); o.w = cvtpk(v[6], v[7]);
                        *(u32x4*)((bf16_t*)(ws + WS_WR) + (size_t)(n0 + n) * 1024 + k0 + 8 * c) = o;
                        u32x4 o2; o2.x = cvtpk(l[0], l[1]); o2.y = cvtpk(l[2], l[3]); o2.z = cvtpk(l[4], l[5]); o2.w = cvtpk(l[6], l[7]);
                        *(u32x4*)((bf16_t*)(ws + WS_WR) + 48 * 1024 + (size_t)(n0 + n) * 1024 + k0 + 8 * c) = o2; } }
                asm volatile("s_waitcnt lgkmcnt(0)" ::: "memory");
                continue;
            }
            const float* srcp; int ldw, Kd, k0, n0; const float* ksc = nullptr; bf16_t* WT;
            if (r < I0) {
                const int kb = r / 24, nb = r % 24; n0 = nb * 64; k0 = kb * 64; const int np = n0 + 4 * c4;
                const int pn = np >> 8, wc = (np >> 6) & 3, n = (np >> 4) & 3, f = np & 15; int src;
                if (pn < 4) { const int ch = pn * 128 + wc * 32 + (n >> 1) * 16 + f; src = (n & 1) ? 512 + ch : ch; }
                else if (pn == 4) src = np;
                else { const int j = np - 1280; src = (j < 160) ? 1280 + j : -1; }
                srcp = src >= 0 ? w_in + src : nullptr; ldw = 1440; Kd = 1024; WT = (bf16_t*)(ws + WS_WIN);
            } else if ((r -= I0) < I1) {
                const int kb = r / 16, nb = r % 16; n0 = nb * 64; k0 = kb * 64; const int np = n0 + 4 * c4, hd = np >> 7, j = np & 127;
                srcp = j < 96 ? w_qb + hd * 96 + j : nullptr; ldw = 768; Kd = 256; ksc = qan; WT = (bf16_t*)(ws + WS_WQ);
            } else if ((r -= I1) < I2) {
                const int kb = r / 16, nb = r % 16; n0 = nb * 64; k0 = kb * 64;
                srcp = w_kvb + n0 + 4 * c4; ldw = 1024; Kd = 128; ksc = kvan; WT = (bf16_t*)(ws + WS_WKV);
            } else if ((r -= I2) < I3) {
                const int kb = r / 16, nb = r % 16; n0 = nb * 64; k0 = kb * 64;
                srcp = w_out + n0 + 4 * c4; ldw = 1024; Kd = 1024; WT = (bf16_t*)(ws + WS_WOUT);
            } else if ((r -= I3) < I4) {
                const int e = r >> 7, q = r & 127, kb = q / 8, nb = q % 8; n0 = nb * 64; k0 = kb * 64; const int np = n0 + 4 * c4;
                const int ct = np >> 8, wc = (np >> 6) & 3, n = (np >> 4) & 3, f = np & 15, ch = ct * 128 + wc * 32 + (n >> 1) * 16 + f;
                srcp = ((n & 1) ? w_up : w_gate) + (size_t)e * 1024 * 256 + ch; ldw = 256; Kd = 1024; WT = (bf16_t*)(ws + WS_WGU) + (size_t)e * 512 * 1024;
            } else {
                r -= I4; const int e = r >> 6, q = r & 63, kb = q / 16, nb = q % 16; n0 = nb * 64; k0 = kb * 64;
                srcp = w_down + (size_t)e * 256 * 1024 + n0 + 4 * c4; ldw = 1024; Kd = 256; WT = (bf16_t*)(ws + WS_WD) + (size_t)e * 1024 * 256;
            }
            f32x4 v0[8], v1[8];
#pragma unroll
            for (int i = 0; i < 8; ++i) { const int k = k0 + 8 * i + 2 * kp;
                if (srcp) { v0[i] = *(const f32x4*)(srcp + (size_t)k * ldw); v1[i] = *(const f32x4*)(srcp + (size_t)(k + 1) * ldw); }
                else { v0[i] = (f32x4){0.f, 0.f, 0.f, 0.f}; v1[i] = v0[i]; } }
#pragma unroll
            for (int i = 0; i < 8; ++i) { const int k = k0 + 8 * i + 2 * kp; f32x4 a = v0[i], b = v1[i];
                if (ksc) { a = a * ksc[k]; b = b * ksc[k + 1]; }
                LAS unsigned* d = scr + (4 * c4) * 33 + 4 * i + kp;
                d[0] = cvtpk(a.x, b.x); d[33] = cvtpk(a.y, b.y); d[66] = cvtpk(a.z, b.z); d[99] = cvtpk(a.w, b.w); }
            asm volatile("s_waitcnt lgkmcnt(0)" ::: "memory");
            const int c = lane & 7;
#pragma unroll
            for (int j = 0; j < 8; ++j) { const int n = (lane >> 3) + 8 * j; const LAS unsigned* sp = scr + n * 33 + 4 * c;
                u32x4 o; o.x = sp[0]; o.y = sp[1]; o.z = sp[2]; o.w = sp[3];
                *(u32x4*)(WT + (size_t)(n0 + n) * Kd + k0 + 8 * c) = o; }
            asm volatile("s_waitcnt lgkmcnt(0)" ::: "memory");
        }
    }
}

__device__ __forceinline__ void phase1a(CP p) {
    const int tid = threadIdx.x, lane = tid & 63, wave = tid >> 6;
    const int gw = blockIdx.x * 8 + wave, NGW = gridDim.x * 8;
    const float* x = (const float*)p->in[0]; const float* nm = (const float*)p->in[5]; const float* mod = (const float*)(p->ws + WS_MOD);
    bf16_t* h = (bf16_t*)(p->ws + WS_H);
    for (int grp = gw; grp < MT / 16; grp += NGW) {
        const int r0 = grp * 16, b = r0 >> 12;
        f32x4 gm[4], sh[4];
#pragma unroll
        for (int j = 0; j < 4; ++j) { const int col = 4 * lane + 256 * j; const f32x4 g = *(const f32x4*)(nm + col), s = *(const f32x4*)(mod + b * 6144 + 1024 + col);
            gm[j] = g * (s + 1.0f); sh[j] = *(const f32x4*)(mod + b * 6144 + col); }
#pragma unroll 1
        for (int rb = 0; rb < 16; rb += 4) {
            f32x4 v[4][4];
#pragma unroll
            for (int rr = 0; rr < 4; ++rr) { const float* xr = x + (size_t)(r0 + rb + rr) * DM;
#pragma unroll
                for (int j = 0; j < 4; ++j) v[rr][j] = *(const f32x4*)(xr + 4 * lane + 256 * j); }
#pragma unroll
            for (int rr = 0; rr < 4; ++rr) { float s = 0.f;
#pragma unroll
                for (int j = 0; j < 4; ++j) s += (v[rr][j].x * v[rr][j].x + v[rr][j].y * v[rr][j].y) + (v[rr][j].z * v[rr][j].z + v[rr][j].w * v[rr][j].w);
                const float rstd = __builtin_amdgcn_rsqf(wave_sum(s) * (1.0f / DM) + EPS);
                bf16_t* hr = h + (size_t)(r0 + rb + rr) * DM;
#pragma unroll
                for (int j = 0; j < 4; ++j) { const f32x4 o = v[rr][j] * rstd * gm[j] + sh[j]; u32x2 w; w.x = cvtpk(o.x, o.y); w.y = cvtpk(o.z, o.w); *(u32x2*)(hr + 4 * lane + 256 * j) = w; } }
        }
    }
}

__device__ __forceinline__ void phase1b(CP p, LAS unsigned char* lds) {
    const int tid = threadIdx.x, lane = tid & 63, wid = __builtin_amdgcn_readfirstlane(tid >> 6), wr = wid >> 2, wc = wid & 3, fr = lane & 15, fq = lane >> 4;
    unsigned char* ws = p->ws;
    const bf16_t* h = (const bf16_t*)(ws + WS_H); const bf16_t* win = (const bf16_t*)(ws + WS_WIN);
    for (int u = vcu_id(); u < 128 * 6; u += gridDim.x) {
        const int pm = u / 6, pn = u % 6;
        const bf16_t* ap[4]; const bf16_t* bp[4];
        stage_ptrs_dense<4>(h, 1024, pm * 256, ap); stage_ptrs_dense<4>(win, 1024, pn * 256, bp);
        f32x4 acc[8][4];
#pragma unroll
        for (int m = 0; m < 8; ++m)
#pragma unroll
            for (int n = 0; n < 4; ++n) acc[m][n] = (f32x4){0.f, 0.f, 0.f, 0.f};
        gemm_block<8, 4, true>(lds, ap, bp, 16, acc);
        const int rowb = pm * 256 + wr * 128 + fr;
        if (pn < 4) {
            bf16_t* ub = (bf16_t*)(ws + WS_U);
#pragma unroll
            for (int m = 0; m < 8; ++m) { const size_t row = rowb + m * 16;
#pragma unroll
                for (int h2 = 0; h2 < 2; ++h2) { const f32x4 v = acc[m][2 * h2], g = acc[m][2 * h2 + 1];
                    const int ch = pn * 128 + wc * 32 + h2 * 16 + fq * 4;
                    u32x2 w; w.x = cvtpk(v.x * sigmoidf_(g.x), v.y * sigmoidf_(g.y)); w.y = cvtpk(v.z * sigmoidf_(g.z), v.w * sigmoidf_(g.w));
                    *(u32x2*)(ub + row * 512 + ch) = w; } }
        } else if (pn == 4) {
            bf16_t* cq = (bf16_t*)(ws + WS_CQ); float* sq = (float*)(ws + WS_SSQQ);
#pragma unroll
            for (int m = 0; m < 8; ++m) { const size_t row = rowb + m * 16; float s = 0.f;
#pragma unroll
                for (int n = 0; n < 4; ++n) { const f32x4 v = acc[m][n]; s += (v.x * v.x + v.y * v.y) + (v.z * v.z + v.w * v.w);
                    u32x2 w; w.x = cvtpk(v.x, v.y); w.y = cvtpk(v.z, v.w); *(u32x2*)(cq + row * 256 + wc * 64 + n * 16 + fq * 4) = w; }
                s += __shfl_xor(s, 16); s += __shfl_xor(s, 32);
                if (fq == 0) sq[row * 4 + wc] = s; }
        } else {
            if (wc < 2) {
                bf16_t* ckv = (bf16_t*)(ws + WS_CKV); float* sq = (float*)(ws + WS_SSQKV);
#pragma unroll
                for (int m = 0; m < 8; ++m) { const size_t row = rowb + m * 16; float s = 0.f;
#pragma unroll
                    for (int n = 0; n < 4; ++n) { const f32x4 v = acc[m][n]; s += (v.x * v.x + v.y * v.y) + (v.z * v.z + v.w * v.w);
                        u32x2 w; w.x = cvtpk(v.x, v.y); w.y = cvtpk(v.z, v.w); *(u32x2*)(ckv + row * 128 + wc * 64 + n * 16 + fq * 4) = w; }
                    s += __shfl_xor(s, 16); s += __shfl_xor(s, 32);
                    if (fq == 0) sq[row * 2 + wc] = s; }
            } else if (wc == 2) {
                float* kr = (float*)(ws + WS_KROPE); float* sq = (float*)(ws + WS_SSQKR);
#pragma unroll
                for (int m = 0; m < 8; ++m) { const size_t row = rowb + m * 16; float s = 0.f;
#pragma unroll
                    for (int n = 0; n < 2; ++n) { const f32x4 v = acc[m][n]; s += (v.x * v.x + v.y * v.y) + (v.z * v.z + v.w * v.w);
                        *(f32x4*)(kr + row * 32 + n * 16 + fq * 4) = v; }
                    s += __shfl_xor(s, 16); s += __shfl_xor(s, 32);
                    if (fq == 0) sq[row] = s; }
            }
        }
    }
}

constexpr int EPI_SCR = 131072;
__device__ __forceinline__ void q_item(CP p, LAS unsigned char* lds, int pm) {
    const int tid = threadIdx.x, lane = tid & 63, wid = __builtin_amdgcn_readfirstlane(tid >> 6), wr = wid >> 2, wc = wid & 3, fr = lane & 15, fq = lane >> 4;
    unsigned char* ws = p->ws;
    const bf16_t* ap[2]; const bf16_t* bp[4];
    stage_ptrs_dense<2>((const bf16_t*)(ws + WS_CQ), 256, pm * 128, ap);
    stage_ptrs_dense<4>((const bf16_t*)(ws + WS_WQ), 256, 0, bp);
    __syncthreads();
    gemm_load_ares<4>(lds, ap, 4);
    gemm_stage<4, 4, true>(lds, 65536, ap, bp, 0, 0);
    const float* sq = (const float*)(ws + WS_SSQQ); const float* qn = (const float*)p->in[15];
    LAS float* part = (LAS float*)(lds + EPI_SCR);
    const int rowb = pm * 128 + wr * 64 + fr;
    float rq[4];
#pragma unroll
    for (int m = 0; m < 4; ++m) { const f32x4 s4 = *(const f32x4*)(sq + (size_t)(rowb + m * 16) * 4); rq[m] = 1.0f / sqrtf(((s4.x + s4.y) + (s4.z + s4.w)) * (1.0f / 256.0f) + EPS); }
    bf16_t* qb = (bf16_t*)(ws + WS_Q); const f32x2* rope = (const f32x2*)(ws + WS_ROPE);
    const int i0 = fq * 4;
    f32x4 gq[4], cs01[4], cs23[4];
    if ((wc & 1) == 0) {
#pragma unroll
        for (int n = 0; n < 4; ++n) gq[n] = *(const f32x4*)(qn + n * 16 + i0);
#pragma unroll
        for (int m = 0; m < 4; ++m) { cs01[m] = (f32x4){0.f, 0.f, 0.f, 0.f}; cs23[m] = cs01[m]; }
    } else {
        gq[0] = *(const f32x4*)(qn + 64 + i0); gq[1] = *(const f32x4*)(qn + 80 + i0); gq[2] = gq[0]; gq[3] = gq[1];
#pragma unroll
        for (int m = 0; m < 4; ++m) { const size_t tok = rowb + m * 16; cs01[m] = *(const f32x4*)(rope + tok * 16 + i0); cs23[m] = *(const f32x4*)(rope + tok * 16 + i0 + 2); }
    }
    const int bb = (pm * 128) >> 12, sb = rowb & 4095;
#pragma unroll 1
    for (int pn = 0; pn < 4; ++pn) {
        f32x4 acc[4][4];
#pragma unroll
        for (int m = 0; m < 4; ++m)
#pragma unroll
            for (int n = 0; n < 4; ++n) acc[m][n] = (f32x4){0.f, 0.f, 0.f, 0.f};
        gemm_main<4, 4, true, true>(lds, 65536, ap, bp, 4, acc);
        if (pn < 3) {
#pragma unroll
            for (int i = 0; i < 4; ++i) bp[i] += 256 * 256;
            gemm_stage<4, 4, true>(lds, 65536, ap, bp, 0, 0);
        }
        const int nval = (wc & 1) ? 2 : 4;
#pragma unroll
        for (int m = 0; m < 4; ++m) { float s = 0.f;
#pragma unroll
            for (int n = 0; n < 4; ++n) { acc[m][n] = acc[m][n] * rq[m]; if (n < nval) { const f32x4 v = acc[m][n]; s += (v.x * v.x + v.y * v.y) + (v.z * v.z + v.w * v.w); } }
            s += __shfl_xor(s, 16); s += __shfl_xor(s, 32);
            if (fq == 0) part[wid * 64 + m * 16 + fr] = s; }
        __syncthreads();
        const int hd = pn * 2 + (wc >> 1);
        bf16_t* dst0 = qb + ((size_t)(bb * 8 + hd) * 4096 + sb) * 96;
#pragma unroll
        for (int m = 0; m < 4; ++m) {
            const float tot = part[wid * 64 + m * 16 + fr] + part[(wid ^ 1) * 64 + m * 16 + fr];
            const float rh = __builtin_amdgcn_rsqf(tot * (1.0f / 96.0f) + EPS) * QSCALE;
            bf16_t* dst = dst0 + (m * 16) * 96;
            if ((wc & 1) == 0) {
#pragma unroll
                for (int n = 0; n < 4; ++n) { const int j = n * 16 + i0; const f32x4 v = acc[m][n] * rh * gq[n];
                    u32x2 w; w.x = cvtpk(v.x, v.y); w.y = cvtpk(v.z, v.w); *(u32x2*)(dst + j) = w; }
            } else {
                const f32x4 x1 = acc[m][0] * rh * gq[0], x2 = acc[m][1] * rh * gq[1];
                const f32x4 c01 = cs01[m], c23 = cs23[m];
                f32x4 o1, o2;
                o1.x = x1.x * c01.x - x2.x * c01.y; o2.x = x1.x * c01.y + x2.x * c01.x;
                o1.y = x1.y * c01.z - x2.y * c01.w; o2.y = x1.y * c01.w + x2.y * c01.z;
                o1.z = x1.z * c23.x - x2.z * c23.y; o2.z = x1.z * c23.y + x2.z * c23.x;
                o1.w = x1.w * c23.z - x2.w * c23.w; o2.w = x1.w * c23.w + x2.w * c23.z;
                u32x2 w; w.x = cvtpk(o1.x, o1.y); w.y = cvtpk(o1.z, o1.w); *(u32x2*)(dst + 64 + i0) = w;
                w.x = cvtpk(o2.x, o2.y); w.y = cvtpk(o2.z, o2.w); *(u32x2*)(dst + 80 + i0) = w;
            }
        }
        __syncthreads();
    }
}

constexpr int KV_SCR = 98304;
__device__ __forceinline__ void kv_item(CP p, LAS unsigned char* lds, int pm) {
    const int tid = threadIdx.x, lane = tid & 63, wid = __builtin_amdgcn_readfirstlane(tid >> 6), wr = wid >> 2, wc = wid & 3, fr = lane & 15, fq = lane >> 4;
    unsigned char* ws = p->ws;
    const bf16_t* ap[2]; const bf16_t* bp[4];
    stage_ptrs_dense<2>((const bf16_t*)(ws + WS_CKV), 128, pm * 128, ap);
    stage_ptrs_dense<4>((const bf16_t*)(ws + WS_WKV), 128, 0, bp);
    __syncthreads();
    gemm_load_ares<4>(lds, ap, 2);
    gemm_stage<4, 4, true>(lds, 32768, ap, bp, 0, 0);
    LAS float* kr_l = (LAS float*)(lds + KV_SCR); LAS float* rp_l = kr_l + 128 * 33; LAS float* rkv_l = rp_l + 128 * 34; LAS float* skr_l = rkv_l + 128;
    {
        const float* krp = (const float*)(ws + WS_KROPE) + (size_t)pm * 128 * 32; const float* rope = (const float*)(ws + WS_ROPE) + (size_t)pm * 128 * 32;
        f32x4 a[2], b[2];
#pragma unroll
        for (int k = 0; k < 2; ++k) { const int idx = tid + 512 * k; a[k] = *(const f32x4*)(krp + idx * 4); b[k] = *(const f32x4*)(rope + idx * 4); }
        float rk = 0.f, sk = 0.f;
        if (tid < 128) { const f32x2 s2 = *(const f32x2*)((const float*)(ws + WS_SSQKV) + (size_t)(pm * 128 + tid) * 2); rk = __builtin_amdgcn_rsqf((s2.x + s2.y) * (1.0f / 128.0f) + EPS); sk = ((const float*)(ws + WS_SSQKR))[pm * 128 + tid]; }
#pragma unroll
        for (int k = 0; k < 2; ++k) { const int idx = tid + 512 * k, row = idx >> 3, c4 = (idx & 7) * 4;
            LAS float* d = kr_l + row * 33 + c4; d[0] = a[k].x; d[1] = a[k].y; d[2] = a[k].z; d[3] = a[k].w;
            LAS float* e = rp_l + row * 34 + c4; e[0] = b[k].x; e[1] = b[k].y; e[2] = b[k].z; e[3] = b[k].w; }
        if (tid < 128) { rkv_l[tid] = rk; skr_l[tid] = sk; }
    }
    const float* kn = (const float*)p->in[16];
    const int rowl = wr * 64 + fq * 4, rowb = pm * 128 + rowl;
    float g[4];
#pragma unroll
    for (int n = 0; n < 4; ++n) g[n] = kn[n * 16 + fr];
    const float g1 = kn[64 + fr], g2 = kn[80 + fr];
    const int bb = (pm * 128) >> 12, sb = rowb & 4095;
#pragma unroll 1
    for (int pn = 0; pn < 4; ++pn) {
        f32x4 acc[4][4];
#pragma unroll
        for (int m = 0; m < 4; ++m)
#pragma unroll
            for (int n = 0; n < 4; ++n) acc[m][n] = (f32x4){0.f, 0.f, 0.f, 0.f};
        gemm_main<4, 4, false, true>(lds, 32768, ap, bp, 2, acc);
        if (pn < 3) {
#pragma unroll
            for (int i = 0; i < 4; ++i) bp[i] += 256 * 128;
            gemm_stage<4, 4, true>(lds, 32768, ap, bp, 0, 0);
        }
        const int hd = pn * 2 + (wc >> 1);
        if ((wc & 1) == 0) {
            bf16_t* dst_p = (bf16_t*)(ws + WS_K) + ((size_t)(bb * 8 + hd) * 4096 + sb) * 96 + fr;
#pragma unroll
            for (int m = 0; m < 4; ++m) {
#pragma unroll
                for (int j = 0; j < 4; ++j) {
                    const int o = m * 16 + j, rl = rowl + o;
                    const float rkv = rkv_l[rl];
                    float v[4], ss = 0.f;
#pragma unroll
                    for (int n = 0; n < 4; ++n) { v[n] = acc[m][n][j] * rkv; ss += v[n] * v[n]; }
                    ss += __shfl_xor(ss, 1); ss += __shfl_xor(ss, 2); ss += __shfl_xor(ss, 4); ss += __shfl_xor(ss, 8);
                    const float rk = __builtin_amdgcn_rsqf((ss + skr_l[rl]) * (1.0f / 96.0f) + EPS);
                    bf16_t* dst = dst_p + o * 96;
#pragma unroll
                    for (int n = 0; n < 4; ++n) dst[n * 16] = f2bf(v[n] * rk * g[n]);
                    const float x1 = kr_l[rl * 33 + fr] * rk * g1, x2 = kr_l[rl * 33 + 16 + fr] * rk * g2;
                    const float cs_c = rp_l[rl * 34 + 2 * fr], cs_s = rp_l[rl * 34 + 2 * fr + 1];
                    dst[64] = f2bf(x1 * cs_c - x2 * cs_s); dst[80] = f2bf(x1 * cs_s + x2 * cs_c);
                }
            }
        } else {
            bf16_t* vt_p = (bf16_t*)(ws + WS_VT) + ((size_t)(bb * 8 + hd) * 64 + fr) * 4096 + sb;
#pragma unroll
            for (int m = 0; m < 4; ++m) {
                float rkv[4];
#pragma unroll
                for (int j = 0; j < 4; ++j) rkv[j] = rkv_l[rowl + m * 16 + j];
#pragma unroll
                for (int n = 0; n < 4; ++n) { const f32x4 a = acc[m][n];
                    u32x2 w; w.x = cvtpk(a.x * rkv[0], a.y * rkv[1]); w.y = cvtpk(a.z * rkv[2], a.w * rkv[3]);
                    *(u32x2*)(vt_p + (size_t)(n * 16) * 4096 + m * 16) = w; }
            }
        }
    }
}

template <int R> __device__ __forceinline__ void conv_row(float (&o)[64], const float (&w)[31], float x) {
    constexpr int T0 = R > 30 ? R - 30 : 0, T1 = R < 63 ? R : 63;
#pragma unroll
    for (int t = T0; t <= T1; ++t) o[t] += w[R - t] * x;
}
template <int... R> __device__ __forceinline__ void conv_rows(float (&o)[64], const float (&w)[31], const float (&x)[94], std::integer_sequence<int, R...>) { (conv_row<R>(o, w, x[R]), ...); }
__device__ __forceinline__ void conv_unit(CP p, LAS unsigned char* lds, int cu) {
    const int tid = threadIdx.x, lane = tid & 63, wave = tid >> 6;
    const int b = cu >> 6, s0 = (cu & 63) * 64, c = tid;
    const bf16_t* ub = (const bf16_t*)(p->ws + WS_U) + ((size_t)b * 4096) * 512 + c;
    const float* cw = (const float*)p->in[7]; const float* cb = (const float*)p->in[8]; const float* lg = (const float*)p->in[9]; const float* lb = (const float*)p->in[10];
    float w[31];
#pragma unroll
    for (int j = 0; j < 31; ++j) w[j] = cw[j * 512 + c];
    float xin[94];
#pragma unroll
    for (int r = 0; r < 94; ++r) { const int s = s0 - 30 + r; xin[r] = bf2f(ub[(size_t)(s < 0 ? 0 : s) * 512]); }
    if (s0 == 0) {
#pragma unroll
        for (int r = 0; r < 30; ++r) xin[r] = 0.f;
    }
    float o[64];
    { const float bias = cb[c];
#pragma unroll
      for (int t = 0; t < 64; ++t) o[t] = bias; }
    conv_rows(o, w, xin, std::make_integer_sequence<int, 94>{});
    float s1, s2;
    {
        const bool b5 = lane & 32, b4 = lane & 16, b3 = lane & 8, b2 = lane & 4, b1 = lane & 2, b0 = lane & 1;
#define CONV_BFLY(RES, SQ) do { float a32[32]; \
        _Pragma("unroll") for (int i = 0; i < 32; ++i) { const float lo = SQ ? o[i] * o[i] : o[i], hi = SQ ? o[32 + i] * o[32 + i] : o[32 + i]; a32[i] = (b5 ? hi : lo) + __shfl_xor(b5 ? lo : hi, 32); } \
        float a16[16]; _Pragma("unroll") for (int i = 0; i < 16; ++i) a16[i] = (b4 ? a32[16 + i] : a32[i]) + __shfl_xor(b4 ? a32[i] : a32[16 + i], 16); \
        float a8[8]; _Pragma("unroll") for (int i = 0; i < 8; ++i) a8[i] = (b3 ? a16[8 + i] : a16[i]) + __shfl_xor(b3 ? a16[i] : a16[8 + i], 8); \
        float a4[4]; _Pragma("unroll") for (int i = 0; i < 4; ++i) a4[i] = (b2 ? a8[4 + i] : a8[i]) + __shfl_xor(b2 ? a8[i] : a8[4 + i], 4); \
        float a2[2]; _Pragma("unroll") for (int i = 0; i < 2; ++i) a2[i] = (b1 ? a4[2 + i] : a4[i]) + __shfl_xor(b1 ? a4[i] : a4[2 + i], 2); \
        RES = (b0 ? a2[1] : a2[0]) + __shfl_xor(b0 ? a2[0] : a2[1], 1); } while (0)
        CONV_BFLY(s1, false);
        asm volatile("" : "+v"(s1));
        CONV_BFLY(s2, true);
#undef CONV_BFLY
    }
    LAS float* red = (LAS float*)(lds + EPI_SCR);
    LAS float* stat = (LAS float*)(lds + EPI_SCR + 4096);
    red[(wave * 64 + lane) * 2] = s1; red[(wave * 64 + lane) * 2 + 1] = s2;
    __syncthreads();
    if (tid < 64) { float t1 = 0.f, t2 = 0.f;
#pragma unroll
        for (int k = 0; k < 8; ++k) { t1 += red[(k * 64 + tid) * 2]; t2 += red[(k * 64 + tid) * 2 + 1]; }
        const float mean = t1 * (1.0f / 512.0f); float var = t2 * (1.0f / 512.0f) - mean * mean; var = var < 0.f ? 0.f : var;
        stat[tid * 2] = mean; stat[tid * 2 + 1] = __builtin_amdgcn_rsqf(var + EPS); }
    __syncthreads();
    const float g = lg[c], bb = lb[c];
    bf16_t* cat = (bf16_t*)(p->ws + WS_CAT) + ((size_t)b * 4096 + s0) * 1024 + c;
#pragma unroll
    for (int t = 0; t < 64; ++t) { const float y = (o[t] - stat[t * 2]) * stat[t * 2 + 1] * g + bb; cat[(size_t)t * 1024] = f2bf(y * __builtin_amdgcn_rcpf(1.0f + __expf(-y))); }
    __syncthreads();
}

__device__ __forceinline__ void phase1c(CP p, LAS unsigned char* lds) {
#ifndef SUBREP
#define SUBREP -1
#endif
#pragma unroll 1
    for (int r_ = 0; r_ < (SUBREP == 0 ? 2 : 1); ++r_)
    for (int u = blockIdx.x; u < 256; u += gridDim.x) q_item(p, lds, u);
#pragma unroll 1
    for (int r_ = 0; r_ < (SUBREP == 1 ? 2 : 1); ++r_)
    for (int u = blockIdx.x; u < 256; u += gridDim.x) kv_item(p, lds, u);
    __syncthreads();
#pragma unroll 1
    for (int r_ = 0; r_ < (SUBREP == 2 ? 2 : 1); ++r_)
    for (int u = blockIdx.x; u < 512; u += gridDim.x) conv_unit(p, lds, u);
}

__device__ __forceinline__ int swap23(int r) { return (r & ~12) | ((r & 4) << 1) | ((r & 8) >> 1); }
constexpr int KROW = 208, VROW = 144, KBUF = 64 * KROW, VBUF = 64 * VROW, ABUF = KBUF + VBUF;
__device__ __forceinline__ void attn_unit(CP p, LAS unsigned char* lds, int bh, int qblk) {
    const int tid = threadIdx.x, lane = tid & 63, wid = __builtin_amdgcn_readfirstlane(tid >> 6), q = lane & 31, H = lane >> 5;
    unsigned char* ws = p->ws;
    const bf16_t* qg = (const bf16_t*)(ws + WS_Q) + (size_t)bh * 4096 * 96;
    const bf16_t* kg = (const bf16_t*)(ws + WS_K) + (size_t)bh * 4096 * 96;
    const bf16_t* vg = (const bf16_t*)(ws + WS_VT) + (size_t)bh * 64 * 4096;
    const int row0 = qblk * 256 + wid * 32, mychunk = 4 * qblk + (wid >> 1), NT = 4 * qblk + 4;
    bf16x8 qf[6];
#pragma unroll
    for (int s = 0; s < 6; ++s) qf[s] = *(const bf16x8*)(qg + (size_t)(row0 + q) * 96 + 16 * s + 8 * H);
    const int kr0 = tid / 12, kc0 = tid % 12, kr1 = (tid + 512) / 12, kc1 = (tid + 512) % 12, vd = tid >> 3, vc = tid & 7;
    const bool k1 = tid < 256;
    const bf16_t* ksrc0 = kg + (size_t)kr0 * 96 + kc0 * 8; const bf16_t* ksrc1 = kg + (size_t)kr1 * 96 + kc1 * 8; const bf16_t* vsrc = vg + (size_t)vd * 4096 + vc * 8;
    const int kdst0 = kr0 * KROW + kc0 * 16, kdst1 = kr1 * KROW + kc1 * 16, vdst = KBUF + vd * VROW + vc * 16;
    u32x4 rk0, rk1 = (u32x4){0, 0, 0, 0}, rv;
#define AT_LOAD(t) do { rk0 = *(const u32x4*)(ksrc0 + (size_t)(t) * 64 * 96); if (k1) rk1 = *(const u32x4*)(ksrc1 + (size_t)(t) * 64 * 96); rv = *(const u32x4*)(vsrc + (t) * 64); } while (0)
#define AT_WRITE(buf) do { LAS unsigned char* b_ = lds + (buf) * ABUF; *(LAS u32x4*)(b_ + kdst0) = rk0; if (k1) *(LAS u32x4*)(b_ + kdst1) = rk1; *(LAS u32x4*)(b_ + vdst) = rv; } while (0)
    AT_LOAD(0); AT_WRITE(0);
    __syncthreads();
    f32x16 o0 = {0}, o1 = {0};
    float mrun = -INFINITY, lsum = 0.f;
    const int koff = swap23(q) * KROW + 16 * H, voff = KBUF + q * VROW + 16 * H;
    for (int t = 0; t < NT; ++t) {
        if (t + 1 < NT) AT_LOAD(t + 1);
        if (t <= mychunk) {
            const LAS unsigned char* kb = lds + (t & 1) * ABUF + koff; const LAS unsigned char* vb = lds + (t & 1) * ABUF + voff;
            f32x16 s0 = {0}, s1 = {0};
#pragma unroll
            for (int s = 0; s < 6; ++s) {
                const bf16x8 a0 = *(const LAS bf16x8*)(kb + 32 * s), a1 = *(const LAS bf16x8*)(kb + 32 * KROW + 32 * s);
                s0 = __builtin_amdgcn_mfma_f32_32x32x16_bf16(a0, qf[s], s0, 0, 0, 0);
                s1 = __builtin_amdgcn_mfma_f32_32x32x16_bf16(a1, qf[s], s1, 0, 0, 0);
            }
            float mloc = s0[0];
#pragma unroll
            for (int r = 1; r < 16; ++r) mloc = fmaxf(mloc, s0[r]);
#pragma unroll
            for (int r = 0; r < 16; ++r) mloc = fmaxf(mloc, s1[r]);
            mloc = fmaxf(mloc, __shfl_xor(mloc, 32));
            const float mnew = fmaxf(mrun, mloc);
            const float alpha = __builtin_amdgcn_exp2f(mrun - mnew);
            mrun = mnew;
            float ps = 0.f;
#pragma unroll
            for (int r = 0; r < 16; ++r) { s0[r] = __builtin_amdgcn_exp2f(s0[r] - mnew); s1[r] = __builtin_amdgcn_exp2f(s1[r] - mnew); ps += s0[r] + s1[r]; }
            lsum = lsum * alpha + ps;
#pragma unroll
            for (int r = 0; r < 16; ++r) { o0[r] *= alpha; o1[r] *= alpha; }
            u32x4 pw[4];
            pw[0] = (u32x4){cvtpk(s0[0], s0[1]), cvtpk(s0[2], s0[3]), cvtpk(s0[4], s0[5]), cvtpk(s0[6], s0[7])};
            pw[1] = (u32x4){cvtpk(s0[8], s0[9]), cvtpk(s0[10], s0[11]), cvtpk(s0[12], s0[13]), cvtpk(s0[14], s0[15])};
            pw[2] = (u32x4){cvtpk(s1[0], s1[1]), cvtpk(s1[2], s1[3]), cvtpk(s1[4], s1[5]), cvtpk(s1[6], s1[7])};
            pw[3] = (u32x4){cvtpk(s1[8], s1[9]), cvtpk(s1[10], s1[11]), cvtpk(s1[12], s1[13]), cvtpk(s1[14], s1[15])};
#pragma unroll
            for (int ks = 0; ks < 4; ++ks) {
                const bf16x8 v0 = *(const LAS bf16x8*)(vb + 32 * ks), v1 = *(const LAS bf16x8*)(vb + 32 * VROW + 32 * ks);
                const bf16x8 pb = __builtin_bit_cast(bf16x8, pw[ks]);
                o0 = __builtin_amdgcn_mfma_f32_32x32x16_bf16(v0, pb, o0, 0, 0, 0);
                o1 = __builtin_amdgcn_mfma_f32_32x32x16_bf16(v1, pb, o1, 0, 0, 0);
            }
        }
        if (t + 1 < NT) AT_WRITE((t + 1) & 1);
        __syncthreads();
    }
#undef AT_LOAD
#undef AT_WRITE
    const float ltot = lsum + __shfl_xor(lsum, 32), inv = 1.0f / ltot;
    const int b = bh >> 3, hd = bh & 7;
    bf16_t* dst = (bf16_t*)(ws + WS_CAT) + ((size_t)b * 4096 + row0 + q) * 1024 + 512 + hd * 64;
#pragma unroll
    for (int g = 0; g < 4; ++g) {
        u32x2 w; w.x = cvtpk(o0[4 * g] * inv, o0[4 * g + 1] * inv); w.y = cvtpk(o0[4 * g + 2] * inv, o0[4 * g + 3] * inv); *(u32x2*)(dst + 8 * g + 4 * H) = w;
        w.x = cvtpk(o1[4 * g] * inv, o1[4 * g + 1] * inv); w.y = cvtpk(o1[4 * g + 2] * inv, o1[4 * g + 3] * inv); *(u32x2*)(dst + 32 + 8 * g + 4 * H) = w;
    }
}
constexpr int AF_NS = 6, AF_KB = 64 * 192, AF_STG = AF_KB + 64 * 128;
__device__ __forceinline__ void attn_unit_fast(CP p, LAS unsigned char* lds, int bh, int qblk) {
    const int tid = threadIdx.x, lane = tid & 63, wid = __builtin_amdgcn_readfirstlane(tid >> 6), q = lane & 31, H = lane >> 5;
    unsigned char* ws = p->ws;
    const bf16_t* qg = (const bf16_t*)(ws + WS_Q) + (size_t)bh * 4096 * 96;
    const bf16_t* kg = (const bf16_t*)(ws + WS_K) + (size_t)bh * 4096 * 96;
    const bf16_t* vg = (const bf16_t*)(ws + WS_VT) + (size_t)bh * 64 * 4096;
    const int row0 = qblk * 256 + wid * 32, mychunk = 4 * qblk + (wid >> 1), NT = 4 * qblk + 4;
    int ks0, ks1, vs0;
    { int P = wid * 64 + lane, r = P / 12, c = (P % 12) ^ ((r >> 2) & 3); ks0 = r * 96 + c * 8;
      P = (8 + (wid & 3)) * 64 + lane; r = P / 12; c = (P % 12) ^ ((r >> 2) & 3); ks1 = r * 96 + c * 8;
      P = wid * 64 + lane; r = P >> 3; c = (P & 7) ^ ((r >> 1) & 7); vs0 = r * 4096 + c * 8; }
    const bool two = wid < 4;
#define AF_ISSUE(u) do { const int u_ = (u) < NT ? (u) : NT - 1; LAS unsigned char* st_ = lds + ((u) % AF_NS) * AF_STG; \
        __builtin_amdgcn_global_load_lds((const unsigned*)(kg + (size_t)u_ * 64 * 96 + ks0), (LAS unsigned*)(st_ + wid * 1024), 16, 0, 0); \
        if (two) __builtin_amdgcn_global_load_lds((const unsigned*)(kg + (size_t)u_ * 64 * 96 + ks1), (LAS unsigned*)(st_ + (8 + wid) * 1024), 16, 0, 0); \
        __builtin_amdgcn_global_load_lds((const unsigned*)(vg + u_ * 64 + vs0), (LAS unsigned*)(st_ + AF_KB + wid * 1024), 16, 0, 0); } while (0)
#define AF_WAITBAR() do { if (two) asm volatile("s_waitcnt vmcnt(6)" ::: "memory"); else asm volatile("s_waitcnt vmcnt(4)" ::: "memory"); \
        asm volatile("s_waitcnt lgkmcnt(0)" ::: "memory"); __builtin_amdgcn_s_barrier(); asm volatile("" ::: "memory"); } while (0)
    static_assert(AF_NS == 6, "vmcnt immediates above are (AF_NS - 4) * pieces per tile");
    const int pr = swap23(q), kx = (pr >> 2) & 3;
    const int kbe = pr * 192 + 16 * ((H ^ (kx & 1)) + 2 * (kx >> 1)), kbo = pr * 192 + 16 * ((H ^ (kx & 1)) + 2 * (1 ^ (kx >> 1)));
    const int vx = (q >> 1) & 7, vbase = AF_KB + q * 128 + 16 * (H ^ (vx & 1)), vxx = (vx >> 1) * 32;
    bf16x8 qf[6];
#pragma unroll
    for (int s = 0; s < 6; ++s) qf[s] = *(const bf16x8*)(qg + (size_t)(row0 + q) * 96 + 16 * s + 8 * H);
#define AF_QK(S0, S1, u) do { const LAS unsigned char* kb_ = lds + ((u) % AF_NS) * AF_STG; \
        { const bf16x8 a0_ = *(const LAS bf16x8*)(kb_ + kbe), a1_ = *(const LAS bf16x8*)(kb_ + kbe + 32 * 192); \
          S0 = __builtin_amdgcn_mfma_f32_32x32x16_bf16(a0_, qf[0], (f32x16){0.f, 0.f, 0.f, 0.f, 0.f, 0.f, 0.f, 0.f, 0.f, 0.f, 0.f, 0.f, 0.f, 0.f, 0.f, 0.f}, 0, 0, 0); \
          S1 = __builtin_amdgcn_mfma_f32_32x32x16_bf16(a1_, qf[0], (f32x16){0.f, 0.f, 0.f, 0.f, 0.f, 0.f, 0.f, 0.f, 0.f, 0.f, 0.f, 0.f, 0.f, 0.f, 0.f, 0.f}, 0, 0, 0); } \
        _Pragma("unroll") for (int s_ = 1; s_ < 6; ++s_) { const int o_ = ((s_ & 1) ? kbo : kbe) + 64 * (s_ >> 1); \
            const bf16x8 a0_ = *(const LAS bf16x8*)(kb_ + o_), a1_ = *(const LAS bf16x8*)(kb_ + o_ + 32 * 192); \
            S0 = __builtin_amdgcn_mfma_f32_32x32x16_bf16(a0_, qf[s_], S0, 0, 0, 0); \
            S1 = __builtin_amdgcn_mfma_f32_32x32x16_bf16(a1_, qf[s_], S1, 0, 0, 0); } } while (0)
    asm volatile("s_waitcnt vmcnt(0) lgkmcnt(0)" ::: "memory"); __builtin_amdgcn_s_barrier(); asm volatile("" ::: "memory");
    AF_ISSUE(0); AF_ISSUE(1); AF_ISSUE(2); AF_ISSUE(3);
    AF_WAITBAR();
    f32x16 o0 = {0}, o1 = {0}, c0, c1;
    float lsum = 0.f;
    AF_QK(c0, c1, 0);
    for (int t = 0; t < NT; ++t) {
        AF_ISSUE(t + AF_NS - 2);
        if (t <= mychunk) {
            f32x16 n0, n1;
            AF_QK(n0, n1, t + 1);
            float ps = 0.f;
#pragma unroll
            for (int r = 0; r < 16; ++r) { c0[r] = __builtin_amdgcn_exp2f(c0[r]); c1[r] = __builtin_amdgcn_exp2f(c1[r]); ps += c0[r] + c1[r]; }
            lsum += ps;
            u32x4 pw[4];
            pw[0] = (u32x4){cvtpk(c0[0], c0[1]), cvtpk(c0[2], c0[3]), cvtpk(c0[4], c0[5]), cvtpk(c0[6], c0[7])};
            pw[1] = (u32x4){cvtpk(c0[8], c0[9]), cvtpk(c0[10], c0[11]), cvtpk(c0[12], c0[13]), cvtpk(c0[14], c0[15])};
            pw[2] = (u32x4){cvtpk(c1[0], c1[1]), cvtpk(c1[2], c1[3]), cvtpk(c1[4], c1[5]), cvtpk(c1[6], c1[7])};
            pw[3] = (u32x4){cvtpk(c1[8], c1[9]), cvtpk(c1[10], c1[11]), cvtpk(c1[12], c1[13]), cvtpk(c1[14], c1[15])};
            const LAS unsigned char* vb = lds + (t % AF_NS) * AF_STG + vbase;
#pragma unroll
            for (int ks = 0; ks < 4; ++ks) {
                const int vo = (ks * 32) ^ vxx;
                const bf16x8 v0 = *(const LAS bf16x8*)(vb + vo), v1 = *(const LAS bf16x8*)(vb + vo + 32 * 128);
                const bf16x8 pb = __builtin_bit_cast(bf16x8, pw[ks]);
                o0 = __builtin_amdgcn_mfma_f32_32x32x16_bf16(v0, pb, o0, 0, 0, 0);
                o1 = __builtin_amdgcn_mfma_f32_32x32x16_bf16(v1, pb, o1, 0, 0, 0);
            }
            c0 = n0; c1 = n1;
        }
        AF_WAITBAR();
    }
#undef AF_ISSUE
#undef AF_WAITBAR
#undef AF_QK
    const float ltot = lsum + __shfl_xor(lsum, 32), inv = 1.0f / ltot;
    const int b = bh >> 3, hd = bh & 7;
    bf16_t* dst = (bf16_t*)(ws + WS_CAT) + ((size_t)b * 4096 + row0 + q) * 1024 + 512 + hd * 64;
#pragma unroll
    for (int g = 0; g < 4; ++g) {
        u32x2 w; w.x = cvtpk(o0[4 * g] * inv, o0[4 * g + 1] * inv); w.y = cvtpk(o0[4 * g + 2] * inv, o0[4 * g + 3] * inv); *(u32x2*)(dst + 8 * g + 4 * H) = w;
        w.x = cvtpk(o1[4 * g] * inv, o1[4 * g + 1] * inv); w.y = cvtpk(o1[4 * g + 2] * inv, o1[4 * g + 3] * inv); *(u32x2*)(dst + 32 + 8 * g + 4 * H) = w;
    }
}
__device__ __forceinline__ void phase2(CP p, LAS unsigned char* lds) {
    const int lane = threadIdx.x & 63;
    const float* qn = (const float*)p->in[15]; const float* kn = (const float*)p->in[16];
    float mq = 0.f, mk = 0.f;
    for (int j = lane; j < 96; j += 64) { mq = fmaxf(mq, fabsf(qn[j])); mk = fmaxf(mk, fabsf(kn[j])); }
#pragma unroll
    for (int o = 1; o < 64; o <<= 1) { mq = fmaxf(mq, __shfl_xor(mq, o)); mk = fmaxf(mk, __shfl_xor(mk, o)); }
    const float bound = 96.0f * mq * mk * QSCALE * 1.01f;
    if (bound <= 40.0f) {
        for (int u = vcu_id(); u < 512; u += gridDim.x) { const int bh = u >> 3, pr = u & 7; attn_unit_fast(p, lds, bh, 15 - pr); attn_unit_fast(p, lds, bh, pr); }
    } else {
        for (int u = vcu_id(); u < 512; u += gridDim.x) { const int bh = u >> 3, pr = u & 7; attn_unit(p, lds, bh, 15 - pr); attn_unit(p, lds, bh, pr); }
    }
    asm volatile("s_waitcnt vmcnt(0)" ::: "memory"); __syncthreads();
}

__device__ __forceinline__ void phase3(CP p, LAS unsigned char* lds) {
    const int tid = threadIdx.x, lane = tid & 63, wid = __builtin_amdgcn_readfirstlane(tid >> 6), wr = wid >> 2, wc = wid & 3, fr = lane & 15, fq = lane >> 4;
    unsigned char* ws = p->ws;
    const float* x = (const float*)p->in[0]; const float* mod = (const float*)(ws + WS_MOD); float* sq1 = (float*)(ws + WS_SSQ1);
    for (int u = vcu_id(); u < 512; u += gridDim.x) {
        const int pm = u >> 2, pn = u & 3;
        const bf16_t* ap[4]; const bf16_t* bp[4];
        stage_ptrs_dense<4>((const bf16_t*)(ws + WS_CAT), 1024, pm * 256, ap); stage_ptrs_dense<4>((const bf16_t*)(ws + WS_WOUT), 1024, pn * 256, bp);
        f32x4 acc[8][4];
#pragma unroll
        for (int m = 0; m < 8; ++m)
#pragma unroll
            for (int n = 0; n < 4; ++n) acc[m][n] = (f32x4){0.f, 0.f, 0.f, 0.f};
        gemm_block<8, 4, true>(lds, ap, bp, 16, acc);
        const int rowb = pm * 256 + wr * 128 + fr, b = (pm * 256) >> 12, colb = pn * 256 + wc * 64 + fq * 4;
        f32x4 ga[4];
#pragma unroll
        for (int n = 0; n < 4; ++n) ga[n] = *(const f32x4*)(mod + b * 6144 + 2048 + colb + n * 16);
#pragma unroll
        for (int mb = 0; mb < 8; mb += 4) {
            f32x4 xv[4][4];
#pragma unroll
            for (int m = 0; m < 4; ++m)
#pragma unroll
                for (int n = 0; n < 4; ++n) xv[m][n] = *(const f32x4*)(x + (size_t)(rowb + (mb + m) * 16) * DM + colb + n * 16);
#pragma unroll
            for (int m = 0; m < 4; ++m) { const size_t row = rowb + (mb + m) * 16; float s = 0.f;
#pragma unroll
                for (int n = 0; n < 4; ++n) { const f32x4 v = xv[m][n] + ga[n] * acc[mb + m][n];
                    *(f32x4*)(p->out + row * DM + colb + n * 16) = v; s += (v.x * v.x + v.y * v.y) + (v.z * v.z + v.w * v.w); }
                s += __shfl_xor(s, 16); s += __shfl_xor(s, 32);
                if (fq == 0) sq1[row * 16 + pn * 4 + wc] = s; }
        }
    }
}

constexpr int RROW = 2064;
__device__ __forceinline__ void phase3b(CP p, LAS unsigned char* lds, bool dry) {
    const int tid = threadIdx.x, lane = tid & 63, wave = __builtin_amdgcn_readfirstlane(tid >> 6), fr = lane & 15, fq = lane >> 4;
    unsigned char* ws = p->ws;
    const float* nf = (const float*)p->in[18]; const float* mod = (const float*)(ws + WS_MOD); const float* sq1 = (const float*)(ws + WS_SSQ1);
    const float* bg = (const float*)p->in[20]; const float* be = (const float*)p->in[22];
    bf16_t* h2 = (bf16_t*)(ws + WS_H); const bf16_t* wrh = (const bf16_t*)(ws + WS_WR); const bf16_t* wrl = wrh + 48 * 1024;
    LAS unsigned char* Ahi = lds; LAS unsigned char* Alo = lds + 32 * RROW; LAS float* part = (LAS float*)lds; LAS float* lg = (LAS float*)(lds + 8 * 32 * 48 * 4);
    unsigned* ctl = (unsigned*)(ws + WS_CTL); int* lists = (int*)(ws + WS_LIST); int* blists = (int*)(ws + WS_BLIST); float* tokw = (float*)(ws + WS_TOKW);
    bf16x8 Bh[3][4], Bl[3][4];
#pragma unroll
    for (int nt = 0; nt < 3; ++nt)
#pragma unroll
        for (int kk = 0; kk < 4; ++kk) { const size_t o = (size_t)(nt * 16 + fr) * 1024 + wave * 128 + kk * 32 + fq * 8; Bh[nt][kk] = *(const bf16x8*)(wrh + o); Bl[nt][kk] = *(const bf16x8*)(wrl + o); }
#pragma unroll 1
    for (int tile = blockIdx.x; tile < MT / 32; tile += gridDim.x) {
        const int r0 = tile * 32, b = r0 >> 12;
        {
            f32x4 gm[4], sh[4];
#pragma unroll
            for (int j = 0; j < 4; ++j) { const int col = 4 * lane + 256 * j; const f32x4 g = *(const f32x4*)(nf + col), s = *(const f32x4*)(mod + b * 6144 + 4096 + col);
                gm[j] = g * (s + 1.0f); sh[j] = *(const f32x4*)(mod + b * 6144 + 3072 + col); }
#pragma unroll
            for (int rb = 0; rb < 4; rb += 2) {
                f32x4 xr[2][4]; float rs[2];
#pragma unroll
                for (int rr = 0; rr < 2; ++rr) { const size_t row = r0 + wave * 4 + rb + rr; float ss = 0.f;
#pragma unroll
                    for (int k = 0; k < 4; ++k) { const f32x4 s4 = *(const f32x4*)(sq1 + row * 16 + 4 * k); ss += (s4.x + s4.y) + (s4.z + s4.w); }
                    rs[rr] = ss;
#pragma unroll
                    for (int j = 0; j < 4; ++j) xr[rr][j] = *(const f32x4*)(p->out + row * DM + 4 * lane + 256 * j); }
#pragma unroll
                for (int rr = 0; rr < 2; ++rr) {
                    const int lr = wave * 4 + rb + rr; const size_t row = r0 + lr;
                    const float rstd = __builtin_amdgcn_rsqf(rs[rr] * (1.0f / DM) + EPS);
#pragma unroll
                    for (int j = 0; j < 4; ++j) { const int col = 4 * lane + 256 * j; const f32x4 xv = xr[rr][j];
                        const f32x4 o = xv * rstd * gm[j] + sh[j];
                        u32x2 w; w.x = cvtpk(o.x, o.y); w.y = cvtpk(o.z, o.w);
                        *(u32x2*)(h2 + row * DM + col) = w; *(LAS u32x2*)(Ahi + lr * RROW + col * 2) = w;
                        const float lx = o.x - __builtin_bit_cast(float, w.x << 16), ly = o.y - __builtin_bit_cast(float, w.x & 0xffff0000u), lz = o.z - __builtin_bit_cast(float, w.y << 16), lw = o.w - __builtin_bit_cast(float, w.y & 0xffff0000u);
                        u32x2 wl; wl.x = cvtpk(lx, ly); wl.y = cvtpk(lz, lw); *(LAS u32x2*)(Alo + lr * RROW + col * 2) = wl; }
                }
            }
        }
        __syncthreads();
        f32x4 P[2][3];
#pragma unroll
        for (int mt = 0; mt < 2; ++mt)
#pragma unroll
            for (int nt = 0; nt < 3; ++nt) P[mt][nt] = (f32x4){0.f, 0.f, 0.f, 0.f};
#pragma unroll
        for (int mt = 0; mt < 2; ++mt)
#pragma unroll
            for (int kk = 0; kk < 4; ++kk) {
                const int ao = (mt * 16 + fr) * RROW + (wave * 128 + kk * 32 + fq * 8) * 2;
                const bf16x8 a_h = *(const LAS bf16x8*)(Ahi + ao), a_l = *(const LAS bf16x8*)(Alo + ao);
#pragma unroll
                for (int nt = 0; nt < 3; ++nt) {
                    P[mt][nt] = __builtin_amdgcn_mfma_f32_16x16x32_bf16(a_h, Bh[nt][kk], P[mt][nt], 0, 0, 0);
                    P[mt][nt] = __builtin_amdgcn_mfma_f32_16x16x32_bf16(a_l, Bh[nt][kk], P[mt][nt], 0, 0, 0);
                    P[mt][nt] = __builtin_amdgcn_mfma_f32_16x16x32_bf16(a_h, Bl[nt][kk], P[mt][nt], 0, 0, 0);
                }
            }
        __syncthreads();
#pragma unroll
        for (int mt = 0; mt < 2; ++mt)
#pragma unroll
            for (int nt = 0; nt < 3; ++nt)
#pragma unroll
                for (int j = 0; j < 4; ++j) part[(wave * 32 + mt * 16 + fq * 4 + j) * 48 + nt * 16 + fr] = P[mt][nt][j];
        __syncthreads();
#pragma unroll
        for (int i = 0; i < 3; ++i) { const int idx = tid + 512 * i; float v = 0.f;
#pragma unroll
            for (int w8 = 0; w8 < 8; ++w8) v += part[w8 * 1536 + idx];
            lg[idx] = v; }
        __syncthreads();
        if (tid < 32 && !dry) {
            const LAS float* l = lg + tid * 48; const int tok = r0 + tid;
            float gl[4]; int gi = 0; float gmx;
#pragma unroll
            for (int i = 0; i < 4; ++i) gl[i] = l[i] + bg[i];
            gmx = gl[0];
#pragma unroll
            for (int i = 1; i < 4; ++i) if (gl[i] > gmx) { gmx = gl[i]; gi = i; }
            float gs = 0.f;
#pragma unroll
            for (int i = 0; i < 4; ++i) gs += __expf(gl[i] - gmx);
            const float gtop = 1.0f / gs;
            float el[8];
#pragma unroll
            for (int i = 0; i < 8; ++i) el[i] = l[4 + gi * 8 + i] + be[gi * 8 + i];
            int e1 = 0; float m1 = el[0];
#pragma unroll
            for (int i = 1; i < 8; ++i) if (el[i] > m1) { m1 = el[i]; e1 = i; }
            int e2 = -1; float m2 = -INFINITY;
#pragma unroll
            for (int i = 0; i < 8; ++i) if (i != e1 && el[i] > m2) { m2 = el[i]; e2 = i; }
            const float p2 = __expf(m2 - m1);
            const float w1 = gtop / (1.0f + p2), w2 = gtop * p2 / (1.0f + p2);
            const int lo = e1 < e2 ? e1 : e2, hi = e1 < e2 ? e2 : e1;
            const float wlo = e1 < e2 ? w1 : w2, whi = e1 < e2 ? w2 : w1;
            const int bk = gi * 28 + lo * 8 - ((lo * (lo + 1)) >> 1) + (hi - lo - 1);
            const int El = gi * 8 + lo, Eh = gi * 8 + hi;
            const unsigned p1 = atomicAdd(ctl + CW_CNT + 64 * El, 1u), pp2 = atomicAdd(ctl + CW_CNT + 64 * Eh, 1u), p3 = atomicAdd(ctl + CW_CNT + 64 * (32 + bk), 1u);
            lists[(size_t)El * MT + p1] = tok * 2; lists[(size_t)Eh * MT + pp2] = tok * 2 + 1;
            blists[(size_t)bk * MT + p3] = tok;
            tokw[tok * 2] = wlo; tokw[tok * 2 + 1] = whi;
        }
        __syncthreads();
    }
}

struct U4a { int e, rt, ct, cnt; };
__device__ __forceinline__ int prefix_find(const LAS unsigned* pre, int n, int u) {
    const int lane = threadIdx.x & 63; int res = -1;
    for (int b0 = 0; b0 < n; b0 += 64) { const int i = b0 + lane; const bool hit = i < n && (int)pre[i] <= u && u < (int)pre[i + 1];
        const unsigned long long m = __ballot(hit); if (m) { res = b0 + __builtin_ctzll(m); break; } }
    return res;
}
__device__ __forceinline__ bool p4a_find(const LAS unsigned* cnts, const LAS unsigned* pre, int u, U4a& r) {
    const int i = prefix_find(pre, 32, u); if (i < 0) return false;
    const int uu = u - (int)pre[i]; r.e = i; r.rt = uu >> 1; r.ct = uu & 1; r.cnt = (int)cnts[i]; return true;
}
template <int MI, int NI>
__device__ __forceinline__ void p4a_ptrs(CP p, int e, int row0, int cnt, int col0, const bf16_t* (&ap)[MI / 2], const bf16_t* (&bp)[NI]) {
    const int tid = threadIdx.x, lane = tid & 63;
    const int* lst = (const int*)(p->ws + WS_LIST) + (size_t)e * MT + row0; const int nrow = cnt - row0;
    const bf16_t* h2 = (const bf16_t*)(p->ws + WS_H);
    int tok[MI / 2], C[MI / 2];
#pragma unroll
    for (int i = 0; i < MI / 2; ++i) { int R; stage_rc2((tid >> 6) * 1024 + i * 8192 + lane * 16, R, C[i]); tok[i] = lst[R < nrow ? R : 0] >> 1; }
#pragma unroll
    for (int i = 0; i < MI / 2; ++i) ap[i] = h2 + (size_t)tok[i] * 1024 + C[i];
    stage_ptrs_dense<NI>((const bf16_t*)(p->ws + WS_WGU) + (size_t)e * 512 * 1024, 1024, col0, bp);
}
template <int MI, int NI>
__device__ __forceinline__ void p4a_epilogue(CP p, int e, int row0, int cnt, int col0, const f32x4 (&acc)[MI][NI]) {
    const int tid = threadIdx.x, lane = tid & 63, wid = __builtin_amdgcn_readfirstlane(tid >> 6), wr = wid >> 2, wc = wid & 3, fr = lane & 15, fq = lane >> 4;
    unsigned char* ws = p->ws;
    const float* tokw = (const float*)(ws + WS_TOKW); bf16_t* ab = (bf16_t*)(ws + WS_ABUF);
    const int* lst = (const int*)(ws + WS_LIST) + (size_t)e * MT + row0; const int nrow = cnt - row0;
    int ent[MI]; float w[MI];
#pragma unroll
    for (int m = 0; m < MI; ++m) { const int R = wr * (MI * 16) + m * 16 + fr; ent[m] = lst[R < nrow ? R : 0]; }
#pragma unroll
    for (int m = 0; m < MI; ++m) w[m] = tokw[ent[m]];
#pragma unroll
    for (int m = 0; m < MI; ++m) { const int R = wr * (MI * 16) + m * 16 + fr; const float wm = w[m];
#pragma unroll
        for (int h = 0; h < NI / 2; ++h) { const f32x4 g = acc[m][2 * h], uu = acc[m][2 * h + 1];
            const int np = col0 + wc * (NI * 16) + h * 32 + fq * 4, ch = (np >> 8) * 128 + ((np >> 6) & 3) * 32 + ((np >> 5) & 1) * 16 + (np & 15);
            u32x2 o; o.x = cvtpk(g.x * __builtin_amdgcn_rcpf(1.0f + __expf(-g.x)) * uu.x * wm, g.y * __builtin_amdgcn_rcpf(1.0f + __expf(-g.y)) * uu.y * wm);
            o.y = cvtpk(g.z * __builtin_amdgcn_rcpf(1.0f + __expf(-g.z)) * uu.z * wm, g.w * __builtin_amdgcn_rcpf(1.0f + __expf(-g.w)) * uu.w * wm);
            if (R < nrow) *(u32x2*)(ab + (size_t)ent[m] * 256 + ch) = o; } }
}
__device__ __forceinline__ void phase4a(CP p, LAS unsigned char* lds, const LAS unsigned* cnts, const LAS unsigned* pre) {
    const int G = gridDim.x, v = vcu_id();
    const int U = (int)pre[32], F = U - U % G;
    {
        int u = v; U4a cur;
        if (u < F && p4a_find(cnts, pre, u, cur)) {
            const bf16_t* ap[4]; const bf16_t* bp[4];
            p4a_ptrs<8, 4>(p, cur.e, cur.rt * 256, cur.cnt, cur.ct * 256, ap, bp);
            __syncthreads();
            gemm_stage<8, 4, false>(lds, 0, ap, bp, 0, 0);
            for (;;) {
                f32x4 acc[8][4];
#pragma unroll
                for (int m = 0; m < 8; ++m)
#pragma unroll
                    for (int n = 0; n < 4; ++n) acc[m][n] = (f32x4){0.f, 0.f, 0.f, 0.f};
                gemm_main<8, 4, true, false>(lds, 0, ap, bp, 16, acc);
                U4a nxt; u += G; const bool has_next = u < F && p4a_find(cnts, pre, u, nxt);
                if (has_next) { p4a_ptrs<8, 4>(p, nxt.e, nxt.rt * 256, nxt.cnt, nxt.ct * 256, ap, bp); gemm_stage<8, 4, false>(lds, 0, ap, bp, 0, 0); }
                p4a_epilogue<8, 4>(p, cur.e, cur.rt * 256, cur.cnt, cur.ct * 256, acc);
                if (!has_next) break;
                cur = nxt;
            }
        }
    }
    asm volatile("s_waitcnt vmcnt(0)" ::: "memory"); __syncthreads();
#pragma unroll 1
    for (int sv = v; sv < 4 * (U - F); sv += G) {
        U4a t; if (!p4a_find(cnts, pre, F + (sv >> 2), t)) break;
        const int row0 = t.rt * 256 + ((sv >> 1) & 1) * 128, col0 = t.ct * 256 + (sv & 1) * 128;
        if (row0 < t.cnt) {
            const bf16_t* ap[2]; const bf16_t* bp[2];
            p4a_ptrs<4, 2>(p, t.e, row0, t.cnt, col0, ap, bp);
            __syncthreads();
            gemm_stage<4, 2, false>(lds, 0, ap, bp, 0, 0);
            f32x4 acc[4][2];
#pragma unroll
            for (int m = 0; m < 4; ++m)
#pragma unroll
                for (int n = 0; n < 2; ++n) acc[m][n] = (f32x4){0.f, 0.f, 0.f, 0.f};
            gemm_main<4, 2, true, false>(lds, 0, ap, bp, 16, acc);
            p4a_epilogue<4, 2>(p, t.e, row0, t.cnt, col0, acc);
        }
    }
    asm volatile("s_waitcnt vmcnt(0)" ::: "memory"); __syncthreads();
}
struct U4b { int bk, rt, ct, cnt; };
__device__ __forceinline__ bool p4b_find(const LAS unsigned* cnts, const LAS unsigned* pre, int u, U4b& r) {
    const int i = prefix_find(pre + 33, 112, u); if (i < 0) return false;
    const int uu = u - (int)pre[33 + i]; r.bk = i; r.rt = uu >> 2; r.ct = uu & 3; r.cnt = (int)cnts[32 + i]; return true;
}
__device__ __forceinline__ void p4b_ptrs(CP p, const U4b& u, const bf16_t* (&ap)[2], const bf16_t* (&bp)[4], const bf16_t* (&bq)[4]) {
    const int tid = threadIdx.x, lane = tid & 63;
    const int g = u.bk / 28; int pi = u.bk % 28, lo = 0; while (pi >= 7 - lo) { pi -= 7 - lo; ++lo; } const int hi = lo + 1 + pi;
    const int* lst = (const int*)(p->ws + WS_BLIST) + (size_t)u.bk * MT + u.rt * 128; const int nrow = u.cnt - u.rt * 128;
    const bf16_t* ab = (const bf16_t*)(p->ws + WS_ABUF);
#pragma unroll
    for (int i = 0; i < 2; ++i) { int R, C; stage_rc2((tid >> 6) * 1024 + i * 8192 + lane * 16, R, C); const int tok = lst[R < nrow ? R : 0]; ap[i] = ab + (size_t)tok * 512 + C; }
    stage_ptrs_dense<4>((const bf16_t*)(p->ws + WS_WD) + (size_t)(g * 8 + lo) * 1024 * 256, 256, u.ct * 256, bp);
    stage_ptrs_dense<4>((const bf16_t*)(p->ws + WS_WD) + (size_t)(g * 8 + hi) * 1024 * 256, 256, u.ct * 256, bq);
#pragma unroll
    for (int i = 0; i < 4; ++i) bq[i] -= 256;
}
__device__ __forceinline__ void phase4b(CP p, LAS unsigned char* lds, const LAS unsigned* cnts, const LAS unsigned* pre) {
    const int tid = threadIdx.x, lane = tid & 63, wid = __builtin_amdgcn_readfirstlane(tid >> 6), wr = wid >> 2, wc = wid & 3, fr = lane & 15, fq = lane >> 4;
    unsigned char* ws = p->ws;
    const float* mod = (const float*)(ws + WS_MOD); float* out = p->out;
    int u = vcu_id(); U4b cur;
    if (!p4b_find(cnts, pre, u, cur)) return;
    const bf16_t* ap[2]; const bf16_t* bp[4]; const bf16_t* bq[4];
    p4b_ptrs(p, cur, ap, bp, bq);
    int tok[4];
    { const int* lst = (const int*)(ws + WS_BLIST) + (size_t)cur.bk * MT + cur.rt * 128; const int nrow = cur.cnt - cur.rt * 128;
#pragma unroll
      for (int m = 0; m < 4; ++m) { const int R = wr * 64 + m * 16 + fr; tok[m] = lst[R < nrow ? R : 0]; } }
    __syncthreads();
    gemm_stage<4, 4, false>(lds, 0, ap, bp, 0, 0);
    for (;;) {
        const int colb = cur.ct * 256 + wc * 64 + fq * 4; const int nrow = cur.cnt - cur.rt * 128;
        f32x4 old[4][4];
#pragma unroll
        for (int m = 0; m < 4; ++m)
#pragma unroll
            for (int n = 0; n < 4; ++n) old[m][n] = *(const f32x4*)(out + (size_t)tok[m] * DM + colb + n * 16);
        f32x4 acc[4][4];
#pragma unroll
        for (int m = 0; m < 4; ++m)
#pragma unroll
            for (int n = 0; n < 4; ++n) acc[m][n] = (f32x4){0.f, 0.f, 0.f, 0.f};
        gemm_main2<4, 4, true, false>(lds, 0, ap, bp, bq, 4, 8, acc);
        U4b nxt; u += gridDim.x; const bool has_next = p4b_find(cnts, pre, u, nxt);
        int tokn[4] = {0, 0, 0, 0};
        if (has_next) { p4b_ptrs(p, nxt, ap, bp, bq); gemm_stage<4, 4, false>(lds, 0, ap, bp, 0, 0);
            const int* lst = (const int*)(ws + WS_BLIST) + (size_t)nxt.bk * MT + nxt.rt * 128; const int nr2 = nxt.cnt - nxt.rt * 128;
#pragma unroll
            for (int m = 0; m < 4; ++m) { const int R = wr * 64 + m * 16 + fr; tokn[m] = lst[R < nr2 ? R : 0]; } }
#pragma unroll
        for (int m = 0; m < 4; ++m) { const int R = wr * 64 + m * 16 + fr; const int b = tok[m] >> 12;
#pragma unroll
            for (int n = 0; n < 4; ++n) { const f32x4 gf = *(const f32x4*)(mod + b * 6144 + 5120 + colb + n * 16);
                const f32x4 o = old[m][n] + gf * acc[m][n]; if (R < nrow) *(f32x4*)(out + (size_t)tok[m] * DM + colb + n * 16) = o; } }
        if (!has_next) break;
        cur = nxt;
#pragma unroll
        for (int m = 0; m < 4; ++m) tok[m] = tokn[m];
    }
    asm volatile("s_waitcnt vmcnt(0)" ::: "memory"); __syncthreads();
}

__global__ void __launch_bounds__(512, 2) hybrid_block_fwd(Params p) {
    extern __shared__ __attribute__((aligned(16))) unsigned char lds_raw[];
    LAS unsigned char* lds = (LAS unsigned char*)lds_raw;
    volatile LAS unsigned* MISC = (volatile LAS unsigned*)(lds + MISC_OFF);
    LAS unsigned* cnts = (LAS unsigned*)(lds + MISC_OFF + 256);
    const int tid = threadIdx.x;
    if (tid < 16) MISC[tid] = 0u;
    __syncthreads();
    unsigned* ctl = (unsigned*)(p.ws + WS_CTL);
    const bool single = (p.ph_hi - p.ph_lo) > 1;
    XcdBarrier bar; bar.bar = ctl + CW_BAR; bar.x = 0; bar.st = nullptr;
    if (single) bar = xcd_barrier_post(ctl + CW_BAR, MISC + 8);
#ifndef PH_MASK
#define PH_MASK 0x1ff
#endif
#define IN(k) (((PH_MASK >> (k)) & 1) && p.ph_lo <= (k) && (k) < p.ph_hi)
#define SEAM(k) do { if (IN(k) && IN((k) + 1)) xcd_barrier(bar); } while (0)
#ifndef REPEAT_PH
#define REPEAT_PH -1
#endif
#define NREP(k) ((REPEAT_PH == (k)) ? 2 : 1)
    if (IN(0)) { for (int r_ = 0; r_ < NREP(0); ++r_) phase0(get_params(), lds); } SEAM(0);
    if (IN(1)) { for (int r_ = 0; r_ < NREP(1); ++r_) phase1a(get_params()); } SEAM(1);
    if (IN(2)) { for (int r_ = 0; r_ < NREP(2); ++r_) phase1b(get_params(), lds); } SEAM(2);
    if (IN(3)) { for (int r_ = 0; r_ < NREP(3); ++r_) phase1c(get_params(), lds); } SEAM(3);
    if (IN(4)) { for (int r_ = 0; r_ < NREP(4); ++r_) phase2(get_params(), lds); } SEAM(4);
    if (IN(5)) { for (int r_ = 0; r_ < NREP(5); ++r_) phase3(get_params(), lds); } SEAM(5);
    if (IN(6)) { for (int r_ = 0; r_ < NREP(6); ++r_) phase3b(get_params(), lds, r_ + 1 < NREP(6)); } SEAM(6);
    LAS unsigned* pre = (LAS unsigned*)(lds + MISC_OFF + 256 + 640);
    if (IN(7) || IN(8)) {
        if (tid < 144) cnts[tid] = __hip_atomic_load(ctl + CW_CNT + 64 * tid, __ATOMIC_RELAXED, __HIP_MEMORY_SCOPE_AGENT);
        __syncthreads();
        if (tid == 0) { unsigned a = 0; for (int i = 0; i < 32; ++i) { pre[i] = a; a += ((cnts[i] + 255u) >> 8) * 2u; } pre[32] = a;
                        a = 0; for (int i = 0; i < 112; ++i) { pre[33 + i] = a; a += ((cnts[32 + i] + 127u) >> 7) * 4u; } pre[33 + 112] = a; }
        __syncthreads();
    }
    if (IN(7)) { for (int r_ = 0; r_ < NREP(7); ++r_) phase4a(get_params(), lds, cnts, pre); } SEAM(7);
    if (IN(8)) { phase4b(get_params(), lds, cnts, pre); }
#undef IN
#undef SEAM
}

extern "C" void kernel_launch(void* const* d_in, const int* in_sizes, int n_in, void* d_out, int out_size, void* d_ws, size_t ws_size, hipStream_t stream) {
    static int grid = 0;
    if (grid == 0) {
        if (n_in != 26 || out_size != MT * DM || ws_size < WS_END) { fprintf(stderr, "kernel_launch: unexpected problem (n_in %d out %d ws %zu)\n", n_in, out_size, ws_size); grid = -1; return; }
        int dev = 0, cus = 0, per_cu = 0;
        hipGetDevice(&dev); hipDeviceGetAttribute(&cus, hipDeviceAttributeMultiprocessorCount, dev);
        hipFuncSetAttribute((const void*)hybrid_block_fwd, hipFuncAttributeMaxDynamicSharedMemorySize, LDS_BYTES);
        hipOccupancyMaxActiveBlocksPerMultiprocessor(&per_cu, (const void*)hybrid_block_fwd, 512, LDS_BYTES);
        (void)hipGetLastError();
        if (per_cu < 1) { fprintf(stderr, "kernel_launch: occupancy query says %d blocks/CU\n", per_cu); per_cu = 1; }
        grid = cus;
    }
    if (grid < 0) return;
    hipMemsetAsync((char*)d_ws + WS_CTL, 0, CTL_BYTES, stream);
    Params prm{};
    for (int i = 0; i < 26; ++i) prm.in[i] = d_in[i];
    prm.out = (float*)d_out; prm.ws = (unsigned char*)d_ws;
#if N_LAUNCH_SPLIT
    for (int ph = 0; ph <= DBG_LAST_PHASE; ++ph) { prm.ph_lo = ph; prm.ph_hi = ph + 1; hipLaunchKernelGGL(hybrid_block_fwd, dim3(grid), dim3(512), LDS_BYTES, stream, prm); }
#else
    prm.ph_lo = 0; prm.ph_hi = DBG_LAST_PHASE + 1;
    hipLaunchKernelGGL(hybrid_block_fwd, dim3(grid), dim3(512), LDS_BYTES, stream, prm);
#endif
}
```

```cpp
#include <hip/hip_runtime.h>
#include <cstdio>
#include <cstdint>
#include <utility>

#ifndef N_LAUNCH_SPLIT
#define N_LAUNCH_SPLIT 0
#endif
#ifndef DBG_LAST_PHASE
#define DBG_LAST_PHASE 8
#endif

#define LAS __attribute__((address_space(3)))
#define GAS __attribute__((address_space(1)))
typedef unsigned short bf16_t;
typedef short bf16x8 __attribute__((ext_vector_type(8)));
typedef float f32x4 __attribute__((ext_vector_type(4)));
typedef float f32x2 __attribute__((ext_vector_type(2)));
typedef float f32x16 __attribute__((ext_vector_type(16)));
typedef unsigned u32x4 __attribute__((ext_vector_type(4)));
typedef unsigned u32x2 __attribute__((ext_vector_type(2)));
typedef __bf16 bf16x2_t __attribute__((ext_vector_type(2)));

constexpr int NB = 8, SEQ = 4096, DM = 1024, MT = NB * SEQ;
constexpr int NHEAD = 8, DQK = 96, DV = 64;
constexpr int NEXP = 32;
constexpr float EPS = 1e-6f;
constexpr float QSCALE = 0.14724444602590306f;
constexpr int NPH = 9;

constexpr size_t MiB = 1u << 20;
constexpr size_t WS_CTL = 0, CTL_BYTES = 1 * MiB;
constexpr size_t WS_MOD = 1 * MiB;
constexpr size_t WS_ROPE = 2 * MiB;
constexpr size_t WS_WIN = 6 * MiB;
constexpr size_t WS_WQ = 9 * MiB;
constexpr size_t WS_WKV = 9 * MiB + 512 * 1024;
constexpr size_t WS_WR = 9 * MiB + 768 * 1024;
constexpr size_t WS_WOUT = 10 * MiB;
constexpr size_t WS_WGU = 12 * MiB;
constexpr size_t WS_WD = 44 * MiB;
constexpr size_t WS_SSQQ = 60 * MiB;
constexpr size_t WS_SSQKV = 60 * MiB + 512 * 1024;
constexpr size_t WS_SSQKR = 60 * MiB + 768 * 1024;
constexpr size_t WS_SSQ1 = 61 * MiB;
constexpr size_t WS_TOKW = 63 * MiB;
constexpr size_t WS_KROPE = 64 * MiB;
constexpr size_t WS_CQ = 68 * MiB;
constexpr size_t WS_CKV = 84 * MiB;
constexpr size_t WS_LIST = 92 * MiB;
constexpr size_t WS_H = 100 * MiB;
constexpr size_t WS_U = 164 * MiB;
constexpr size_t WS_Q = 196 * MiB;
constexpr size_t WS_K = 244 * MiB;
constexpr size_t WS_VT = 292 * MiB;
constexpr size_t WS_CAT = 324 * MiB;
constexpr size_t WS_ABUF = 388 * MiB;
constexpr size_t WS_BLIST = 420 * MiB;
constexpr size_t WS_END = 435 * MiB;
constexpr int CW_BAR = 4096;
constexpr int CW_CNT = 16384;

constexpr int SCR_BYTES = 155648;
constexpr int MISC_OFF = SCR_BYTES;
constexpr int LDS_BYTES = SCR_BYTES + 2048;

__device__ __forceinline__ unsigned cvtpk(float lo, float hi) { f32x2 v = {lo, hi}; bf16x2_t b = __builtin_convertvector(v, bf16x2_t); return __builtin_bit_cast(unsigned, b); }
__device__ __forceinline__ float bf2f(unsigned short h) { return __builtin_bit_cast(float, (unsigned)h << 16); }
__device__ __forceinline__ unsigned short f2bf(float f) { return (unsigned short)(cvtpk(f, 0.f) & 0xffffu); }
__device__ __forceinline__ float sigmoidf_(float x) { return __builtin_amdgcn_rcpf(1.0f + __expf(-x)); }
__device__ __forceinline__ float siluf_(float x) { return x * __builtin_amdgcn_rcpf(1.0f + __expf(-x)); }
__device__ __forceinline__ float wave_sum(float v) {
#pragma unroll
    for (int o = 1; o < 64; o <<= 1) v += __shfl_xor(v, o);
    return v;
}

__device__ __forceinline__ int vcu_id() { const int g = gridDim.x, b = blockIdx.x; return (g & 7) == 0 ? (b & 7) * (g >> 3) + (b >> 3) : b; }
#define XB_TMO      128
#define XB_XCNT(j)  (256  + 64 * (j))
#define XB_XSUB(j)  (1280 + 64 * (j))
#define XB_XGEN(j)  (2304 + 64 * (j))
#define XB_TOP      3328
#define XB_TOPGEN   3392
#define XCD_BAR_WORDS 3456
#define XB_SPIN_CAP (1u << 20)
__device__ __forceinline__ unsigned xb_ld(unsigned* p)              { return __hip_atomic_load(p, __ATOMIC_RELAXED, __HIP_MEMORY_SCOPE_AGENT); }
__device__ __forceinline__ unsigned xb_add(unsigned* p, unsigned v) { return __hip_atomic_fetch_add(p, v, __ATOMIC_RELAXED, __HIP_MEMORY_SCOPE_AGENT); }
__device__ __forceinline__ unsigned xb_xcc_id() { return (unsigned)__builtin_amdgcn_s_getreg((3 << 11) | 20) & 0xFu; }
#define XB_SPIN(cond, bar) do { unsigned _sp = 0; while (cond) { __builtin_amdgcn_s_sleep(1); \
    if ((++_sp & 255u) == 0u) { if (xb_ld(&(bar)[XB_TMO])) break; if (_sp > XB_SPIN_CAP) { atomicAdd(&(bar)[XB_TMO], 1u); break; } } } } while (0)
struct XcdBarrier { unsigned* bar; unsigned x; volatile LAS unsigned* st; };
__device__ __forceinline__ XcdBarrier xcd_barrier_post(unsigned* bar, volatile LAS unsigned* st) {
    XcdBarrier b; b.bar = bar; b.x = xb_xcc_id(); b.st = st;
    if (threadIdx.x == 0) (void)xb_add(&bar[XB_XCNT(b.x)], 1u);
    return b;
}
__device__ __forceinline__ void xcd_barrier_complete(unsigned* bar, unsigned x, unsigned& nloc, unsigned& nx) {
    const unsigned G = gridDim.x * gridDim.y * gridDim.z;
    unsigned sum, cnt, mine, sp = 0u;
    for (;;) {
        sum = 0u; cnt = 0u; mine = 0u;
#pragma unroll
        for (unsigned j = 0; j < 16; ++j) { const unsigned c = xb_ld(&bar[XB_XCNT(j)]); sum += c; cnt += (c > 0u) ? 1u : 0u; mine = (j == x) ? c : mine; }
        if (sum == G) break;
        __builtin_amdgcn_s_sleep(1);
        if ((++sp & 255u) == 0u) { if (xb_ld(&bar[XB_TMO])) break; if (sp > XB_SPIN_CAP) { atomicAdd(&bar[XB_TMO], 1u); break; } }
    }
    nloc = mine > 0u ? mine : 1u; nx = cnt > 0u ? cnt : 1u;
}
__device__ __forceinline__ void xcd_barrier(const XcdBarrier& b) {
    asm volatile("s_waitcnt vmcnt(0)" ::: "memory");
    __syncthreads();
    if (threadIdx.x == 0) {
        unsigned* bar = b.bar;
        __builtin_amdgcn_s_waitcnt(0);
        unsigned nloc = b.st[0], nx = b.st[1];
        if (nloc == 0u) { xcd_barrier_complete(bar, b.x, nloc, nx); b.st[0] = nloc; b.st[1] = nx; }
        const unsigned old = xb_add(&bar[XB_XSUB(b.x)], 1u);
        const unsigned gen = old / nloc;
        if (old + 1u == (gen + 1u) * nloc) {
            __builtin_amdgcn_fence(__ATOMIC_RELEASE, "agent");
            asm volatile("s_waitcnt vmcnt(0)" ::: "memory");
            const unsigned og = xb_add(&bar[XB_TOP], 1u);
            const unsigned tg = og / nx;
            if (og + 1u == (tg + 1u) * nx) xb_add(&bar[XB_TOPGEN], 1u);
            else XB_SPIN(xb_ld(&bar[XB_TOPGEN]) == tg, bar);
            __builtin_amdgcn_fence(__ATOMIC_ACQUIRE, "agent");
            xb_add(&bar[XB_XGEN(b.x)], 1u);
            asm volatile("s_waitcnt vmcnt(0)" ::: "memory");
        } else {
            XB_SPIN(xb_ld(&bar[XB_XGEN(b.x)]) == gen, bar);
            __builtin_amdgcn_fence(__ATOMIC_ACQUIRE, "agent");
            asm volatile("s_waitcnt vmcnt(0)" ::: "memory");
        }
    }
    __syncthreads();
}

__device__ __forceinline__ int lds_byte2(int r, int c) { const int st = (r >> 4) * 2 + (c >> 5), ob = (r & 15) * 64 + (c & 31) * 2; return st * 1024 + (ob ^ (((ob >> 9) & 1) << 5)); }
__device__ __forceinline__ void stage_rc2(int b, int& R, int& C) { const int st = b >> 10, sb = b & 1023, swz = sb ^ (((sb >> 9) & 1) << 5); R = (st >> 1) * 16 + swz / 64; C = (st & 1) * 32 + (swz % 64) / 2; }

template <int MI, int NI, bool TRANS>
__device__ __forceinline__ void gemm_block(LAS unsigned char* lds, const bf16_t* const (&ap)[MI / 2], const bf16_t* const (&bp)[NI], int nkt, f32x4 (&acc)[MI][NI]) {
    constexpr int BM = 32 * MI, BN = 64 * NI, TA = BM * 128, TB = BN * 128, STG = TA + TB, GLA = MI / 2, GLB = NI;
    static_assert(2 * STG <= SCR_BYTES, "LDS");
    const int tid = threadIdx.x, lane = tid & 63, wid = __builtin_amdgcn_readfirstlane(tid >> 6), wr = wid >> 2, wc = wid & 3, fr = lane & 15, fq = lane >> 4;
    const int aoff = lds_byte2(wr * (MI * 16) + fr, fq * 8), boff = TA + lds_byte2(wc * (NI * 16) + fr, fq * 8);
#define GB_STAGE(buf, kt) do { \
        _Pragma("unroll") for (int i_ = 0; i_ < GLA; ++i_) __builtin_amdgcn_global_load_lds((const unsigned*)(ap[i_] + (kt) * 64), (LAS unsigned*)(lds + (buf) * STG + wid * 1024 + i_ * 8192), 16, 0, 0); \
        _Pragma("unroll") for (int i_ = 0; i_ < GLB; ++i_) __builtin_amdgcn_global_load_lds((const unsigned*)(bp[i_] + (kt) * 64), (LAS unsigned*)(lds + (buf) * STG + TA + wid * 1024 + i_ * 8192), 16, 0, 0); } while (0)
    GB_STAGE(0, 0);
    asm volatile("s_waitcnt vmcnt(0)" ::: "memory"); __syncthreads();
    for (int t = 0; t < nkt; ++t) {
        const int cur = t & 1;
        if (t + 1 < nkt) GB_STAGE(cur ^ 1, t + 1);
        const LAS unsigned char* sb = lds + cur * STG;
#pragma unroll
        for (int ks = 0; ks < 2; ++ks) {
            bf16x8 At[MI], Bf[NI];
#pragma unroll
            for (int m = 0; m < MI; ++m) At[m] = *(const LAS bf16x8*)(sb + aoff + m * 2048 + ks * 1024);
#pragma unroll
            for (int n = 0; n < NI; ++n) Bf[n] = *(const LAS bf16x8*)(sb + boff + n * 2048 + ks * 1024);
#pragma unroll
            for (int m = 0; m < MI; ++m)
#pragma unroll
                for (int n = 0; n < NI; ++n)
                    acc[m][n] = TRANS ? __builtin_amdgcn_mfma_f32_16x16x32_bf16(Bf[n], At[m], acc[m][n], 0, 0, 0)
                                      : __builtin_amdgcn_mfma_f32_16x16x32_bf16(At[m], Bf[n], acc[m][n], 0, 0, 0);
        }
        asm volatile("s_waitcnt vmcnt(0)" ::: "memory"); __syncthreads();
    }
#undef GB_STAGE
}
template <int MI, int NI, bool ARES>
__device__ __forceinline__ void gemm_stage(LAS unsigned char* lds, int abytes, const bf16_t* const (&ap)[MI / 2], const bf16_t* const (&bp)[NI], int buf, int kt) {
    constexpr int TA = MI * 32 * 128, TB = NI * 64 * 128, STG = ARES ? TB : TA + TB;
    const int wid = __builtin_amdgcn_readfirstlane(threadIdx.x >> 6);
    LAS unsigned char* base = lds + (ARES ? abytes : 0) + buf * STG + wid * 1024;
    if (!ARES) {
#pragma unroll
        for (int i = 0; i < MI / 2; ++i) __builtin_amdgcn_global_load_lds((const unsigned*)(ap[i] + kt * 64), (LAS unsigned*)(base + i * 8192), 16, 0, 0);
    }
#pragma unroll
    for (int i = 0; i < NI; ++i) __builtin_amdgcn_global_load_lds((const unsigned*)(bp[i] + kt * 64), (LAS unsigned*)(base + (ARES ? 0 : TA) + i * 8192), 16, 0, 0);
}
template <int MI>
__device__ __forceinline__ void gemm_load_ares(LAS unsigned char* lds, const bf16_t* const (&ap)[MI / 2], int nkt) {
    constexpr int TA = MI * 32 * 128;
    const int wid = __builtin_amdgcn_readfirstlane(threadIdx.x >> 6);
    for (int kt = 0; kt < nkt; ++kt) {
#pragma unroll
        for (int i = 0; i < MI / 2; ++i) __builtin_amdgcn_global_load_lds((const unsigned*)(ap[i] + kt * 64), (LAS unsigned*)(lds + kt * TA + wid * 1024 + i * 8192), 16, 0, 0);
    }
}
template <int MI, int NI, bool TRANS, bool ARES>
__device__ __forceinline__ void gemm_main2(LAS unsigned char* lds, int abytes, const bf16_t* const (&ap)[MI / 2], const bf16_t* const (&bp)[NI], const bf16_t* const (&bq)[NI], int ksplit, int nkt, f32x4 (&acc)[MI][NI]) {
    constexpr int TA = MI * 32 * 128, TB = NI * 64 * 128, STG = ARES ? TB : TA + TB;
    const int tid = threadIdx.x, lane = tid & 63, wid = __builtin_amdgcn_readfirstlane(tid >> 6), wr = wid >> 2, wc = wid & 3, fr = lane & 15, fq = lane >> 4;
    const int aoff = lds_byte2(wr * (MI * 16) + fr, fq * 8), boff = (ARES ? abytes : TA) + lds_byte2(wc * (NI * 16) + fr, fq * 8);
#pragma unroll 1
    for (int t = 0; t < nkt; ++t) {
        const int cur = t & 1;
        asm volatile("s_waitcnt vmcnt(0)" ::: "memory"); __syncthreads();
        if (t + 1 < nkt) { if (t + 1 < ksplit) gemm_stage<MI, NI, ARES>(lds, abytes, ap, bp, cur ^ 1, t + 1); else gemm_stage<MI, NI, ARES>(lds, abytes, ap, bq, cur ^ 1, t + 1); }
        const LAS unsigned char* sa = ARES ? lds + t * TA : lds + cur * STG;
        const LAS unsigned char* sb = lds + cur * STG;
#pragma unroll
        for (int ks = 0; ks < 2; ++ks) {
            bf16x8 At[MI], Bf[NI];
#pragma unroll
            for (int m = 0; m < MI; ++m) At[m] = *(const LAS bf16x8*)(sa + aoff + m * 2048 + ks * 1024);
#pragma unroll
            for (int n = 0; n < NI; ++n) Bf[n] = *(const LAS bf16x8*)(sb + boff + n * 2048 + ks * 1024);
#pragma unroll
            for (int m = 0; m < MI; ++m)
#pragma unroll
                for (int n = 0; n < NI; ++n)
                    acc[m][n] = TRANS ? __builtin_amdgcn_mfma_f32_16x16x32_bf16(Bf[n], At[m], acc[m][n], 0, 0, 0)
                                      : __builtin_amdgcn_mfma_f32_16x16x32_bf16(At[m], Bf[n], acc[m][n], 0, 0, 0);
        }
    }
    if (nkt & 1) __syncthreads();
}
template <int MI, int NI, bool TRANS, bool ARES>
__device__ __forceinline__ void gemm_main(LAS unsigned char* lds, int abytes, const bf16_t* const (&ap)[MI / 2], const bf16_t* const (&bp)[NI], int nkt, f32x4 (&acc)[MI][NI]) {
    gemm_main2<MI, NI, TRANS, ARES>(lds, abytes, ap, bp, bp, nkt, nkt, acc);
}
template <int GL>
__device__ __forceinline__ void stage_ptrs_dense(const bf16_t* base, size_t ld, int r0, const bf16_t* (&p)[GL]) {
    const int tid = threadIdx.x, lane = tid & 63, wid = tid >> 6;
#pragma unroll
    for (int i = 0; i < GL; ++i) { int R, C; stage_rc2(wid * 1024 + i * 8192 + lane * 16, R, C); p[i] = base + (size_t)(r0 + R) * ld + C; }
}

struct Params {
    const void* in[26];
    float* out;
    unsigned char* ws;
    int ph_lo, ph_hi;
};
typedef const __attribute__((address_space(4))) Params* CP;
__device__ __forceinline__ CP get_params() { CP q = (CP)__builtin_amdgcn_kernarg_segment_ptr(); asm volatile("" : "+s"(q)); return q; }

__device__ const float INVF[16] = {1.000000000e+00f, 5.623413324e-01f, 3.162277639e-01f, 1.778279394e-01f, 1.000000015e-01f, 5.623413250e-02f, 3.162277490e-02f, 1.778279431e-02f,
                                   9.999999776e-03f, 5.623413250e-03f, 3.162277630e-03f, 1.778279431e-03f, 1.000000047e-03f, 5.623413017e-04f, 3.162277571e-04f, 1.778279402e-04f};

__device__ __forceinline__ void tr_item(const float* srcp, int ldw, const float* kscale, bf16_t* WT, int Kd, int k0, int n0, LAS float* scr, int lane) {
#pragma unroll 8
    for (int i = 0; i < 32; ++i) { const int kk = 2 * i + (lane >> 5); float v = 0.f; if (srcp) { v = srcp[(size_t)(k0 + kk) * ldw]; if (kscale) v *= kscale[k0 + kk]; } scr[kk * 33 + (lane & 31)] = v; }
    asm volatile("s_waitcnt lgkmcnt(0)" ::: "memory");
    const int c = lane & 7;
#pragma unroll
    for (int j = 0; j < 4; ++j) { const int n = (lane >> 3) + 8 * j; const LAS float* s = scr + (8 * c) * 33 + n;
        u32x4 o; o.x = cvtpk(s[0 * 33], s[1 * 33]); o.y = cvtpk(s[2 * 33], s[3 * 33]); o.z = cvtpk(s[4 * 33], s[5 * 33]); o.w = cvtpk(s[6 * 33], s[7 * 33]);
        *(u32x4*)(WT + (size_t)(n0 + n) * Kd + k0 + 8 * c) = o; }
    asm volatile("s_waitcnt lgkmcnt(0)" ::: "memory");
}

__device__ __forceinline__ void phase0(CP p, LAS unsigned char* lds) {
    const int tid = threadIdx.x, lane = tid & 63, wave = __builtin_amdgcn_readfirstlane(tid >> 6);
    const int G = gridDim.x, bid = blockIdx.x;
    unsigned char* ws = p->ws;
    if (bid < 192) {
        const float* c = (const float*)p->in[1]; const float* w_ada = (const float*)p->in[3]; const float* b_ada = (const float*)p->in[4];
        LAS float* sc = (LAS float*)lds;
        LAS float* red = (LAS float*)(lds + 32768);
        for (int i = tid; i < 8192; i += 512) sc[i] = siluf_(c[i]);
        __syncthreads();
        const int col = tid & 31, ks = tid >> 5, n0 = bid * 32;
        float a[8] = {0, 0, 0, 0, 0, 0, 0, 0};
#pragma unroll 8
        for (int i = 0; i < 64; ++i) { const int k = ks * 64 + i; const float w = w_ada[(size_t)k * 6144 + n0 + col];
#pragma unroll
            for (int b = 0; b < 8; ++b) a[b] += sc[b * 1024 + k] * w; }
#pragma unroll
        for (int b = 0; b < 8; ++b) red[(ks * 32 + col) * 8 + b] = a[b];
        __syncthreads();
        if (tid < 256) { const int cc = tid & 31, b = tid >> 5; float s = 0.f;
#pragma unroll
            for (int k2 = 0; k2 < 16; ++k2) s += red[(k2 * 32 + cc) * 8 + b];
            ((float*)(ws + WS_MOD))[b * 6144 + n0 + cc] = s + b_ada[n0 + cc]; }
        __syncthreads();
    }
    {
        const int* pos = (const int*)p->in[2]; f32x2* rt = (f32x2*)(ws + WS_ROPE);
        for (int e = bid * 512 + tid; e < MT * 16; e += G * 512) {
            const int tok = e >> 4, i = e & 15;
            const float a32 = (float)pos[tok] * INVF[i];
            const double rev = (double)a32 * 0.15915494309189535;
            const float fr = (float)(rev - __builtin_rint(rev));
            rt[e] = (f32x2){__builtin_amdgcn_cosf(fr), __builtin_amdgcn_sinf(fr)};
        }
    }
    {
        LAS unsigned* scr = (LAS unsigned*)(lds + 65536) + wave * 2112;
        const int gw = bid * 8 + wave, NGW = G * 8;
        const float* w_in = (const float*)p->in[6]; const float* qan = (const float*)p->in[11]; const float* w_qb = (const float*)p->in[12];
        const float* kvan = (const float*)p->in[13]; const float* w_kvb = (const float*)p->in[14]; const float* w_out = (const float*)p->in[17];
        const float* w_group = (const float*)p->in[19]; const float* w_expert = (const float*)p->in[21];
        const float* w_gate = (const float*)p->in[23]; const float* w_up = (const float*)p->in[24]; const float* w_down = (const float*)p->in[25];
        constexpr int I0 = 16 * 24, I1 = 4 * 12, I2 = 2 * 16, I3 = 16 * 16, I4 = 32 * 128, I5 = 32 * 64, I6 = 16 * 2;
        constexpr int NIT = I0 + I1 + I2 + I3 + I4 + I5 + I6;
        const int c4 = lane & 15, kp = lane >> 4;
        for (int it = gw; it < NIT; it += NGW) {
            int r = it;
            if (r >= NIT - I6) {
                r -= NIT - I6;
                LAS float* fscr = (LAS float*)scr; const int nl = lane & 31;
                const int kb = r >> 1, nb = r & 1, n0 = nb * 32, np = n0 + nl, k0 = kb * 64;
                const float* srcp = nullptr; int ldw = 0;
                if (np < 4) { srcp = w_group + np; ldw = 4; } else if (np < 36) { srcp = w_expert + (np - 4); ldw = 32; }
#pragma unroll 8
                for (int i = 0; i < 32; ++i) { const int kk = 2 * i + (lane >> 5); fscr[kk * 33 + nl] = srcp ? srcp[(size_t)(k0 + kk) * ldw] : 0.f; }
                asm volatile("s_waitcnt lgkmcnt(0)" ::: "memory");
                const int c = lane & 7;
#pragma unroll
                for (int j = 0; j < 4; ++j) { const int n = (lane >> 3) + 8 * j; const LAS float* sp = fscr + (8 * c) * 33 + n;
                    float v[8], l[8];
#pragma unroll
                    for (int q = 0; q < 8; ++q) { v[q] = sp[q * 33]; l[q] = v[q] - bf2f(f2bf(v[q])); }
                    if (n0 + n < 48) {
                        u32x4 o; o.x = cvtpk(v[0], v[1]); o.y = cvtpk(v[2], v[3]); o.z = cvtpk(v[4], v[5]); o.w = cvtpk(v[6], v[7]);
                        *(u32x4*)((bf16_t*)(ws + WS_WR) + (size_t)(n0 + n) * 1024 + k0 + 8 * c) = o;
                        u32x4 o2; o2.x = cvtpk(l[0], l[1]); o2.y = cvtpk(l[2], l[3]); o2.z = cvtpk(l[4], l[5]); o2.w = cvtpk(l[6], l[7]);
                        *(u32x4*)((bf16_t*)(ws + WS_WR) + 48 * 1024 + (size_t)(n0 + n) * 1024 + k0 + 8 * c) = o2; } }
                asm volatile("s_waitcnt lgkmcnt(0)" ::: "memory");
                continue;
            }
            const float* srcp; int ldw, Kd, k0, n0; const float* ksc = nullptr; bf16_t* WT;
            if (r < I0) {
                const int kb = r / 24, nb = r % 24; n0 = nb * 64; k0 = kb * 64; const int np = n0 + 4 * c4;
                const int pn = np >> 8, wc = (np >> 6) & 3, n = (np >> 4) & 3, f = np & 15; int src;
                if (pn < 4) { const int ch = pn * 128 + wc * 32 + (n >> 1) * 16 + f; src = (n & 1) ? 512 + ch : ch; }
                else if (pn == 4) src = np;
                else { const int j = np - 1280; src = (j < 160) ? 1280 + j : -1; }
                srcp = src >= 0 ? w_in + src : nullptr; ldw = 1440; Kd = 1024; WT = (bf16_t*)(ws + WS_WIN);
            } else if ((r -= I0) < I1) {
                const int kb = r / 12, nb = r % 12; n0 = nb * 64; k0 = kb * 64;
                srcp = w_qb + n0 + 4 * c4; ldw = 768; Kd = 256; ksc = qan; WT = (bf16_t*)(ws + WS_WQ);
            } else if ((r -= I1) < I2) {
                const int kb = r / 16, nb = r % 16; n0 = nb * 64; k0 = kb * 64;
                srcp = w_kvb + n0 + 4 * c4; ldw = 1024; Kd = 128; ksc = kvan; WT = (bf16_t*)(ws + WS_WKV);
            } else if ((r -= I2) < I3) {
                const int kb = r / 16, nb = r % 16; n0 = nb * 64; k0 = kb * 64;
                srcp = w_out + n0 + 4 * c4; ldw = 1024; Kd = 1024; WT = (bf16_t*)(ws + WS_WOUT);
            } else if ((r -= I3) < I4) {
                const int e = r >> 7, q = r & 127, kb = q / 8, nb = q % 8; n0 = nb * 64; k0 = kb * 64; const int np = n0 + 4 * c4;
                const int ct = np >> 8, wc = (np >> 6) & 3, n = (np >> 4) & 3, f = np & 15, ch = ct * 128 + wc * 32 + (n >> 1) * 16 + f;
                srcp = ((n & 1) ? w_up : w_gate) + (size_t)e * 1024 * 256 + ch; ldw = 256; Kd = 1024; WT = (bf16_t*)(ws + WS_WGU) + (size_t)e * 512 * 1024;
            } else {
                r -= I4; const int e = r >> 6, q = r & 63, kb = q / 16, nb = q % 16; n0 = nb * 64; k0 = kb * 64;
                srcp = w_down + (size_t)e * 256 * 1024 + n0 + 4 * c4; ldw = 1024; Kd = 256; WT = (bf16_t*)(ws + WS_WD) + (size_t)e * 1024 * 256;
            }
            f32x4 v0[8], v1[8];
#pragma unroll
            for (int i = 0; i < 8; ++i) { const int k = k0 + 8 * i + 2 * kp;
                if (srcp) { v0[i] = *(const f32x4*)(srcp + (size_t)k * ldw); v1[i] = *(const f32x4*)(srcp + (size_t)(k + 1) * ldw); }
                else { v0[i] = (f32x4){0.f, 0.f, 0.f, 0.f}; v1[i] = v0[i]; } }
#pragma unroll
            for (int i = 0; i < 8; ++i) { const int k = k0 + 8 * i + 2 * kp; f32x4 a = v0[i], b = v1[i];
                if (ksc) { a = a * ksc[k]; b = b * ksc[k + 1]; }
                LAS unsigned* d = scr + (4 * c4) * 33 + 4 * i + kp;
                d[0] = cvtpk(a.x, b.x); d[33] = cvtpk(a.y, b.y); d[66] = cvtpk(a.z, b.z); d[99] = cvtpk(a.w, b.w); }
            asm volatile("s_waitcnt lgkmcnt(0)" ::: "memory");
            const int c = lane & 7;
#pragma unroll
            for (int j = 0; j < 8; ++j) { const int n = (lane >> 3) + 8 * j; const LAS unsigned* sp = scr + n * 33 + 4 * c;
                u32x4 o; o.x = sp[0]; o.y = sp[1]; o.z = sp[2]; o.w = sp[3];
                *(u32x4*)(WT + (size_t)(n0 + n) * Kd + k0 + 8 * c) = o; }
            asm volatile("s_waitcnt lgkmcnt(0)" ::: "memory");
        }
    }
}

__device__ __forceinline__ void phase1a(CP p) {
    const int tid = threadIdx.x, lane = tid & 63, wave = tid >> 6;
    const int gw = blockIdx.x * 8 + wave, NGW = gridDim.x * 8;
    const float* x = (const float*)p->in[0]; const float* nm = (const float*)p->in[5]; const float* mod = (const float*)(p->ws + WS_MOD);
    bf16_t* h = (bf16_t*)(p->ws + WS_H);
    for (int grp = gw; grp < MT / 16; grp += NGW) {
        const int r0 = grp * 16, b = r0 >> 12;
        f32x4 gm[4], sh[4];
#pragma unroll
        for (int j = 0; j < 4; ++j) { const int col = 4 * lane + 256 * j; const f32x4 g = *(const f32x4*)(nm + col), s = *(const f32x4*)(mod + b * 6144 + 1024 + col);
            gm[j] = g * (s + 1.0f); sh[j] = *(const f32x4*)(mod + b * 6144 + col); }
#pragma unroll 1
        for (int rb = 0; rb < 16; rb += 4) {
            f32x4 v[4][4];
#pragma unroll
            for (int rr = 0; rr < 4; ++rr) { const float* xr = x + (size_t)(r0 + rb + rr) * DM;
#pragma unroll
                for (int j = 0; j < 4; ++j) v[rr][j] = *(const f32x4*)(xr + 4 * lane + 256 * j); }
#pragma unroll
            for (int rr = 0; rr < 4; ++rr) { float s = 0.f;
#pragma unroll
                for (int j = 0; j < 4; ++j) s += (v[rr][j].x * v[rr][j].x + v[rr][j].y * v[rr][j].y) + (v[rr][j].z * v[rr][j].z + v[rr][j].w * v[rr][j].w);
                const float rstd = __builtin_amdgcn_rsqf(wave_sum(s) * (1.0f / DM) + EPS);
                bf16_t* hr = h + (size_t)(r0 + rb + rr) * DM;
#pragma unroll
                for (int j = 0; j < 4; ++j) { const f32x4 o = v[rr][j] * rstd * gm[j] + sh[j]; u32x2 w; w.x = cvtpk(o.x, o.y); w.y = cvtpk(o.z, o.w); *(u32x2*)(hr + 4 * lane + 256 * j) = w; } }
        }
    }
}

__device__ __forceinline__ void phase1b(CP p, LAS unsigned char* lds) {
    const int tid = threadIdx.x, lane = tid & 63, wid = __builtin_amdgcn_readfirstlane(tid >> 6), wr = wid >> 2, wc = wid & 3, fr = lane & 15, fq = lane >> 4;
    unsigned char* ws = p->ws;
    const bf16_t* h = (const bf16_t*)(ws + WS_H); const bf16_t* win = (const bf16_t*)(ws + WS_WIN);
    for (int u = vcu_id(); u < 128 * 6; u += gridDim.x) {
        const int pm = u / 6, pn = u % 6;
        const bf16_t* ap[4]; const bf16_t* bp[4];
        stage_ptrs_dense<4>(h, 1024, pm * 256, ap); stage_ptrs_dense<4>(win, 1024, pn * 256, bp);
        f32x4 acc[8][4];
#pragma unroll
        for (int m = 0; m < 8; ++m)
#pragma unroll
            for (int n = 0; n < 4; ++n) acc[m][n] = (f32x4){0.f, 0.f, 0.f, 0.f};
        gemm_block<8, 4, true>(lds, ap, bp, 16, acc);
        const int rowb = pm * 256 + wr * 128 + fr;
        if (pn < 4) {
            bf16_t* ub = (bf16_t*)(ws + WS_U);
#pragma unroll
            for (int m = 0; m < 8; ++m) { const size_t row = rowb + m * 16;
#pragma unroll
                for (int h2 = 0; h2 < 2; ++h2) { const f32x4 v = acc[m][2 * h2], g = acc[m][2 * h2 + 1];
                    const int ch = pn * 128 + wc * 32 + h2 * 16 + fq * 4;
                    u32x2 w; w.x = cvtpk(v.x * sigmoidf_(g.x), v.y * sigmoidf_(g.y)); w.y = cvtpk(v.z * sigmoidf_(g.z), v.w * sigmoidf_(g.w));
                    *(u32x2*)(ub + row * 512 + ch) = w; } }
        } else if (pn == 4) {
            bf16_t* cq = (bf16_t*)(ws + WS_CQ); float* sq = (float*)(ws + WS_SSQQ);
#pragma unroll
            for (int m = 0; m < 8; ++m) { const size_t row = rowb + m * 16; float s = 0.f;
#pragma unroll
                for (int n = 0; n < 4; ++n) { const f32x4 v = acc[m][n]; s += (v.x * v.x + v.y * v.y) + (v.z * v.z + v.w * v.w);
                    u32x2 w; w.x = cvtpk(v.x, v.y); w.y = cvtpk(v.z, v.w); *(u32x2*)(cq + row * 256 + wc * 64 + n * 16 + fq * 4) = w; }
                s += __shfl_xor(s, 16); s += __shfl_xor(s, 32);
                if (fq == 0) sq[row * 4 + wc] = s; }
        } else {
            if (wc < 2) {
                bf16_t* ckv = (bf16_t*)(ws + WS_CKV); float* sq = (float*)(ws + WS_SSQKV);
#pragma unroll
                for (int m = 0; m < 8; ++m) { const size_t row = rowb + m * 16; float s = 0.f;
#pragma unroll
                    for (int n = 0; n < 4; ++n) { const f32x4 v = acc[m][n]; s += (v.x * v.x + v.y * v.y) + (v.z * v.z + v.w * v.w);
                        u32x2 w; w.x = cvtpk(v.x, v.y); w.y = cvtpk(v.z, v.w); *(u32x2*)(ckv + row * 128 + wc * 64 + n * 16 + fq * 4) = w; }
                    s += __shfl_xor(s, 16); s += __shfl_xor(s, 32);
                    if (fq == 0) sq[row * 2 + wc] = s; }
            } else if (wc == 2) {
                float* kr = (float*)(ws + WS_KROPE); float* sq = (float*)(ws + WS_SSQKR);
#pragma unroll
                for (int m = 0; m < 8; ++m) { const size_t row = rowb + m * 16; float s = 0.f;
#pragma unroll
                    for (int n = 0; n < 2; ++n) { const f32x4 v = acc[m][n]; s += (v.x * v.x + v.y * v.y) + (v.z * v.z + v.w * v.w);
                        *(f32x4*)(kr + row * 32 + n * 16 + fq * 4) = v; }
                    s += __shfl_xor(s, 16); s += __shfl_xor(s, 32);
                    if (fq == 0) sq[row] = s; }
            }
        }
    }
}

constexpr int EPI_SCR = 131072;
__device__ __forceinline__ void q_item(CP p, LAS unsigned char* lds, int item) {
    const int tid = threadIdx.x, lane = tid & 63, wid = __builtin_amdgcn_readfirstlane(tid >> 6), wr = wid >> 2, wc = wid & 3, fr = lane & 15, fq = lane >> 4;
    unsigned char* ws = p->ws;
    const int pm = item >> 1, ct = item & 1;
    const bf16_t* ap[2]; const bf16_t* bp[6];
    stage_ptrs_dense<2>((const bf16_t*)(ws + WS_CQ), 256, pm * 128, ap);
    stage_ptrs_dense<6>((const bf16_t*)(ws + WS_WQ), 256, ct * 384, bp);
    __syncthreads();
    gemm_stage<4, 6, false>(lds, 0, ap, bp, 0, 0);
    const float* sq = (const float*)(ws + WS_SSQQ); const float* qn = (const float*)p->in[15];
    const int rowb = pm * 128 + wr * 64 + fr, i0 = fq * 4;
    float rq[4]; f32x4 gq[6], cs01[4], cs23[4];
#pragma unroll
    for (int m = 0; m < 4; ++m) { const f32x4 s4 = *(const f32x4*)(sq + (size_t)(rowb + m * 16) * 4); rq[m] = __builtin_amdgcn_rsqf(((s4.x + s4.y) + (s4.z + s4.w)) * (1.0f / 256.0f) + EPS); }
#pragma unroll
    for (int n = 0; n < 6; ++n) gq[n] = *(const f32x4*)(qn + n * 16 + i0);
    const f32x2* rope = (const f32x2*)(ws + WS_ROPE);
#pragma unroll
    for (int m = 0; m < 4; ++m) { const size_t tok = rowb + m * 16; cs01[m] = *(const f32x4*)(rope + tok * 16 + i0); cs23[m] = *(const f32x4*)(rope + tok * 16 + i0 + 2); }
    f32x4 acc[4][6];
#pragma unroll
    for (int m = 0; m < 4; ++m)
#pragma unroll
        for (int n = 0; n < 6; ++n) acc[m][n] = (f32x4){0.f, 0.f, 0.f, 0.f};
    gemm_main<4, 6, true, false>(lds, 0, ap, bp, 4, acc);
    const int hd = ct * 4 + wc, bb = (pm * 128) >> 12, sb = rowb & 4095;
    bf16_t* dst0 = (bf16_t*)(ws + WS_Q) + ((size_t)(bb * 8 + hd) * 4096 + sb) * 96;
#pragma unroll
    for (int m = 0; m < 4; ++m) { float s = 0.f;
#pragma unroll
        for (int n = 0; n < 6; ++n) { acc[m][n] = acc[m][n] * rq[m]; const f32x4 v = acc[m][n]; s += (v.x * v.x + v.y * v.y) + (v.z * v.z + v.w * v.w); }
        s += __shfl_xor(s, 16); s += __shfl_xor(s, 32);
        const float rh = __builtin_amdgcn_rsqf(s * (1.0f / 96.0f) + EPS) * QSCALE;
        bf16_t* dst = dst0 + (m * 16) * 96;
#pragma unroll
        for (int n = 0; n < 4; ++n) { const f32x4 v = acc[m][n] * rh * gq[n]; u32x2 w; w.x = cvtpk(v.x, v.y); w.y = cvtpk(v.z, v.w); *(u32x2*)(dst + n * 16 + i0) = w; }
        const f32x4 x1 = acc[m][4] * rh * gq[4], x2 = acc[m][5] * rh * gq[5];
        const f32x4 c01 = cs01[m], c23 = cs23[m];
        f32x4 o1, o2;
        o1.x = x1.x * c01.x - x2.x * c01.y; o2.x = x1.x * c01.y + x2.x * c01.x;
        o1.y = x1.y * c01.z - x2.y * c01.w; o2.y = x1.y * c01.w + x2.y * c01.z;
        o1.z = x1.z * c23.x - x2.z * c23.y; o2.z = x1.z * c23.y + x2.z * c23.x;
        o1.w = x1.w * c23.z - x2.w * c23.w; o2.w = x1.w * c23.w + x2.w * c23.z;
        u32x2 w; w.x = cvtpk(o1.x, o1.y); w.y = cvtpk(o1.z, o1.w); *(u32x2*)(dst + 64 + i0) = w;
        w.x = cvtpk(o2.x, o2.y); w.y = cvtpk(o2.z, o2.w); *(u32x2*)(dst + 80 + i0) = w;
    }
}

constexpr int KV_SCR = 98304;
__device__ __forceinline__ void kv_item(CP p, LAS unsigned char* lds, int pm) {
    const int tid = threadIdx.x, lane = tid & 63, wid = __builtin_amdgcn_readfirstlane(tid >> 6), wr = wid >> 2, wc = wid & 3, fr = lane & 15, fq = lane >> 4;
    unsigned char* ws = p->ws;
    const bf16_t* ap[2]; const bf16_t* bp[4];
    stage_ptrs_dense<2>((const bf16_t*)(ws + WS_CKV), 128, pm * 128, ap);
    stage_ptrs_dense<4>((const bf16_t*)(ws + WS_WKV), 128, 0, bp);
    __syncthreads();
    gemm_load_ares<4>(lds, ap, 2);
    gemm_stage<4, 4, true>(lds, 32768, ap, bp, 0, 0);
    LAS float* kr_l = (LAS float*)(lds + KV_SCR); LAS float* rp_l = kr_l + 128 * 33; LAS float* rkv_l = rp_l + 128 * 34; LAS float* skr_l = rkv_l + 128;
    {
        const float* krp = (const float*)(ws + WS_KROPE) + (size_t)pm * 128 * 32; const float* rope = (const float*)(ws + WS_ROPE) + (size_t)pm * 128 * 32;
        f32x4 a[2], b[2];
#pragma unroll
        for (int k = 0; k < 2; ++k) { const int idx = tid + 512 * k; a[k] = *(const f32x4*)(krp + idx * 4); b[k] = *(const f32x4*)(rope + idx * 4); }
        float rk = 0.f, sk = 0.f;
        if (tid < 128) { const f32x2 s2 = *(const f32x2*)((const float*)(ws + WS_SSQKV) + (size_t)(pm * 128 + tid) * 2); rk = __builtin_amdgcn_rsqf((s2.x + s2.y) * (1.0f / 128.0f) + EPS); sk = ((const float*)(ws + WS_SSQKR))[pm * 128 + tid]; }
#pragma unroll
        for (int k = 0; k < 2; ++k) { const int idx = tid + 512 * k, row = idx >> 3, c4 = (idx & 7) * 4;
            LAS float* d = kr_l + row * 33 + c4; d[0] = a[k].x; d[1] = a[k].y; d[2] = a[k].z; d[3] = a[k].w;
            LAS float* e = rp_l + row * 34 + c4; e[0] = b[k].x; e[1] = b[k].y; e[2] = b[k].z; e[3] = b[k].w; }
        if (tid < 128) { rkv_l[tid] = rk; skr_l[tid] = sk; }
    }
    const float* kn = (const float*)p->in[16];
    const int rowl = wr * 64 + fq * 4, rowb = pm * 128 + rowl;
    float g[4];
#pragma unroll
    for (int n = 0; n < 4; ++n) g[n] = kn[n * 16 + fr];
    const float g1 = kn[64 + fr], g2 = kn[80 + fr];
    const int bb = (pm * 128) >> 12, sb = rowb & 4095;
#pragma unroll 1
    for (int pn = 0; pn < 4; ++pn) {
        f32x4 acc[4][4];
#pragma unroll
        for (int m = 0; m < 4; ++m)
#pragma unroll
            for (int n = 0; n < 4; ++n) acc[m][n] = (f32x4){0.f, 0.f, 0.f, 0.f};
        gemm_main<4, 4, false, true>(lds, 32768, ap, bp, 2, acc);
        if (pn < 3) {
#pragma unroll
            for (int i = 0; i < 4; ++i) bp[i] += 256 * 128;
            gemm_stage<4, 4, true>(lds, 32768, ap, bp, 0, 0);
        }
        const int hd = pn * 2 + (wc >> 1);
        if ((wc & 1) == 0) {
            bf16_t* dst_p = (bf16_t*)(ws + WS_K) + ((size_t)(bb * 8 + hd) * 4096 + sb) * 96 + fr;
#pragma unroll
            for (int m = 0; m < 4; ++m) {
#pragma unroll
                for (int j = 0; j < 4; ++j) {
                    const int o = m * 16 + j, rl = rowl + o;
                    const float rkv = rkv_l[rl];
                    float v[4], ss = 0.f;
#pragma unroll
                    for (int n = 0; n < 4; ++n) { v[n] = acc[m][n][j] * rkv; ss += v[n] * v[n]; }
                    ss += __shfl_xor(ss, 1); ss += __shfl_xor(ss, 2); ss += __shfl_xor(ss, 4); ss += __shfl_xor(ss, 8);
                    const float rk = __builtin_amdgcn_rsqf((ss + skr_l[rl]) * (1.0f / 96.0f) + EPS);
                    bf16_t* dst = dst_p + o * 96;
#pragma unroll
                    for (int n = 0; n < 4; ++n) dst[n * 16] = f2bf(v[n] * rk * g[n]);
                    const float x1 = kr_l[rl * 33 + fr] * rk * g1, x2 = kr_l[rl * 33 + 16 + fr] * rk * g2;
                    const float cs_c = rp_l[rl * 34 + 2 * fr], cs_s = rp_l[rl * 34 + 2 * fr + 1];
                    dst[64] = f2bf(x1 * cs_c - x2 * cs_s); dst[80] = f2bf(x1 * cs_s + x2 * cs_c);
                }
            }
        } else {
            bf16_t* vt_p = (bf16_t*)(ws + WS_VT) + ((size_t)(bb * 8 + hd) * 64 + fr) * 4096 + sb;
#pragma unroll
            for (int m = 0; m < 4; ++m) {
                float rkv[4];
#pragma unroll
                for (int j = 0; j < 4; ++j) rkv[j] = rkv_l[rowl + m * 16 + j];
#pragma unroll
                for (int n = 0; n < 4; ++n) { const f32x4 a = acc[m][n];
                    u32x2 w; w.x = cvtpk(a.x * rkv[0], a.y * rkv[1]); w.y = cvtpk(a.z * rkv[2], a.w * rkv[3]);
                    *(u32x2*)(vt_p + (size_t)(n * 16) * 4096 + m * 16) = w; }
            }
        }
    }
}

template <int R> __device__ __forceinline__ void conv_row(float (&o)[64], const float (&w)[31], float x) {
    constexpr int T0 = R > 30 ? R - 30 : 0, T1 = R < 63 ? R : 63;
#pragma unroll
    for (int t = T0; t <= T1; ++t) o[t] += w[R - t] * x;
}
template <int... R> __device__ __forceinline__ void conv_rows(float (&o)[64], const float (&w)[31], const float (&x)[94], std::integer_sequence<int, R...>) { (conv_row<R>(o, w, x[R]), ...); }
__device__ __forceinline__ void conv_unit(CP p, LAS unsigned char* lds, int cu) {
    const int tid = threadIdx.x, lane = tid & 63, wave = tid >> 6;
    const int b = cu >> 6, s0 = (cu & 63) * 64, c = tid;
    const bf16_t* ub = (const bf16_t*)(p->ws + WS_U) + ((size_t)b * 4096) * 512 + c;
    const float* cw = (const float*)p->in[7]; const float* cb = (const float*)p->in[8]; const float* lg = (const float*)p->in[9]; const float* lb = (const float*)p->in[10];
    float w[31];
#pragma unroll
    for (int j = 0; j < 31; ++j) w[j] = cw[j * 512 + c];
    float xin[94];
#pragma unroll
    for (int r = 0; r < 94; ++r) { const int s = s0 - 30 + r; xin[r] = bf2f(ub[(size_t)(s < 0 ? 0 : s) * 512]); }
    if (s0 == 0) {
#pragma unroll
        for (int r = 0; r < 30; ++r) xin[r] = 0.f;
    }
    float o[64];
    { const float bias = cb[c];
#pragma unroll
      for (int t = 0; t < 64; ++t) o[t] = bias; }
    conv_rows(o, w, xin, std::make_integer_sequence<int, 94>{});
    float s1, s2;
    {
        const bool b5 = lane & 32, b4 = lane & 16, b3 = lane & 8, b2 = lane & 4, b1 = lane & 2, b0 = lane & 1;
#define CONV_BFLY(RES, SQ) do { float a32[32]; \
        _Pragma("unroll") for (int i = 0; i < 32; ++i) { const float lo = SQ ? o[i] * o[i] : o[i], hi = SQ ? o[32 + i] * o[32 + i] : o[32 + i]; a32[i] = (b5 ? hi : lo) + __shfl_xor(b5 ? lo : hi, 32); } \
        float a16[16]; _Pragma("unroll") for (int i = 0; i < 16; ++i) a16[i] = (b4 ? a32[16 + i] : a32[i]) + __shfl_xor(b4 ? a32[i] : a32[16 + i], 16); \
        float a8[8]; _Pragma("unroll") for (int i = 0; i < 8; ++i) a8[i] = (b3 ? a16[8 + i] : a16[i]) + __shfl_xor(b3 ? a16[i] : a16[8 + i], 8); \
        float a4[4]; _Pragma("unroll") for (int i = 0; i < 4; ++i) a4[i] = (b2 ? a8[4 + i] : a8[i]) + __shfl_xor(b2 ? a8[i] : a8[4 + i], 4); \
        float a2[2]; _Pragma("unroll") for (int i = 0; i < 2; ++i) a2[i] = (b1 ? a4[2 + i] : a4[i]) + __shfl_xor(b1 ? a4[i] : a4[2 + i], 2); \
        RES = (b0 ? a2[1] : a2[0]) + __shfl_xor(b0 ? a2[0] : a2[1], 1); } while (0)
        CONV_BFLY(s1, false);
        asm volatile("" : "+v"(s1));
        CONV_BFLY(s2, true);
#undef CONV_BFLY
    }
    LAS float* red = (LAS float*)(lds + EPI_SCR);
    LAS float* stat = (LAS float*)(lds + EPI_SCR + 4096);
    red[(wave * 64 + lane) * 2] = s1; red[(wave * 64 + lane) * 2 + 1] = s2;
    __syncthreads();
    if (tid < 64) { float t1 = 0.f, t2 = 0.f;
#pragma unroll
        for (int k = 0; k < 8; ++k) { t1 += red[(k * 64 + tid) * 2]; t2 += red[(k * 64 + tid) * 2 + 1]; }
        const float mean = t1 * (1.0f / 512.0f); float var = t2 * (1.0f / 512.0f) - mean * mean; var = var < 0.f ? 0.f : var;
        stat[tid * 2] = mean; stat[tid * 2 + 1] = __builtin_amdgcn_rsqf(var + EPS); }
    __syncthreads();
    const float g = lg[c], bb = lb[c];
    bf16_t* cat = (bf16_t*)(p->ws + WS_CAT) + ((size_t)b * 4096 + s0) * 1024 + c;
#pragma unroll
    for (int t = 0; t < 64; ++t) { const float y = (o[t] - stat[t * 2]) * stat[t * 2 + 1] * g + bb; cat[(size_t)t * 1024] = f2bf(y * __builtin_amdgcn_rcpf(1.0f + __expf(-y))); }
    __syncthreads();
}

__device__ __forceinline__ void phase1c(CP p, LAS unsigned char* lds) {
#ifndef SUBREP
#define SUBREP -1
#endif
#pragma unroll 1
    for (int r_ = 0; r_ < (SUBREP == 0 ? 2 : 1); ++r_)
    for (int u = blockIdx.x; u < 512; u += gridDim.x) q_item(p, lds, u);
#pragma unroll 1
    for (int r_ = 0; r_ < (SUBREP == 1 ? 2 : 1); ++r_)
    for (int u = blockIdx.x; u < 256; u += gridDim.x) kv_item(p, lds, u);
    __syncthreads();
#pragma unroll 1
    for (int r_ = 0; r_ < (SUBREP == 2 ? 2 : 1); ++r_)
    for (int u = blockIdx.x; u < 512; u += gridDim.x) conv_unit(p, lds, u);
}

__device__ __forceinline__ int swap23(int r) { return (r & ~12) | ((r & 4) << 1) | ((r & 8) >> 1); }
constexpr int KROW = 208, VROW = 144, KBUF = 64 * KROW, VBUF = 64 * VROW, ABUF = KBUF + VBUF;
__device__ __forceinline__ void attn_unit(CP p, LAS unsigned char* lds, int bh, int qblk) {
    const int tid = threadIdx.x, lane = tid & 63, wid = __builtin_amdgcn_readfirstlane(tid >> 6), q = lane & 31, H = lane >> 5;
    unsigned char* ws = p->ws;
    const bf16_t* qg = (const bf16_t*)(ws + WS_Q) + (size_t)bh * 4096 * 96;
    const bf16_t* kg = (const bf16_t*)(ws + WS_K) + (size_t)bh * 4096 * 96;
    const bf16_t* vg = (const bf16_t*)(ws + WS_VT) + (size_t)bh * 64 * 4096;
    const int row0 = qblk * 256 + wid * 32, mychunk = 4 * qblk + (wid >> 1), NT = 4 * qblk + 4;
    bf16x8 qf[6];
#pragma unroll
    for (int s = 0; s < 6; ++s) qf[s] = *(const bf16x8*)(qg + (size_t)(row0 + q) * 96 + 16 * s + 8 * H);
    const int kr0 = tid / 12, kc0 = tid % 12, kr1 = (tid + 512) / 12, kc1 = (tid + 512) % 12, vd = tid >> 3, vc = tid & 7;
    const bool k1 = tid < 256;
    const bf16_t* ksrc0 = kg + (size_t)kr0 * 96 + kc0 * 8; const bf16_t* ksrc1 = kg + (size_t)kr1 * 96 + kc1 * 8; const bf16_t* vsrc = vg + (size_t)vd * 4096 + vc * 8;
    const int kdst0 = kr0 * KROW + kc0 * 16, kdst1 = kr1 * KROW + kc1 * 16, vdst = KBUF + vd * VROW + vc * 16;
    u32x4 rk0, rk1 = (u32x4){0, 0, 0, 0}, rv;
#define AT_LOAD(t) do { rk0 = *(const u32x4*)(ksrc0 + (size_t)(t) * 64 * 96); if (k1) rk1 = *(const u32x4*)(ksrc1 + (size_t)(t) * 64 * 96); rv = *(const u32x4*)(vsrc + (t) * 64); } while (0)
#define AT_WRITE(buf) do { LAS unsigned char* b_ = lds + (buf) * ABUF; *(LAS u32x4*)(b_ + kdst0) = rk0; if (k1) *(LAS u32x4*)(b_ + kdst1) = rk1; *(LAS u32x4*)(b_ + vdst) = rv; } while (0)
    AT_LOAD(0); AT_WRITE(0);
    __syncthreads();
    f32x16 o0 = {0}, o1 = {0};
    float mrun = -INFINITY, lsum = 0.f;
    const int koff = swap23(q) * KROW + 16 * H, voff = KBUF + q * VROW + 16 * H;
    for (int t = 0; t < NT; ++t) {
        if (t + 1 < NT) AT_LOAD(t + 1);
        if (t <= mychunk) {
            const LAS unsigned char* kb = lds + (t & 1) * ABUF + koff; const LAS unsigned char* vb = lds + (t & 1) * ABUF + voff;
            f32x16 s0 = {0}, s1 = {0};
#pragma unroll
            for (int s = 0; s < 6; ++s) {
                const bf16x8 a0 = *(const LAS bf16x8*)(kb + 32 * s), a1 = *(const LAS bf16x8*)(kb + 32 * KROW + 32 * s);
                s0 = __builtin_amdgcn_mfma_f32_32x32x16_bf16(a0, qf[s], s0, 0, 0, 0);
                s1 = __builtin_amdgcn_mfma_f32_32x32x16_bf16(a1, qf[s], s1, 0, 0, 0);
            }
            float mloc = s0[0];
#pragma unroll
            for (int r = 1; r < 16; ++r) mloc = fmaxf(mloc, s0[r]);
#pragma unroll
            for (int r = 0; r < 16; ++r) mloc = fmaxf(mloc, s1[r]);
            mloc = fmaxf(mloc, __shfl_xor(mloc, 32));
            const float mnew = fmaxf(mrun, mloc);
            const float alpha = __builtin_amdgcn_exp2f(mrun - mnew);
            mrun = mnew;
            float ps = 0.f;
#pragma unroll
            for (int r = 0; r < 16; ++r) { s0[r] = __builtin_amdgcn_exp2f(s0[r] - mnew); s1[r] = __builtin_amdgcn_exp2f(s1[r] - mnew); ps += s0[r] + s1[r]; }
            lsum = lsum * alpha + ps;
#pragma unroll
            for (int r = 0; r < 16; ++r) { o0[r] *= alpha; o1[r] *= alpha; }
            u32x4 pw[4];
            pw[0] = (u32x4){cvtpk(s0[0], s0[1]), cvtpk(s0[2], s0[3]), cvtpk(s0[4], s0[5]), cvtpk(s0[6], s0[7])};
            pw[1] = (u32x4){cvtpk(s0[8], s0[9]), cvtpk(s0[10], s0[11]), cvtpk(s0[12], s0[13]), cvtpk(s0[14], s0[15])};
            pw[2] = (u32x4){cvtpk(s1[0], s1[1]), cvtpk(s1[2], s1[3]), cvtpk(s1[4], s1[5]), cvtpk(s1[6], s1[7])};
            pw[3] = (u32x4){cvtpk(s1[8], s1[9]), cvtpk(s1[10], s1[11]), cvtpk(s1[12], s1[13]), cvtpk(s1[14], s1[15])};
#pragma unroll
            for (int ks = 0; ks < 4; ++ks) {
                const bf16x8 v0 = *(const LAS bf16x8*)(vb + 32 * ks), v1 = *(const LAS bf16x8*)(vb + 32 * VROW + 32 * ks);
                const bf16x8 pb = __builtin_bit_cast(bf16x8, pw[ks]);
                o0 = __builtin_amdgcn_mfma_f32_32x32x16_bf16(v0, pb, o0, 0, 0, 0);
                o1 = __builtin_amdgcn_mfma_f32_32x32x16_bf16(v1, pb, o1, 0, 0, 0);
            }
        }
        if (t + 1 < NT) AT_WRITE((t + 1) & 1);
        __syncthreads();
    }
#undef AT_LOAD
#undef AT_WRITE
    const float ltot = lsum + __shfl_xor(lsum, 32), inv = 1.0f / ltot;
    const int b = bh >> 3, hd = bh & 7;
    bf16_t* dst = (bf16_t*)(ws + WS_CAT) + ((size_t)b * 4096 + row0 + q) * 1024 + 512 + hd * 64;
#pragma unroll
    for (int g = 0; g < 4; ++g) {
        u32x2 w; w.x = cvtpk(o0[4 * g] * inv, o0[4 * g + 1] * inv); w.y = cvtpk(o0[4 * g + 2] * inv, o0[4 * g + 3] * inv); *(u32x2*)(dst + 8 * g + 4 * H) = w;
        w.x = cvtpk(o1[4 * g] * inv, o1[4 * g + 1] * inv); w.y = cvtpk(o1[4 * g + 2] * inv, o1[4 * g + 3] * inv); *(u32x2*)(dst + 32 + 8 * g + 4 * H) = w;
    }
}
constexpr int AF_NS = 6, AF_KB = 64 * 192, AF_STG = AF_KB + 64 * 128;
__device__ __forceinline__ void attn_unit_fast(CP p, LAS unsigned char* lds, int bh, int qblk) {
    const int tid = threadIdx.x, lane = tid & 63, wid = __builtin_amdgcn_readfirstlane(tid >> 6), q = lane & 31, H = lane >> 5;
    unsigned char* ws = p->ws;
    const bf16_t* qg = (const bf16_t*)(ws + WS_Q) + (size_t)bh * 4096 * 96;
    const bf16_t* kg = (const bf16_t*)(ws + WS_K) + (size_t)bh * 4096 * 96;
    const bf16_t* vg = (const bf16_t*)(ws + WS_VT) + (size_t)bh * 64 * 4096;
    const int row0 = qblk * 256 + wid * 32, mychunk = 4 * qblk + (wid >> 1), NT = 4 * qblk + 4;
    int ks0, ks1, vs0;
    { int P = wid * 64 + lane, r = P / 12, c = (P % 12) ^ ((r >> 2) & 3); ks0 = r * 96 + c * 8;
      P = (8 + (wid & 3)) * 64 + lane; r = P / 12; c = (P % 12) ^ ((r >> 2) & 3); ks1 = r * 96 + c * 8;
      P = wid * 64 + lane; r = P >> 3; c = (P & 7) ^ ((r >> 1) & 7); vs0 = r * 4096 + c * 8; }
    const bool two = wid < 4;
#define AF_ISSUE(u) do { const int u_ = (u) < NT ? (u) : NT - 1; LAS unsigned char* st_ = lds + ((u) % AF_NS) * AF_STG; \
        __builtin_amdgcn_global_load_lds((const unsigned*)(kg + (size_t)u_ * 64 * 96 + ks0), (LAS unsigned*)(st_ + wid * 1024), 16, 0, 0); \
        if (two) __builtin_amdgcn_global_load_lds((const unsigned*)(kg + (size_t)u_ * 64 * 96 + ks1), (LAS unsigned*)(st_ + (8 + wid) * 1024), 16, 0, 0); \
        __builtin_amdgcn_global_load_lds((const unsigned*)(vg + u_ * 64 + vs0), (LAS unsigned*)(st_ + AF_KB + wid * 1024), 16, 0, 0); } while (0)
#define AF_WAITBAR() do { if (two) asm volatile("s_waitcnt vmcnt(3)" ::: "memory"); else asm volatile("s_waitcnt vmcnt(2)" ::: "memory"); \
        asm volatile("s_waitcnt lgkmcnt(0)" ::: "memory"); __builtin_amdgcn_s_barrier(); asm volatile("" ::: "memory"); } while (0)
    static_assert(AF_NS == 6, "ring depth vs the issue / wait pattern below (one tile may stay in flight across a barrier)");
    const int pr = swap23(q), kx = (pr >> 2) & 3;
    const int kbe = pr * 192 + 16 * ((H ^ (kx & 1)) + 2 * (kx >> 1)), kbo = pr * 192 + 16 * ((H ^ (kx & 1)) + 2 * (1 ^ (kx >> 1)));
    const int vx = (q >> 1) & 7, vbase = AF_KB + q * 128 + 16 * (H ^ (vx & 1)), vxx = (vx >> 1) * 32;
    bf16x8 qf[6];
#pragma unroll
    for (int s = 0; s < 6; ++s) qf[s] = *(const bf16x8*)(qg + (size_t)(row0 + q) * 96 + 16 * s + 8 * H);
#define AF_QK(S0, S1, u) do { const LAS unsigned char* kb_ = lds + ((u) % AF_NS) * AF_STG; \
        { const bf16x8 a0_ = *(const LAS bf16x8*)(kb_ + kbe), a1_ = *(const LAS bf16x8*)(kb_ + kbe + 32 * 192); \
          S0 = __builtin_amdgcn_mfma_f32_32x32x16_bf16(a0_, qf[0], (f32x16){0.f, 0.f, 0.f, 0.f, 0.f, 0.f, 0.f, 0.f, 0.f, 0.f, 0.f, 0.f, 0.f, 0.f, 0.f, 0.f}, 0, 0, 0); \
          S1 = __builtin_amdgcn_mfma_f32_32x32x16_bf16(a1_, qf[0], (f32x16){0.f, 0.f, 0.f, 0.f, 0.f, 0.f, 0.f, 0.f, 0.f, 0.f, 0.f, 0.f, 0.f, 0.f, 0.f, 0.f}, 0, 0, 0); } \
        _Pragma("unroll") for (int s_ = 1; s_ < 6; ++s_) { const int o_ = ((s_ & 1) ? kbo : kbe) + 64 * (s_ >> 1); \
            const bf16x8 a0_ = *(const LAS bf16x8*)(kb_ + o_), a1_ = *(const LAS bf16x8*)(kb_ + o_ + 32 * 192); \
            S0 = __builtin_amdgcn_mfma_f32_32x32x16_bf16(a0_, qf[s_], S0, 0, 0, 0); \
            S1 = __builtin_amdgcn_mfma_f32_32x32x16_bf16(a1_, qf[s_], S1, 0, 0, 0); } } while (0)
    asm volatile("s_waitcnt vmcnt(0) lgkmcnt(0)" ::: "memory"); __builtin_amdgcn_s_barrier(); asm volatile("" ::: "memory");
    AF_ISSUE(0); AF_ISSUE(1); AF_ISSUE(2); AF_ISSUE(3);
    AF_WAITBAR();
    f32x16 o0 = {0}, o1 = {0}, c0, c1;
    float lsum = 0.f;
    AF_QK(c0, c1, 0);
#define AF_STEP(t, CA, CB, NA, NB) do { if ((t) <= mychunk) { \
            AF_QK(NA, NB, (t) + 1);                      \
            float ps = 0.f; \
            _Pragma("unroll") for (int r = 0; r < 16; ++r) { CA[r] = __builtin_amdgcn_exp2f(CA[r]); CB[r] = __builtin_amdgcn_exp2f(CB[r]); ps += CA[r] + CB[r]; } \
            lsum += ps; \
            u32x4 pw[4]; \
            pw[0] = (u32x4){cvtpk(CA[0], CA[1]), cvtpk(CA[2], CA[3]), cvtpk(CA[4], CA[5]), cvtpk(CA[6], CA[7])}; \
            pw[1] = (u32x4){cvtpk(CA[8], CA[9]), cvtpk(CA[10], CA[11]), cvtpk(CA[12], CA[13]), cvtpk(CA[14], CA[15])}; \
            pw[2] = (u32x4){cvtpk(CB[0], CB[1]), cvtpk(CB[2], CB[3]), cvtpk(CB[4], CB[5]), cvtpk(CB[6], CB[7])}; \
            pw[3] = (u32x4){cvtpk(CB[8], CB[9]), cvtpk(CB[10], CB[11]), cvtpk(CB[12], CB[13]), cvtpk(CB[14], CB[15])}; \
            const LAS unsigned char* vb = lds + ((t) % AF_NS) * AF_STG + vbase; \
            _Pragma("unroll") for (int ks = 0; ks < 4; ++ks) { \
                const int vo = (ks * 32) ^ vxx; \
                const bf16x8 v0 = *(const LAS bf16x8*)(vb + vo), v1 = *(const LAS bf16x8*)(vb + vo + 32 * 128); \
                const bf16x8 pb = __builtin_bit_cast(bf16x8, pw[ks]); \
                o0 = __builtin_amdgcn_mfma_f32_32x32x16_bf16(v0, pb, o0, 0, 0, 0); \
                o1 = __builtin_amdgcn_mfma_f32_32x32x16_bf16(v1, pb, o1, 0, 0, 0); } } } while (0)
    f32x16 d0, d1;
#pragma unroll 1
    for (int t = 0; t < NT; t += 2) {
        AF_ISSUE(t + 4); AF_ISSUE(t + 5);
        AF_STEP(t, c0, c1, d0, d1);
        AF_STEP(t + 1, d0, d1, c0, c1);
        AF_WAITBAR();
    }
#undef AF_STEP
#undef AF_ISSUE
#undef AF_WAITBAR
#undef AF_QK
    const float ltot = lsum + __shfl_xor(lsum, 32), inv = 1.0f / ltot;
    const int b = bh >> 3, hd = bh & 7;
    bf16_t* dst = (bf16_t*)(ws + WS_CAT) + ((size_t)b * 4096 + row0 + q) * 1024 + 512 + hd * 64;
#pragma unroll
    for (int g = 0; g < 4; ++g) {
        u32x2 w; w.x = cvtpk(o0[4 * g] * inv, o0[4 * g + 1] * inv); w.y = cvtpk(o0[4 * g + 2] * inv, o0[4 * g + 3] * inv); *(u32x2*)(dst + 8 * g + 4 * H) = w;
        w.x = cvtpk(o1[4 * g] * inv, o1[4 * g + 1] * inv); w.y = cvtpk(o1[4 * g + 2] * inv, o1[4 * g + 3] * inv); *(u32x2*)(dst + 32 + 8 * g + 4 * H) = w;
    }
}
__device__ __forceinline__ void attn_unit2(CP p, LAS unsigned char* lds, int bh, int QB) {
    int lane = threadIdx.x & 63; asm volatile("" : "+v"(lane));
    const int tid = threadIdx.x, wid = __builtin_amdgcn_readfirstlane(tid >> 6), q = lane & 31, H = lane >> 5;
    unsigned char* ws = p->ws;
    const bf16_t* qg = (const bf16_t*)(ws + WS_Q) + (size_t)bh * 4096 * 96;
    const bf16_t* kg = (const bf16_t*)(ws + WS_K) + (size_t)bh * 4096 * 96;
    const bf16_t* vg = (const bf16_t*)(ws + WS_VT) + (size_t)bh * 64 * 4096;
    const int rowA = QB * 512 + wid * 32, rowB = QB * 512 + (15 - wid) * 32;
    const int chA = 8 * QB + (wid >> 1), chB = 8 * QB + ((15 - wid) >> 1), NT = 8 * QB + 8;
    int ks0, ks1, vs0;
    { int P = wid * 64 + lane, r = P / 12, c = (P % 12) ^ ((r >> 2) & 3); ks0 = r * 96 + c * 8;
      P = (8 + (wid & 3)) * 64 + lane; r = P / 12; c = (P % 12) ^ ((r >> 2) & 3); ks1 = r * 96 + c * 8;
      P = wid * 64 + lane; r = P >> 3; c = (P & 7) ^ ((r >> 1) & 7); vs0 = r * 4096 + c * 8; }
    const bool two = wid < 4;
#define A2_ISSUE(u) do { const int u_ = (u) < NT ? (u) : NT - 1; LAS unsigned char* st_ = lds + ((u) % AF_NS) * AF_STG; \
        __builtin_amdgcn_global_load_lds((const unsigned*)(kg + (size_t)u_ * 64 * 96 + ks0), (LAS unsigned*)(st_ + wid * 1024), 16, 0, 0); \
        if (two) __builtin_amdgcn_global_load_lds((const unsigned*)(kg + (size_t)u_ * 64 * 96 + ks1), (LAS unsigned*)(st_ + (8 + wid) * 1024), 16, 0, 0); \
        __builtin_amdgcn_global_load_lds((const unsigned*)(vg + u_ * 64 + vs0), (LAS unsigned*)(st_ + AF_KB + wid * 1024), 16, 0, 0); } while (0)
#define A2_WAITBAR() do { if (two) asm volatile("s_waitcnt vmcnt(3)" ::: "memory"); else asm volatile("s_waitcnt vmcnt(2)" ::: "memory"); \
        asm volatile("s_waitcnt lgkmcnt(0)" ::: "memory"); __builtin_amdgcn_s_barrier(); asm volatile("" ::: "memory"); } while (0)
    const int pr = swap23(q), kx = (pr >> 2) & 3;
    const int kbe = pr * 192 + 16 * ((H ^ (kx & 1)) + 2 * (kx >> 1)), kbo = pr * 192 + 16 * ((H ^ (kx & 1)) + 2 * (1 ^ (kx >> 1)));
    const int vx = (q >> 1) & 7, vbase = AF_KB + q * 128 + 16 * (H ^ (vx & 1)), vxx = (vx >> 1) * 32;
    bf16x8 qa[6], qb[6];
#pragma unroll
    for (int s = 0; s < 6; ++s) { qa[s] = *(const bf16x8*)(qg + (size_t)(rowA + q) * 96 + 16 * s + 8 * H); qb[s] = *(const bf16x8*)(qg + (size_t)(rowB + q) * 96 + 16 * s + 8 * H); }
    asm volatile("s_waitcnt vmcnt(0) lgkmcnt(0)" ::: "memory"); __builtin_amdgcn_s_barrier(); asm volatile("" ::: "memory");
    A2_ISSUE(0); A2_ISSUE(1); A2_ISSUE(2); A2_ISSUE(3);
    A2_WAITBAR();
    f32x16 oa0 = {0}, oa1 = {0}, ob0 = {0}, ob1 = {0};
    float la = 0.f, lb = 0.f;
#define A2_ZERO (f32x16){0.f, 0.f, 0.f, 0.f, 0.f, 0.f, 0.f, 0.f, 0.f, 0.f, 0.f, 0.f, 0.f, 0.f, 0.f, 0.f}
#define A2_PACK2(PW, C) do { \
        PW[0] = (u32x4){cvtpk(C[0], C[1]), cvtpk(C[2], C[3]), cvtpk(C[4], C[5]), cvtpk(C[6], C[7])}; \
        PW[1] = (u32x4){cvtpk(C[8], C[9]), cvtpk(C[10], C[11]), cvtpk(C[12], C[13]), cvtpk(C[14], C[15])}; } while (0)
#define A2_HALF(t, hh) do { const LAS unsigned char* kb_ = lds + ((t) % AF_NS) * AF_STG + (hh) * (32 * 192); const LAS unsigned char* vb_ = lds + ((t) % AF_NS) * AF_STG + vbase; \
        if ((t) <= chA) {                                    \
            f32x16 sa, sb; \
            _Pragma("unroll") for (int s_ = 0; s_ < 6; ++s_) { const int o_ = ((s_ & 1) ? kbo : kbe) + 64 * (s_ >> 1); \
                const bf16x8 a_ = *(const LAS bf16x8*)(kb_ + o_); \
                sa = __builtin_amdgcn_mfma_f32_32x32x16_bf16(a_, qa[s_], s_ == 0 ? A2_ZERO : sa, 0, 0, 0); \
                sb = __builtin_amdgcn_mfma_f32_32x32x16_bf16(a_, qb[s_], s_ == 0 ? A2_ZERO : sb, 0, 0, 0); } \
            float pa = 0.f, pb = 0.f; \
            _Pragma("unroll") for (int r = 0; r < 16; ++r) { sa[r] = __builtin_amdgcn_exp2f(sa[r]); pa += sa[r]; } \
            _Pragma("unroll") for (int r = 0; r < 16; ++r) { sb[r] = __builtin_amdgcn_exp2f(sb[r]); pb += sb[r]; } \
            la += pa; lb += pb; \
            u32x4 pwa[2], pwb[2]; A2_PACK2(pwa, sa); A2_PACK2(pwb, sb); \
            _Pragma("unroll") for (int k2 = 0; k2 < 2; ++k2) { const int vo = (((hh) * 2 + k2) * 32) ^ vxx; \
                const bf16x8 v0 = *(const LAS bf16x8*)(vb_ + vo), v1 = *(const LAS bf16x8*)(vb_ + vo + 32 * 128); \
                const bf16x8 xa = __builtin_bit_cast(bf16x8, pwa[k2]), xb = __builtin_bit_cast(bf16x8, pwb[k2]); \
                oa0 = __builtin_amdgcn_mfma_f32_32x32x16_bf16(v0, xa, oa0, 0, 0, 0); oa1 = __builtin_amdgcn_mfma_f32_32x32x16_bf16(v1, xa, oa1, 0, 0, 0); \
                ob0 = __builtin_amdgcn_mfma_f32_32x32x16_bf16(v0, xb, ob0, 0, 0, 0); ob1 = __builtin_amdgcn_mfma_f32_32x32x16_bf16(v1, xb, ob1, 0, 0, 0); } \
        } else if ((t) <= chB) {                             \
            f32x16 sb; \
            _Pragma("unroll") for (int s_ = 0; s_ < 6; ++s_) { const int o_ = ((s_ & 1) ? kbo : kbe) + 64 * (s_ >> 1); \
                const bf16x8 a_ = *(const LAS bf16x8*)(kb_ + o_); \
                sb = __builtin_amdgcn_mfma_f32_32x32x16_bf16(a_, qb[s_], s_ == 0 ? A2_ZERO : sb, 0, 0, 0); } \
            float pb = 0.f; \
            _Pragma("unroll") for (int r = 0; r < 16; ++r) { sb[r] = __builtin_amdgcn_exp2f(sb[r]); pb += sb[r]; } \
            lb += pb; \
            u32x4 pwb[2]; A2_PACK2(pwb, sb); \
            _Pragma("unroll") for (int k2 = 0; k2 < 2; ++k2) { const int vo = (((hh) * 2 + k2) * 32) ^ vxx; \
                const bf16x8 v0 = *(const LAS bf16x8*)(vb_ + vo), v1 = *(const LAS bf16x8*)(vb_ + vo + 32 * 128); \
                const bf16x8 xb = __builtin_bit_cast(bf16x8, pwb[k2]); \
                ob0 = __builtin_amdgcn_mfma_f32_32x32x16_bf16(v0, xb, ob0, 0, 0, 0); ob1 = __builtin_amdgcn_mfma_f32_32x32x16_bf16(v1, xb, ob1, 0, 0, 0); } \
        } } while (0)
#define A2_STEP(t) do { A2_HALF(t, 0); __builtin_amdgcn_sched_barrier(0); A2_HALF(t, 1); __builtin_amdgcn_sched_barrier(0); } while (0)
#pragma unroll 1
    for (int t = 0; t < NT; t += 2) {
        A2_ISSUE(t + 4); A2_ISSUE(t + 5);
        A2_STEP(t);
        A2_STEP(t + 1);
        A2_WAITBAR();
    }
#undef A2_STEP
#undef A2_HALF
#undef A2_PACK2
#undef A2_ZERO
#undef A2_ISSUE
#undef A2_WAITBAR
    const int b = bh >> 3, hd = bh & 7;
    {
        const float ltot = la + __shfl_xor(la, 32), inv = 1.0f / ltot;
        bf16_t* dst = (bf16_t*)(ws + WS_CAT) + ((size_t)b * 4096 + rowA + q) * 1024 + 512 + hd * 64;
#pragma unroll
        for (int g = 0; g < 4; ++g) {
            u32x2 w; w.x = cvtpk(oa0[4 * g] * inv, oa0[4 * g + 1] * inv); w.y = cvtpk(oa0[4 * g + 2] * inv, oa0[4 * g + 3] * inv); *(u32x2*)(dst + 8 * g + 4 * H) = w;
            w.x = cvtpk(oa1[4 * g] * inv, oa1[4 * g + 1] * inv); w.y = cvtpk(oa1[4 * g + 2] * inv, oa1[4 * g + 3] * inv); *(u32x2*)(dst + 32 + 8 * g + 4 * H) = w;
        }
    }
    {
        const float ltot = lb + __shfl_xor(lb, 32), inv = 1.0f / ltot;
        bf16_t* dst = (bf16_t*)(ws + WS_CAT) + ((size_t)b * 4096 + rowB + q) * 1024 + 512 + hd * 64;
#pragma unroll
        for (int g = 0; g < 4; ++g) {
            u32x2 w; w.x = cvtpk(ob0[4 * g] * inv, ob0[4 * g + 1] * inv); w.y = cvtpk(ob0[4 * g + 2] * inv, ob0[4 * g + 3] * inv); *(u32x2*)(dst + 8 * g + 4 * H) = w;
            w.x = cvtpk(ob1[4 * g] * inv, ob1[4 * g + 1] * inv); w.y = cvtpk(ob1[4 * g + 2] * inv, ob1[4 * g + 3] * inv); *(u32x2*)(dst + 32 + 8 * g + 4 * H) = w;
        }
    }
}
__device__ __forceinline__ void phase2(CP p, LAS unsigned char* lds) {
    const int lane = threadIdx.x & 63;
    const float* qn = (const float*)p->in[15]; const float* kn = (const float*)p->in[16];
    float mq = 0.f, mk = 0.f;
    for (int j = lane; j < 96; j += 64) { mq = fmaxf(mq, fabsf(qn[j])); mk = fmaxf(mk, fabsf(kn[j])); }
#pragma unroll
    for (int o = 1; o < 64; o <<= 1) { mq = fmaxf(mq, __shfl_xor(mq, o)); mk = fmaxf(mk, __shfl_xor(mk, o)); }
    const float bound = 96.0f * mq * mk * QSCALE * 1.01f;
    if (bound <= 40.0f) {
        for (int u = vcu_id(); u < 256; u += gridDim.x) { const int bh = u >> 2, pr = u & 3; attn_unit2(p, lds, bh, 7 - pr); attn_unit2(p, lds, bh, pr); }
    } else {
        for (int u = vcu_id(); u < 512; u += gridDim.x) { const int bh = u >> 3, pr = u & 7; attn_unit(p, lds, bh, 15 - pr); attn_unit(p, lds, bh, pr); }
    }
    asm volatile("s_waitcnt vmcnt(0)" ::: "memory"); __syncthreads();
}

__device__ __forceinline__ void phase3(CP p, LAS unsigned char* lds) {
    const int tid = threadIdx.x, lane = tid & 63, wid = __builtin_amdgcn_readfirstlane(tid >> 6), wr = wid >> 2, wc = wid & 3, fr = lane & 15, fq = lane >> 4;
    unsigned char* ws = p->ws;
    const float* x = (const float*)p->in[0]; const float* mod = (const float*)(ws + WS_MOD); float* sq1 = (float*)(ws + WS_SSQ1);
    for (int u = vcu_id(); u < 512; u += gridDim.x) {
        const int pm = u >> 2, pn = u & 3;
        const bf16_t* ap[4]; const bf16_t* bp[4];
        stage_ptrs_dense<4>((const bf16_t*)(ws + WS_CAT), 1024, pm * 256, ap); stage_ptrs_dense<4>((const bf16_t*)(ws + WS_WOUT), 1024, pn * 256, bp);
        f32x4 acc[8][4];
#pragma unroll
        for (int m = 0; m < 8; ++m)
#pragma unroll
            for (int n = 0; n < 4; ++n) acc[m][n] = (f32x4){0.f, 0.f, 0.f, 0.f};
        gemm_block<8, 4, true>(lds, ap, bp, 16, acc);
        const int rowb = pm * 256 + wr * 128 + fr, b = (pm * 256) >> 12, colb = pn * 256 + wc * 64 + fq * 4;
        f32x4 ga[4];
#pragma unroll
        for (int n = 0; n < 4; ++n) ga[n] = *(const f32x4*)(mod + b * 6144 + 2048 + colb + n * 16);
#pragma unroll
        for (int mb = 0; mb < 8; mb += 4) {
            f32x4 xv[4][4];
#pragma unroll
            for (int m = 0; m < 4; ++m)
#pragma unroll
                for (int n = 0; n < 4; ++n) xv[m][n] = *(const f32x4*)(x + (size_t)(rowb + (mb + m) * 16) * DM + colb + n * 16);
#pragma unroll
            for (int m = 0; m < 4; ++m) { const size_t row = rowb + (mb + m) * 16; float s = 0.f;
#pragma unroll
                for (int n = 0; n < 4; ++n) { const f32x4 v = xv[m][n] + ga[n] * acc[mb + m][n];
                    *(f32x4*)(p->out + row * DM + colb + n * 16) = v; s += (v.x * v.x + v.y * v.y) + (v.z * v.z + v.w * v.w); }
                s += __shfl_xor(s, 16); s += __shfl_xor(s, 32);
                if (fq == 0) sq1[row * 16 + pn * 4 + wc] = s; }
        }
    }
}

constexpr int RROW = 2064;
__device__ __forceinline__ void phase3b(CP p, LAS unsigned char* lds, bool dry) {
    const int tid = threadIdx.x, lane = tid & 63, wave = __builtin_amdgcn_readfirstlane(tid >> 6), fr = lane & 15, fq = lane >> 4;
    unsigned char* ws = p->ws;
    const float* nf = (const float*)p->in[18]; const float* mod = (const float*)(ws + WS_MOD); const float* sq1 = (const float*)(ws + WS_SSQ1);
    const float* bg = (const float*)p->in[20]; const float* be = (const float*)p->in[22];
    bf16_t* h2 = (bf16_t*)(ws + WS_H); const bf16_t* wrh = (const bf16_t*)(ws + WS_WR); const bf16_t* wrl = wrh + 48 * 1024;
    LAS unsigned char* Ahi = lds; LAS unsigned char* Alo = lds + 32 * RROW; LAS float* part = (LAS float*)lds; LAS float* lg = (LAS float*)(lds + 8 * 32 * 48 * 4);
    unsigned* ctl = (unsigned*)(ws + WS_CTL); int* lists = (int*)(ws + WS_LIST); int* blists = (int*)(ws + WS_BLIST); float* tokw = (float*)(ws + WS_TOKW);
    bf16x8 Bh[3][4], Bl[3][4];
#pragma unroll
    for (int nt = 0; nt < 3; ++nt)
#pragma unroll
        for (int kk = 0; kk < 4; ++kk) { const size_t o = (size_t)(nt * 16 + fr) * 1024 + wave * 128 + kk * 32 + fq * 8; Bh[nt][kk] = *(const bf16x8*)(wrh + o); Bl[nt][kk] = *(const bf16x8*)(wrl + o); }
#pragma unroll 1
    for (int tile = blockIdx.x; tile < MT / 32; tile += gridDim.x) {
        const int r0 = tile * 32, b = r0 >> 12;
        {
            f32x4 gm[4], sh[4];
#pragma unroll
            for (int j = 0; j < 4; ++j) { const int col = 4 * lane + 256 * j; const f32x4 g = *(const f32x4*)(nf + col), s = *(const f32x4*)(mod + b * 6144 + 4096 + col);
                gm[j] = g * (s + 1.0f); sh[j] = *(const f32x4*)(mod + b * 6144 + 3072 + col); }
#pragma unroll
            for (int rb = 0; rb < 4; rb += 2) {
                f32x4 xr[2][4]; float rs[2];
#pragma unroll
                for (int rr = 0; rr < 2; ++rr) { const size_t row = r0 + wave * 4 + rb + rr; float ss = 0.f;
#pragma unroll
                    for (int k = 0; k < 4; ++k) { const f32x4 s4 = *(const f32x4*)(sq1 + row * 16 + 4 * k); ss += (s4.x + s4.y) + (s4.z + s4.w); }
                    rs[rr] = ss;
#pragma unroll
                    for (int j = 0; j < 4; ++j) xr[rr][j] = *(const f32x4*)(p->out + row * DM + 4 * lane + 256 * j); }
#pragma unroll
                for (int rr = 0; rr < 2; ++rr) {
                    const int lr = wave * 4 + rb + rr; const size_t row = r0 + lr;
                    const float rstd = __builtin_amdgcn_rsqf(rs[rr] * (1.0f / DM) + EPS);
#pragma unroll
                    for (int j = 0; j < 4; ++j) { const int col = 4 * lane + 256 * j; const f32x4 xv = xr[rr][j];
                        const f32x4 o = xv * rstd * gm[j] + sh[j];
                        u32x2 w; w.x = cvtpk(o.x, o.y); w.y = cvtpk(o.z, o.w);
                        *(u32x2*)(h2 + row * DM + col) = w; *(LAS u32x2*)(Ahi + lr * RROW + col * 2) = w;
                        const float lx = o.x - __builtin_bit_cast(float, w.x << 16), ly = o.y - __builtin_bit_cast(float, w.x & 0xffff0000u), lz = o.z - __builtin_bit_cast(float, w.y << 16), lw = o.w - __builtin_bit_cast(float, w.y & 0xffff0000u);
                        u32x2 wl; wl.x = cvtpk(lx, ly); wl.y = cvtpk(lz, lw); *(LAS u32x2*)(Alo + lr * RROW + col * 2) = wl; }
                }
            }
        }
        __syncthreads();
        f32x4 P[2][3];
#pragma unroll
        for (int mt = 0; mt < 2; ++mt)
#pragma unroll
            for (int nt = 0; nt < 3; ++nt) P[mt][nt] = (f32x4){0.f, 0.f, 0.f, 0.f};
#pragma unroll
        for (int mt = 0; mt < 2; ++mt)
#pragma unroll
            for (int kk = 0; kk < 4; ++kk) {
                const int ao = (mt * 16 + fr) * RROW + (wave * 128 + kk * 32 + fq * 8) * 2;
                const bf16x8 a_h = *(const LAS bf16x8*)(Ahi + ao), a_l = *(const LAS bf16x8*)(Alo + ao);
#pragma unroll
                for (int nt = 0; nt < 3; ++nt) {
                    P[mt][nt] = __builtin_amdgcn_mfma_f32_16x16x32_bf16(a_h, Bh[nt][kk], P[mt][nt], 0, 0, 0);
                    P[mt][nt] = __builtin_amdgcn_mfma_f32_16x16x32_bf16(a_l, Bh[nt][kk], P[mt][nt], 0, 0, 0);
                    P[mt][nt] = __builtin_amdgcn_mfma_f32_16x16x32_bf16(a_h, Bl[nt][kk], P[mt][nt], 0, 0, 0);
                }
            }
        __syncthreads();
#pragma unroll
        for (int mt = 0; mt < 2; ++mt)
#pragma unroll
            for (int nt = 0; nt < 3; ++nt)
#pragma unroll
                for (int j = 0; j < 4; ++j) part[(wave * 32 + mt * 16 + fq * 4 + j) * 48 + nt * 16 + fr] = P[mt][nt][j];
        __syncthreads();
#pragma unroll
        for (int i = 0; i < 3; ++i) { const int idx = tid + 512 * i; float v = 0.f;
#pragma unroll
            for (int w8 = 0; w8 < 8; ++w8) v += part[w8 * 1536 + idx];
            lg[idx] = v; }
        __syncthreads();
        if (tid < 32 && !dry) {
            const LAS float* l = lg + tid * 48; const int tok = r0 + tid;
            float gl[4]; int gi = 0; float gmx;
#pragma unroll
            for (int i = 0; i < 4; ++i) gl[i] = l[i] + bg[i];
            gmx = gl[0];
#pragma unroll
            for (int i = 1; i < 4; ++i) if (gl[i] > gmx) { gmx = gl[i]; gi = i; }
            float gs = 0.f;
#pragma unroll
            for (int i = 0; i < 4; ++i) gs += __expf(gl[i] - gmx);
            const float gtop = 1.0f / gs;
            float el[8];
#pragma unroll
            for (int i = 0; i < 8; ++i) el[i] = l[4 + gi * 8 + i] + be[gi * 8 + i];
            int e1 = 0; float m1 = el[0];
#pragma unroll
            for (int i = 1; i < 8; ++i) if (el[i] > m1) { m1 = el[i]; e1 = i; }
            int e2 = -1; float m2 = -INFINITY;
#pragma unroll
            for (int i = 0; i < 8; ++i) if (i != e1 && el[i] > m2) { m2 = el[i]; e2 = i; }
            const float p2 = __expf(m2 - m1);
            const float w1 = gtop / (1.0f + p2), w2 = gtop * p2 / (1.0f + p2);
            const int lo = e1 < e2 ? e1 : e2, hi = e1 < e2 ? e2 : e1;
            const float wlo = e1 < e2 ? w1 : w2, whi = e1 < e2 ? w2 : w1;
            const int bk = gi * 28 + lo * 8 - ((lo * (lo + 1)) >> 1) + (hi - lo - 1);
            const int El = gi * 8 + lo, Eh = gi * 8 + hi;
            const unsigned p1 = atomicAdd(ctl + CW_CNT + 64 * El, 1u), pp2 = atomicAdd(ctl + CW_CNT + 64 * Eh, 1u), p3 = atomicAdd(ctl + CW_CNT + 64 * (32 + bk), 1u);
            lists[(size_t)El * MT + p1] = tok * 2; lists[(size_t)Eh * MT + pp2] = tok * 2 + 1;
            blists[(size_t)bk * MT + p3] = tok;
            tokw[tok * 2] = wlo; tokw[tok * 2 + 1] = whi;
        }
        __syncthreads();
    }
}

struct U4a { int e, rt, ct, cnt; };
__device__ __forceinline__ int prefix_find(const LAS unsigned* pre, int n, int u) {
    const int lane = threadIdx.x & 63; int res = -1;
    for (int b0 = 0; b0 < n; b0 += 64) { const int i = b0 + lane; const bool hit = i < n && (int)pre[i] <= u && u < (int)pre[i + 1];
        const unsigned long long m = __ballot(hit); if (m) { res = b0 + __builtin_ctzll(m); break; } }
    return res;
}
__device__ __forceinline__ bool p4a_find(const LAS unsigned* cnts, const LAS unsigned* pre, int u, U4a& r) {
    const int i = prefix_find(pre, 32, u); if (i < 0) return false;
    const int uu = u - (int)pre[i]; r.e = i; r.rt = uu >> 1; r.ct = uu & 1; r.cnt = (int)cnts[i]; return true;
}
template <int MI, int NI>
__device__ __forceinline__ void p4a_ptrs(CP p, int e, int row0, int cnt, int col0, const bf16_t* (&ap)[MI / 2], const bf16_t* (&bp)[NI]) {
    const int tid = threadIdx.x, lane = tid & 63;
    const int* lst = (const int*)(p->ws + WS_LIST) + (size_t)e * MT + row0; const int nrow = cnt - row0;
    const bf16_t* h2 = (const bf16_t*)(p->ws + WS_H);
    int tok[MI / 2], C[MI / 2];
#pragma unroll
    for (int i = 0; i < MI / 2; ++i) { int R; stage_rc2((tid >> 6) * 1024 + i * 8192 + lane * 16, R, C[i]); tok[i] = lst[R < nrow ? R : 0] >> 1; }
#pragma unroll
    for (int i = 0; i < MI / 2; ++i) ap[i] = h2 + (size_t)tok[i] * 1024 + C[i];
    stage_ptrs_dense<NI>((const bf16_t*)(p->ws + WS_WGU) + (size_t)e * 512 * 1024, 1024, col0, bp);
}
template <int MI, int NI>
__device__ __forceinline__ void p4a_epilogue(CP p, int e, int row0, int cnt, int col0, const f32x4 (&acc)[MI][NI]) {
    const int tid = threadIdx.x, lane = tid & 63, wid = __builtin_amdgcn_readfirstlane(tid >> 6), wr = wid >> 2, wc = wid & 3, fr = lane & 15, fq = lane >> 4;
    unsigned char* ws = p->ws;
    const float* tokw = (const float*)(ws + WS_TOKW); bf16_t* ab = (bf16_t*)(ws + WS_ABUF);
    const int* lst = (const int*)(ws + WS_LIST) + (size_t)e * MT + row0; const int nrow = cnt - row0;
    int ent[MI]; float w[MI];
#pragma unroll
    for (int m = 0; m < MI; ++m) { const int R = wr * (MI * 16) + m * 16 + fr; ent[m] = lst[R < nrow ? R : 0]; }
#pragma unroll
    for (int m = 0; m < MI; ++m) w[m] = tokw[ent[m]];
#pragma unroll
    for (int m = 0; m < MI; ++m) { const int R = wr * (MI * 16) + m * 16 + fr; const float wm = w[m];
#pragma unroll
        for (int h = 0; h < NI / 2; ++h) { const f32x4 g = acc[m][2 * h], uu = acc[m][2 * h + 1];
            const int np = col0 + wc * (NI * 16) + h * 32 + fq * 4, ch = (np >> 8) * 128 + ((np >> 6) & 3) * 32 + ((np >> 5) & 1) * 16 + (np & 15);
            u32x2 o; o.x = cvtpk(g.x * __builtin_amdgcn_rcpf(1.0f + __expf(-g.x)) * uu.x * wm, g.y * __builtin_amdgcn_rcpf(1.0f + __expf(-g.y)) * uu.y * wm);
            o.y = cvtpk(g.z * __builtin_amdgcn_rcpf(1.0f + __expf(-g.z)) * uu.z * wm, g.w * __builtin_amdgcn_rcpf(1.0f + __expf(-g.w)) * uu.w * wm);
            if (R < nrow) *(u32x2*)(ab + (size_t)ent[m] * 256 + ch) = o; } }
}
__device__ __forceinline__ void phase4a(CP p, LAS unsigned char* lds, const LAS unsigned* cnts, const LAS unsigned* pre) {
    const int G = gridDim.x, v = vcu_id();
    const int U = (int)pre[32], F = U - U % G;
    {
        int u = v; U4a cur;
        if (u < F && p4a_find(cnts, pre, u, cur)) {
            const bf16_t* ap[4]; const bf16_t* bp[4];
            p4a_ptrs<8, 4>(p, cur.e, cur.rt * 256, cur.cnt, cur.ct * 256, ap, bp);
            __syncthreads();
            gemm_stage<8, 4, false>(lds, 0, ap, bp, 0, 0);
            for (;;) {
                f32x4 acc[8][4];
#pragma unroll
                for (int m = 0; m < 8; ++m)
#pragma unroll
                    for (int n = 0; n < 4; ++n) acc[m][n] = (f32x4){0.f, 0.f, 0.f, 0.f};
                gemm_main<8, 4, true, false>(lds, 0, ap, bp, 16, acc);
                U4a nxt; u += G; const bool has_next = u < F && p4a_find(cnts, pre, u, nxt);
                if (has_next) { p4a_ptrs<8, 4>(p, nxt.e, nxt.rt * 256, nxt.cnt, nxt.ct * 256, ap, bp); gemm_stage<8, 4, false>(lds, 0, ap, bp, 0, 0); }
                p4a_epilogue<8, 4>(p, cur.e, cur.rt * 256, cur.cnt, cur.ct * 256, acc);
                if (!has_next) break;
                cur = nxt;
                stage_ptrs_dense<4>((const bf16_t*)(p->ws + WS_WGU) + (size_t)cur.e * 512 * 1024, 1024, cur.ct * 256, bp);
            }
        }
    }
    asm volatile("s_waitcnt vmcnt(0)" ::: "memory"); __syncthreads();
#pragma unroll 1
    for (int sv = v; sv < 4 * (U - F); sv += G) {
        U4a t; if (!p4a_find(cnts, pre, F + (sv >> 2), t)) break;
        const int row0 = t.rt * 256 + ((sv >> 1) & 1) * 128, col0 = t.ct * 256 + (sv & 1) * 128;
        if (row0 < t.cnt) {
            const bf16_t* ap[2]; const bf16_t* bp[2];
            p4a_ptrs<4, 2>(p, t.e, row0, t.cnt, col0, ap, bp);
            __syncthreads();
            gemm_stage<4, 2, false>(lds, 0, ap, bp, 0, 0);
            f32x4 acc[4][2];
#pragma unroll
            for (int m = 0; m < 4; ++m)
#pragma unroll
                for (int n = 0; n < 2; ++n) acc[m][n] = (f32x4){0.f, 0.f, 0.f, 0.f};
            gemm_main<4, 2, true, false>(lds, 0, ap, bp, 16, acc);
            p4a_epilogue<4, 2>(p, t.e, row0, t.cnt, col0, acc);
        }
    }
    asm volatile("s_waitcnt vmcnt(0)" ::: "memory"); __syncthreads();
}
struct U4b { int bk, rt, ct, cnt; };
__device__ __forceinline__ bool p4b_find(const LAS unsigned* cnts, const LAS unsigned* pre, int u, U4b& r) {
    const int i = prefix_find(pre + 33, 112, u); if (i < 0) return false;
    const int uu = u - (int)pre[33 + i]; r.bk = i; r.rt = uu >> 2; r.ct = uu & 3; r.cnt = (int)cnts[32 + i]; return true;
}
__device__ __forceinline__ void p4b_ptrs(CP p, const U4b& u, const bf16_t* (&ap)[2], const bf16_t* (&bp)[4], const bf16_t* (&bq)[4]) {
    const int tid = threadIdx.x, lane = tid & 63;
    const int g = u.bk / 28; int pi = u.bk % 28, lo = 0; while (pi >= 7 - lo) { pi -= 7 - lo; ++lo; } const int hi = lo + 1 + pi;
    const int* lst = (const int*)(p->ws + WS_BLIST) + (size_t)u.bk * MT + u.rt * 128; const int nrow = u.cnt - u.rt * 128;
    const bf16_t* ab = (const bf16_t*)(p->ws + WS_ABUF);
#pragma unroll
    for (int i = 0; i < 2; ++i) { int R, C; stage_rc2((tid >> 6) * 1024 + i * 8192 + lane * 16, R, C); const int tok = lst[R < nrow ? R : 0]; ap[i] = ab + (size_t)tok * 512 + C; }
    stage_ptrs_dense<4>((const bf16_t*)(p->ws + WS_WD) + (size_t)(g * 8 + lo) * 1024 * 256, 256, u.ct * 256, bp);
    stage_ptrs_dense<4>((const bf16_t*)(p->ws + WS_WD) + (size_t)(g * 8 + hi) * 1024 * 256, 256, u.ct * 256, bq);
#pragma unroll
    for (int i = 0; i < 4; ++i) bq[i] -= 256;
}
__device__ __forceinline__ void phase4b(CP p, LAS unsigned char* lds, const LAS unsigned* cnts, const LAS unsigned* pre) {
    const int tid = threadIdx.x, lane = tid & 63, wid = __builtin_amdgcn_readfirstlane(tid >> 6), wr = wid >> 2, wc = wid & 3, fr = lane & 15, fq = lane >> 4;
    unsigned char* ws = p->ws;
    const float* mod = (const float*)(ws + WS_MOD); float* out = p->out;
    int u = vcu_id(); U4b cur;
    if (!p4b_find(cnts, pre, u, cur)) return;
    const bf16_t* ap[2]; const bf16_t* bp[4]; const bf16_t* bq[4];
    p4b_ptrs(p, cur, ap, bp, bq);
    int tok[4];
    { const int* lst = (const int*)(ws + WS_BLIST) + (size_t)cur.bk * MT + cur.rt * 128; const int nrow = cur.cnt - cur.rt * 128;
#pragma unroll
      for (int m = 0; m < 4; ++m) { const int R = wr * 64 + m * 16 + fr; tok[m] = lst[R < nrow ? R : 0]; } }
    __syncthreads();
    gemm_stage<4, 4, false>(lds, 0, ap, bp, 0, 0);
    for (;;) {
        const int colb = cur.ct * 256 + wc * 64 + fq * 4; const int nrow = cur.cnt - cur.rt * 128;
        f32x4 old[4][4];
#pragma unroll
        for (int m = 0; m < 4; ++m)
#pragma unroll
            for (int n = 0; n < 4; ++n) old[m][n] = *(const f32x4*)(out + (size_t)tok[m] * DM + colb + n * 16);
        f32x4 acc[4][4];
#pragma unroll
        for (int m = 0; m < 4; ++m)
#pragma unroll
            for (int n = 0; n < 4; ++n) acc[m][n] = (f32x4){0.f, 0.f, 0.f, 0.f};
        gemm_main2<4, 4, true, false>(lds, 0, ap, bp, bq, 4, 8, acc);
        U4b nxt; u += gridDim.x; const bool has_next = p4b_find(cnts, pre, u, nxt);
        int tokn[4] = {0, 0, 0, 0};
        if (has_next) { p4b_ptrs(p, nxt, ap, bp, bq); gemm_stage<4, 4, false>(lds, 0, ap, bp, 0, 0);
            const int* lst = (const int*)(ws + WS_BLIST) + (size_t)nxt.bk * MT + nxt.rt * 128; const int nr2 = nxt.cnt - nxt.rt * 128;
#pragma unroll
            for (int m = 0; m < 4; ++m) { const int R = wr * 64 + m * 16 + fr; tokn[m] = lst[R < nr2 ? R : 0]; } }
#pragma unroll
        for (int m = 0; m < 4; ++m) { const int R = wr * 64 + m * 16 + fr; const int b = tok[m] >> 12;
#pragma unroll
            for (int n = 0; n < 4; ++n) { const f32x4 gf = *(const f32x4*)(mod + b * 6144 + 5120 + colb + n * 16);
                const f32x4 o = old[m][n] + gf * acc[m][n]; if (R < nrow) *(f32x4*)(out + (size_t)tok[m] * DM + colb + n * 16) = o; } }
        if (!has_next) break;
        cur = nxt;
#pragma unroll
        for (int m = 0; m < 4; ++m) tok[m] = tokn[m];
    }
    asm volatile("s_waitcnt vmcnt(0)" ::: "memory"); __syncthreads();
}

__global__ void __launch_bounds__(512, 2) hybrid_block_fwd(Params p) {
    extern __shared__ __attribute__((aligned(16))) unsigned char lds_raw[];
    LAS unsigned char* lds = (LAS unsigned char*)lds_raw;
    volatile LAS unsigned* MISC = (volatile LAS unsigned*)(lds + MISC_OFF);
    LAS unsigned* cnts = (LAS unsigned*)(lds + MISC_OFF + 256);
    const int tid = threadIdx.x;
    if (tid < 16) MISC[tid] = 0u;
    __syncthreads();
    unsigned* ctl = (unsigned*)(p.ws + WS_CTL);
    const bool single = (p.ph_hi - p.ph_lo) > 1;
    XcdBarrier bar; bar.bar = ctl + CW_BAR; bar.x = 0; bar.st = nullptr;
    if (single) bar = xcd_barrier_post(ctl + CW_BAR, MISC + 8);
#ifndef PH_MASK
#define PH_MASK 0x1ff
#endif
#define IN(k) (((PH_MASK >> (k)) & 1) && p.ph_lo <= (k) && (k) < p.ph_hi)
#define SEAM(k) do { if (IN(k) && IN((k) + 1)) xcd_barrier(bar); } while (0)
#ifndef REPEAT_PH
#define REPEAT_PH -1
#endif
#define NREP(k) ((REPEAT_PH == (k)) ? 2 : 1)
    if (IN(0)) { for (int r_ = 0; r_ < NREP(0); ++r_) phase0(get_params(), lds); } SEAM(0);
    if (IN(1)) { for (int r_ = 0; r_ < NREP(1); ++r_) phase1a(get_params()); } SEAM(1);
    if (IN(2)) { for (int r_ = 0; r_ < NREP(2); ++r_) phase1b(get_params(), lds); } SEAM(2);
    if (IN(3)) { for (int r_ = 0; r_ < NREP(3); ++r_) phase1c(get_params(), lds); } SEAM(3);
    if (IN(4)) { for (int r_ = 0; r_ < NREP(4); ++r_) phase2(get_params(), lds); } SEAM(4);
    if (IN(5)) { for (int r_ = 0; r_ < NREP(5); ++r_) phase3(get_params(), lds); } SEAM(5);
    if (IN(6)) { for (int r_ = 0; r_ < NREP(6); ++r_) phase3b(get_params(), lds, r_ + 1 < NREP(6)); } SEAM(6);
    LAS unsigned* pre = (LAS unsigned*)(lds + MISC_OFF + 256 + 640);
    if (IN(7) || IN(8)) {
        if (tid < 144) cnts[tid] = __hip_atomic_load(ctl + CW_CNT + 64 * tid, __ATOMIC_RELAXED, __HIP_MEMORY_SCOPE_AGENT);
        __syncthreads();
        if (tid == 0) { unsigned a = 0; for (int i = 0; i < 32; ++i) { pre[i] = a; a += ((cnts[i] + 255u) >> 8) * 2u; } pre[32] = a;
                        a = 0; for (int i = 0; i < 112; ++i) { pre[33 + i] = a; a += ((cnts[32 + i] + 127u) >> 7) * 4u; } pre[33 + 112] = a; }
        __syncthreads();
    }
    if (IN(7)) { for (int r_ = 0; r_ < NREP(7); ++r_) phase4a(get_params(), lds, cnts, pre); } SEAM(7);
    if (IN(8)) { phase4b(get_params(), lds, cnts, pre); }
#undef IN
#undef SEAM
}

extern "C" void kernel_launch(void* const* d_in, const int* in_sizes, int n_in, void* d_out, int out_size, void* d_ws, size_t ws_size, hipStream_t stream) {
    static int grid = 0;
    if (grid == 0) {
        if (n_in != 26 || out_size != MT * DM || ws_size < WS_END) { fprintf(stderr, "kernel_launch: unexpected problem (n_in %d out %d ws %zu)\n", n_in, out_size, ws_size); grid = -1; return; }
        int dev = 0, cus = 0, per_cu = 0;
        hipGetDevice(&dev); hipDeviceGetAttribute(&cus, hipDeviceAttributeMultiprocessorCount, dev);
        hipFuncSetAttribute((const void*)hybrid_block_fwd, hipFuncAttributeMaxDynamicSharedMemorySize, LDS_BYTES);
        hipOccupancyMaxActiveBlocksPerMultiprocessor(&per_cu, (const void*)hybrid_block_fwd, 512, LDS_BYTES);
        (void)hipGetLastError();
        if (per_cu < 1) { fprintf(stderr, "kernel_launch: occupancy query says %d blocks/CU\n", per_cu); per_cu = 1; }
        grid = cus;
    }
    if (grid < 0) return;
    hipMemsetAsync((char*)d_ws + WS_CTL, 0, CTL_BYTES, stream);
    Params prm{};
    for (int i = 0; i < 26; ++i) prm.in[i] = d_in[i];
    prm.out = (float*)d_out; prm.ws = (unsigned char*)d_ws;
#if N_LAUNCH_SPLIT
    for (int ph = 0; ph <= DBG_LAST_PHASE; ++ph) { prm.ph_lo = ph; prm.ph_hi = ph + 1; hipLaunchKernelGGL(hybrid_block_fwd, dim3(grid), dim3(512), LDS_BYTES, stream, prm); }
#else
    prm.ph_lo = 0; prm.ph_hi = DBG_LAST_PHASE + 1;
    hipLaunchKernelGGL(hybrid_block_fwd, dim3(grid), dim3(512), LDS_BYTES, stream, prm);
#endif
}
```

```cpp
#include <hip/hip_runtime.h>
#include <cstdio>
#include <cstdint>
#include <utility>

#ifndef N_LAUNCH_SPLIT
#define N_LAUNCH_SPLIT 0
#endif
#ifndef DBG_LAST_PHASE
#define DBG_LAST_PHASE 8
#endif

#define LAS __attribute__((address_space(3)))
#define GAS __attribute__((address_space(1)))
typedef unsigned short bf16_t;
typedef short bf16x8 __attribute__((ext_vector_type(8)));
typedef float f32x4 __attribute__((ext_vector_type(4)));
typedef float f32x2 __attribute__((ext_vector_type(2)));
typedef float f32x16 __attribute__((ext_vector_type(16)));
typedef unsigned u32x4 __attribute__((ext_vector_type(4)));
typedef unsigned u32x2 __attribute__((ext_vector_type(2)));
typedef __bf16 bf16x2_t __attribute__((ext_vector_type(2)));

constexpr int NB = 8, SEQ = 4096, DM = 1024, MT = NB * SEQ;
constexpr int NHEAD = 8, DQK = 96, DV = 64;
constexpr int NEXP = 32;
constexpr float EPS = 1e-6f;
constexpr float QSCALE = 0.14724444602590306f;
constexpr int NPH = 9;

constexpr size_t MiB = 1u << 20;
constexpr size_t WS_CTL = 0, CTL_BYTES = 128 * 1024;
constexpr size_t WS_MOD = 1 * MiB;
constexpr size_t WS_ROPE = 2 * MiB;
constexpr size_t WS_WIN = 6 * MiB;
constexpr size_t WS_WQ = 9 * MiB;
constexpr size_t WS_WKV = 9 * MiB + 512 * 1024;
constexpr size_t WS_WR = 9 * MiB + 768 * 1024;
constexpr size_t WS_WOUT = 10 * MiB;
constexpr size_t WS_WGU = 12 * MiB;
constexpr size_t WS_WD = 44 * MiB;
constexpr size_t WS_SSQQ = 60 * MiB;
constexpr size_t WS_SSQKV = 60 * MiB + 512 * 1024;
constexpr size_t WS_SSQKR = 60 * MiB + 768 * 1024;
constexpr size_t WS_SSQ1 = 61 * MiB;
constexpr size_t WS_TOKW = 63 * MiB;
constexpr size_t WS_KROPE = 64 * MiB;
constexpr size_t WS_CQ = 68 * MiB;
constexpr size_t WS_CKV = 84 * MiB;
constexpr size_t WS_LIST = 92 * MiB;
constexpr size_t WS_H = 100 * MiB;
constexpr size_t WS_U = 164 * MiB;
constexpr size_t WS_Q = 196 * MiB;
constexpr size_t WS_K = 244 * MiB;
constexpr size_t WS_VT = 292 * MiB;
constexpr size_t WS_CAT = 324 * MiB;
constexpr size_t WS_ABUF = 388 * MiB;
constexpr size_t WS_BLIST = 420 * MiB;
constexpr size_t WS_END = 435 * MiB;
constexpr int CW_BAR = 4096;
constexpr int CW_CNT = 16384;

constexpr int SCR_BYTES = 155648;
constexpr int MISC_OFF = SCR_BYTES;
constexpr int LDS_BYTES = SCR_BYTES + 2048;

__device__ __forceinline__ unsigned cvtpk(float lo, float hi) { f32x2 v = {lo, hi}; bf16x2_t b = __builtin_convertvector(v, bf16x2_t); return __builtin_bit_cast(unsigned, b); }
__device__ __forceinline__ float bf2f(unsigned short h) { return __builtin_bit_cast(float, (unsigned)h << 16); }
__device__ __forceinline__ unsigned short f2bf(float f) { return (unsigned short)(cvtpk(f, 0.f) & 0xffffu); }
__device__ __forceinline__ float sigmoidf_(float x) { return __builtin_amdgcn_rcpf(1.0f + __expf(-x)); }
__device__ __forceinline__ float siluf_(float x) { return x * __builtin_amdgcn_rcpf(1.0f + __expf(-x)); }
__device__ __forceinline__ float wave_sum(float v) {
#pragma unroll
    for (int o = 1; o < 64; o <<= 1) v += __shfl_xor(v, o);
    return v;
}

__device__ __forceinline__ int vcu_id() { const int g = gridDim.x, b = blockIdx.x; return (g & 7) == 0 ? (b & 7) * (g >> 3) + (b >> 3) : b; }
#define XB_TMO      128
#define XB_XCNT(j)  (256  + 64 * (j))
#define XB_XSUB(j)  (1280 + 64 * (j))
#define XB_XGEN(j)  (2304 + 64 * (j))
#define XB_TOP      3328
#define XB_TOPGEN   3392
#define XCD_BAR_WORDS 3456
#define XB_SPIN_CAP (1u << 20)
__device__ __forceinline__ unsigned xb_ld(unsigned* p)              { return __hip_atomic_load(p, __ATOMIC_RELAXED, __HIP_MEMORY_SCOPE_AGENT); }
__device__ __forceinline__ unsigned xb_add(unsigned* p, unsigned v) { return __hip_atomic_fetch_add(p, v, __ATOMIC_RELAXED, __HIP_MEMORY_SCOPE_AGENT); }
__device__ __forceinline__ unsigned xb_xcc_id() { return (unsigned)__builtin_amdgcn_s_getreg((3 << 11) | 20) & 0xFu; }
#define XB_SPIN(cond, bar) do { unsigned _sp = 0; while (cond) { __builtin_amdgcn_s_sleep(1); \
    if ((++_sp & 255u) == 0u) { if (xb_ld(&(bar)[XB_TMO])) break; if (_sp > XB_SPIN_CAP) { atomicAdd(&(bar)[XB_TMO], 1u); break; } } } } while (0)
struct XcdBarrier { unsigned* bar; unsigned x; volatile LAS unsigned* st; };
__device__ __forceinline__ XcdBarrier xcd_barrier_post(unsigned* bar, volatile LAS unsigned* st) {
    XcdBarrier b; b.bar = bar; b.x = xb_xcc_id(); b.st = st;
    if (threadIdx.x == 0) (void)xb_add(&bar[XB_XCNT(b.x)], 1u);
    return b;
}
__device__ __forceinline__ void xcd_barrier_complete(unsigned* bar, unsigned x, unsigned& nloc, unsigned& nx) {
    const unsigned G = gridDim.x * gridDim.y * gridDim.z;
    unsigned sum, cnt, mine, sp = 0u;
    for (;;) {
        sum = 0u; cnt = 0u; mine = 0u;
#pragma unroll
        for (unsigned j = 0; j < 16; ++j) { const unsigned c = xb_ld(&bar[XB_XCNT(j)]); sum += c; cnt += (c > 0u) ? 1u : 0u; mine = (j == x) ? c : mine; }
        if (sum == G) break;
        __builtin_amdgcn_s_sleep(1);
        if ((++sp & 255u) == 0u) { if (xb_ld(&bar[XB_TMO])) break; if (sp > XB_SPIN_CAP) { atomicAdd(&bar[XB_TMO], 1u); break; } }
    }
    nloc = mine > 0u ? mine : 1u; nx = cnt > 0u ? cnt : 1u;
}
__device__ __forceinline__ void xcd_barrier(const XcdBarrier& b) {
    asm volatile("s_waitcnt vmcnt(0)" ::: "memory");
    __syncthreads();
    if (threadIdx.x == 0) {
        unsigned* bar = b.bar;
        __builtin_amdgcn_s_waitcnt(0);
        unsigned nloc = b.st[0], nx = b.st[1];
        if (nloc == 0u) { xcd_barrier_complete(bar, b.x, nloc, nx); b.st[0] = nloc; b.st[1] = nx; }
        const unsigned old = xb_add(&bar[XB_XSUB(b.x)], 1u);
        const unsigned gen = old / nloc;
        if (old + 1u == (gen + 1u) * nloc) {
            __builtin_amdgcn_fence(__ATOMIC_RELEASE, "agent");
            asm volatile("s_waitcnt vmcnt(0)" ::: "memory");
            const unsigned og = xb_add(&bar[XB_TOP], 1u);
            const unsigned tg = og / nx;
            if (og + 1u == (tg + 1u) * nx) xb_add(&bar[XB_TOPGEN], 1u);
            else XB_SPIN(xb_ld(&bar[XB_TOPGEN]) == tg, bar);
            __builtin_amdgcn_fence(__ATOMIC_ACQUIRE, "agent");
            xb_add(&bar[XB_XGEN(b.x)], 1u);
            asm volatile("s_waitcnt vmcnt(0)" ::: "memory");
        } else {
            XB_SPIN(xb_ld(&bar[XB_XGEN(b.x)]) == gen, bar);
            __builtin_amdgcn_fence(__ATOMIC_ACQUIRE, "agent");
            asm volatile("s_waitcnt vmcnt(0)" ::: "memory");
        }
    }
    __syncthreads();
}

__device__ __forceinline__ int lds_byte2(int r, int c) { const int st = (r >> 4) * 2 + (c >> 5), ob = (r & 15) * 64 + (c & 31) * 2; return st * 1024 + (ob ^ (((ob >> 9) & 1) << 5)); }
__device__ __forceinline__ void stage_rc2(int b, int& R, int& C) { const int st = b >> 10, sb = b & 1023, swz = sb ^ (((sb >> 9) & 1) << 5); R = (st >> 1) * 16 + swz / 64; C = (st & 1) * 32 + (swz % 64) / 2; }

template <int MI, int NI, bool TRANS>
__device__ __forceinline__ void gemm_block(LAS unsigned char* lds, const bf16_t* const (&ap)[MI / 2], const bf16_t* const (&bp)[NI], int nkt, f32x4 (&acc)[MI][NI]) {
    constexpr int BM = 32 * MI, BN = 64 * NI, TA = BM * 128, TB = BN * 128, STG = TA + TB, GLA = MI / 2, GLB = NI;
    static_assert(2 * STG <= SCR_BYTES, "LDS");
    const int tid = threadIdx.x, lane = tid & 63, wid = __builtin_amdgcn_readfirstlane(tid >> 6), wr = wid >> 2, wc = wid & 3, fr = lane & 15, fq = lane >> 4;
    const int aoff = lds_byte2(wr * (MI * 16) + fr, fq * 8), boff = TA + lds_byte2(wc * (NI * 16) + fr, fq * 8);
#define GB_STAGE(buf, kt) do { \
        _Pragma("unroll") for (int i_ = 0; i_ < GLA; ++i_) __builtin_amdgcn_global_load_lds((const unsigned*)(ap[i_] + (kt) * 64), (LAS unsigned*)(lds + (buf) * STG + wid * 1024 + i_ * 8192), 16, 0, 0); \
        _Pragma("unroll") for (int i_ = 0; i_ < GLB; ++i_) __builtin_amdgcn_global_load_lds((const unsigned*)(bp[i_] + (kt) * 64), (LAS unsigned*)(lds + (buf) * STG + TA + wid * 1024 + i_ * 8192), 16, 0, 0); } while (0)
    GB_STAGE(0, 0);
    asm volatile("s_waitcnt vmcnt(0)" ::: "memory"); __syncthreads();
    for (int t = 0; t < nkt; ++t) {
        const int cur = t & 1;
        if (t + 1 < nkt) GB_STAGE(cur ^ 1, t + 1);
        const LAS unsigned char* sb = lds + cur * STG;
#pragma unroll
        for (int ks = 0; ks < 2; ++ks) {
            bf16x8 At[MI], Bf[NI];
#pragma unroll
            for (int m = 0; m < MI; ++m) At[m] = *(const LAS bf16x8*)(sb + aoff + m * 2048 + ks * 1024);
#pragma unroll
            for (int n = 0; n < NI; ++n) Bf[n] = *(const LAS bf16x8*)(sb + boff + n * 2048 + ks * 1024);
#pragma unroll
            for (int m = 0; m < MI; ++m)
#pragma unroll
                for (int n = 0; n < NI; ++n)
                    acc[m][n] = TRANS ? __builtin_amdgcn_mfma_f32_16x16x32_bf16(Bf[n], At[m], acc[m][n], 0, 0, 0)
                                      : __builtin_amdgcn_mfma_f32_16x16x32_bf16(At[m], Bf[n], acc[m][n], 0, 0, 0);
        }
        asm volatile("s_waitcnt vmcnt(0)" ::: "memory"); __syncthreads();
    }
#undef GB_STAGE
}
template <int MI, int NI, bool ARES>
__device__ __forceinline__ void gemm_stage(LAS unsigned char* lds, int abytes, const bf16_t* const (&ap)[MI / 2], const bf16_t* const (&bp)[NI], int buf, int kt) {
    constexpr int TA = MI * 32 * 128, TB = NI * 64 * 128, STG = ARES ? TB : TA + TB;
    const int wid = __builtin_amdgcn_readfirstlane(threadIdx.x >> 6);
    LAS unsigned char* base = lds + (ARES ? abytes : 0) + buf * STG + wid * 1024;
    if (!ARES) {
#pragma unroll
        for (int i = 0; i < MI / 2; ++i) __builtin_amdgcn_global_load_lds((const unsigned*)(ap[i] + kt * 64), (LAS unsigned*)(base + i * 8192), 16, 0, 0);
    }
#pragma unroll
    for (int i = 0; i < NI; ++i) __builtin_amdgcn_global_load_lds((const unsigned*)(bp[i] + kt * 64), (LAS unsigned*)(base + (ARES ? 0 : TA) + i * 8192), 16, 0, 0);
}
template <int MI>
__device__ __forceinline__ void gemm_load_ares(LAS unsigned char* lds, const bf16_t* const (&ap)[MI / 2], int nkt) {
    constexpr int TA = MI * 32 * 128;
    const int wid = __builtin_amdgcn_readfirstlane(threadIdx.x >> 6);
    for (int kt = 0; kt < nkt; ++kt) {
#pragma unroll
        for (int i = 0; i < MI / 2; ++i) __builtin_amdgcn_global_load_lds((const unsigned*)(ap[i] + kt * 64), (LAS unsigned*)(lds + kt * TA + wid * 1024 + i * 8192), 16, 0, 0);
    }
}
template <int MI, int NI, bool TRANS, bool ARES>
__device__ __forceinline__ void gemm_main2(LAS unsigned char* lds, int abytes, const bf16_t* const (&ap)[MI / 2], const bf16_t* const (&bp)[NI], const bf16_t* const (&bq)[NI], int ksplit, int nkt, f32x4 (&acc)[MI][NI]) {
    constexpr int TA = MI * 32 * 128, TB = NI * 64 * 128, STG = ARES ? TB : TA + TB;
    const int tid = threadIdx.x, lane = tid & 63, wid = __builtin_amdgcn_readfirstlane(tid >> 6), wr = wid >> 2, wc = wid & 3, fr = lane & 15, fq = lane >> 4;
    const int aoff = lds_byte2(wr * (MI * 16) + fr, fq * 8), boff = (ARES ? abytes : TA) + lds_byte2(wc * (NI * 16) + fr, fq * 8);
#pragma unroll 1
    for (int t = 0; t < nkt; ++t) {
        const int cur = t & 1;
        asm volatile("s_waitcnt vmcnt(0)" ::: "memory"); __syncthreads();
        if (t + 1 < nkt) { if (t + 1 < ksplit) gemm_stage<MI, NI, ARES>(lds, abytes, ap, bp, cur ^ 1, t + 1); else gemm_stage<MI, NI, ARES>(lds, abytes, ap, bq, cur ^ 1, t + 1); }
        const LAS unsigned char* sa = ARES ? lds + t * TA : lds + cur * STG;
        const LAS unsigned char* sb = lds + cur * STG;
#pragma unroll
        for (int ks = 0; ks < 2; ++ks) {
            bf16x8 At[MI], Bf[NI];
#pragma unroll
            for (int m = 0; m < MI; ++m) At[m] = *(const LAS bf16x8*)(sa + aoff + m * 2048 + ks * 1024);
#pragma unroll
            for (int n = 0; n < NI; ++n) Bf[n] = *(const LAS bf16x8*)(sb + boff + n * 2048 + ks * 1024);
#pragma unroll
            for (int m = 0; m < MI; ++m)
#pragma unroll
                for (int n = 0; n < NI; ++n)
                    acc[m][n] = TRANS ? __builtin_amdgcn_mfma_f32_16x16x32_bf16(Bf[n], At[m], acc[m][n], 0, 0, 0)
                                      : __builtin_amdgcn_mfma_f32_16x16x32_bf16(At[m], Bf[n], acc[m][n], 0, 0, 0);
        }
    }
    if (nkt & 1) __syncthreads();
}
template <int MI, int NI, bool TRANS, bool ARES>
__device__ __forceinline__ void gemm_main(LAS unsigned char* lds, int abytes, const bf16_t* const (&ap)[MI / 2], const bf16_t* const (&bp)[NI], int nkt, f32x4 (&acc)[MI][NI]) {
    gemm_main2<MI, NI, TRANS, ARES>(lds, abytes, ap, bp, bp, nkt, nkt, acc);
}
template <int GL>
__device__ __forceinline__ void stage_ptrs_dense(const bf16_t* base, size_t ld, int r0, const bf16_t* (&p)[GL]) {
    const int tid = threadIdx.x, lane = tid & 63, wid = tid >> 6;
#pragma unroll
    for (int i = 0; i < GL; ++i) { int R, C; stage_rc2(wid * 1024 + i * 8192 + lane * 16, R, C); p[i] = base + (size_t)(r0 + R) * ld + C; }
}

struct Params {
    const void* in[26];
    float* out;
    unsigned char* ws;
    int ph_lo, ph_hi;
};
typedef const __attribute__((address_space(4))) Params* CP;
__device__ __forceinline__ CP get_params() { CP q = (CP)__builtin_amdgcn_kernarg_segment_ptr(); asm volatile("" : "+s"(q)); return q; }

__device__ const float INVF[16] = {1.000000000e+00f, 5.623413324e-01f, 3.162277639e-01f, 1.778279394e-01f, 1.000000015e-01f, 5.623413250e-02f, 3.162277490e-02f, 1.778279431e-02f,
                                   9.999999776e-03f, 5.623413250e-03f, 3.162277630e-03f, 1.778279431e-03f, 1.000000047e-03f, 5.623413017e-04f, 3.162277571e-04f, 1.778279402e-04f};

__device__ __forceinline__ void tr_item(const float* srcp, int ldw, const float* kscale, bf16_t* WT, int Kd, int k0, int n0, LAS float* scr, int lane) {
#pragma unroll 8
    for (int i = 0; i < 32; ++i) { const int kk = 2 * i + (lane >> 5); float v = 0.f; if (srcp) { v = srcp[(size_t)(k0 + kk) * ldw]; if (kscale) v *= kscale[k0 + kk]; } scr[kk * 33 + (lane & 31)] = v; }
    asm volatile("s_waitcnt lgkmcnt(0)" ::: "memory");
    const int c = lane & 7;
#pragma unroll
    for (int j = 0; j < 4; ++j) { const int n = (lane >> 3) + 8 * j; const LAS float* s = scr + (8 * c) * 33 + n;
        u32x4 o; o.x = cvtpk(s[0 * 33], s[1 * 33]); o.y = cvtpk(s[2 * 33], s[3 * 33]); o.z = cvtpk(s[4 * 33], s[5 * 33]); o.w = cvtpk(s[6 * 33], s[7 * 33]);
        *(u32x4*)(WT + (size_t)(n0 + n) * Kd + k0 + 8 * c) = o; }
    asm volatile("s_waitcnt lgkmcnt(0)" ::: "memory");
}

constexpr int TR_I0 = 16 * 24, TR_I1 = 4 * 12, TR_I2 = 2 * 16, TR_I3 = 16 * 16, TR_I4 = 32 * 128, TR_I5 = 32 * 64, TR_I6 = 16 * 2;
constexpr int TR_NIT = TR_I0 + TR_I1 + TR_I2 + TR_I3 + TR_I4 + TR_I5 + TR_I6, TR_EARLY = TR_I0 + TR_I1 + TR_I2;
__device__ __forceinline__ void transpose_items(CP p, LAS unsigned char* lds, int it0, int it1) {
    const int tid = threadIdx.x, lane = tid & 63, wave = __builtin_amdgcn_readfirstlane(tid >> 6);
    const int G = gridDim.x, bid = blockIdx.x;
    unsigned char* ws = p->ws;
    {
        LAS unsigned* scr = (LAS unsigned*)(lds + 65536) + wave * 2112;
        const int gw = bid * 8 + wave, NGW = G * 8;
        const float* w_in = (const float*)p->in[6]; const float* qan = (const float*)p->in[11]; const float* w_qb = (const float*)p->in[12];
        const float* kvan = (const float*)p->in[13]; const float* w_kvb = (const float*)p->in[14]; const float* w_out = (const float*)p->in[17];
        const float* w_group = (const float*)p->in[19]; const float* w_expert = (const float*)p->in[21];
        const float* w_gate = (const float*)p->in[23]; const float* w_up = (const float*)p->in[24]; const float* w_down = (const float*)p->in[25];
        constexpr int I0 = TR_I0, I1 = TR_I1, I2 = TR_I2, I3 = TR_I3, I4 = TR_I4, I5 = TR_I5, I6 = TR_I6, NIT = TR_NIT;
        const int c4 = lane & 15, kp = lane >> 4;
        for (int it = it0 + gw; it < it1; it += NGW) {
            int r = it;
            if (r >= NIT - I6) {
                r -= NIT - I6;
                LAS float* fscr = (LAS float*)scr; const int nl = lane & 31;
                const int kb = r >> 1, nb = r & 1, n0 = nb * 32, np = n0 + nl, k0 = kb * 64;
                const float* srcp = nullptr; int ldw = 0;
                if (np < 4) { srcp = w_group + np; ldw = 4; } else if (np < 36) { srcp = w_expert + (np - 4); ldw = 32; }
#pragma unroll 8
                for (int i = 0; i < 32; ++i) { const int kk = 2 * i + (lane >> 5); fscr[kk * 33 + nl] = srcp ? srcp[(size_t)(k0 + kk) * ldw] : 0.f; }
                asm volatile("s_waitcnt lgkmcnt(0)" ::: "memory");
                const int c = lane & 7;
#pragma unroll
                for (int j = 0; j < 4; ++j) { const int n = (lane >> 3) + 8 * j; const LAS float* sp = fscr + (8 * c) * 33 + n;
                    float v[8], l[8];
#pragma unroll
                    for (int q = 0; q < 8; ++q) { v[q] = sp[q * 33]; l[q] = v[q] - bf2f(f2bf(v[q])); }
                    if (n0 + n < 48) {
                        u32x4 o; o.x = cvtpk(v[0], v[1]); o.y = cvtpk(v[2], v[3]); o.z = cvtpk(v[4], v[5]); o.w = cvtpk(v[6], v[7]);
                        *(u32x4*)((bf16_t*)(ws + WS_WR) + (size_t)(n0 + n) * 1024 + k0 + 8 * c) = o;
                        u32x4 o2; o2.x = cvtpk(l[0], l[1]); o2.y = cvtpk(l[2], l[3]); o2.z = cvtpk(l[4], l[5]); o2.w = cvtpk(l[6], l[7]);
                        *(u32x4*)((bf16_t*)(ws + WS_WR) + 48 * 1024 + (size_t)(n0 + n) * 1024 + k0 + 8 * c) = o2; } }
                asm volatile("s_waitcnt lgkmcnt(0)" ::: "memory");
                continue;
            }
            const float* srcp; int ldw, Kd, k0, n0; const float* ksc = nullptr; bf16_t* WT;
            if (r < I0) {
                const int kb = r / 24, nb = r % 24; n0 = nb * 64; k0 = kb * 64; const int np = n0 + 4 * c4;
                const int pn = np >> 8, wc = (np >> 6) & 3, n = (np >> 4) & 3, f = np & 15; int src;
                if (pn < 4) { const int ch = pn * 128 + wc * 32 + (n >> 1) * 16 + f; src = (n & 1) ? 512 + ch : ch; }
                else if (pn == 4) src = np;
                else { const int j = np - 1280; src = (j < 160) ? 1280 + j : -1; }
                srcp = src >= 0 ? w_in + src : nullptr; ldw = 1440; Kd = 1024; WT = (bf16_t*)(ws + WS_WIN);
            } else if ((r -= I0) < I1) {
                const int kb = r / 12, nb = r % 12; n0 = nb * 64; k0 = kb * 64;
                srcp = w_qb + n0 + 4 * c4; ldw = 768; Kd = 256; ksc = qan; WT = (bf16_t*)(ws + WS_WQ);
            } else if ((r -= I1) < I2) {
                const int kb = r / 16, nb = r % 16; n0 = nb * 64; k0 = kb * 64;
                srcp = w_kvb + n0 + 4 * c4; ldw = 1024; Kd = 128; ksc = kvan; WT = (bf16_t*)(ws + WS_WKV);
            } else if ((r -= I2) < I3) {
                const int kb = r / 16, nb = r % 16; n0 = nb * 64; k0 = kb * 64;
                srcp = w_out + n0 + 4 * c4; ldw = 1024; Kd = 1024; WT = (bf16_t*)(ws + WS_WOUT);
            } else if ((r -= I3) < I4) {
                const int e = r >> 7, q = r & 127, kb = q / 8, nb = q % 8; n0 = nb * 64; k0 = kb * 64; const int np = n0 + 4 * c4;
                const int ct = np >> 8, wc = (np >> 6) & 3, n = (np >> 4) & 3, f = np & 15, ch = ct * 128 + wc * 32 + (n >> 1) * 16 + f;
                srcp = ((n & 1) ? w_up : w_gate) + (size_t)e * 1024 * 256 + ch; ldw = 256; Kd = 1024; WT = (bf16_t*)(ws + WS_WGU) + (size_t)e * 512 * 1024;
            } else {
                r -= I4; const int e = r >> 6, q = r & 63, kb = q / 16, nb = q % 16; n0 = nb * 64; k0 = kb * 64;
                srcp = w_down + (size_t)e * 256 * 1024 + n0 + 4 * c4; ldw = 1024; Kd = 256; WT = (bf16_t*)(ws + WS_WD) + (size_t)e * 1024 * 256;
            }
            f32x4 v0[8], v1[8];
#pragma unroll
            for (int i = 0; i < 8; ++i) { const int k = k0 + 8 * i + 2 * kp;
                if (srcp) { v0[i] = *(const f32x4*)(srcp + (size_t)k * ldw); v1[i] = *(const f32x4*)(srcp + (size_t)(k + 1) * ldw); }
                else { v0[i] = (f32x4){0.f, 0.f, 0.f, 0.f}; v1[i] = v0[i]; } }
#pragma unroll
            for (int i = 0; i < 8; ++i) { const int k = k0 + 8 * i + 2 * kp; f32x4 a = v0[i], b = v1[i];
                if (ksc) { a = a * ksc[k]; b = b * ksc[k + 1]; }
                LAS unsigned* d = scr + (4 * c4) * 33 + 4 * i + kp;
                d[0] = cvtpk(a.x, b.x); d[33] = cvtpk(a.y, b.y); d[66] = cvtpk(a.z, b.z); d[99] = cvtpk(a.w, b.w); }
            asm volatile("s_waitcnt lgkmcnt(0)" ::: "memory");
            const int c = lane & 7;
#pragma unroll
            for (int j = 0; j < 8; ++j) { const int n = (lane >> 3) + 8 * j; const LAS unsigned* sp = scr + n * 33 + 4 * c;
                u32x4 o; o.x = sp[0]; o.y = sp[1]; o.z = sp[2]; o.w = sp[3];
                *(u32x4*)(WT + (size_t)(n0 + n) * Kd + k0 + 8 * c) = o; }
            asm volatile("s_waitcnt lgkmcnt(0)" ::: "memory");
        }
    }
}

__device__ __forceinline__ void phase0(CP p, LAS unsigned char* lds) {
    const int tid = threadIdx.x, lane = tid & 63, wave = __builtin_amdgcn_readfirstlane(tid >> 6);
    const int G = gridDim.x, bid = blockIdx.x;
    unsigned char* ws = p->ws;
    if (bid < 192) {
        const float* c = (const float*)p->in[1]; const float* w_ada = (const float*)p->in[3]; const float* b_ada = (const float*)p->in[4];
        LAS float* sc = (LAS float*)lds;
        LAS float* red = (LAS float*)(lds + 32768);
        for (int i = tid; i < 8192; i += 512) sc[i] = siluf_(c[i]);
        __syncthreads();
        const int col = tid & 31, ks = tid >> 5, n0 = bid * 32;
        float a[8] = {0, 0, 0, 0, 0, 0, 0, 0};
#pragma unroll 8
        for (int i = 0; i < 64; ++i) { const int k = ks * 64 + i; const float w = w_ada[(size_t)k * 6144 + n0 + col];
#pragma unroll
            for (int b = 0; b < 8; ++b) a[b] += sc[b * 1024 + k] * w; }
#pragma unroll
        for (int b = 0; b < 8; ++b) red[(ks * 32 + col) * 8 + b] = a[b];
        __syncthreads();
        if (tid < 256) { const int cc = tid & 31, b = tid >> 5; float s = 0.f;
#pragma unroll
            for (int k2 = 0; k2 < 16; ++k2) s += red[(k2 * 32 + cc) * 8 + b];
            ((float*)(ws + WS_MOD))[b * 6144 + n0 + cc] = s + b_ada[n0 + cc]; }
        __syncthreads();
    }
    {
        const int* pos = (const int*)p->in[2]; f32x2* rt = (f32x2*)(ws + WS_ROPE);
        for (int e = bid * 512 + tid; e < MT * 16; e += G * 512) {
            const int tok = e >> 4, i = e & 15;
            const float a32 = (float)pos[tok] * INVF[i];
            const double rev = (double)a32 * 0.15915494309189535;
            const float fr = (float)(rev - __builtin_rint(rev));
            rt[e] = (f32x2){__builtin_amdgcn_cosf(fr), __builtin_amdgcn_sinf(fr)};
        }
    }
    transpose_items(p, lds, 0, N_LAUNCH_SPLIT ? TR_NIT : TR_EARLY);
}

__device__ __forceinline__ void phase1a(CP p) {
    const int tid = threadIdx.x, lane = tid & 63, wave = tid >> 6;
    const int gw = blockIdx.x * 8 + wave, NGW = gridDim.x * 8;
    const float* x = (const float*)p->in[0]; const float* nm = (const float*)p->in[5]; const float* mod = (const float*)(p->ws + WS_MOD);
    bf16_t* h = (bf16_t*)(p->ws + WS_H);
    for (int grp = gw; grp < MT / 16; grp += NGW) {
        const int r0 = grp * 16, b = r0 >> 12;
        f32x4 gm[4], sh[4];
#pragma unroll
        for (int j = 0; j < 4; ++j) { const int col = 4 * lane + 256 * j; const f32x4 g = *(const f32x4*)(nm + col), s = *(const f32x4*)(mod + b * 6144 + 1024 + col);
            gm[j] = g * (s + 1.0f); sh[j] = *(const f32x4*)(mod + b * 6144 + col); }
#pragma unroll 1
        for (int rb = 0; rb < 16; rb += 4) {
            f32x4 v[4][4];
#pragma unroll
            for (int rr = 0; rr < 4; ++rr) { const float* xr = x + (size_t)(r0 + rb + rr) * DM;
#pragma unroll
                for (int j = 0; j < 4; ++j) v[rr][j] = *(const f32x4*)(xr + 4 * lane + 256 * j); }
#pragma unroll
            for (int rr = 0; rr < 4; ++rr) { float s = 0.f;
#pragma unroll
                for (int j = 0; j < 4; ++j) s += (v[rr][j].x * v[rr][j].x + v[rr][j].y * v[rr][j].y) + (v[rr][j].z * v[rr][j].z + v[rr][j].w * v[rr][j].w);
                const float rstd = __builtin_amdgcn_rsqf(wave_sum(s) * (1.0f / DM) + EPS);
                bf16_t* hr = h + (size_t)(r0 + rb + rr) * DM;
#pragma unroll
                for (int j = 0; j < 4; ++j) { const f32x4 o = v[rr][j] * rstd * gm[j] + sh[j]; u32x2 w; w.x = cvtpk(o.x, o.y); w.y = cvtpk(o.z, o.w); *(u32x2*)(hr + 4 * lane + 256 * j) = w; } }
        }
    }
}

__device__ __forceinline__ void phase1b(CP p, LAS unsigned char* lds) {
    const int tid = threadIdx.x, lane = tid & 63, wid = __builtin_amdgcn_readfirstlane(tid >> 6), wr = wid >> 2, wc = wid & 3, fr = lane & 15, fq = lane >> 4;
    unsigned char* ws = p->ws;
    const bf16_t* h = (const bf16_t*)(ws + WS_H); const bf16_t* win = (const bf16_t*)(ws + WS_WIN);
    for (int u = vcu_id(); u < 128 * 6; u += gridDim.x) {
        const int pm = u / 6, pn = u % 6;
        const bf16_t* ap[4]; const bf16_t* bp[4];
        stage_ptrs_dense<4>(h, 1024, pm * 256, ap); stage_ptrs_dense<4>(win, 1024, pn * 256, bp);
        f32x4 acc[8][4];
#pragma unroll
        for (int m = 0; m < 8; ++m)
#pragma unroll
            for (int n = 0; n < 4; ++n) acc[m][n] = (f32x4){0.f, 0.f, 0.f, 0.f};
        gemm_block<8, 4, true>(lds, ap, bp, 16, acc);
        const int rowb = pm * 256 + wr * 128 + fr;
        if (pn < 4) {
            bf16_t* ub = (bf16_t*)(ws + WS_U);
#pragma unroll
            for (int m = 0; m < 8; ++m) { const size_t row = rowb + m * 16;
#pragma unroll
                for (int h2 = 0; h2 < 2; ++h2) { const f32x4 v = acc[m][2 * h2], g = acc[m][2 * h2 + 1];
                    const int ch = pn * 128 + wc * 32 + h2 * 16 + fq * 4;
                    u32x2 w; w.x = cvtpk(v.x * sigmoidf_(g.x), v.y * sigmoidf_(g.y)); w.y = cvtpk(v.z * sigmoidf_(g.z), v.w * sigmoidf_(g.w));
                    *(u32x2*)(ub + row * 512 + ch) = w; } }
        } else if (pn == 4) {
            bf16_t* cq = (bf16_t*)(ws + WS_CQ); float* sq = (float*)(ws + WS_SSQQ);
#pragma unroll
            for (int m = 0; m < 8; ++m) { const size_t row = rowb + m * 16; float s = 0.f;
#pragma unroll
                for (int n = 0; n < 4; ++n) { const f32x4 v = acc[m][n]; s += (v.x * v.x + v.y * v.y) + (v.z * v.z + v.w * v.w);
                    u32x2 w; w.x = cvtpk(v.x, v.y); w.y = cvtpk(v.z, v.w); *(u32x2*)(cq + row * 256 + wc * 64 + n * 16 + fq * 4) = w; }
                s += __shfl_xor(s, 16); s += __shfl_xor(s, 32);
                if (fq == 0) sq[row * 4 + wc] = s; }
        } else {
            if (wc < 2) {
                bf16_t* ckv = (bf16_t*)(ws + WS_CKV); float* sq = (float*)(ws + WS_SSQKV);
#pragma unroll
                for (int m = 0; m < 8; ++m) { const size_t row = rowb + m * 16; float s = 0.f;
#pragma unroll
                    for (int n = 0; n < 4; ++n) { const f32x4 v = acc[m][n]; s += (v.x * v.x + v.y * v.y) + (v.z * v.z + v.w * v.w);
                        u32x2 w; w.x = cvtpk(v.x, v.y); w.y = cvtpk(v.z, v.w); *(u32x2*)(ckv + row * 128 + wc * 64 + n * 16 + fq * 4) = w; }
                    s += __shfl_xor(s, 16); s += __shfl_xor(s, 32);
                    if (fq == 0) sq[row * 2 + wc] = s; }
            } else if (wc == 2) {
                float* kr = (float*)(ws + WS_KROPE); float* sq = (float*)(ws + WS_SSQKR);
#pragma unroll
                for (int m = 0; m < 8; ++m) { const size_t row = rowb + m * 16; float s = 0.f;
#pragma unroll
                    for (int n = 0; n < 2; ++n) { const f32x4 v = acc[m][n]; s += (v.x * v.x + v.y * v.y) + (v.z * v.z + v.w * v.w);
                        *(f32x4*)(kr + row * 32 + n * 16 + fq * 4) = v; }
                    s += __shfl_xor(s, 16); s += __shfl_xor(s, 32);
                    if (fq == 0) sq[row] = s; }
            }
        }
    }
}

constexpr int EPI_SCR = 131072;
__device__ __forceinline__ void q_item(CP p, LAS unsigned char* lds, int item) {
    const int tid = threadIdx.x, lane = tid & 63, wid = __builtin_amdgcn_readfirstlane(tid >> 6), wr = wid >> 2, wc = wid & 3, fr = lane & 15, fq = lane >> 4;
    unsigned char* ws = p->ws;
    const int pm = item >> 1, ct = item & 1;
    const bf16_t* ap[2]; const bf16_t* bp[6];
    stage_ptrs_dense<2>((const bf16_t*)(ws + WS_CQ), 256, pm * 128, ap);
    stage_ptrs_dense<6>((const bf16_t*)(ws + WS_WQ), 256, ct * 384, bp);
    __syncthreads();
    gemm_stage<4, 6, false>(lds, 0, ap, bp, 0, 0);
    const float* sq = (const float*)(ws + WS_SSQQ); const float* qn = (const float*)p->in[15];
    const int rowb = pm * 128 + wr * 64 + fr, i0 = fq * 4;
    float rq[4]; f32x4 gq[6], cs01[4], cs23[4];
#pragma unroll
    for (int m = 0; m < 4; ++m) { const f32x4 s4 = *(const f32x4*)(sq + (size_t)(rowb + m * 16) * 4); rq[m] = __builtin_amdgcn_rsqf(((s4.x + s4.y) + (s4.z + s4.w)) * (1.0f / 256.0f) + EPS); }
#pragma unroll
    for (int n = 0; n < 6; ++n) gq[n] = *(const f32x4*)(qn + n * 16 + i0);
    const f32x2* rope = (const f32x2*)(ws + WS_ROPE);
#pragma unroll
    for (int m = 0; m < 4; ++m) { const size_t tok = rowb + m * 16; cs01[m] = *(const f32x4*)(rope + tok * 16 + i0); cs23[m] = *(const f32x4*)(rope + tok * 16 + i0 + 2); }
    f32x4 acc[4][6];
#pragma unroll
    for (int m = 0; m < 4; ++m)
#pragma unroll
        for (int n = 0; n < 6; ++n) acc[m][n] = (f32x4){0.f, 0.f, 0.f, 0.f};
    gemm_main<4, 6, true, false>(lds, 0, ap, bp, 4, acc);
    const int hd = ct * 4 + wc, bb = (pm * 128) >> 12, sb = rowb & 4095;
    bf16_t* dst0 = (bf16_t*)(ws + WS_Q) + ((size_t)(bb * 8 + hd) * 4096 + sb) * 96;
#pragma unroll
    for (int m = 0; m < 4; ++m) { float s = 0.f;
#pragma unroll
        for (int n = 0; n < 6; ++n) { acc[m][n] = acc[m][n] * rq[m]; const f32x4 v = acc[m][n]; s += (v.x * v.x + v.y * v.y) + (v.z * v.z + v.w * v.w); }
        s += __shfl_xor(s, 16); s += __shfl_xor(s, 32);
        const float rh = __builtin_amdgcn_rsqf(s * (1.0f / 96.0f) + EPS) * QSCALE;
        bf16_t* dst = dst0 + (m * 16) * 96;
#pragma unroll
        for (int n = 0; n < 4; ++n) { const f32x4 v = acc[m][n] * rh * gq[n]; u32x2 w; w.x = cvtpk(v.x, v.y); w.y = cvtpk(v.z, v.w); *(u32x2*)(dst + n * 16 + i0) = w; }
        const f32x4 x1 = acc[m][4] * rh * gq[4], x2 = acc[m][5] * rh * gq[5];
        const f32x4 c01 = cs01[m], c23 = cs23[m];
        f32x4 o1, o2;
        o1.x = x1.x * c01.x - x2.x * c01.y; o2.x = x1.x * c01.y + x2.x * c01.x;
        o1.y = x1.y * c01.z - x2.y * c01.w; o2.y = x1.y * c01.w + x2.y * c01.z;
        o1.z = x1.z * c23.x - x2.z * c23.y; o2.z = x1.z * c23.y + x2.z * c23.x;
        o1.w = x1.w * c23.z - x2.w * c23.w; o2.w = x1.w * c23.w + x2.w * c23.z;
        u32x2 w; w.x = cvtpk(o1.x, o1.y); w.y = cvtpk(o1.z, o1.w); *(u32x2*)(dst + 64 + i0) = w;
        w.x = cvtpk(o2.x, o2.y); w.y = cvtpk(o2.z, o2.w); *(u32x2*)(dst + 80 + i0) = w;
    }
}

constexpr int KV_SCR = 98304;
__device__ __forceinline__ void kv_item(CP p, LAS unsigned char* lds, int pm) {
    const int tid = threadIdx.x, lane = tid & 63, wid = __builtin_amdgcn_readfirstlane(tid >> 6), wr = wid >> 2, wc = wid & 3, fr = lane & 15, fq = lane >> 4;
    unsigned char* ws = p->ws;
    const bf16_t* ap[2]; const bf16_t* bp[4];
    stage_ptrs_dense<2>((const bf16_t*)(ws + WS_CKV), 128, pm * 128, ap);
    stage_ptrs_dense<4>((const bf16_t*)(ws + WS_WKV), 128, 0, bp);
    __syncthreads();
    gemm_load_ares<4>(lds, ap, 2);
    gemm_stage<4, 4, true>(lds, 32768, ap, bp, 0, 0);
    LAS float* kr_l = (LAS float*)(lds + KV_SCR); LAS float* rp_l = kr_l + 128 * 33; LAS float* rkv_l = rp_l + 128 * 34; LAS float* skr_l = rkv_l + 128;
    {
        const float* krp = (const float*)(ws + WS_KROPE) + (size_t)pm * 128 * 32; const float* rope = (const float*)(ws + WS_ROPE) + (size_t)pm * 128 * 32;
        f32x4 a[2], b[2];
#pragma unroll
        for (int k = 0; k < 2; ++k) { const int idx = tid + 512 * k; a[k] = *(const f32x4*)(krp + idx * 4); b[k] = *(const f32x4*)(rope + idx * 4); }
        float rk = 0.f, sk = 0.f;
        if (tid < 128) { const f32x2 s2 = *(const f32x2*)((const float*)(ws + WS_SSQKV) + (size_t)(pm * 128 + tid) * 2); rk = __builtin_amdgcn_rsqf((s2.x + s2.y) * (1.0f / 128.0f) + EPS); sk = ((const float*)(ws + WS_SSQKR))[pm * 128 + tid]; }
#pragma unroll
        for (int k = 0; k < 2; ++k) { const int idx = tid + 512 * k, row = idx >> 3, c4 = (idx & 7) * 4;
            LAS float* d = kr_l + row * 33 + c4; d[0] = a[k].x; d[1] = a[k].y; d[2] = a[k].z; d[3] = a[k].w;
            LAS float* e = rp_l + row * 34 + c4; e[0] = b[k].x; e[1] = b[k].y; e[2] = b[k].z; e[3] = b[k].w; }
        if (tid < 128) { rkv_l[tid] = rk; skr_l[tid] = sk; }
    }
    const float* kn = (const float*)p->in[16];
    const int rowl = wr * 64 + fq * 4, rowb = pm * 128 + rowl;
    float g[4];
#pragma unroll
    for (int n = 0; n < 4; ++n) g[n] = kn[n * 16 + fr];
    const float g1 = kn[64 + fr], g2 = kn[80 + fr];
    const int bb = (pm * 128) >> 12, sb = rowb & 4095;
#pragma unroll 1
    for (int pn = 0; pn < 4; ++pn) {
        f32x4 acc[4][4];
#pragma unroll
        for (int m = 0; m < 4; ++m)
#pragma unroll
            for (int n = 0; n < 4; ++n) acc[m][n] = (f32x4){0.f, 0.f, 0.f, 0.f};
        gemm_main<4, 4, false, true>(lds, 32768, ap, bp, 2, acc);
        if (pn < 3) {
#pragma unroll
            for (int i = 0; i < 4; ++i) bp[i] += 256 * 128;
            gemm_stage<4, 4, true>(lds, 32768, ap, bp, 0, 0);
        }
        const int hd = pn * 2 + (wc >> 1);
        if ((wc & 1) == 0) {
            bf16_t* dst_p = (bf16_t*)(ws + WS_K) + ((size_t)(bb * 8 + hd) * 4096 + sb) * 96 + fr;
#pragma unroll
            for (int m = 0; m < 4; ++m) {
#pragma unroll
                for (int j = 0; j < 4; ++j) {
                    const int o = m * 16 + j, rl = rowl + o;
                    const float rkv = rkv_l[rl];
                    float v[4], ss = 0.f;
#pragma unroll
                    for (int n = 0; n < 4; ++n) { v[n] = acc[m][n][j] * rkv; ss += v[n] * v[n]; }
                    ss += __shfl_xor(ss, 1); ss += __shfl_xor(ss, 2); ss += __shfl_xor(ss, 4); ss += __shfl_xor(ss, 8);
                    const float rk = __builtin_amdgcn_rsqf((ss + skr_l[rl]) * (1.0f / 96.0f) + EPS);
                    bf16_t* dst = dst_p + o * 96;
#pragma unroll
                    for (int n = 0; n < 4; ++n) dst[n * 16] = f2bf(v[n] * rk * g[n]);
                    const float x1 = kr_l[rl * 33 + fr] * rk * g1, x2 = kr_l[rl * 33 + 16 + fr] * rk * g2;
                    const float cs_c = rp_l[rl * 34 + 2 * fr], cs_s = rp_l[rl * 34 + 2 * fr + 1];
                    dst[64] = f2bf(x1 * cs_c - x2 * cs_s); dst[80] = f2bf(x1 * cs_s + x2 * cs_c);
                }
            }
        } else {
            bf16_t* vt_p = (bf16_t*)(ws + WS_VT) + ((size_t)(bb * 8 + hd) * 64 + fr) * 4096 + sb;
#pragma unroll
            for (int m = 0; m < 4; ++m) {
                float rkv[4];
#pragma unroll
                for (int j = 0; j < 4; ++j) rkv[j] = rkv_l[rowl + m * 16 + j];
#pragma unroll
                for (int n = 0; n < 4; ++n) { const f32x4 a = acc[m][n];
                    u32x2 w; w.x = cvtpk(a.x * rkv[0], a.y * rkv[1]); w.y = cvtpk(a.z * rkv[2], a.w * rkv[3]);
                    *(u32x2*)(vt_p + (size_t)(n * 16) * 4096 + m * 16) = w; }
            }
        }
    }
}

template <int R> __device__ __forceinline__ void conv_row(float (&o)[64], const float (&w)[31], float x) {
    constexpr int T0 = R > 30 ? R - 30 : 0, T1 = R < 63 ? R : 63;
#pragma unroll
    for (int t = T0; t <= T1; ++t) o[t] += w[R - t] * x;
}
template <int... R> __device__ __forceinline__ void conv_rows(float (&o)[64], const float (&w)[31], const float (&x)[94], std::integer_sequence<int, R...>) { (conv_row<R>(o, w, x[R]), ...); }
__device__ __forceinline__ void conv_unit(CP p, LAS unsigned char* lds, int cu) {
    const int tid = threadIdx.x, lane = tid & 63, wave = tid >> 6;
    const int b = cu >> 6, s0 = (cu & 63) * 64, c = tid;
    const bf16_t* ub = (const bf16_t*)(p->ws + WS_U) + ((size_t)b * 4096) * 512 + c;
    const float* cw = (const float*)p->in[7]; const float* cb = (const float*)p->in[8]; const float* lg = (const float*)p->in[9]; const float* lb = (const float*)p->in[10];
    float w[31];
#pragma unroll
    for (int j = 0; j < 31; ++j) w[j] = cw[j * 512 + c];
    float xin[94];
#pragma unroll
    for (int r = 0; r < 94; ++r) { const int s = s0 - 30 + r; xin[r] = bf2f(ub[(size_t)(s < 0 ? 0 : s) * 512]); }
    if (s0 == 0) {
#pragma unroll
        for (int r = 0; r < 30; ++r) xin[r] = 0.f;
    }
    float o[64];
    { const float bias = cb[c];
#pragma unroll
      for (int t = 0; t < 64; ++t) o[t] = bias; }
    conv_rows(o, w, xin, std::make_integer_sequence<int, 94>{});
    float s1, s2;
    {
        const bool b5 = lane & 32, b4 = lane & 16, b3 = lane & 8, b2 = lane & 4, b1 = lane & 2, b0 = lane & 1;
#define CONV_BFLY(RES, SQ) do { float a32[32]; \
        _Pragma("unroll") for (int i = 0; i < 32; ++i) { const float lo = SQ ? o[i] * o[i] : o[i], hi = SQ ? o[32 + i] * o[32 + i] : o[32 + i]; a32[i] = (b5 ? hi : lo) + __shfl_xor(b5 ? lo : hi, 32); } \
        float a16[16]; _Pragma("unroll") for (int i = 0; i < 16; ++i) a16[i] = (b4 ? a32[16 + i] : a32[i]) + __shfl_xor(b4 ? a32[i] : a32[16 + i], 16); \
        float a8[8]; _Pragma("unroll") for (int i = 0; i < 8; ++i) a8[i] = (b3 ? a16[8 + i] : a16[i]) + __shfl_xor(b3 ? a16[i] : a16[8 + i], 8); \
        float a4[4]; _Pragma("unroll") for (int i = 0; i < 4; ++i) a4[i] = (b2 ? a8[4 + i] : a8[i]) + __shfl_xor(b2 ? a8[i] : a8[4 + i], 4); \
        float a2[2]; _Pragma("unroll") for (int i = 0; i < 2; ++i) a2[i] = (b1 ? a4[2 + i] : a4[i]) + __shfl_xor(b1 ? a4[i] : a4[2 + i], 2); \
        RES = (b0 ? a2[1] : a2[0]) + __shfl_xor(b0 ? a2[0] : a2[1], 1); } while (0)
        CONV_BFLY(s1, false);
        asm volatile("" : "+v"(s1));
        CONV_BFLY(s2, true);
#undef CONV_BFLY
    }
    LAS float* red = (LAS float*)(lds + EPI_SCR);
    LAS float* stat = (LAS float*)(lds + EPI_SCR + 4096);
    red[(wave * 64 + lane) * 2] = s1; red[(wave * 64 + lane) * 2 + 1] = s2;
    __syncthreads();
    if (tid < 64) { float t1 = 0.f, t2 = 0.f;
#pragma unroll
        for (int k = 0; k < 8; ++k) { t1 += red[(k * 64 + tid) * 2]; t2 += red[(k * 64 + tid) * 2 + 1]; }
        const float mean = t1 * (1.0f / 512.0f); float var = t2 * (1.0f / 512.0f) - mean * mean; var = var < 0.f ? 0.f : var;
        stat[tid * 2] = mean; stat[tid * 2 + 1] = __builtin_amdgcn_rsqf(var + EPS); }
    __syncthreads();
    const float g = lg[c], bb = lb[c];
    bf16_t* cat = (bf16_t*)(p->ws + WS_CAT) + ((size_t)b * 4096 + s0) * 1024 + c;
#pragma unroll
    for (int t = 0; t < 64; ++t) { const float y = (o[t] - stat[t * 2]) * stat[t * 2 + 1] * g + bb; cat[(size_t)t * 1024] = f2bf(y * __builtin_amdgcn_rcpf(1.0f + __expf(-y))); }
    __syncthreads();
}

__device__ __forceinline__ void xcd_barrier_work(const XcdBarrier& b, CP p, LAS unsigned char* lds, int it0, int it1, bool with_conv) {
    asm volatile("s_waitcnt vmcnt(0)" ::: "memory");
    __syncthreads();
    unsigned gen = 0; bool leader = false;
    if (threadIdx.x == 0) {
        unsigned* bar = b.bar;
        __builtin_amdgcn_s_waitcnt(0);
        unsigned nloc = b.st[0], nx = b.st[1];
        if (nloc == 0u) { xcd_barrier_complete(bar, b.x, nloc, nx); b.st[0] = nloc; b.st[1] = nx; }
        const unsigned old = xb_add(&bar[XB_XSUB(b.x)], 1u);
        gen = old / nloc; leader = (old + 1u == (gen + 1u) * nloc);
        if (leader) {
            __builtin_amdgcn_fence(__ATOMIC_RELEASE, "agent");
            asm volatile("s_waitcnt vmcnt(0)" ::: "memory");
            const unsigned og = xb_add(&bar[XB_TOP], 1u);
            const unsigned tg = og / nx;
            if (og + 1u == (tg + 1u) * nx) xb_add(&bar[XB_TOPGEN], 1u);
            else XB_SPIN(xb_ld(&bar[XB_TOPGEN]) == tg, bar);
            __builtin_amdgcn_fence(__ATOMIC_ACQUIRE, "agent");
            xb_add(&bar[XB_XGEN(b.x)], 1u);
            asm volatile("s_waitcnt vmcnt(0)" ::: "memory");
        }
    }
    transpose_items(p, lds, it0, it1);
    if (with_conv) { __syncthreads(); for (int u = blockIdx.x; u < 512; u += gridDim.x) conv_unit(p, lds, u); }
    if (threadIdx.x == 0 && !leader) {
        unsigned* bar = b.bar;
        XB_SPIN(xb_ld(&bar[XB_XGEN(b.x)]) == gen, bar);
        __builtin_amdgcn_fence(__ATOMIC_ACQUIRE, "agent");
        asm volatile("s_waitcnt vmcnt(0)" ::: "memory");
    }
    __syncthreads();
}

__device__ __forceinline__ void phase1c(CP p, LAS unsigned char* lds) {
#ifndef SUBREP
#define SUBREP -1
#endif
#pragma unroll 1
    for (int r_ = 0; r_ < (SUBREP == 0 ? 2 : 1); ++r_)
    for (int u = blockIdx.x; u < 512; u += gridDim.x) q_item(p, lds, u);
#pragma unroll 1
    for (int r_ = 0; r_ < (SUBREP == 1 ? 2 : 1); ++r_)
    for (int u = blockIdx.x; u < 256; u += gridDim.x) kv_item(p, lds, u);
    __syncthreads();
    if (N_LAUNCH_SPLIT) { for (int u = blockIdx.x; u < 512; u += gridDim.x) conv_unit(p, lds, u); }
}

__device__ __forceinline__ int swap23(int r) { return (r & ~12) | ((r & 4) << 1) | ((r & 8) >> 1); }
constexpr int KROW = 208, VROW = 144, KBUF = 64 * KROW, VBUF = 64 * VROW, ABUF = KBUF + VBUF;
__device__ __forceinline__ void attn_unit(CP p, LAS unsigned char* lds, int bh, int qblk) {
    const int tid = threadIdx.x, lane = tid & 63, wid = __builtin_amdgcn_readfirstlane(tid >> 6), q = lane & 31, H = lane >> 5;
    unsigned char* ws = p->ws;
    const bf16_t* qg = (const bf16_t*)(ws + WS_Q) + (size_t)bh * 4096 * 96;
    const bf16_t* kg = (const bf16_t*)(ws + WS_K) + (size_t)bh * 4096 * 96;
    const bf16_t* vg = (const bf16_t*)(ws + WS_VT) + (size_t)bh * 64 * 4096;
    const int row0 = qblk * 256 + wid * 32, mychunk = 4 * qblk + (wid >> 1), NT = 4 * qblk + 4;
    bf16x8 qf[6];
#pragma unroll
    for (int s = 0; s < 6; ++s) qf[s] = *(const bf16x8*)(qg + (size_t)(row0 + q) * 96 + 16 * s + 8 * H);
    const int kr0 = tid / 12, kc0 = tid % 12, kr1 = (tid + 512) / 12, kc1 = (tid + 512) % 12, vd = tid >> 3, vc = tid & 7;
    const bool k1 = tid < 256;
    const bf16_t* ksrc0 = kg + (size_t)kr0 * 96 + kc0 * 8; const bf16_t* ksrc1 = kg + (size_t)kr1 * 96 + kc1 * 8; const bf16_t* vsrc = vg + (size_t)vd * 4096 + vc * 8;
    const int kdst0 = kr0 * KROW + kc0 * 16, kdst1 = kr1 * KROW + kc1 * 16, vdst = KBUF + vd * VROW + vc * 16;
    u32x4 rk0, rk1 = (u32x4){0, 0, 0, 0}, rv;
#define AT_LOAD(t) do { rk0 = *(const u32x4*)(ksrc0 + (size_t)(t) * 64 * 96); if (k1) rk1 = *(const u32x4*)(ksrc1 + (size_t)(t) * 64 * 96); rv = *(const u32x4*)(vsrc + (t) * 64); } while (0)
#define AT_WRITE(buf) do { LAS unsigned char* b_ = lds + (buf) * ABUF; *(LAS u32x4*)(b_ + kdst0) = rk0; if (k1) *(LAS u32x4*)(b_ + kdst1) = rk1; *(LAS u32x4*)(b_ + vdst) = rv; } while (0)
    AT_LOAD(0); AT_WRITE(0);
    __syncthreads();
    f32x16 o0 = {0}, o1 = {0};
    float mrun = -INFINITY, lsum = 0.f;
    const int koff = swap23(q) * KROW + 16 * H, voff = KBUF + q * VROW + 16 * H;
    for (int t = 0; t < NT; ++t) {
        if (t + 1 < NT) AT_LOAD(t + 1);
        if (t <= mychunk) {
            const LAS unsigned char* kb = lds + (t & 1) * ABUF + koff; const LAS unsigned char* vb = lds + (t & 1) * ABUF + voff;
            f32x16 s0 = {0}, s1 = {0};
#pragma unroll
            for (int s = 0; s < 6; ++s) {
                const bf16x8 a0 = *(const LAS bf16x8*)(kb + 32 * s), a1 = *(const LAS bf16x8*)(kb + 32 * KROW + 32 * s);
                s0 = __builtin_amdgcn_mfma_f32_32x32x16_bf16(a0, qf[s], s0, 0, 0, 0);
                s1 = __builtin_amdgcn_mfma_f32_32x32x16_bf16(a1, qf[s], s1, 0, 0, 0);
            }
            float mloc = s0[0];
#pragma unroll
            for (int r = 1; r < 16; ++r) mloc = fmaxf(mloc, s0[r]);
#pragma unroll
            for (int r = 0; r < 16; ++r) mloc = fmaxf(mloc, s1[r]);
            mloc = fmaxf(mloc, __shfl_xor(mloc, 32));
            const float mnew = fmaxf(mrun, mloc);
            const float alpha = __builtin_amdgcn_exp2f(mrun - mnew);
            mrun = mnew;
            float ps = 0.f;
#pragma unroll
            for (int r = 0; r < 16; ++r) { s0[r] = __builtin_amdgcn_exp2f(s0[r] - mnew); s1[r] = __builtin_amdgcn_exp2f(s1[r] - mnew); ps += s0[r] + s1[r]; }
            lsum = lsum * alpha + ps;
#pragma unroll
            for (int r = 0; r < 16; ++r) { o0[r] *= alpha; o1[r] *= alpha; }
            u32x4 pw[4];
            pw[0] = (u32x4){cvtpk(s0[0], s0[1]), cvtpk(s0[2], s0[3]), cvtpk(s0[4], s0[5]), cvtpk(s0[6], s0[7])};
            pw[1] = (u32x4){cvtpk(s0[8], s0[9]), cvtpk(s0[10], s0[11]), cvtpk(s0[12], s0[13]), cvtpk(s0[14], s0[15])};
            pw[2] = (u32x4){cvtpk(s1[0], s1[1]), cvtpk(s1[2], s1[3]), cvtpk(s1[4], s1[5]), cvtpk(s1[6], s1[7])};
            pw[3] = (u32x4){cvtpk(s1[8], s1[9]), cvtpk(s1[10], s1[11]), cvtpk(s1[12], s1[13]), cvtpk(s1[14], s1[15])};
#pragma unroll
            for (int ks = 0; ks < 4; ++ks) {
                const bf16x8 v0 = *(const LAS bf16x8*)(vb + 32 * ks), v1 = *(const LAS bf16x8*)(vb + 32 * VROW + 32 * ks);
                const bf16x8 pb = __builtin_bit_cast(bf16x8, pw[ks]);
                o0 = __builtin_amdgcn_mfma_f32_32x32x16_bf16(v0, pb, o0, 0, 0, 0);
                o1 = __builtin_amdgcn_mfma_f32_32x32x16_bf16(v1, pb, o1, 0, 0, 0);
            }
        }
        if (t + 1 < NT) AT_WRITE((t + 1) & 1);
        __syncthreads();
    }
#undef AT_LOAD
#undef AT_WRITE
    const float ltot = lsum + __shfl_xor(lsum, 32), inv = 1.0f / ltot;
    const int b = bh >> 3, hd = bh & 7;
    bf16_t* dst = (bf16_t*)(ws + WS_CAT) + ((size_t)b * 4096 + row0 + q) * 1024 + 512 + hd * 64;
#pragma unroll
    for (int g = 0; g < 4; ++g) {
        u32x2 w; w.x = cvtpk(o0[4 * g] * inv, o0[4 * g + 1] * inv); w.y = cvtpk(o0[4 * g + 2] * inv, o0[4 * g + 3] * inv); *(u32x2*)(dst + 8 * g + 4 * H) = w;
        w.x = cvtpk(o1[4 * g] * inv, o1[4 * g + 1] * inv); w.y = cvtpk(o1[4 * g + 2] * inv, o1[4 * g + 3] * inv); *(u32x2*)(dst + 32 + 8 * g + 4 * H) = w;
    }
}
constexpr int AF_NS = 6, AF_KB = 64 * 192, AF_STG = AF_KB + 64 * 128;
__device__ __forceinline__ void attn_unit_fast(CP p, LAS unsigned char* lds, int bh, int qblk) {
    const int tid = threadIdx.x, lane = tid & 63, wid = __builtin_amdgcn_readfirstlane(tid >> 6), q = lane & 31, H = lane >> 5;
    unsigned char* ws = p->ws;
    const bf16_t* qg = (const bf16_t*)(ws + WS_Q) + (size_t)bh * 4096 * 96;
    const bf16_t* kg = (const bf16_t*)(ws + WS_K) + (size_t)bh * 4096 * 96;
    const bf16_t* vg = (const bf16_t*)(ws + WS_VT) + (size_t)bh * 64 * 4096;
    const int row0 = qblk * 256 + wid * 32, mychunk = 4 * qblk + (wid >> 1), NT = 4 * qblk + 4;
    int ks0, ks1, vs0;
    { int P = wid * 64 + lane, r = P / 12, c = (P % 12) ^ ((r >> 2) & 3); ks0 = r * 96 + c * 8;
      P = (8 + (wid & 3)) * 64 + lane; r = P / 12; c = (P % 12) ^ ((r >> 2) & 3); ks1 = r * 96 + c * 8;
      P = wid * 64 + lane; r = P >> 3; c = (P & 7) ^ ((r >> 1) & 7); vs0 = r * 4096 + c * 8; }
    const bool two = wid < 4;
#define AF_ISSUE(u) do { const int u_ = (u) < NT ? (u) : NT - 1; LAS unsigned char* st_ = lds + ((u) % AF_NS) * AF_STG; \
        __builtin_amdgcn_global_load_lds((const unsigned*)(kg + (size_t)u_ * 64 * 96 + ks0), (LAS unsigned*)(st_ + wid * 1024), 16, 0, 0); \
        if (two) __builtin_amdgcn_global_load_lds((const unsigned*)(kg + (size_t)u_ * 64 * 96 + ks1), (LAS unsigned*)(st_ + (8 + wid) * 1024), 16, 0, 0); \
        __builtin_amdgcn_global_load_lds((const unsigned*)(vg + u_ * 64 + vs0), (LAS unsigned*)(st_ + AF_KB + wid * 1024), 16, 0, 0); } while (0)
#define AF_WAITBAR() do { if (two) asm volatile("s_waitcnt vmcnt(3)" ::: "memory"); else asm volatile("s_waitcnt vmcnt(2)" ::: "memory"); \
        asm volatile("s_waitcnt lgkmcnt(0)" ::: "memory"); __builtin_amdgcn_s_barrier(); asm volatile("" ::: "memory"); } while (0)
    static_assert(AF_NS == 6, "ring depth vs the issue / wait pattern below (one tile may stay in flight across a barrier)");
    const int pr = swap23(q), kx = (pr >> 2) & 3;
    const int kbe = pr * 192 + 16 * ((H ^ (kx & 1)) + 2 * (kx >> 1)), kbo = pr * 192 + 16 * ((H ^ (kx & 1)) + 2 * (1 ^ (kx >> 1)));
    const int vx = (q >> 1) & 7, vbase = AF_KB + q * 128 + 16 * (H ^ (vx & 1)), vxx = (vx >> 1) * 32;
    bf16x8 qf[6];
#pragma unroll
    for (int s = 0; s < 6; ++s) qf[s] = *(const bf16x8*)(qg + (size_t)(row0 + q) * 96 + 16 * s + 8 * H);
#define AF_QK(S0, S1, u) do { const LAS unsigned char* kb_ = lds + ((u) % AF_NS) * AF_STG; \
        { const bf16x8 a0_ = *(const LAS bf16x8*)(kb_ + kbe), a1_ = *(const LAS bf16x8*)(kb_ + kbe + 32 * 192); \
          S0 = __builtin_amdgcn_mfma_f32_32x32x16_bf16(a0_, qf[0], (f32x16){0.f, 0.f, 0.f, 0.f, 0.f, 0.f, 0.f, 0.f, 0.f, 0.f, 0.f, 0.f, 0.f, 0.f, 0.f, 0.f}, 0, 0, 0); \
          S1 = __builtin_amdgcn_mfma_f32_32x32x16_bf16(a1_, qf[0], (f32x16){0.f, 0.f, 0.f, 0.f, 0.f, 0.f, 0.f, 0.f, 0.f, 0.f, 0.f, 0.f, 0.f, 0.f, 0.f, 0.f}, 0, 0, 0); } \
        _Pragma("unroll") for (int s_ = 1; s_ < 6; ++s_) { const int o_ = ((s_ & 1) ? kbo : kbe) + 64 * (s_ >> 1); \
            const bf16x8 a0_ = *(const LAS bf16x8*)(kb_ + o_), a1_ = *(const LAS bf16x8*)(kb_ + o_ + 32 * 192); \
            S0 = __builtin_amdgcn_mfma_f32_32x32x16_bf16(a0_, qf[s_], S0, 0, 0, 0); \
            S1 = __builtin_amdgcn_mfma_f32_32x32x16_bf16(a1_, qf[s_], S1, 0, 0, 0); } } while (0)
    asm volatile("s_waitcnt vmcnt(0) lgkmcnt(0)" ::: "memory"); __builtin_amdgcn_s_barrier(); asm volatile("" ::: "memory");
    AF_ISSUE(0); AF_ISSUE(1); AF_ISSUE(2); AF_ISSUE(3);
    AF_WAITBAR();
    f32x16 o0 = {0}, o1 = {0}, c0, c1;
    float lsum = 0.f;
    AF_QK(c0, c1, 0);
#define AF_STEP(t, CA, CB, NA, NB) do { if ((t) <= mychunk) { \
            AF_QK(NA, NB, (t) + 1);                      \
            float ps = 0.f; \
            _Pragma("unroll") for (int r = 0; r < 16; ++r) { CA[r] = __builtin_amdgcn_exp2f(CA[r]); CB[r] = __builtin_amdgcn_exp2f(CB[r]); ps += CA[r] + CB[r]; } \
            lsum += ps; \
            u32x4 pw[4]; \
            pw[0] = (u32x4){cvtpk(CA[0], CA[1]), cvtpk(CA[2], CA[3]), cvtpk(CA[4], CA[5]), cvtpk(CA[6], CA[7])}; \
            pw[1] = (u32x4){cvtpk(CA[8], CA[9]), cvtpk(CA[10], CA[11]), cvtpk(CA[12], CA[13]), cvtpk(CA[14], CA[15])}; \
            pw[2] = (u32x4){cvtpk(CB[0], CB[1]), cvtpk(CB[2], CB[3]), cvtpk(CB[4], CB[5]), cvtpk(CB[6], CB[7])}; \
            pw[3] = (u32x4){cvtpk(CB[8], CB[9]), cvtpk(CB[10], CB[11]), cvtpk(CB[12], CB[13]), cvtpk(CB[14], CB[15])}; \
            const LAS unsigned char* vb = lds + ((t) % AF_NS) * AF_STG + vbase; \
            _Pragma("unroll") for (int ks = 0; ks < 4; ++ks) { \
                const int vo = (ks * 32) ^ vxx; \
                const bf16x8 v0 = *(const LAS bf16x8*)(vb + vo), v1 = *(const LAS bf16x8*)(vb + vo + 32 * 128); \
                const bf16x8 pb = __builtin_bit_cast(bf16x8, pw[ks]); \
                o0 = __builtin_amdgcn_mfma_f32_32x32x16_bf16(v0, pb, o0, 0, 0, 0); \
                o1 = __builtin_amdgcn_mfma_f32_32x32x16_bf16(v1, pb, o1, 0, 0, 0); } } } while (0)
    f32x16 d0, d1;
#pragma unroll 1
    for (int t = 0; t < NT; t += 2) {
        AF_ISSUE(t + 4); AF_ISSUE(t + 5);
        AF_STEP(t, c0, c1, d0, d1);
        AF_STEP(t + 1, d0, d1, c0, c1);
        AF_WAITBAR();
    }
#undef AF_STEP
#undef AF_ISSUE
#undef AF_WAITBAR
#undef AF_QK
    const float ltot = lsum + __shfl_xor(lsum, 32), inv = 1.0f / ltot;
    const int b = bh >> 3, hd = bh & 7;
    bf16_t* dst = (bf16_t*)(ws + WS_CAT) + ((size_t)b * 4096 + row0 + q) * 1024 + 512 + hd * 64;
#pragma unroll
    for (int g = 0; g < 4; ++g) {
        u32x2 w; w.x = cvtpk(o0[4 * g] * inv, o0[4 * g + 1] * inv); w.y = cvtpk(o0[4 * g + 2] * inv, o0[4 * g + 3] * inv); *(u32x2*)(dst + 8 * g + 4 * H) = w;
        w.x = cvtpk(o1[4 * g] * inv, o1[4 * g + 1] * inv); w.y = cvtpk(o1[4 * g + 2] * inv, o1[4 * g + 3] * inv); *(u32x2*)(dst + 32 + 8 * g + 4 * H) = w;
    }
}
__device__ __forceinline__ void attn_unit2(CP p, LAS unsigned char* lds, int bh, int QB) {
    int lane = threadIdx.x & 63; asm volatile("" : "+v"(lane));
    const int tid = threadIdx.x, wid = __builtin_amdgcn_readfirstlane(tid >> 6), q = lane & 31, H = lane >> 5;
    unsigned char* ws = p->ws;
    const bf16_t* qg = (const bf16_t*)(ws + WS_Q) + (size_t)bh * 4096 * 96;
    const bf16_t* kg = (const bf16_t*)(ws + WS_K) + (size_t)bh * 4096 * 96;
    const bf16_t* vg = (const bf16_t*)(ws + WS_VT) + (size_t)bh * 64 * 4096;
    const int rowA = QB * 512 + wid * 32, rowB = QB * 512 + (15 - wid) * 32;
    const int chA = 8 * QB + (wid >> 1), chB = 8 * QB + ((15 - wid) >> 1), NT = 8 * QB + 8;
    int ks0, ks1, vs0;
    { int P = wid * 64 + lane, r = P / 12, c = (P % 12) ^ ((r >> 2) & 3); ks0 = r * 96 + c * 8;
      P = (8 + (wid & 3)) * 64 + lane; r = P / 12; c = (P % 12) ^ ((r >> 2) & 3); ks1 = r * 96 + c * 8;
      P = wid * 64 + lane; r = P >> 3; c = (P & 7) ^ ((r >> 1) & 7); vs0 = r * 4096 + c * 8; }
    const bool two = wid < 4;
#define A2_ISSUE(u) do { const int u_ = (u) < NT ? (u) : NT - 1; LAS unsigned char* st_ = lds + ((u) % AF_NS) * AF_STG; \
        __builtin_amdgcn_global_load_lds((const unsigned*)(kg + (size_t)u_ * 64 * 96 + ks0), (LAS unsigned*)(st_ + wid * 1024), 16, 0, 0); \
        if (two) __builtin_amdgcn_global_load_lds((const unsigned*)(kg + (size_t)u_ * 64 * 96 + ks1), (LAS unsigned*)(st_ + (8 + wid) * 1024), 16, 0, 0); \
        __builtin_amdgcn_global_load_lds((const unsigned*)(vg + u_ * 64 + vs0), (LAS unsigned*)(st_ + AF_KB + wid * 1024), 16, 0, 0); } while (0)
#define A2_WAITBAR() do { if (two) asm volatile("s_waitcnt vmcnt(3)" ::: "memory"); else asm volatile("s_waitcnt vmcnt(2)" ::: "memory"); \
        asm volatile("s_waitcnt lgkmcnt(0)" ::: "memory"); __builtin_amdgcn_s_barrier(); asm volatile("" ::: "memory"); } while (0)
    const int pr = swap23(q), kx = (pr >> 2) & 3;
    const int kbe = pr * 192 + 16 * ((H ^ (kx & 1)) + 2 * (kx >> 1)), kbo = pr * 192 + 16 * ((H ^ (kx & 1)) + 2 * (1 ^ (kx >> 1)));
    const int vx = (q >> 1) & 7, vbase = AF_KB + q * 128 + 16 * (H ^ (vx & 1)), vxx = (vx >> 1) * 32;
    bf16x8 qa[6], qb[6];
#pragma unroll
    for (int s = 0; s < 6; ++s) { qa[s] = *(const bf16x8*)(qg + (size_t)(rowA + q) * 96 + 16 * s + 8 * H); qb[s] = *(const bf16x8*)(qg + (size_t)(rowB + q) * 96 + 16 * s + 8 * H); }
    asm volatile("s_waitcnt vmcnt(0) lgkmcnt(0)" ::: "memory"); __builtin_amdgcn_s_barrier(); asm volatile("" ::: "memory");
    A2_ISSUE(0); A2_ISSUE(1); A2_ISSUE(2); A2_ISSUE(3);
    A2_WAITBAR();
    f32x16 oa0 = {0}, oa1 = {0}, ob0 = {0}, ob1 = {0};
    float la = 0.f, lb = 0.f;
#define A2_ZERO (f32x16){0.f, 0.f, 0.f, 0.f, 0.f, 0.f, 0.f, 0.f, 0.f, 0.f, 0.f, 0.f, 0.f, 0.f, 0.f, 0.f}
#define A2_PACK2(PW, C) do { \
        PW[0] = (u32x4){cvtpk(C[0], C[1]), cvtpk(C[2], C[3]), cvtpk(C[4], C[5]), cvtpk(C[6], C[7])}; \
        PW[1] = (u32x4){cvtpk(C[8], C[9]), cvtpk(C[10], C[11]), cvtpk(C[12], C[13]), cvtpk(C[14], C[15])}; } while (0)
#define A2_HALF(t, hh) do { const LAS unsigned char* kb_ = lds + ((t) % AF_NS) * AF_STG + (hh) * (32 * 192); const LAS unsigned char* vb_ = lds + ((t) % AF_NS) * AF_STG + vbase; \
        if ((t) <= chB) {                                    \
            const bool both_ = (t) <= chA; \
            f32x16 sa = A2_ZERO, sb; \
            _Pragma("unroll") for (int s_ = 0; s_ < 6; ++s_) { const int o_ = ((s_ & 1) ? kbo : kbe) + 64 * (s_ >> 1); \
                const bf16x8 a_ = *(const LAS bf16x8*)(kb_ + o_); \
                sb = __builtin_amdgcn_mfma_f32_32x32x16_bf16(a_, qb[s_], s_ == 0 ? A2_ZERO : sb, 0, 0, 0); \
                if (both_) sa = __builtin_amdgcn_mfma_f32_32x32x16_bf16(a_, qa[s_], sa, 0, 0, 0); } \
            float pb = 0.f; \
            _Pragma("unroll") for (int r = 0; r < 16; ++r) { sb[r] = __builtin_amdgcn_exp2f(sb[r]); pb += sb[r]; } \
            lb += pb; \
            u32x4 pwa[2] = {(u32x4){0, 0, 0, 0}, (u32x4){0, 0, 0, 0}}, pwb[2]; A2_PACK2(pwb, sb); \
            if (both_) { float pa = 0.f; \
                _Pragma("unroll") for (int r = 0; r < 16; ++r) { sa[r] = __builtin_amdgcn_exp2f(sa[r]); pa += sa[r]; } \
                la += pa; A2_PACK2(pwa, sa); } \
            _Pragma("unroll") for (int k2 = 0; k2 < 2; ++k2) { const int vo = (((hh) * 2 + k2) * 32) ^ vxx; \
                const bf16x8 v0 = *(const LAS bf16x8*)(vb_ + vo), v1 = *(const LAS bf16x8*)(vb_ + vo + 32 * 128); \
                const bf16x8 xb = __builtin_bit_cast(bf16x8, pwb[k2]); \
                ob0 = __builtin_amdgcn_mfma_f32_32x32x16_bf16(v0, xb, ob0, 0, 0, 0); ob1 = __builtin_amdgcn_mfma_f32_32x32x16_bf16(v1, xb, ob1, 0, 0, 0); \
                if (both_) { const bf16x8 xa = __builtin_bit_cast(bf16x8, pwa[k2]); \
                    oa0 = __builtin_amdgcn_mfma_f32_32x32x16_bf16(v0, xa, oa0, 0, 0, 0); oa1 = __builtin_amdgcn_mfma_f32_32x32x16_bf16(v1, xa, oa1, 0, 0, 0); } } \
        } } while (0)
#define A2_STEP(t) do { A2_HALF(t, 0); __builtin_amdgcn_sched_barrier(0); A2_HALF(t, 1); __builtin_amdgcn_sched_barrier(0); } while (0)
#pragma unroll 1
    for (int t = 0; t < NT; t += 2) {
        A2_ISSUE(t + 4); A2_ISSUE(t + 5);
        A2_STEP(t);
        A2_STEP(t + 1);
        A2_WAITBAR();
    }
#undef A2_STEP
#undef A2_HALF
#undef A2_PACK2
#undef A2_ZERO
#undef A2_ISSUE
#undef A2_WAITBAR
    const int b = bh >> 3, hd = bh & 7;
    {
        const float ltot = la + __shfl_xor(la, 32), inv = 1.0f / ltot;
        bf16_t* dst = (bf16_t*)(ws + WS_CAT) + ((size_t)b * 4096 + rowA + q) * 1024 + 512 + hd * 64;
#pragma unroll
        for (int g = 0; g < 4; ++g) {
            u32x2 w; w.x = cvtpk(oa0[4 * g] * inv, oa0[4 * g + 1] * inv); w.y = cvtpk(oa0[4 * g + 2] * inv, oa0[4 * g + 3] * inv); *(u32x2*)(dst + 8 * g + 4 * H) = w;
            w.x = cvtpk(oa1[4 * g] * inv, oa1[4 * g + 1] * inv); w.y = cvtpk(oa1[4 * g + 2] * inv, oa1[4 * g + 3] * inv); *(u32x2*)(dst + 32 + 8 * g + 4 * H) = w;
        }
    }
    {
        const float ltot = lb + __shfl_xor(lb, 32), inv = 1.0f / ltot;
        bf16_t* dst = (bf16_t*)(ws + WS_CAT) + ((size_t)b * 4096 + rowB + q) * 1024 + 512 + hd * 64;
#pragma unroll
        for (int g = 0; g < 4; ++g) {
            u32x2 w; w.x = cvtpk(ob0[4 * g] * inv, ob0[4 * g + 1] * inv); w.y = cvtpk(ob0[4 * g + 2] * inv, ob0[4 * g + 3] * inv); *(u32x2*)(dst + 8 * g + 4 * H) = w;
            w.x = cvtpk(ob1[4 * g] * inv, ob1[4 * g + 1] * inv); w.y = cvtpk(ob1[4 * g + 2] * inv, ob1[4 * g + 3] * inv); *(u32x2*)(dst + 32 + 8 * g + 4 * H) = w;
        }
    }
}
__device__ __forceinline__ void phase2(CP p, LAS unsigned char* lds) {
    const int lane = threadIdx.x & 63;
    const float* qn = (const float*)p->in[15]; const float* kn = (const float*)p->in[16];
    float mq = 0.f, mk = 0.f;
    for (int j = lane; j < 96; j += 64) { mq = fmaxf(mq, fabsf(qn[j])); mk = fmaxf(mk, fabsf(kn[j])); }
#pragma unroll
    for (int o = 1; o < 64; o <<= 1) { mq = fmaxf(mq, __shfl_xor(mq, o)); mk = fmaxf(mk, __shfl_xor(mk, o)); }
    const float bound = 96.0f * mq * mk * QSCALE * 1.01f;
    if (bound <= 40.0f) {
        for (int u = vcu_id(); u < 256; u += gridDim.x) { const int bh = u >> 2, pr = u & 3; attn_unit2(p, lds, bh, 7 - pr); attn_unit2(p, lds, bh, pr); }
    } else {
        for (int u = vcu_id(); u < 512; u += gridDim.x) { const int bh = u >> 3, pr = u & 7; attn_unit(p, lds, bh, 15 - pr); attn_unit(p, lds, bh, pr); }
    }
    asm volatile("s_waitcnt vmcnt(0)" ::: "memory"); __syncthreads();
}

__device__ __forceinline__ void phase3(CP p, LAS unsigned char* lds) {
    const int tid = threadIdx.x, lane = tid & 63, wid = __builtin_amdgcn_readfirstlane(tid >> 6), wr = wid >> 2, wc = wid & 3, fr = lane & 15, fq = lane >> 4;
    unsigned char* ws = p->ws;
    const float* x = (const float*)p->in[0]; const float* mod = (const float*)(ws + WS_MOD); float* sq1 = (float*)(ws + WS_SSQ1);
    for (int u = vcu_id(); u < 512; u += gridDim.x) {
        const int pm = u >> 2, pn = u & 3;
        const bf16_t* ap[4]; const bf16_t* bp[4];
        stage_ptrs_dense<4>((const bf16_t*)(ws + WS_CAT), 1024, pm * 256, ap); stage_ptrs_dense<4>((const bf16_t*)(ws + WS_WOUT), 1024, pn * 256, bp);
        f32x4 acc[8][4];
#pragma unroll
        for (int m = 0; m < 8; ++m)
#pragma unroll
            for (int n = 0; n < 4; ++n) acc[m][n] = (f32x4){0.f, 0.f, 0.f, 0.f};
        gemm_block<8, 4, true>(lds, ap, bp, 16, acc);
        const int rowb = pm * 256 + wr * 128 + fr, b = (pm * 256) >> 12, colb = pn * 256 + wc * 64 + fq * 4;
        f32x4 ga[4];
#pragma unroll
        for (int n = 0; n < 4; ++n) ga[n] = *(const f32x4*)(mod + b * 6144 + 2048 + colb + n * 16);
#pragma unroll
        for (int mb = 0; mb < 8; mb += 4) {
            f32x4 xv[4][4];
#pragma unroll
            for (int m = 0; m < 4; ++m)
#pragma unroll
                for (int n = 0; n < 4; ++n) xv[m][n] = *(const f32x4*)(x + (size_t)(rowb + (mb + m) * 16) * DM + colb + n * 16);
#pragma unroll
            for (int m = 0; m < 4; ++m) { const size_t row = rowb + (mb + m) * 16; float s = 0.f;
#pragma unroll
                for (int n = 0; n < 4; ++n) { const f32x4 v = xv[m][n] + ga[n] * acc[mb + m][n];
                    *(f32x4*)(p->out + row * DM + colb + n * 16) = v; s += (v.x * v.x + v.y * v.y) + (v.z * v.z + v.w * v.w); }
                s += __shfl_xor(s, 16); s += __shfl_xor(s, 32);
                if (fq == 0) sq1[row * 16 + pn * 4 + wc] = s; }
        }
    }
}

constexpr int RROW = 2064;
__device__ __forceinline__ void phase3b(CP p, LAS unsigned char* lds, bool dry) {
    const int tid = threadIdx.x, lane = tid & 63, wave = __builtin_amdgcn_readfirstlane(tid >> 6), fr = lane & 15, fq = lane >> 4;
    unsigned char* ws = p->ws;
    const float* nf = (const float*)p->in[18]; const float* mod = (const float*)(ws + WS_MOD); const float* sq1 = (const float*)(ws + WS_SSQ1);
    const float* bg = (const float*)p->in[20]; const float* be = (const float*)p->in[22];
    bf16_t* h2 = (bf16_t*)(ws + WS_H); const bf16_t* wrh = (const bf16_t*)(ws + WS_WR); const bf16_t* wrl = wrh + 48 * 1024;
    LAS unsigned char* Ahi = lds; LAS unsigned char* Alo = lds + 32 * RROW; LAS float* part = (LAS float*)lds; LAS float* lg = (LAS float*)(lds + 8 * 32 * 48 * 4);
    unsigned* ctl = (unsigned*)(ws + WS_CTL); int* lists = (int*)(ws + WS_LIST); int* blists = (int*)(ws + WS_BLIST); float* tokw = (float*)(ws + WS_TOKW);
    bf16x8 Bh[3][4], Bl[3][4];
#pragma unroll
    for (int nt = 0; nt < 3; ++nt)
#pragma unroll
        for (int kk = 0; kk < 4; ++kk) { const size_t o = (size_t)(nt * 16 + fr) * 1024 + wave * 128 + kk * 32 + fq * 8; Bh[nt][kk] = *(const bf16x8*)(wrh + o); Bl[nt][kk] = *(const bf16x8*)(wrl + o); }
#pragma unroll 1
    for (int tile = blockIdx.x; tile < MT / 32; tile += gridDim.x) {
        const int r0 = tile * 32, b = r0 >> 12;
        {
            f32x4 gm[4], sh[4];
#pragma unroll
            for (int j = 0; j < 4; ++j) { const int col = 4 * lane + 256 * j; const f32x4 g = *(const f32x4*)(nf + col), s = *(const f32x4*)(mod + b * 6144 + 4096 + col);
                gm[j] = g * (s + 1.0f); sh[j] = *(const f32x4*)(mod + b * 6144 + 3072 + col); }
#pragma unroll
            for (int rb = 0; rb < 4; rb += 2) {
                f32x4 xr[2][4]; float rs[2];
#pragma unroll
                for (int rr = 0; rr < 2; ++rr) { const size_t row = r0 + wave * 4 + rb + rr; float ss = 0.f;
#pragma unroll
                    for (int k = 0; k < 4; ++k) { const f32x4 s4 = *(const f32x4*)(sq1 + row * 16 + 4 * k); ss += (s4.x + s4.y) + (s4.z + s4.w); }
                    rs[rr] = ss;
#pragma unroll
                    for (int j = 0; j < 4; ++j) xr[rr][j] = *(const f32x4*)(p->out + row * DM + 4 * lane + 256 * j); }
#pragma unroll
                for (int rr = 0; rr < 2; ++rr) {
                    const int lr = wave * 4 + rb + rr; const size_t row = r0 + lr;
                    const float rstd = __builtin_amdgcn_rsqf(rs[rr] * (1.0f / DM) + EPS);
#pragma unroll
                    for (int j = 0; j < 4; ++j) { const int col = 4 * lane + 256 * j; const f32x4 xv = xr[rr][j];
                        const f32x4 o = xv * rstd * gm[j] + sh[j];
                        u32x2 w; w.x = cvtpk(o.x, o.y); w.y = cvtpk(o.z, o.w);
                        *(u32x2*)(h2 + row * DM + col) = w; *(LAS u32x2*)(Ahi + lr * RROW + col * 2) = w;
                        const float lx = o.x - __builtin_bit_cast(float, w.x << 16), ly = o.y - __builtin_bit_cast(float, w.x & 0xffff0000u), lz = o.z - __builtin_bit_cast(float, w.y << 16), lw = o.w - __builtin_bit_cast(float, w.y & 0xffff0000u);
                        u32x2 wl; wl.x = cvtpk(lx, ly); wl.y = cvtpk(lz, lw); *(LAS u32x2*)(Alo + lr * RROW + col * 2) = wl; }
                }
            }
        }
        __syncthreads();
        f32x4 P[2][3];
#pragma unroll
        for (int mt = 0; mt < 2; ++mt)
#pragma unroll
            for (int nt = 0; nt < 3; ++nt) P[mt][nt] = (f32x4){0.f, 0.f, 0.f, 0.f};
#pragma unroll
        for (int mt = 0; mt < 2; ++mt)
#pragma unroll
            for (int kk = 0; kk < 4; ++kk) {
                const int ao = (mt * 16 + fr) * RROW + (wave * 128 + kk * 32 + fq * 8) * 2;
                const bf16x8 a_h = *(const LAS bf16x8*)(Ahi + ao), a_l = *(const LAS bf16x8*)(Alo + ao);
#pragma unroll
                for (int nt = 0; nt < 3; ++nt) {
                    P[mt][nt] = __builtin_amdgcn_mfma_f32_16x16x32_bf16(a_h, Bh[nt][kk], P[mt][nt], 0, 0, 0);
                    P[mt][nt] = __builtin_amdgcn_mfma_f32_16x16x32_bf16(a_l, Bh[nt][kk], P[mt][nt], 0, 0, 0);
                    P[mt][nt] = __builtin_amdgcn_mfma_f32_16x16x32_bf16(a_h, Bl[nt][kk], P[mt][nt], 0, 0, 0);
                }
            }
        __syncthreads();
#pragma unroll
        for (int mt = 0; mt < 2; ++mt)
#pragma unroll
            for (int nt = 0; nt < 3; ++nt)
#pragma unroll
                for (int j = 0; j < 4; ++j) part[(wave * 32 + mt * 16 + fq * 4 + j) * 48 + nt * 16 + fr] = P[mt][nt][j];
        __syncthreads();
#pragma unroll
        for (int i = 0; i < 3; ++i) { const int idx = tid + 512 * i; float v = 0.f;
#pragma unroll
            for (int w8 = 0; w8 < 8; ++w8) v += part[w8 * 1536 + idx];
            lg[idx] = v; }
        __syncthreads();
        if (tid < 32 && !dry) {
            const LAS float* l = lg + tid * 48; const int tok = r0 + tid;
            float gl[4]; int gi = 0; float gmx;
#pragma unroll
            for (int i = 0; i < 4; ++i) gl[i] = l[i] + bg[i];
            gmx = gl[0];
#pragma unroll
            for (int i = 1; i < 4; ++i) if (gl[i] > gmx) { gmx = gl[i]; gi = i; }
            float gs = 0.f;
#pragma unroll
            for (int i = 0; i < 4; ++i) gs += __expf(gl[i] - gmx);
            const float gtop = 1.0f / gs;
            float el[8];
#pragma unroll
            for (int i = 0; i < 8; ++i) el[i] = l[4 + gi * 8 + i] + be[gi * 8 + i];
            int e1 = 0; float m1 = el[0];
#pragma unroll
            for (int i = 1; i < 8; ++i) if (el[i] > m1) { m1 = el[i]; e1 = i; }
            int e2 = -1; float m2 = -INFINITY;
#pragma unroll
            for (int i = 0; i < 8; ++i) if (i != e1 && el[i] > m2) { m2 = el[i]; e2 = i; }
            const float p2 = __expf(m2 - m1);
            const float w1 = gtop / (1.0f + p2), w2 = gtop * p2 / (1.0f + p2);
            const int lo = e1 < e2 ? e1 : e2, hi = e1 < e2 ? e2 : e1;
            const float wlo = e1 < e2 ? w1 : w2, whi = e1 < e2 ? w2 : w1;
            const int bk = gi * 28 + lo * 8 - ((lo * (lo + 1)) >> 1) + (hi - lo - 1);
            const int El = gi * 8 + lo, Eh = gi * 8 + hi;
            const unsigned p1 = atomicAdd(ctl + CW_CNT + 64 * El, 1u), pp2 = atomicAdd(ctl + CW_CNT + 64 * Eh, 1u), p3 = atomicAdd(ctl + CW_CNT + 64 * (32 + bk), 1u);
            lists[(size_t)El * MT + p1] = tok * 2; lists[(size_t)Eh * MT + pp2] = tok * 2 + 1;
            blists[(size_t)bk * MT + p3] = tok;
            tokw[tok * 2] = wlo; tokw[tok * 2 + 1] = whi;
        }
        __syncthreads();
    }
}

struct U4a { int e, rt, ct, cnt; };
__device__ __forceinline__ int prefix_find(const LAS unsigned* pre, int n, int u) {
    const int lane = threadIdx.x & 63; int res = -1;
    for (int b0 = 0; b0 < n; b0 += 64) { const int i = b0 + lane; const bool hit = i < n && (int)pre[i] <= u && u < (int)pre[i + 1];
        const unsigned long long m = __ballot(hit); if (m) { res = b0 + __builtin_ctzll(m); break; } }
    return res;
}
__device__ __forceinline__ bool p4a_find(const LAS unsigned* cnts, const LAS unsigned* pre, int u, U4a& r) {
    const int i = prefix_find(pre, 32, u); if (i < 0) return false;
    const int uu = u - (int)pre[i]; r.e = i; r.rt = uu >> 1; r.ct = uu & 1; r.cnt = (int)cnts[i]; return true;
}
template <int MI, int NI>
__device__ __forceinline__ void p4a_ptrs(CP p, int e, int row0, int cnt, int col0, const bf16_t* (&ap)[MI / 2], const bf16_t* (&bp)[NI]) {
    const int tid = threadIdx.x, lane = tid & 63;
    const int* lst = (const int*)(p->ws + WS_LIST) + (size_t)e * MT + row0; const int nrow = cnt - row0;
    const bf16_t* h2 = (const bf16_t*)(p->ws + WS_H);
    int tok[MI / 2], C[MI / 2];
#pragma unroll
    for (int i = 0; i < MI / 2; ++i) { int R; stage_rc2((tid >> 6) * 1024 + i * 8192 + lane * 16, R, C[i]); tok[i] = lst[R < nrow ? R : 0] >> 1; }
#pragma unroll
    for (int i = 0; i < MI / 2; ++i) ap[i] = h2 + (size_t)tok[i] * 1024 + C[i];
    stage_ptrs_dense<NI>((const bf16_t*)(p->ws + WS_WGU) + (size_t)e * 512 * 1024, 1024, col0, bp);
}
template <int MI, int NI>
__device__ __forceinline__ void p4a_epilogue(CP p, int e, int row0, int cnt, int col0, const f32x4 (&acc)[MI][NI]) {
    const int tid = threadIdx.x, lane = tid & 63, wid = __builtin_amdgcn_readfirstlane(tid >> 6), wr = wid >> 2, wc = wid & 3, fr = lane & 15, fq = lane >> 4;
    unsigned char* ws = p->ws;
    const float* tokw = (const float*)(ws + WS_TOKW); bf16_t* ab = (bf16_t*)(ws + WS_ABUF);
    const int* lst = (const int*)(ws + WS_LIST) + (size_t)e * MT + row0; const int nrow = cnt - row0;
    int ent[MI]; float w[MI];
#pragma unroll
    for (int m = 0; m < MI; ++m) { const int R = wr * (MI * 16) + m * 16 + fr; ent[m] = lst[R < nrow ? R : 0]; }
#pragma unroll
    for (int m = 0; m < MI; ++m) w[m] = tokw[ent[m]];
#pragma unroll
    for (int m = 0; m < MI; ++m) { const int R = wr * (MI * 16) + m * 16 + fr; const float wm = w[m];
#pragma unroll
        for (int h = 0; h < NI / 2; ++h) { const f32x4 g = acc[m][2 * h], uu = acc[m][2 * h + 1];
            const int np = col0 + wc * (NI * 16) + h * 32 + fq * 4, ch = (np >> 8) * 128 + ((np >> 6) & 3) * 32 + ((np >> 5) & 1) * 16 + (np & 15);
            u32x2 o; o.x = cvtpk(g.x * __builtin_amdgcn_rcpf(1.0f + __expf(-g.x)) * uu.x * wm, g.y * __builtin_amdgcn_rcpf(1.0f + __expf(-g.y)) * uu.y * wm);
            o.y = cvtpk(g.z * __builtin_amdgcn_rcpf(1.0f + __expf(-g.z)) * uu.z * wm, g.w * __builtin_amdgcn_rcpf(1.0f + __expf(-g.w)) * uu.w * wm);
            if (R < nrow) *(u32x2*)(ab + (size_t)ent[m] * 256 + ch) = o; } }
}
__device__ __forceinline__ void phase4a(CP p, LAS unsigned char* lds, const LAS unsigned* cnts, const LAS unsigned* pre) {
    const int G = gridDim.x, v = vcu_id();
    const int U = (int)pre[32], F = U - U % G;
    {
        int u = v; U4a cur;
        if (u < F && p4a_find(cnts, pre, u, cur)) {
            const bf16_t* ap[4]; const bf16_t* bp[4];
            p4a_ptrs<8, 4>(p, cur.e, cur.rt * 256, cur.cnt, cur.ct * 256, ap, bp);
            __syncthreads();
            gemm_stage<8, 4, false>(lds, 0, ap, bp, 0, 0);
            for (;;) {
                f32x4 acc[8][4];
#pragma unroll
                for (int m = 0; m < 8; ++m)
#pragma unroll
                    for (int n = 0; n < 4; ++n) acc[m][n] = (f32x4){0.f, 0.f, 0.f, 0.f};
                gemm_main<8, 4, true, false>(lds, 0, ap, bp, 16, acc);
                U4a nxt; u += G; const bool has_next = u < F && p4a_find(cnts, pre, u, nxt);
                if (has_next) { p4a_ptrs<8, 4>(p, nxt.e, nxt.rt * 256, nxt.cnt, nxt.ct * 256, ap, bp); gemm_stage<8, 4, false>(lds, 0, ap, bp, 0, 0); }
                p4a_epilogue<8, 4>(p, cur.e, cur.rt * 256, cur.cnt, cur.ct * 256, acc);
                if (!has_next) break;
                cur = nxt;
                stage_ptrs_dense<4>((const bf16_t*)(p->ws + WS_WGU) + (size_t)cur.e * 512 * 1024, 1024, cur.ct * 256, bp);
            }
        }
    }
    asm volatile("s_waitcnt vmcnt(0)" ::: "memory"); __syncthreads();
#pragma unroll 1
    for (int sv = v; sv < 4 * (U - F); sv += G) {
        U4a t; if (!p4a_find(cnts, pre, F + (sv >> 2), t)) break;
        const int row0 = t.rt * 256 + ((sv >> 1) & 1) * 128, col0 = t.ct * 256 + (sv & 1) * 128;
        if (row0 < t.cnt) {
            const bf16_t* ap[2]; const bf16_t* bp[2];
            p4a_ptrs<4, 2>(p, t.e, row0, t.cnt, col0, ap, bp);
            __syncthreads();
            gemm_stage<4, 2, false>(lds, 0, ap, bp, 0, 0);
            f32x4 acc[4][2];
#pragma unroll
            for (int m = 0; m < 4; ++m)
#pragma unroll
                for (int n = 0; n < 2; ++n) acc[m][n] = (f32x4){0.f, 0.f, 0.f, 0.f};
            gemm_main<4, 2, true, false>(lds, 0, ap, bp, 16, acc);
            p4a_epilogue<4, 2>(p, t.e, row0, t.cnt, col0, acc);
        }
    }
    asm volatile("s_waitcnt vmcnt(0)" ::: "memory"); __syncthreads();
}
struct U4b { int bk, rt, ct, cnt; };
__device__ __forceinline__ bool p4b_find(const LAS unsigned* cnts, const LAS unsigned* pre, int u, U4b& r) {
    const int i = prefix_find(pre + 33, 112, u); if (i < 0) return false;
    const int uu = u - (int)pre[33 + i]; r.bk = i; r.rt = uu >> 2; r.ct = uu & 3; r.cnt = (int)cnts[32 + i]; return true;
}
__device__ __forceinline__ void p4b_ptrs(CP p, const U4b& u, const bf16_t* (&ap)[2], const bf16_t* (&bp)[4], const bf16_t* (&bq)[4]) {
    const int tid = threadIdx.x, lane = tid & 63;
    const int g = u.bk / 28; int pi = u.bk % 28, lo = 0; while (pi >= 7 - lo) { pi -= 7 - lo; ++lo; } const int hi = lo + 1 + pi;
    const int* lst = (const int*)(p->ws + WS_BLIST) + (size_t)u.bk * MT + u.rt * 128; const int nrow = u.cnt - u.rt * 128;
    const bf16_t* ab = (const bf16_t*)(p->ws + WS_ABUF);
#pragma unroll
    for (int i = 0; i < 2; ++i) { int R, C; stage_rc2((tid >> 6) * 1024 + i * 8192 + lane * 16, R, C); const int tok = lst[R < nrow ? R : 0]; ap[i] = ab + (size_t)tok * 512 + C; }
    stage_ptrs_dense<4>((const bf16_t*)(p->ws + WS_WD) + (size_t)(g * 8 + lo) * 1024 * 256, 256, u.ct * 256, bp);
    stage_ptrs_dense<4>((const bf16_t*)(p->ws + WS_WD) + (size_t)(g * 8 + hi) * 1024 * 256, 256, u.ct * 256, bq);
#pragma unroll
    for (int i = 0; i < 4; ++i) bq[i] -= 256;
}
__device__ __forceinline__ void phase4b(CP p, LAS unsigned char* lds, const LAS unsigned* cnts, const LAS unsigned* pre) {
    const int tid = threadIdx.x, lane = tid & 63, wid = __builtin_amdgcn_readfirstlane(tid >> 6), wr = wid >> 2, wc = wid & 3, fr = lane & 15, fq = lane >> 4;
    unsigned char* ws = p->ws;
    const float* mod = (const float*)(ws + WS_MOD); float* out = p->out;
    int u = vcu_id(); U4b cur;
    if (!p4b_find(cnts, pre, u, cur)) return;
    const bf16_t* ap[2]; const bf16_t* bp[4]; const bf16_t* bq[4];
    p4b_ptrs(p, cur, ap, bp, bq);
    int tok[4];
    { const int* lst = (const int*)(ws + WS_BLIST) + (size_t)cur.bk * MT + cur.rt * 128; const int nrow = cur.cnt - cur.rt * 128;
#pragma unroll
      for (int m = 0; m < 4; ++m) { const int R = wr * 64 + m * 16 + fr; tok[m] = lst[R < nrow ? R : 0]; } }
    __syncthreads();
    gemm_stage<4, 4, false>(lds, 0, ap, bp, 0, 0);
    for (;;) {
        const int colb = cur.ct * 256 + wc * 64 + fq * 4; const int nrow = cur.cnt - cur.rt * 128;
        f32x4 old[4][4];
#pragma unroll
        for (int m = 0; m < 4; ++m)
#pragma unroll
            for (int n = 0; n < 4; ++n) old[m][n] = *(const f32x4*)(out + (size_t)tok[m] * DM + colb + n * 16);
        f32x4 acc[4][4];
#pragma unroll
        for (int m = 0; m < 4; ++m)
#pragma unroll
            for (int n = 0; n < 4; ++n) acc[m][n] = (f32x4){0.f, 0.f, 0.f, 0.f};
        gemm_main2<4, 4, true, false>(lds, 0, ap, bp, bq, 4, 8, acc);
        U4b nxt; u += gridDim.x; const bool has_next = p4b_find(cnts, pre, u, nxt);
        int tokn[4] = {0, 0, 0, 0};
        if (has_next) { p4b_ptrs(p, nxt, ap, bp, bq); gemm_stage<4, 4, false>(lds, 0, ap, bp, 0, 0);
            const int* lst = (const int*)(ws + WS_BLIST) + (size_t)nxt.bk * MT + nxt.rt * 128; const int nr2 = nxt.cnt - nxt.rt * 128;
#pragma unroll
            for (int m = 0; m < 4; ++m) { const int R = wr * 64 + m * 16 + fr; tokn[m] = lst[R < nr2 ? R : 0]; } }
#pragma unroll
        for (int m = 0; m < 4; ++m) { const int R = wr * 64 + m * 16 + fr; const int b = tok[m] >> 12;
#pragma unroll
            for (int n = 0; n < 4; ++n) { const f32x4 gf = *(const f32x4*)(mod + b * 6144 + 5120 + colb + n * 16);
                const f32x4 o = old[m][n] + gf * acc[m][n]; if (R < nrow) *(f32x4*)(out + (size_t)tok[m] * DM + colb + n * 16) = o; } }
        if (!has_next) break;
        cur = nxt;
#pragma unroll
        for (int m = 0; m < 4; ++m) tok[m] = tokn[m];
    }
    asm volatile("s_waitcnt vmcnt(0)" ::: "memory"); __syncthreads();
}

__global__ void __launch_bounds__(512, 2) hybrid_block_fwd(Params p) {
    extern __shared__ __attribute__((aligned(16))) unsigned char lds_raw[];
    LAS unsigned char* lds = (LAS unsigned char*)lds_raw;
    volatile LAS unsigned* MISC = (volatile LAS unsigned*)(lds + MISC_OFF);
    LAS unsigned* cnts = (LAS unsigned*)(lds + MISC_OFF + 256);
    const int tid = threadIdx.x;
    if (tid < 16) MISC[tid] = 0u;
    __syncthreads();
    unsigned* ctl = (unsigned*)(p.ws + WS_CTL);
    const bool single = (p.ph_hi - p.ph_lo) > 1;
    XcdBarrier bar; bar.bar = ctl + CW_BAR; bar.x = 0; bar.st = nullptr;
    if (single) bar = xcd_barrier_post(ctl + CW_BAR, MISC + 8);
#ifndef PH_MASK
#define PH_MASK 0x1ff
#endif
#define IN(k) (((PH_MASK >> (k)) & 1) && p.ph_lo <= (k) && (k) < p.ph_hi)
#define SEAM(k) do { if (IN(k) && IN((k) + 1)) xcd_barrier(bar); } while (0)
    constexpr int TR_DEF = TR_NIT - TR_EARLY, TR_CH = (TR_DEF + 3) / 4;
#define SEAM_W(k, c) do { if (IN(k) && IN((k) + 1)) { const int a_ = TR_EARLY + (c) * TR_CH, e_ = a_ + TR_CH < TR_NIT ? a_ + TR_CH : TR_NIT; xcd_barrier_work(bar, get_params(), lds, a_, e_, (c) == 3 && !N_LAUNCH_SPLIT); } } while (0)
#ifndef REPEAT_PH
#define REPEAT_PH -1
#endif
#define NREP(k) ((REPEAT_PH == (k)) ? 2 : 1)
    if (IN(0)) { for (int r_ = 0; r_ < NREP(0); ++r_) phase0(get_params(), lds); } SEAM_W(0, 0);
    if (IN(1)) { for (int r_ = 0; r_ < NREP(1); ++r_) phase1a(get_params()); } SEAM_W(1, 1);
    if (IN(2)) { for (int r_ = 0; r_ < NREP(2); ++r_) phase1b(get_params(), lds); } SEAM_W(2, 2);
    if (IN(3)) { for (int r_ = 0; r_ < NREP(3); ++r_) phase1c(get_params(), lds); } SEAM_W(3, 3);
    if (IN(4)) { for (int r_ = 0; r_ < NREP(4); ++r_) phase2(get_params(), lds); } SEAM(4);
    if (IN(5)) { for (int r_ = 0; r_ < NREP(5); ++r_) phase3(get_params(), lds); } SEAM(5);
    if (IN(6)) { for (int r_ = 0; r_ < NREP(6); ++r_) phase3b(get_params(), lds, r_ + 1 < NREP(6)); } SEAM(6);
    LAS unsigned* pre = (LAS unsigned*)(lds + MISC_OFF + 256 + 640);
    if (IN(7) || IN(8)) {
        if (tid < 144) cnts[tid] = __hip_atomic_load(ctl + CW_CNT + 64 * tid, __ATOMIC_RELAXED, __HIP_MEMORY_SCOPE_AGENT);
        __syncthreads();
        if (tid == 0) { unsigned a = 0; for (int i = 0; i < 32; ++i) { pre[i] = a; a += ((cnts[i] + 255u) >> 8) * 2u; } pre[32] = a;
                        a = 0; for (int i = 0; i < 112; ++i) { pre[33 + i] = a; a += ((cnts[32 + i] + 127u) >> 7) * 4u; } pre[33 + 112] = a; }
        __syncthreads();
    }
    if (IN(7)) { for (int r_ = 0; r_ < NREP(7); ++r_) phase4a(get_params(), lds, cnts, pre); } SEAM(7);
    if (IN(8)) { phase4b(get_params(), lds, cnts, pre); }
#undef IN
#undef SEAM
}

extern "C" void kernel_launch(void* const* d_in, const int* in_sizes, int n_in, void* d_out, int out_size, void* d_ws, size_t ws_size, hipStream_t stream) {
    static int grid = 0;
    if (grid == 0) {
        if (n_in != 26 || out_size != MT * DM || ws_size < WS_END) { fprintf(stderr, "kernel_launch: unexpected problem (n_in %d out %d ws %zu)\n", n_in, out_size, ws_size); grid = -1; return; }
        int dev = 0, cus = 0, per_cu = 0;
        hipGetDevice(&dev); hipDeviceGetAttribute(&cus, hipDeviceAttributeMultiprocessorCount, dev);
        hipFuncSetAttribute((const void*)hybrid_block_fwd, hipFuncAttributeMaxDynamicSharedMemorySize, LDS_BYTES);
        hipOccupancyMaxActiveBlocksPerMultiprocessor(&per_cu, (const void*)hybrid_block_fwd, 512, LDS_BYTES);
        (void)hipGetLastError();
        if (per_cu < 1) { fprintf(stderr, "kernel_launch: occupancy query says %d blocks/CU\n", per_cu); per_cu = 1; }
        grid = cus;
    }
    if (grid < 0) return;
    hipMemsetAsync((char*)d_ws + WS_CTL, 0, CTL_BYTES, stream);
    Params prm{};
    for (int i = 0; i < 26; ++i) prm.in[i] = d_in[i];
    prm.out = (float*)d_out; prm.ws = (unsigned char*)d_ws;
#if N_LAUNCH_SPLIT
    for (int ph = 0; ph <= DBG_LAST_PHASE; ++ph) { prm.ph_lo = ph; prm.ph_hi = ph + 1; hipLaunchKernelGGL(hybrid_block_fwd, dim3(grid), dim3(512), LDS_BYTES, stream, prm); }
#else
    prm.ph_lo = 0; prm.ph_hi = DBG_LAST_PHASE + 1;
    hipLaunchKernelGGL(hybrid_block_fwd, dim3(grid), dim3(512), LDS_BYTES, stream, prm);
#endif
}
```

```cpp
#include <hip/hip_runtime.h>
#include <cstdio>
#include <cstdint>
#include <utility>

#ifndef N_LAUNCH_SPLIT
#define N_LAUNCH_SPLIT 0
#endif
#ifndef DBG_LAST_PHASE
#define DBG_LAST_PHASE 8
#endif

#define LAS __attribute__((address_space(3)))
#define GAS __attribute__((address_space(1)))
typedef unsigned short bf16_t;
typedef short bf16x8 __attribute__((ext_vector_type(8)));
typedef float f32x4 __attribute__((ext_vector_type(4)));
typedef float f32x2 __attribute__((ext_vector_type(2)));
typedef float f32x16 __attribute__((ext_vector_type(16)));
typedef unsigned u32x4 __attribute__((ext_vector_type(4)));
typedef unsigned u32x2 __attribute__((ext_vector_type(2)));
typedef __bf16 bf16x2_t __attribute__((ext_vector_type(2)));

constexpr int NB = 8, SEQ = 4096, DM = 1024, MT = NB * SEQ;
constexpr int NHEAD = 8, DQK = 96, DV = 64;
constexpr int NEXP = 32;
constexpr float EPS = 1e-6f;
constexpr float QSCALE = 0.14724444602590306f;
constexpr int NPH = 9;

constexpr size_t MiB = 1u << 20;
constexpr size_t WS_CTL = 0, CTL_BYTES = 128 * 1024;
constexpr size_t WS_MOD = 1 * MiB;
constexpr size_t WS_ROPE = 2 * MiB;
constexpr size_t WS_WIN = 6 * MiB;
constexpr size_t WS_WQ = 9 * MiB;
constexpr size_t WS_WKV = 9 * MiB + 512 * 1024;
constexpr size_t WS_WR = 9 * MiB + 768 * 1024;
constexpr size_t WS_WOUT = 10 * MiB;
constexpr size_t WS_WGU = 12 * MiB;
constexpr size_t WS_WD = 44 * MiB;
constexpr size_t WS_SSQQ = 60 * MiB;
constexpr size_t WS_SSQKV = 60 * MiB + 512 * 1024;
constexpr size_t WS_SSQKR = 60 * MiB + 768 * 1024;
constexpr size_t WS_SSQ1 = 61 * MiB;
constexpr size_t WS_TOKW = 63 * MiB;
constexpr size_t WS_KROPE = 64 * MiB;
constexpr size_t WS_CQ = 68 * MiB;
constexpr size_t WS_CKV = 84 * MiB;
constexpr size_t WS_LIST = 92 * MiB;
constexpr size_t WS_H = 100 * MiB;
constexpr size_t WS_U = 164 * MiB;
constexpr size_t WS_Q = 196 * MiB;
constexpr size_t WS_K = 244 * MiB;
constexpr size_t WS_VT = 292 * MiB;
constexpr size_t WS_CAT = 324 * MiB;
constexpr size_t WS_ABUF = 388 * MiB;
constexpr size_t WS_BLIST = 420 * MiB;
constexpr size_t WS_END = 435 * MiB;
constexpr int CW_BAR = 4096;
constexpr int CW_CNT = 16384;

constexpr int SCR_BYTES = 155648;
constexpr int MISC_OFF = SCR_BYTES;
constexpr int LDS_BYTES = SCR_BYTES + 2048;

__device__ __forceinline__ unsigned cvtpk(float lo, float hi) { f32x2 v = {lo, hi}; bf16x2_t b = __builtin_convertvector(v, bf16x2_t); return __builtin_bit_cast(unsigned, b); }
__device__ __forceinline__ float bf2f(unsigned short h) { return __builtin_bit_cast(float, (unsigned)h << 16); }
__device__ __forceinline__ unsigned short f2bf(float f) { return (unsigned short)(cvtpk(f, 0.f) & 0xffffu); }
__device__ __forceinline__ float sigmoidf_(float x) { return __builtin_amdgcn_rcpf(1.0f + __expf(-x)); }
__device__ __forceinline__ float siluf_(float x) { return x * __builtin_amdgcn_rcpf(1.0f + __expf(-x)); }
__device__ __forceinline__ float wave_sum(float v) {
#pragma unroll
    for (int o = 1; o < 64; o <<= 1) v += __shfl_xor(v, o);
    return v;
}

__device__ __forceinline__ int vcu_id() { const int g = gridDim.x, b = blockIdx.x; return (g & 7) == 0 ? (b & 7) * (g >> 3) + (b >> 3) : b; }
#define XB_TMO      128
#define XB_XCNT(j)  (256  + 64 * (j))
#define XB_XSUB(j)  (1280 + 64 * (j))
#define XB_XGEN(j)  (2304 + 64 * (j))
#define XB_TOP      3328
#define XB_TOPGEN   3392
#define XCD_BAR_WORDS 3456
#define XB_SPIN_CAP (1u << 20)
__device__ __forceinline__ unsigned xb_ld(unsigned* p)              { return __hip_atomic_load(p, __ATOMIC_RELAXED, __HIP_MEMORY_SCOPE_AGENT); }
__device__ __forceinline__ unsigned xb_add(unsigned* p, unsigned v) { return __hip_atomic_fetch_add(p, v, __ATOMIC_RELAXED, __HIP_MEMORY_SCOPE_AGENT); }
__device__ __forceinline__ unsigned xb_xcc_id() { return (unsigned)__builtin_amdgcn_s_getreg((3 << 11) | 20) & 0xFu; }
#define XB_SPIN(cond, bar) do { unsigned _sp = 0; while (cond) { __builtin_amdgcn_s_sleep(1); \
    if ((++_sp & 255u) == 0u) { if (xb_ld(&(bar)[XB_TMO])) break; if (_sp > XB_SPIN_CAP) { atomicAdd(&(bar)[XB_TMO], 1u); break; } } } } while (0)
struct XcdBarrier { unsigned* bar; unsigned x; volatile LAS unsigned* st; };
__device__ __forceinline__ XcdBarrier xcd_barrier_post(unsigned* bar, volatile LAS unsigned* st) {
    XcdBarrier b; b.bar = bar; b.x = xb_xcc_id(); b.st = st;
    if (threadIdx.x == 0) (void)xb_add(&bar[XB_XCNT(b.x)], 1u);
    return b;
}
__device__ __forceinline__ void xcd_barrier_complete(unsigned* bar, unsigned x, unsigned& nloc, unsigned& nx) {
    const unsigned G = gridDim.x * gridDim.y * gridDim.z;
    unsigned sum, cnt, mine, sp = 0u;
    for (;;) {
        sum = 0u; cnt = 0u; mine = 0u;
#pragma unroll
        for (unsigned j = 0; j < 16; ++j) { const unsigned c = xb_ld(&bar[XB_XCNT(j)]); sum += c; cnt += (c > 0u) ? 1u : 0u; mine = (j == x) ? c : mine; }
        if (sum == G) break;
        __builtin_amdgcn_s_sleep(1);
        if ((++sp & 255u) == 0u) { if (xb_ld(&bar[XB_TMO])) break; if (sp > XB_SPIN_CAP) { atomicAdd(&bar[XB_TMO], 1u); break; } }
    }
    nloc = mine > 0u ? mine : 1u; nx = cnt > 0u ? cnt : 1u;
}
__device__ __forceinline__ void xcd_barrier(const XcdBarrier& b) {
    asm volatile("s_waitcnt vmcnt(0)" ::: "memory");
    __syncthreads();
    if (threadIdx.x == 0) {
        unsigned* bar = b.bar;
        __builtin_amdgcn_s_waitcnt(0);
        unsigned nloc = b.st[0], nx = b.st[1];
        if (nloc == 0u) { xcd_barrier_complete(bar, b.x, nloc, nx); b.st[0] = nloc; b.st[1] = nx; }
        const unsigned old = xb_add(&bar[XB_XSUB(b.x)], 1u);
        const unsigned gen = old / nloc;
        if (old + 1u == (gen + 1u) * nloc) {
            __builtin_amdgcn_fence(__ATOMIC_RELEASE, "agent");
            asm volatile("s_waitcnt vmcnt(0)" ::: "memory");
            const unsigned og = xb_add(&bar[XB_TOP], 1u);
            const unsigned tg = og / nx;
            if (og + 1u == (tg + 1u) * nx) xb_add(&bar[XB_TOPGEN], 1u);
            else XB_SPIN(xb_ld(&bar[XB_TOPGEN]) == tg, bar);
            __builtin_amdgcn_fence(__ATOMIC_ACQUIRE, "agent");
            xb_add(&bar[XB_XGEN(b.x)], 1u);
            asm volatile("s_waitcnt vmcnt(0)" ::: "memory");
        } else {
            XB_SPIN(xb_ld(&bar[XB_XGEN(b.x)]) == gen, bar);
            __builtin_amdgcn_fence(__ATOMIC_ACQUIRE, "agent");
            asm volatile("s_waitcnt vmcnt(0)" ::: "memory");
        }
    }
    __syncthreads();
}

__device__ __forceinline__ int lds_byte2(int r, int c) { const int st = (r >> 4) * 2 + (c >> 5), ob = (r & 15) * 64 + (c & 31) * 2; return st * 1024 + (ob ^ (((ob >> 9) & 1) << 5)); }
__device__ __forceinline__ void stage_rc2(int b, int& R, int& C) { const int st = b >> 10, sb = b & 1023, swz = sb ^ (((sb >> 9) & 1) << 5); R = (st >> 1) * 16 + swz / 64; C = (st & 1) * 32 + (swz % 64) / 2; }

template <int MI, int NI, bool TRANS>
__device__ __forceinline__ void gemm_block(LAS unsigned char* lds, const bf16_t* const (&ap)[MI / 2], const bf16_t* const (&bp)[NI], int nkt, f32x4 (&acc)[MI][NI]) {
    constexpr int BM = 32 * MI, BN = 64 * NI, TA = BM * 128, TB = BN * 128, STG = TA + TB, GLA = MI / 2, GLB = NI;
    static_assert(2 * STG <= SCR_BYTES, "LDS");
    const int tid = threadIdx.x, lane = tid & 63, wid = __builtin_amdgcn_readfirstlane(tid >> 6), wr = wid >> 2, wc = wid & 3, fr = lane & 15, fq = lane >> 4;
    const int aoff = lds_byte2(wr * (MI * 16) + fr, fq * 8), boff = TA + lds_byte2(wc * (NI * 16) + fr, fq * 8);
#define GB_STAGE(buf, kt) do { \
        _Pragma("unroll") for (int i_ = 0; i_ < GLA; ++i_) __builtin_amdgcn_global_load_lds((const unsigned*)(ap[i_] + (kt) * 64), (LAS unsigned*)(lds + (buf) * STG + wid * 1024 + i_ * 8192), 16, 0, 0); \
        _Pragma("unroll") for (int i_ = 0; i_ < GLB; ++i_) __builtin_amdgcn_global_load_lds((const unsigned*)(bp[i_] + (kt) * 64), (LAS unsigned*)(lds + (buf) * STG + TA + wid * 1024 + i_ * 8192), 16, 0, 0); } while (0)
    GB_STAGE(0, 0);
    asm volatile("s_waitcnt vmcnt(0)" ::: "memory"); __syncthreads();
    for (int t = 0; t < nkt; ++t) {
        const int cur = t & 1;
        if (t + 1 < nkt) GB_STAGE(cur ^ 1, t + 1);
        const LAS unsigned char* sb = lds + cur * STG;
#pragma unroll
        for (int ks = 0; ks < 2; ++ks) {
            bf16x8 At[MI], Bf[NI];
#pragma unroll
            for (int m = 0; m < MI; ++m) At[m] = *(const LAS bf16x8*)(sb + aoff + m * 2048 + ks * 1024);
#pragma unroll
            for (int n = 0; n < NI; ++n) Bf[n] = *(const LAS bf16x8*)(sb + boff + n * 2048 + ks * 1024);
#pragma unroll
            for (int m = 0; m < MI; ++m)
#pragma unroll
                for (int n = 0; n < NI; ++n)
                    acc[m][n] = TRANS ? __builtin_amdgcn_mfma_f32_16x16x32_bf16(Bf[n], At[m], acc[m][n], 0, 0, 0)
                                      : __builtin_amdgcn_mfma_f32_16x16x32_bf16(At[m], Bf[n], acc[m][n], 0, 0, 0);
        }
        asm volatile("s_waitcnt vmcnt(0)" ::: "memory"); __syncthreads();
    }
#undef GB_STAGE
}
template <int MI, int NI, bool ARES>
__device__ __forceinline__ void gemm_stage(LAS unsigned char* lds, int abytes, const bf16_t* const (&ap)[MI / 2], const bf16_t* const (&bp)[NI], int buf, int kt) {
    constexpr int TA = MI * 32 * 128, TB = NI * 64 * 128, STG = ARES ? TB : TA + TB;
    const int wid = __builtin_amdgcn_readfirstlane(threadIdx.x >> 6);
    LAS unsigned char* base = lds + (ARES ? abytes : 0) + buf * STG + wid * 1024;
    if (!ARES) {
#pragma unroll
        for (int i = 0; i < MI / 2; ++i) __builtin_amdgcn_global_load_lds((const unsigned*)(ap[i] + kt * 64), (LAS unsigned*)(base + i * 8192), 16, 0, 0);
    }
#pragma unroll
    for (int i = 0; i < NI; ++i) __builtin_amdgcn_global_load_lds((const unsigned*)(bp[i] + kt * 64), (LAS unsigned*)(base + (ARES ? 0 : TA) + i * 8192), 16, 0, 0);
}
template <int MI>
__device__ __forceinline__ void gemm_load_ares(LAS unsigned char* lds, const bf16_t* const (&ap)[MI / 2], int nkt) {
    constexpr int TA = MI * 32 * 128;
    const int wid = __builtin_amdgcn_readfirstlane(threadIdx.x >> 6);
    for (int kt = 0; kt < nkt; ++kt) {
#pragma unroll
        for (int i = 0; i < MI / 2; ++i) __builtin_amdgcn_global_load_lds((const unsigned*)(ap[i] + kt * 64), (LAS unsigned*)(lds + kt * TA + wid * 1024 + i * 8192), 16, 0, 0);
    }
}
template <int MI, int NI, bool TRANS, bool ARES>
__device__ __forceinline__ void gemm_main2(LAS unsigned char* lds, int abytes, const bf16_t* const (&ap)[MI / 2], const bf16_t* const (&bp)[NI], const bf16_t* const (&bq)[NI], int ksplit, int nkt, f32x4 (&acc)[MI][NI]) {
    constexpr int TA = MI * 32 * 128, TB = NI * 64 * 128, STG = ARES ? TB : TA + TB;
    const int tid = threadIdx.x, lane = tid & 63, wid = __builtin_amdgcn_readfirstlane(tid >> 6), wr = wid >> 2, wc = wid & 3, fr = lane & 15, fq = lane >> 4;
    const int aoff = lds_byte2(wr * (MI * 16) + fr, fq * 8), boff = (ARES ? abytes : TA) + lds_byte2(wc * (NI * 16) + fr, fq * 8);
#pragma unroll 1
    for (int t = 0; t < nkt; ++t) {
        const int cur = t & 1;
        asm volatile("s_waitcnt vmcnt(0)" ::: "memory"); __syncthreads();
        if (t + 1 < nkt) { if (t + 1 < ksplit) gemm_stage<MI, NI, ARES>(lds, abytes, ap, bp, cur ^ 1, t + 1); else gemm_stage<MI, NI, ARES>(lds, abytes, ap, bq, cur ^ 1, t + 1); }
        const LAS unsigned char* sa = ARES ? lds + t * TA : lds + cur * STG;
        const LAS unsigned char* sb = lds + cur * STG;
#pragma unroll
        for (int ks = 0; ks < 2; ++ks) {
            bf16x8 At[MI], Bf[NI];
#pragma unroll
            for (int m = 0; m < MI; ++m) At[m] = *(const LAS bf16x8*)(sa + aoff + m * 2048 + ks * 1024);
#pragma unroll
            for (int n = 0; n < NI; ++n) Bf[n] = *(const LAS bf16x8*)(sb + boff + n * 2048 + ks * 1024);
#pragma unroll
            for (int m = 0; m < MI; ++m)
#pragma unroll
                for (int n = 0; n < NI; ++n)
                    acc[m][n] = TRANS ? __builtin_amdgcn_mfma_f32_16x16x32_bf16(Bf[n], At[m], acc[m][n], 0, 0, 0)
                                      : __builtin_amdgcn_mfma_f32_16x16x32_bf16(At[m], Bf[n], acc[m][n], 0, 0, 0);
        }
    }
    if (nkt & 1) __syncthreads();
}
template <int MI, int NI, bool TRANS, bool ARES>
__device__ __forceinline__ void gemm_main(LAS unsigned char* lds, int abytes, const bf16_t* const (&ap)[MI / 2], const bf16_t* const (&bp)[NI], int nkt, f32x4 (&acc)[MI][NI]) {
    gemm_main2<MI, NI, TRANS, ARES>(lds, abytes, ap, bp, bp, nkt, nkt, acc);
}
template <int GL>
__device__ __forceinline__ void stage_ptrs_dense(const bf16_t* base, size_t ld, int r0, const bf16_t* (&p)[GL]) {
    const int tid = threadIdx.x, lane = tid & 63, wid = tid >> 6;
#pragma unroll
    for (int i = 0; i < GL; ++i) { int R, C; stage_rc2(wid * 1024 + i * 8192 + lane * 16, R, C); p[i] = base + (size_t)(r0 + R) * ld + C; }
}

struct Params {
    const void* in[26];
    float* out;
    unsigned char* ws;
    int ph_lo, ph_hi;
};
typedef const __attribute__((address_space(4))) Params* CP;
__device__ __forceinline__ CP get_params() { CP q = (CP)__builtin_amdgcn_kernarg_segment_ptr(); asm volatile("" : "+s"(q)); return q; }

__device__ const float INVF[16] = {1.000000000e+00f, 5.623413324e-01f, 3.162277639e-01f, 1.778279394e-01f, 1.000000015e-01f, 5.623413250e-02f, 3.162277490e-02f, 1.778279431e-02f,
                                   9.999999776e-03f, 5.623413250e-03f, 3.162277630e-03f, 1.778279431e-03f, 1.000000047e-03f, 5.623413017e-04f, 3.162277571e-04f, 1.778279402e-04f};

__device__ __forceinline__ void tr_item(const float* srcp, int ldw, const float* kscale, bf16_t* WT, int Kd, int k0, int n0, LAS float* scr, int lane) {
#pragma unroll 8
    for (int i = 0; i < 32; ++i) { const int kk = 2 * i + (lane >> 5); float v = 0.f; if (srcp) { v = srcp[(size_t)(k0 + kk) * ldw]; if (kscale) v *= kscale[k0 + kk]; } scr[kk * 33 + (lane & 31)] = v; }
    asm volatile("s_waitcnt lgkmcnt(0)" ::: "memory");
    const int c = lane & 7;
#pragma unroll
    for (int j = 0; j < 4; ++j) { const int n = (lane >> 3) + 8 * j; const LAS float* s = scr + (8 * c) * 33 + n;
        u32x4 o; o.x = cvtpk(s[0 * 33], s[1 * 33]); o.y = cvtpk(s[2 * 33], s[3 * 33]); o.z = cvtpk(s[4 * 33], s[5 * 33]); o.w = cvtpk(s[6 * 33], s[7 * 33]);
        *(u32x4*)(WT + (size_t)(n0 + n) * Kd + k0 + 8 * c) = o; }
    asm volatile("s_waitcnt lgkmcnt(0)" ::: "memory");
}

constexpr int TR_I0 = 16 * 24, TR_I1 = 4 * 12, TR_I2 = 2 * 16, TR_I3 = 16 * 16, TR_I4 = 32 * 128, TR_I5 = 32 * 64, TR_I6 = 16 * 2;
constexpr int TR_NIT = TR_I0 + TR_I1 + TR_I2 + TR_I3 + TR_I4 + TR_I5 + TR_I6, TR_EARLY = TR_I0 + TR_I1 + TR_I2;
__device__ __forceinline__ void transpose_items(CP p, LAS unsigned char* lds, int it0, int it1) {
    const int tid = threadIdx.x, lane = tid & 63, wave = __builtin_amdgcn_readfirstlane(tid >> 6);
    const int G = gridDim.x, bid = blockIdx.x;
    unsigned char* ws = p->ws;
    {
        LAS unsigned* scr = (LAS unsigned*)(lds + 65536) + wave * 2112;
        const int gw = bid * 8 + wave, NGW = G * 8;
        const float* w_in = (const float*)p->in[6]; const float* qan = (const float*)p->in[11]; const float* w_qb = (const float*)p->in[12];
        const float* kvan = (const float*)p->in[13]; const float* w_kvb = (const float*)p->in[14]; const float* w_out = (const float*)p->in[17];
        const float* w_group = (const float*)p->in[19]; const float* w_expert = (const float*)p->in[21];
        const float* w_gate = (const float*)p->in[23]; const float* w_up = (const float*)p->in[24]; const float* w_down = (const float*)p->in[25];
        constexpr int I0 = TR_I0, I1 = TR_I1, I2 = TR_I2, I3 = TR_I3, I4 = TR_I4, I5 = TR_I5, I6 = TR_I6, NIT = TR_NIT;
        const int c4 = lane & 15, kp = lane >> 4;
        for (int it = it0 + gw; it < it1; it += NGW) {
            int r = it;
            if (r >= NIT - I6) {
                r -= NIT - I6;
                LAS float* fscr = (LAS float*)scr; const int nl = lane & 31;
                const int kb = r >> 1, nb = r & 1, n0 = nb * 32, np = n0 + nl, k0 = kb * 64;
                const float* srcp = nullptr; int ldw = 0;
                if (np < 4) { srcp = w_group + np; ldw = 4; } else if (np < 36) { srcp = w_expert + (np - 4); ldw = 32; }
#pragma unroll 8
                for (int i = 0; i < 32; ++i) { const int kk = 2 * i + (lane >> 5); fscr[kk * 33 + nl] = srcp ? srcp[(size_t)(k0 + kk) * ldw] : 0.f; }
                asm volatile("s_waitcnt lgkmcnt(0)" ::: "memory");
                const int c = lane & 7;
#pragma unroll
                for (int j = 0; j < 4; ++j) { const int n = (lane >> 3) + 8 * j; const LAS float* sp = fscr + (8 * c) * 33 + n;
                    float v[8], l[8];
#pragma unroll
                    for (int q = 0; q < 8; ++q) { v[q] = sp[q * 33]; l[q] = v[q] - bf2f(f2bf(v[q])); }
                    if (n0 + n < 48) {
                        u32x4 o; o.x = cvtpk(v[0], v[1]); o.y = cvtpk(v[2], v[3]); o.z = cvtpk(v[4], v[5]); o.w = cvtpk(v[6], v[7]);
                        *(u32x4*)((bf16_t*)(ws + WS_WR) + (size_t)(n0 + n) * 1024 + k0 + 8 * c) = o;
                        u32x4 o2; o2.x = cvtpk(l[0], l[1]); o2.y = cvtpk(l[2], l[3]); o2.z = cvtpk(l[4], l[5]); o2.w = cvtpk(l[6], l[7]);
                        *(u32x4*)((bf16_t*)(ws + WS_WR) + 48 * 1024 + (size_t)(n0 + n) * 1024 + k0 + 8 * c) = o2; } }
                asm volatile("s_waitcnt lgkmcnt(0)" ::: "memory");
                continue;
            }
            const float* srcp; int ldw, Kd, k0, n0; const float* ksc = nullptr; bf16_t* WT;
            if (r < I0) {
                const int kb = r / 24, nb = r % 24; n0 = nb * 64; k0 = kb * 64; const int np = n0 + 4 * c4;
                const int pn = np >> 8, wc = (np >> 6) & 3, n = (np >> 4) & 3, f = np & 15; int src;
                if (pn < 4) { const int ch = pn * 128 + wc * 32 + (n >> 1) * 16 + f; src = (n & 1) ? 512 + ch : ch; }
                else if (pn == 4) src = np;
                else { const int j = np - 1280; src = (j < 160) ? 1280 + j : -1; }
                srcp = src >= 0 ? w_in + src : nullptr; ldw = 1440; Kd = 1024; WT = (bf16_t*)(ws + WS_WIN);
            } else if ((r -= I0) < I1) {
                const int kb = r / 12, nb = r % 12; n0 = nb * 64; k0 = kb * 64;
                srcp = w_qb + n0 + 4 * c4; ldw = 768; Kd = 256; ksc = qan; WT = (bf16_t*)(ws + WS_WQ);
            } else if ((r -= I1) < I2) {
                const int kb = r / 16, nb = r % 16; n0 = nb * 64; k0 = kb * 64;
                srcp = w_kvb + n0 + 4 * c4; ldw = 1024; Kd = 128; ksc = kvan; WT = (bf16_t*)(ws + WS_WKV);
            } else if ((r -= I2) < I3) {
                const int kb = r / 16, nb = r % 16; n0 = nb * 64; k0 = kb * 64;
                srcp = w_out + n0 + 4 * c4; ldw = 1024; Kd = 1024; WT = (bf16_t*)(ws + WS_WOUT);
            } else if ((r -= I3) < I4) {
                const int e = r >> 7, q = r & 127, kb = q / 8, nb = q % 8; n0 = nb * 64; k0 = kb * 64; const int np = n0 + 4 * c4;
                const int ct = np >> 8, wc = (np >> 6) & 3, n = (np >> 4) & 3, f = np & 15, ch = ct * 128 + wc * 32 + (n >> 1) * 16 + f;
                srcp = ((n & 1) ? w_up : w_gate) + (size_t)e * 1024 * 256 + ch; ldw = 256; Kd = 1024; WT = (bf16_t*)(ws + WS_WGU) + (size_t)e * 512 * 1024;
            } else {
                r -= I4; const int e = r >> 6, q = r & 63, kb = q / 16, nb = q % 16; n0 = nb * 64; k0 = kb * 64;
                srcp = w_down + (size_t)e * 256 * 1024 + n0 + 4 * c4; ldw = 1024; Kd = 256; WT = (bf16_t*)(ws + WS_WD) + (size_t)e * 1024 * 256;
            }
            f32x4 v0[8], v1[8];
#pragma unroll
            for (int i = 0; i < 8; ++i) { const int k = k0 + 8 * i + 2 * kp;
                if (srcp) { v0[i] = *(const f32x4*)(srcp + (size_t)k * ldw); v1[i] = *(const f32x4*)(srcp + (size_t)(k + 1) * ldw); }
                else { v0[i] = (f32x4){0.f, 0.f, 0.f, 0.f}; v1[i] = v0[i]; } }
#pragma unroll
            for (int i = 0; i < 8; ++i) { const int k = k0 + 8 * i + 2 * kp; f32x4 a = v0[i], b = v1[i];
                if (ksc) { a = a * ksc[k]; b = b * ksc[k + 1]; }
                LAS unsigned* d = scr + (4 * c4) * 33 + 4 * i + kp;
                d[0] = cvtpk(a.x, b.x); d[33] = cvtpk(a.y, b.y); d[66] = cvtpk(a.z, b.z); d[99] = cvtpk(a.w, b.w); }
            asm volatile("s_waitcnt lgkmcnt(0)" ::: "memory");
            const int c = lane & 7;
#pragma unroll
            for (int j = 0; j < 8; ++j) { const int n = (lane >> 3) + 8 * j; const LAS unsigned* sp = scr + n * 33 + 4 * c;
                u32x4 o; o.x = sp[0]; o.y = sp[1]; o.z = sp[2]; o.w = sp[3];
                *(u32x4*)(WT + (size_t)(n0 + n) * Kd + k0 + 8 * c) = o; }
            asm volatile("s_waitcnt lgkmcnt(0)" ::: "memory");
        }
    }
}

__device__ __forceinline__ void rope_table(CP p) {
    const int* pos = (const int*)p->in[2]; f32x2* rt = (f32x2*)(p->ws + WS_ROPE);
    for (int e = blockIdx.x * 512 + threadIdx.x; e < MT * 16; e += gridDim.x * 512) {
        const int tok = e >> 4, i = e & 15;
        const float a32 = (float)pos[tok] * INVF[i];
        const double rev = (double)a32 * 0.15915494309189535;
        const float fr = (float)(rev - __builtin_rint(rev));
        rt[e] = (f32x2){__builtin_amdgcn_cosf(fr), __builtin_amdgcn_sinf(fr)};
    }
}

__device__ __forceinline__ void phase0(CP p, LAS unsigned char* lds) {
    const int tid = threadIdx.x, lane = tid & 63, wave = __builtin_amdgcn_readfirstlane(tid >> 6);
    const int G = gridDim.x, bid = blockIdx.x;
    unsigned char* ws = p->ws;
    if (bid < 192) {
        const float* c = (const float*)p->in[1]; const float* w_ada = (const float*)p->in[3]; const float* b_ada = (const float*)p->in[4];
        LAS float* sc = (LAS float*)lds;
        LAS float* red = (LAS float*)(lds + 32768);
        for (int i = tid; i < 8192; i += 512) sc[i] = siluf_(c[i]);
        __syncthreads();
        const int col = tid & 31, ks = tid >> 5, n0 = bid * 32;
        float a[8] = {0, 0, 0, 0, 0, 0, 0, 0};
#pragma unroll 8
        for (int i = 0; i < 64; ++i) { const int k = ks * 64 + i; const float w = w_ada[(size_t)k * 6144 + n0 + col];
#pragma unroll
            for (int b = 0; b < 8; ++b) a[b] += sc[b * 1024 + k] * w; }
#pragma unroll
        for (int b = 0; b < 8; ++b) red[(ks * 32 + col) * 8 + b] = a[b];
        __syncthreads();
        if (tid < 256) { const int cc = tid & 31, b = tid >> 5; float s = 0.f;
#pragma unroll
            for (int k2 = 0; k2 < 16; ++k2) s += red[(k2 * 32 + cc) * 8 + b];
            ((float*)(ws + WS_MOD))[b * 6144 + n0 + cc] = s + b_ada[n0 + cc]; }
        __syncthreads();
    }
    if (N_LAUNCH_SPLIT) { rope_table(p); transpose_items(p, lds, 0, TR_NIT); }
}

__device__ __forceinline__ void phase1a(CP p) {
    const int tid = threadIdx.x, lane = tid & 63, wave = tid >> 6;
    const int gw = blockIdx.x * 8 + wave, NGW = gridDim.x * 8;
    const float* x = (const float*)p->in[0]; const float* nm = (const float*)p->in[5]; const float* mod = (const float*)(p->ws + WS_MOD);
    bf16_t* h = (bf16_t*)(p->ws + WS_H);
    for (int grp = gw; grp < MT / 16; grp += NGW) {
        const int r0 = grp * 16, b = r0 >> 12;
        f32x4 gm[4], sh[4];
#pragma unroll
        for (int j = 0; j < 4; ++j) { const int col = 4 * lane + 256 * j; const f32x4 g = *(const f32x4*)(nm + col), s = *(const f32x4*)(mod + b * 6144 + 1024 + col);
            gm[j] = g * (s + 1.0f); sh[j] = *(const f32x4*)(mod + b * 6144 + col); }
#pragma unroll 1
        for (int rb = 0; rb < 16; rb += 4) {
            f32x4 v[4][4];
#pragma unroll
            for (int rr = 0; rr < 4; ++rr) { const float* xr = x + (size_t)(r0 + rb + rr) * DM;
#pragma unroll
                for (int j = 0; j < 4; ++j) v[rr][j] = *(const f32x4*)(xr + 4 * lane + 256 * j); }
#pragma unroll
            for (int rr = 0; rr < 4; ++rr) { float s = 0.f;
#pragma unroll
                for (int j = 0; j < 4; ++j) s += (v[rr][j].x * v[rr][j].x + v[rr][j].y * v[rr][j].y) + (v[rr][j].z * v[rr][j].z + v[rr][j].w * v[rr][j].w);
                const float rstd = __builtin_amdgcn_rsqf(wave_sum(s) * (1.0f / DM) + EPS);
                bf16_t* hr = h + (size_t)(r0 + rb + rr) * DM;
#pragma unroll
                for (int j = 0; j < 4; ++j) { const f32x4 o = v[rr][j] * rstd * gm[j] + sh[j]; u32x2 w; w.x = cvtpk(o.x, o.y); w.y = cvtpk(o.z, o.w); *(u32x2*)(hr + 4 * lane + 256 * j) = w; } }
        }
    }
}

__device__ __forceinline__ void phase1b(CP p, LAS unsigned char* lds) {
    const int tid = threadIdx.x, lane = tid & 63, wid = __builtin_amdgcn_readfirstlane(tid >> 6), wr = wid >> 2, wc = wid & 3, fr = lane & 15, fq = lane >> 4;
    unsigned char* ws = p->ws;
    const bf16_t* h = (const bf16_t*)(ws + WS_H); const bf16_t* win = (const bf16_t*)(ws + WS_WIN);
    for (int u = vcu_id(); u < 128 * 6; u += gridDim.x) {
        const int pm = u / 6, pn = u % 6;
        const bf16_t* ap[4]; const bf16_t* bp[4];
        stage_ptrs_dense<4>(h, 1024, pm * 256, ap); stage_ptrs_dense<4>(win, 1024, pn * 256, bp);
        f32x4 acc[8][4];
#pragma unroll
        for (int m = 0; m < 8; ++m)
#pragma unroll
            for (int n = 0; n < 4; ++n) acc[m][n] = (f32x4){0.f, 0.f, 0.f, 0.f};
        gemm_block<8, 4, true>(lds, ap, bp, 16, acc);
        const int rowb = pm * 256 + wr * 128 + fr;
        if (pn < 4) {
            bf16_t* ub = (bf16_t*)(ws + WS_U);
#pragma unroll
            for (int m = 0; m < 8; ++m) { const size_t row = rowb + m * 16;
#pragma unroll
                for (int h2 = 0; h2 < 2; ++h2) { const f32x4 v = acc[m][2 * h2], g = acc[m][2 * h2 + 1];
                    const int ch = pn * 128 + wc * 32 + h2 * 16 + fq * 4;
                    u32x2 w; w.x = cvtpk(v.x * sigmoidf_(g.x), v.y * sigmoidf_(g.y)); w.y = cvtpk(v.z * sigmoidf_(g.z), v.w * sigmoidf_(g.w));
                    *(u32x2*)(ub + row * 512 + ch) = w; } }
        } else if (pn == 4) {
            bf16_t* cq = (bf16_t*)(ws + WS_CQ); float* sq = (float*)(ws + WS_SSQQ);
#pragma unroll
            for (int m = 0; m < 8; ++m) { const size_t row = rowb + m * 16; float s = 0.f;
#pragma unroll
                for (int n = 0; n < 4; ++n) { const f32x4 v = acc[m][n]; s += (v.x * v.x + v.y * v.y) + (v.z * v.z + v.w * v.w);
                    u32x2 w; w.x = cvtpk(v.x, v.y); w.y = cvtpk(v.z, v.w); *(u32x2*)(cq + row * 256 + wc * 64 + n * 16 + fq * 4) = w; }
                s += __shfl_xor(s, 16); s += __shfl_xor(s, 32);
                if (fq == 0) sq[row * 4 + wc] = s; }
        } else {
            if (wc < 2) {
                bf16_t* ckv = (bf16_t*)(ws + WS_CKV); float* sq = (float*)(ws + WS_SSQKV);
#pragma unroll
                for (int m = 0; m < 8; ++m) { const size_t row = rowb + m * 16; float s = 0.f;
#pragma unroll
                    for (int n = 0; n < 4; ++n) { const f32x4 v = acc[m][n]; s += (v.x * v.x + v.y * v.y) + (v.z * v.z + v.w * v.w);
                        u32x2 w; w.x = cvtpk(v.x, v.y); w.y = cvtpk(v.z, v.w); *(u32x2*)(ckv + row * 128 + wc * 64 + n * 16 + fq * 4) = w; }
                    s += __shfl_xor(s, 16); s += __shfl_xor(s, 32);
                    if (fq == 0) sq[row * 2 + wc] = s; }
            } else if (wc == 2) {
                float* kr = (float*)(ws + WS_KROPE); float* sq = (float*)(ws + WS_SSQKR);
#pragma unroll
                for (int m = 0; m < 8; ++m) { const size_t row = rowb + m * 16; float s = 0.f;
#pragma unroll
                    for (int n = 0; n < 2; ++n) { const f32x4 v = acc[m][n]; s += (v.x * v.x + v.y * v.y) + (v.z * v.z + v.w * v.w);
                        *(f32x4*)(kr + row * 32 + n * 16 + fq * 4) = v; }
                    s += __shfl_xor(s, 16); s += __shfl_xor(s, 32);
                    if (fq == 0) sq[row] = s; }
            }
        }
    }
}

constexpr int EPI_SCR = 131072;
__device__ __forceinline__ void q_item(CP p, LAS unsigned char* lds, int item) {
    const int tid = threadIdx.x, lane = tid & 63, wid = __builtin_amdgcn_readfirstlane(tid >> 6), wr = wid >> 2, wc = wid & 3, fr = lane & 15, fq = lane >> 4;
    unsigned char* ws = p->ws;
    const int pm = item >> 1, ct = item & 1;
    const bf16_t* ap[2]; const bf16_t* bp[6];
    stage_ptrs_dense<2>((const bf16_t*)(ws + WS_CQ), 256, pm * 128, ap);
    stage_ptrs_dense<6>((const bf16_t*)(ws + WS_WQ), 256, ct * 384, bp);
    __syncthreads();
    gemm_stage<4, 6, false>(lds, 0, ap, bp, 0, 0);
    const float* sq = (const float*)(ws + WS_SSQQ); const float* qn = (const float*)p->in[15];
    const int rowb = pm * 128 + wr * 64 + fr, i0 = fq * 4;
    float rq[4]; f32x4 gq[6], cs01[4], cs23[4];
#pragma unroll
    for (int m = 0; m < 4; ++m) { const f32x4 s4 = *(const f32x4*)(sq + (size_t)(rowb + m * 16) * 4); rq[m] = __builtin_amdgcn_rsqf(((s4.x + s4.y) + (s4.z + s4.w)) * (1.0f / 256.0f) + EPS); }
#pragma unroll
    for (int n = 0; n < 6; ++n) gq[n] = *(const f32x4*)(qn + n * 16 + i0);
    const f32x2* rope = (const f32x2*)(ws + WS_ROPE);
#pragma unroll
    for (int m = 0; m < 4; ++m) { const size_t tok = rowb + m * 16; cs01[m] = *(const f32x4*)(rope + tok * 16 + i0); cs23[m] = *(const f32x4*)(rope + tok * 16 + i0 + 2); }
    f32x4 acc[4][6];
#pragma unroll
    for (int m = 0; m < 4; ++m)
#pragma unroll
        for (int n = 0; n < 6; ++n) acc[m][n] = (f32x4){0.f, 0.f, 0.f, 0.f};
    gemm_main<4, 6, true, false>(lds, 0, ap, bp, 4, acc);
    const int hd = ct * 4 + wc, bb = (pm * 128) >> 12, sb = rowb & 4095;
    bf16_t* dst0 = (bf16_t*)(ws + WS_Q) + ((size_t)(bb * 8 + hd) * 4096 + sb) * 96;
#pragma unroll
    for (int m = 0; m < 4; ++m) { float s = 0.f;
#pragma unroll
        for (int n = 0; n < 6; ++n) { acc[m][n] = acc[m][n] * rq[m]; const f32x4 v = acc[m][n]; s += (v.x * v.x + v.y * v.y) + (v.z * v.z + v.w * v.w); }
        s += __shfl_xor(s, 16); s += __shfl_xor(s, 32);
        const float rh = __builtin_amdgcn_rsqf(s * (1.0f / 96.0f) + EPS) * QSCALE;
        bf16_t* dst = dst0 + (m * 16) * 96;
#pragma unroll
        for (int n = 0; n < 4; ++n) { const f32x4 v = acc[m][n] * rh * gq[n]; u32x2 w; w.x = cvtpk(v.x, v.y); w.y = cvtpk(v.z, v.w); *(u32x2*)(dst + n * 16 + i0) = w; }
        const f32x4 x1 = acc[m][4] * rh * gq[4], x2 = acc[m][5] * rh * gq[5];
        const f32x4 c01 = cs01[m], c23 = cs23[m];
        f32x4 o1, o2;
        o1.x = x1.x * c01.x - x2.x * c01.y; o2.x = x1.x * c01.y + x2.x * c01.x;
        o1.y = x1.y * c01.z - x2.y * c01.w; o2.y = x1.y * c01.w + x2.y * c01.z;
        o1.z = x1.z * c23.x - x2.z * c23.y; o2.z = x1.z * c23.y + x2.z * c23.x;
        o1.w = x1.w * c23.z - x2.w * c23.w; o2.w = x1.w * c23.w + x2.w * c23.z;
        u32x2 w; w.x = cvtpk(o1.x, o1.y); w.y = cvtpk(o1.z, o1.w); *(u32x2*)(dst + 64 + i0) = w;
        w.x = cvtpk(o2.x, o2.y); w.y = cvtpk(o2.z, o2.w); *(u32x2*)(dst + 80 + i0) = w;
    }
}

constexpr int KV_SCR = 98304;
__device__ __forceinline__ void kv_item(CP p, LAS unsigned char* lds, int pm) {
    const int tid = threadIdx.x, lane = tid & 63, wid = __builtin_amdgcn_readfirstlane(tid >> 6), wr = wid >> 2, wc = wid & 3, fr = lane & 15, fq = lane >> 4;
    unsigned char* ws = p->ws;
    const bf16_t* ap[2]; const bf16_t* bp[4];
    stage_ptrs_dense<2>((const bf16_t*)(ws + WS_CKV), 128, pm * 128, ap);
    stage_ptrs_dense<4>((const bf16_t*)(ws + WS_WKV), 128, 0, bp);
    __syncthreads();
    gemm_load_ares<4>(lds, ap, 2);
    gemm_stage<4, 4, true>(lds, 32768, ap, bp, 0, 0);
    LAS float* kr_l = (LAS float*)(lds + KV_SCR); LAS float* rp_l = kr_l + 128 * 33; LAS float* rkv_l = rp_l + 128 * 34; LAS float* skr_l = rkv_l + 128;
    {
        const float* krp = (const float*)(ws + WS_KROPE) + (size_t)pm * 128 * 32; const float* rope = (const float*)(ws + WS_ROPE) + (size_t)pm * 128 * 32;
        f32x4 a[2], b[2];
#pragma unroll
        for (int k = 0; k < 2; ++k) { const int idx = tid + 512 * k; a[k] = *(const f32x4*)(krp + idx * 4); b[k] = *(const f32x4*)(rope + idx * 4); }
        float rk = 0.f, sk = 0.f;
        if (tid < 128) { const f32x2 s2 = *(const f32x2*)((const float*)(ws + WS_SSQKV) + (size_t)(pm * 128 + tid) * 2); rk = __builtin_amdgcn_rsqf((s2.x + s2.y) * (1.0f / 128.0f) + EPS); sk = ((const float*)(ws + WS_SSQKR))[pm * 128 + tid]; }
#pragma unroll
        for (int k = 0; k < 2; ++k) { const int idx = tid + 512 * k, row = idx >> 3, c4 = (idx & 7) * 4;
            LAS float* d = kr_l + row * 33 + c4; d[0] = a[k].x; d[1] = a[k].y; d[2] = a[k].z; d[3] = a[k].w;
            LAS float* e = rp_l + row * 34 + c4; e[0] = b[k].x; e[1] = b[k].y; e[2] = b[k].z; e[3] = b[k].w; }
        if (tid < 128) { rkv_l[tid] = rk; skr_l[tid] = sk; }
    }
    const float* kn = (const float*)p->in[16];
    const int rowl = wr * 64 + fq * 4, rowb = pm * 128 + rowl;
    float g[4];
#pragma unroll
    for (int n = 0; n < 4; ++n) g[n] = kn[n * 16 + fr];
    const float g1 = kn[64 + fr], g2 = kn[80 + fr];
    const int bb = (pm * 128) >> 12, sb = rowb & 4095;
#pragma unroll 1
    for (int pn = 0; pn < 4; ++pn) {
        f32x4 acc[4][4];
#pragma unroll
        for (int m = 0; m < 4; ++m)
#pragma unroll
            for (int n = 0; n < 4; ++n) acc[m][n] = (f32x4){0.f, 0.f, 0.f, 0.f};
        gemm_main<4, 4, false, true>(lds, 32768, ap, bp, 2, acc);
        if (pn < 3) {
#pragma unroll
            for (int i = 0; i < 4; ++i) bp[i] += 256 * 128;
            gemm_stage<4, 4, true>(lds, 32768, ap, bp, 0, 0);
        }
        const int hd = pn * 2 + (wc >> 1);
        if ((wc & 1) == 0) {
            bf16_t* dst_p = (bf16_t*)(ws + WS_K) + ((size_t)(bb * 8 + hd) * 4096 + sb) * 96 + fr;
#pragma unroll
            for (int m = 0; m < 4; ++m) {
#pragma unroll
                for (int j = 0; j < 4; ++j) {
                    const int o = m * 16 + j, rl = rowl + o;
                    const float rkv = rkv_l[rl];
                    float v[4], ss = 0.f;
#pragma unroll
                    for (int n = 0; n < 4; ++n) { v[n] = acc[m][n][j] * rkv; ss += v[n] * v[n]; }
                    ss += __shfl_xor(ss, 1); ss += __shfl_xor(ss, 2); ss += __shfl_xor(ss, 4); ss += __shfl_xor(ss, 8);
                    const float rk = __builtin_amdgcn_rsqf((ss + skr_l[rl]) * (1.0f / 96.0f) + EPS);
                    bf16_t* dst = dst_p + o * 96;
#pragma unroll
                    for (int n = 0; n < 4; ++n) dst[n * 16] = f2bf(v[n] * rk * g[n]);
                    const float x1 = kr_l[rl * 33 + fr] * rk * g1, x2 = kr_l[rl * 33 + 16 + fr] * rk * g2;
                    const float cs_c = rp_l[rl * 34 + 2 * fr], cs_s = rp_l[rl * 34 + 2 * fr + 1];
                    dst[64] = f2bf(x1 * cs_c - x2 * cs_s); dst[80] = f2bf(x1 * cs_s + x2 * cs_c);
                }
            }
        } else {
            bf16_t* vt_p = (bf16_t*)(ws + WS_VT) + ((size_t)(bb * 8 + hd) * 64 + fr) * 4096 + sb;
#pragma unroll
            for (int m = 0; m < 4; ++m) {
                float rkv[4];
#pragma unroll
                for (int j = 0; j < 4; ++j) rkv[j] = rkv_l[rowl + m * 16 + j];
#pragma unroll
                for (int n = 0; n < 4; ++n) { const f32x4 a = acc[m][n];
                    u32x2 w; w.x = cvtpk(a.x * rkv[0], a.y * rkv[1]); w.y = cvtpk(a.z * rkv[2], a.w * rkv[3]);
                    *(u32x2*)(vt_p + (size_t)(n * 16) * 4096 + m * 16) = w; }
            }
        }
    }
}

template <int R> __device__ __forceinline__ void conv_row(float (&o)[64], const float (&w)[31], float x) {
    constexpr int T0 = R > 30 ? R - 30 : 0, T1 = R < 63 ? R : 63;
#pragma unroll
    for (int t = T0; t <= T1; ++t) o[t] += w[R - t] * x;
}
template <int... R> __device__ __forceinline__ void conv_rows(float (&o)[64], const float (&w)[31], const float (&x)[94], std::integer_sequence<int, R...>) { (conv_row<R>(o, w, x[R]), ...); }
__device__ __forceinline__ void conv_unit(CP p, LAS unsigned char* lds, int cu) {
    const int tid = threadIdx.x, lane = tid & 63, wave = tid >> 6;
    const int b = cu >> 6, s0 = (cu & 63) * 64, c = tid;
    const bf16_t* ub = (const bf16_t*)(p->ws + WS_U) + ((size_t)b * 4096) * 512 + c;
    const float* cw = (const float*)p->in[7]; const float* cb = (const float*)p->in[8]; const float* lg = (const float*)p->in[9]; const float* lb = (const float*)p->in[10];
    float w[31];
#pragma unroll
    for (int j = 0; j < 31; ++j) w[j] = cw[j * 512 + c];
    float xin[94];
#pragma unroll
    for (int r = 0; r < 94; ++r) { const int s = s0 - 30 + r; xin[r] = bf2f(ub[(size_t)(s < 0 ? 0 : s) * 512]); }
    if (s0 == 0) {
#pragma unroll
        for (int r = 0; r < 30; ++r) xin[r] = 0.f;
    }
    float o[64];
    { const float bias = cb[c];
#pragma unroll
      for (int t = 0; t < 64; ++t) o[t] = bias; }
    conv_rows(o, w, xin, std::make_integer_sequence<int, 94>{});
    float s1, s2;
    {
        const bool b5 = lane & 32, b4 = lane & 16, b3 = lane & 8, b2 = lane & 4, b1 = lane & 2, b0 = lane & 1;
#define CONV_BFLY(RES, SQ) do { float a32[32]; \
        _Pragma("unroll") for (int i = 0; i < 32; ++i) { const float lo = SQ ? o[i] * o[i] : o[i], hi = SQ ? o[32 + i] * o[32 + i] : o[32 + i]; a32[i] = (b5 ? hi : lo) + __shfl_xor(b5 ? lo : hi, 32); } \
        float a16[16]; _Pragma("unroll") for (int i = 0; i < 16; ++i) a16[i] = (b4 ? a32[16 + i] : a32[i]) + __shfl_xor(b4 ? a32[i] : a32[16 + i], 16); \
        float a8[8]; _Pragma("unroll") for (int i = 0; i < 8; ++i) a8[i] = (b3 ? a16[8 + i] : a16[i]) + __shfl_xor(b3 ? a16[i] : a16[8 + i], 8); \
        float a4[4]; _Pragma("unroll") for (int i = 0; i < 4; ++i) a4[i] = (b2 ? a8[4 + i] : a8[i]) + __shfl_xor(b2 ? a8[i] : a8[4 + i], 4); \
        float a2[2]; _Pragma("unroll") for (int i = 0; i < 2; ++i) a2[i] = (b1 ? a4[2 + i] : a4[i]) + __shfl_xor(b1 ? a4[i] : a4[2 + i], 2); \
        RES = (b0 ? a2[1] : a2[0]) + __shfl_xor(b0 ? a2[0] : a2[1], 1); } while (0)
        CONV_BFLY(s1, false);
        asm volatile("" : "+v"(s1));
        CONV_BFLY(s2, true);
#undef CONV_BFLY
    }
    LAS float* red = (LAS float*)(lds + EPI_SCR);
    LAS float* stat = (LAS float*)(lds + EPI_SCR + 4096);
    red[(wave * 64 + lane) * 2] = s1; red[(wave * 64 + lane) * 2 + 1] = s2;
    __syncthreads();
    if (tid < 64) { float t1 = 0.f, t2 = 0.f;
#pragma unroll
        for (int k = 0; k < 8; ++k) { t1 += red[(k * 64 + tid) * 2]; t2 += red[(k * 64 + tid) * 2 + 1]; }
        const float mean = t1 * (1.0f / 512.0f); float var = t2 * (1.0f / 512.0f) - mean * mean; var = var < 0.f ? 0.f : var;
        stat[tid * 2] = mean; stat[tid * 2 + 1] = __builtin_amdgcn_rsqf(var + EPS); }
    __syncthreads();
    const float g = lg[c], bb = lb[c];
    bf16_t* cat = (bf16_t*)(p->ws + WS_CAT) + ((size_t)b * 4096 + s0) * 1024 + c;
#pragma unroll
    for (int t = 0; t < 64; ++t) { const float y = (o[t] - stat[t * 2]) * stat[t * 2 + 1] * g + bb; cat[(size_t)t * 1024] = f2bf(y * __builtin_amdgcn_rcpf(1.0f + __expf(-y))); }
    __syncthreads();
}

constexpr int CW_CONVQ = CW_CNT + 64 * 150;
__device__ __forceinline__ void xcd_barrier_work(const XcdBarrier& b, CP p, LAS unsigned char* lds, int a0, int e0, int a1, int e1, int flags) {
    asm volatile("s_waitcnt vmcnt(0)" ::: "memory");
    __syncthreads();
    unsigned gen = 0; bool leader = false;
    if (threadIdx.x == 0) {
        unsigned* bar = b.bar;
        __builtin_amdgcn_s_waitcnt(0);
        unsigned nloc = b.st[0], nx = b.st[1];
        if (nloc == 0u) { xcd_barrier_complete(bar, b.x, nloc, nx); b.st[0] = nloc; b.st[1] = nx; }
        const unsigned old = xb_add(&bar[XB_XSUB(b.x)], 1u);
        gen = old / nloc; leader = (old + 1u == (gen + 1u) * nloc);
        if (leader) {
            __builtin_amdgcn_fence(__ATOMIC_RELEASE, "agent");
            asm volatile("s_waitcnt vmcnt(0)" ::: "memory");
            const unsigned og = xb_add(&bar[XB_TOP], 1u);
            const unsigned tg = og / nx;
            if (og + 1u == (tg + 1u) * nx) xb_add(&bar[XB_TOPGEN], 1u);
            else XB_SPIN(xb_ld(&bar[XB_TOPGEN]) == tg, bar);
            __builtin_amdgcn_fence(__ATOMIC_ACQUIRE, "agent");
            xb_add(&bar[XB_XGEN(b.x)], 1u);
            asm volatile("s_waitcnt vmcnt(0)" ::: "memory");
        }
    }
    if (flags & 1) rope_table(p);
    transpose_items(p, lds, a0, e0);
    transpose_items(p, lds, a1, e1);
    if (flags & 2) {
        unsigned* q = (unsigned*)(p->ws + WS_CTL) + CW_CONVQ;
        volatile LAS unsigned* slot = (volatile LAS unsigned*)(lds + MISC_OFF + 1600);
        unsigned nxt = 0;
        if (threadIdx.x == 0) nxt = xb_add(q, 1u);
        for (;;) {
            if (threadIdx.x == 0) *slot = nxt;
            __syncthreads();
            const unsigned u = *slot;
            if (u >= 512u) break;
            if (threadIdx.x == 0) nxt = xb_add(q, 1u);
            conv_unit(p, lds, (int)u);
            __syncthreads();
        }
    }
    if (threadIdx.x == 0 && !leader) {
        unsigned* bar = b.bar;
        XB_SPIN(xb_ld(&bar[XB_XGEN(b.x)]) == gen, bar);
        __builtin_amdgcn_fence(__ATOMIC_ACQUIRE, "agent");
        asm volatile("s_waitcnt vmcnt(0)" ::: "memory");
    }
    __syncthreads();
}

__device__ __forceinline__ void phase1c(CP p, LAS unsigned char* lds) {
#ifndef SUBREP
#define SUBREP -1
#endif
#pragma unroll 1
    for (int r_ = 0; r_ < (SUBREP == 0 ? 2 : 1); ++r_)
    for (int u = blockIdx.x; u < 512; u += gridDim.x) q_item(p, lds, u);
#pragma unroll 1
    for (int r_ = 0; r_ < (SUBREP == 1 ? 2 : 1); ++r_)
    for (int u = blockIdx.x; u < 256; u += gridDim.x) kv_item(p, lds, u);
    __syncthreads();
    if (N_LAUNCH_SPLIT) { for (int u = blockIdx.x; u < 512; u += gridDim.x) conv_unit(p, lds, u); }
}

__device__ __forceinline__ int swap23(int r) { return (r & ~12) | ((r & 4) << 1) | ((r & 8) >> 1); }
constexpr int KROW = 208, VROW = 144, KBUF = 64 * KROW, VBUF = 64 * VROW, ABUF = KBUF + VBUF;
__device__ __forceinline__ void attn_unit(CP p, LAS unsigned char* lds, int bh, int qblk) {
    const int tid = threadIdx.x, lane = tid & 63, wid = __builtin_amdgcn_readfirstlane(tid >> 6), q = lane & 31, H = lane >> 5;
    unsigned char* ws = p->ws;
    const bf16_t* qg = (const bf16_t*)(ws + WS_Q) + (size_t)bh * 4096 * 96;
    const bf16_t* kg = (const bf16_t*)(ws + WS_K) + (size_t)bh * 4096 * 96;
    const bf16_t* vg = (const bf16_t*)(ws + WS_VT) + (size_t)bh * 64 * 4096;
    const int row0 = qblk * 256 + wid * 32, mychunk = 4 * qblk + (wid >> 1), NT = 4 * qblk + 4;
    bf16x8 qf[6];
#pragma unroll
    for (int s = 0; s < 6; ++s) qf[s] = *(const bf16x8*)(qg + (size_t)(row0 + q) * 96 + 16 * s + 8 * H);
    const int kr0 = tid / 12, kc0 = tid % 12, kr1 = (tid + 512) / 12, kc1 = (tid + 512) % 12, vd = tid >> 3, vc = tid & 7;
    const bool k1 = tid < 256;
    const bf16_t* ksrc0 = kg + (size_t)kr0 * 96 + kc0 * 8; const bf16_t* ksrc1 = kg + (size_t)kr1 * 96 + kc1 * 8; const bf16_t* vsrc = vg + (size_t)vd * 4096 + vc * 8;
    const int kdst0 = kr0 * KROW + kc0 * 16, kdst1 = kr1 * KROW + kc1 * 16, vdst = KBUF + vd * VROW + vc * 16;
    u32x4 rk0, rk1 = (u32x4){0, 0, 0, 0}, rv;
#define AT_LOAD(t) do { rk0 = *(const u32x4*)(ksrc0 + (size_t)(t) * 64 * 96); if (k1) rk1 = *(const u32x4*)(ksrc1 + (size_t)(t) * 64 * 96); rv = *(const u32x4*)(vsrc + (t) * 64); } while (0)
#define AT_WRITE(buf) do { LAS unsigned char* b_ = lds + (buf) * ABUF; *(LAS u32x4*)(b_ + kdst0) = rk0; if (k1) *(LAS u32x4*)(b_ + kdst1) = rk1; *(LAS u32x4*)(b_ + vdst) = rv; } while (0)
    AT_LOAD(0); AT_WRITE(0);
    __syncthreads();
    f32x16 o0 = {0}, o1 = {0};
    float mrun = -INFINITY, lsum = 0.f;
    const int koff = swap23(q) * KROW + 16 * H, voff = KBUF + q * VROW + 16 * H;
    for (int t = 0; t < NT; ++t) {
        if (t + 1 < NT) AT_LOAD(t + 1);
        if (t <= mychunk) {
            const LAS unsigned char* kb = lds + (t & 1) * ABUF + koff; const LAS unsigned char* vb = lds + (t & 1) * ABUF + voff;
            f32x16 s0 = {0}, s1 = {0};
#pragma unroll
            for (int s = 0; s < 6; ++s) {
                const bf16x8 a0 = *(const LAS bf16x8*)(kb + 32 * s), a1 = *(const LAS bf16x8*)(kb + 32 * KROW + 32 * s);
                s0 = __builtin_amdgcn_mfma_f32_32x32x16_bf16(a0, qf[s], s0, 0, 0, 0);
                s1 = __builtin_amdgcn_mfma_f32_32x32x16_bf16(a1, qf[s], s1, 0, 0, 0);
            }
            float mloc = s0[0];
#pragma unroll
            for (int r = 1; r < 16; ++r) mloc = fmaxf(mloc, s0[r]);
#pragma unroll
            for (int r = 0; r < 16; ++r) mloc = fmaxf(mloc, s1[r]);
            mloc = fmaxf(mloc, __shfl_xor(mloc, 32));
            const float mnew = fmaxf(mrun, mloc);
            const float alpha = __builtin_amdgcn_exp2f(mrun - mnew);
            mrun = mnew;
            float ps = 0.f;
#pragma unroll
            for (int r = 0; r < 16; ++r) { s0[r] = __builtin_amdgcn_exp2f(s0[r] - mnew); s1[r] = __builtin_amdgcn_exp2f(s1[r] - mnew); ps += s0[r] + s1[r]; }
            lsum = lsum * alpha + ps;
#pragma unroll
            for (int r = 0; r < 16; ++r) { o0[r] *= alpha; o1[r] *= alpha; }
            u32x4 pw[4];
            pw[0] = (u32x4){cvtpk(s0[0], s0[1]), cvtpk(s0[2], s0[3]), cvtpk(s0[4], s0[5]), cvtpk(s0[6], s0[7])};
            pw[1] = (u32x4){cvtpk(s0[8], s0[9]), cvtpk(s0[10], s0[11]), cvtpk(s0[12], s0[13]), cvtpk(s0[14], s0[15])};
            pw[2] = (u32x4){cvtpk(s1[0], s1[1]), cvtpk(s1[2], s1[3]), cvtpk(s1[4], s1[5]), cvtpk(s1[6], s1[7])};
            pw[3] = (u32x4){cvtpk(s1[8], s1[9]), cvtpk(s1[10], s1[11]), cvtpk(s1[12], s1[13]), cvtpk(s1[14], s1[15])};
#pragma unroll
            for (int ks = 0; ks < 4; ++ks) {
                const bf16x8 v0 = *(const LAS bf16x8*)(vb + 32 * ks), v1 = *(const LAS bf16x8*)(vb + 32 * VROW + 32 * ks);
                const bf16x8 pb = __builtin_bit_cast(bf16x8, pw[ks]);
                o0 = __builtin_amdgcn_mfma_f32_32x32x16_bf16(v0, pb, o0, 0, 0, 0);
                o1 = __builtin_amdgcn_mfma_f32_32x32x16_bf16(v1, pb, o1, 0, 0, 0);
            }
        }
        if (t + 1 < NT) AT_WRITE((t + 1) & 1);
        __syncthreads();
    }
#undef AT_LOAD
#undef AT_WRITE
    const float ltot = lsum + __shfl_xor(lsum, 32), inv = 1.0f / ltot;
    const int b = bh >> 3, hd = bh & 7;
    bf16_t* dst = (bf16_t*)(ws + WS_CAT) + ((size_t)b * 4096 + row0 + q) * 1024 + 512 + hd * 64;
#pragma unroll
    for (int g = 0; g < 4; ++g) {
        u32x2 w; w.x = cvtpk(o0[4 * g] * inv, o0[4 * g + 1] * inv); w.y = cvtpk(o0[4 * g + 2] * inv, o0[4 * g + 3] * inv); *(u32x2*)(dst + 8 * g + 4 * H) = w;
        w.x = cvtpk(o1[4 * g] * inv, o1[4 * g + 1] * inv); w.y = cvtpk(o1[4 * g + 2] * inv, o1[4 * g + 3] * inv); *(u32x2*)(dst + 32 + 8 * g + 4 * H) = w;
    }
}
constexpr int AF_NS = 6, AF_KB = 64 * 192, AF_STG = AF_KB + 64 * 128;
__device__ __forceinline__ void attn_unit_fast(CP p, LAS unsigned char* lds, int bh, int qblk) {
    const int tid = threadIdx.x, lane = tid & 63, wid = __builtin_amdgcn_readfirstlane(tid >> 6), q = lane & 31, H = lane >> 5;
    unsigned char* ws = p->ws;
    const bf16_t* qg = (const bf16_t*)(ws + WS_Q) + (size_t)bh * 4096 * 96;
    const bf16_t* kg = (const bf16_t*)(ws + WS_K) + (size_t)bh * 4096 * 96;
    const bf16_t* vg = (const bf16_t*)(ws + WS_VT) + (size_t)bh * 64 * 4096;
    const int row0 = qblk * 256 + wid * 32, mychunk = 4 * qblk + (wid >> 1), NT = 4 * qblk + 4;
    int ks0, ks1, vs0;
    { int P = wid * 64 + lane, r = P / 12, c = (P % 12) ^ ((r >> 2) & 3); ks0 = r * 96 + c * 8;
      P = (8 + (wid & 3)) * 64 + lane; r = P / 12; c = (P % 12) ^ ((r >> 2) & 3); ks1 = r * 96 + c * 8;
      P = wid * 64 + lane; r = P >> 3; c = (P & 7) ^ ((r >> 1) & 7); vs0 = r * 4096 + c * 8; }
    const bool two = wid < 4;
#define AF_ISSUE(u) do { const int u_ = (u) < NT ? (u) : NT - 1; LAS unsigned char* st_ = lds + ((u) % AF_NS) * AF_STG; \
        __builtin_amdgcn_global_load_lds((const unsigned*)(kg + (size_t)u_ * 64 * 96 + ks0), (LAS unsigned*)(st_ + wid * 1024), 16, 0, 0); \
        if (two) __builtin_amdgcn_global_load_lds((const unsigned*)(kg + (size_t)u_ * 64 * 96 + ks1), (LAS unsigned*)(st_ + (8 + wid) * 1024), 16, 0, 0); \
        __builtin_amdgcn_global_load_lds((const unsigned*)(vg + u_ * 64 + vs0), (LAS unsigned*)(st_ + AF_KB + wid * 1024), 16, 0, 0); } while (0)
#define AF_WAITBAR() do { if (two) asm volatile("s_waitcnt vmcnt(3)" ::: "memory"); else asm volatile("s_waitcnt vmcnt(2)" ::: "memory"); \
        asm volatile("s_waitcnt lgkmcnt(0)" ::: "memory"); __builtin_amdgcn_s_barrier(); asm volatile("" ::: "memory"); } while (0)
    static_assert(AF_NS == 6, "ring depth vs the issue / wait pattern below (one tile may stay in flight across a barrier)");
    const int pr = swap23(q), kx = (pr >> 2) & 3;
    const int kbe = pr * 192 + 16 * ((H ^ (kx & 1)) + 2 * (kx >> 1)), kbo = pr * 192 + 16 * ((H ^ (kx & 1)) + 2 * (1 ^ (kx >> 1)));
    const int vx = (q >> 1) & 7, vbase = AF_KB + q * 128 + 16 * (H ^ (vx & 1)), vxx = (vx >> 1) * 32;
    bf16x8 qf[6];
#pragma unroll
    for (int s = 0; s < 6; ++s) qf[s] = *(const bf16x8*)(qg + (size_t)(row0 + q) * 96 + 16 * s + 8 * H);
#define AF_QK(S0, S1, u) do { const LAS unsigned char* kb_ = lds + ((u) % AF_NS) * AF_STG; \
        { const bf16x8 a0_ = *(const LAS bf16x8*)(kb_ + kbe), a1_ = *(const LAS bf16x8*)(kb_ + kbe + 32 * 192); \
          S0 = __builtin_amdgcn_mfma_f32_32x32x16_bf16(a0_, qf[0], (f32x16){0.f, 0.f, 0.f, 0.f, 0.f, 0.f, 0.f, 0.f, 0.f, 0.f, 0.f, 0.f, 0.f, 0.f, 0.f, 0.f}, 0, 0, 0); \
          S1 = __builtin_amdgcn_mfma_f32_32x32x16_bf16(a1_, qf[0], (f32x16){0.f, 0.f, 0.f, 0.f, 0.f, 0.f, 0.f, 0.f, 0.f, 0.f, 0.f, 0.f, 0.f, 0.f, 0.f, 0.f}, 0, 0, 0); } \
        _Pragma("unroll") for (int s_ = 1; s_ < 6; ++s_) { const int o_ = ((s_ & 1) ? kbo : kbe) + 64 * (s_ >> 1); \
            const bf16x8 a0_ = *(const LAS bf16x8*)(kb_ + o_), a1_ = *(const LAS bf16x8*)(kb_ + o_ + 32 * 192); \
            S0 = __builtin_amdgcn_mfma_f32_32x32x16_bf16(a0_, qf[s_], S0, 0, 0, 0); \
            S1 = __builtin_amdgcn_mfma_f32_32x32x16_bf16(a1_, qf[s_], S1, 0, 0, 0); } } while (0)
    asm volatile("s_waitcnt vmcnt(0) lgkmcnt(0)" ::: "memory"); __builtin_amdgcn_s_barrier(); asm volatile("" ::: "memory");
    AF_ISSUE(0); AF_ISSUE(1); AF_ISSUE(2); AF_ISSUE(3);
    AF_WAITBAR();
    f32x16 o0 = {0}, o1 = {0}, c0, c1;
    float lsum = 0.f;
    AF_QK(c0, c1, 0);
#define AF_STEP(t, CA, CB, NA, NB) do { if ((t) <= mychunk) { \
            AF_QK(NA, NB, (t) + 1);                      \
            float ps = 0.f; \
            _Pragma("unroll") for (int r = 0; r < 16; ++r) { CA[r] = __builtin_amdgcn_exp2f(CA[r]); CB[r] = __builtin_amdgcn_exp2f(CB[r]); ps += CA[r] + CB[r]; } \
            lsum += ps; \
            u32x4 pw[4]; \
            pw[0] = (u32x4){cvtpk(CA[0], CA[1]), cvtpk(CA[2], CA[3]), cvtpk(CA[4], CA[5]), cvtpk(CA[6], CA[7])}; \
            pw[1] = (u32x4){cvtpk(CA[8], CA[9]), cvtpk(CA[10], CA[11]), cvtpk(CA[12], CA[13]), cvtpk(CA[14], CA[15])}; \
            pw[2] = (u32x4){cvtpk(CB[0], CB[1]), cvtpk(CB[2], CB[3]), cvtpk(CB[4], CB[5]), cvtpk(CB[6], CB[7])}; \
            pw[3] = (u32x4){cvtpk(CB[8], CB[9]), cvtpk(CB[10], CB[11]), cvtpk(CB[12], CB[13]), cvtpk(CB[14], CB[15])}; \
            const LAS unsigned char* vb = lds + ((t) % AF_NS) * AF_STG + vbase; \
            _Pragma("unroll") for (int ks = 0; ks < 4; ++ks) { \
                const int vo = (ks * 32) ^ vxx; \
                const bf16x8 v0 = *(const LAS bf16x8*)(vb + vo), v1 = *(const LAS bf16x8*)(vb + vo + 32 * 128); \
                const bf16x8 pb = __builtin_bit_cast(bf16x8, pw[ks]); \
                o0 = __builtin_amdgcn_mfma_f32_32x32x16_bf16(v0, pb, o0, 0, 0, 0); \
                o1 = __builtin_amdgcn_mfma_f32_32x32x16_bf16(v1, pb, o1, 0, 0, 0); } } } while (0)
    f32x16 d0, d1;
#pragma unroll 1
    for (int t = 0; t < NT; t += 2) {
        AF_ISSUE(t + 4); AF_ISSUE(t + 5);
        AF_STEP(t, c0, c1, d0, d1);
        AF_STEP(t + 1, d0, d1, c0, c1);
        AF_WAITBAR();
    }
#undef AF_STEP
#undef AF_ISSUE
#undef AF_WAITBAR
#undef AF_QK
    const float ltot = lsum + __shfl_xor(lsum, 32), inv = 1.0f / ltot;
    const int b = bh >> 3, hd = bh & 7;
    bf16_t* dst = (bf16_t*)(ws + WS_CAT) + ((size_t)b * 4096 + row0 + q) * 1024 + 512 + hd * 64;
#pragma unroll
    for (int g = 0; g < 4; ++g) {
        u32x2 w; w.x = cvtpk(o0[4 * g] * inv, o0[4 * g + 1] * inv); w.y = cvtpk(o0[4 * g + 2] * inv, o0[4 * g + 3] * inv); *(u32x2*)(dst + 8 * g + 4 * H) = w;
        w.x = cvtpk(o1[4 * g] * inv, o1[4 * g + 1] * inv); w.y = cvtpk(o1[4 * g + 2] * inv, o1[4 * g + 3] * inv); *(u32x2*)(dst + 32 + 8 * g + 4 * H) = w;
    }
}
__device__ __forceinline__ void attn_unit2(CP p, LAS unsigned char* lds, int bh, int QB) {
    int lane = threadIdx.x & 63; asm volatile("" : "+v"(lane));
    const int tid = threadIdx.x, wid = __builtin_amdgcn_readfirstlane(tid >> 6), q = lane & 31, H = lane >> 5;
    unsigned char* ws = p->ws;
    const bf16_t* qg = (const bf16_t*)(ws + WS_Q) + (size_t)bh * 4096 * 96;
    const bf16_t* kg = (const bf16_t*)(ws + WS_K) + (size_t)bh * 4096 * 96;
    const bf16_t* vg = (const bf16_t*)(ws + WS_VT) + (size_t)bh * 64 * 4096;
    const int rowA = QB * 512 + wid * 32, rowB = QB * 512 + (15 - wid) * 32;
    const int chA = 8 * QB + (wid >> 1), chB = 8 * QB + ((15 - wid) >> 1), NT = 8 * QB + 8;
    int ks0, ks1, vs0;
    { int P = wid * 64 + lane, r = P / 12, c = (P % 12) ^ ((r >> 2) & 3); ks0 = r * 96 + c * 8;
      P = (8 + (wid & 3)) * 64 + lane; r = P / 12; c = (P % 12) ^ ((r >> 2) & 3); ks1 = r * 96 + c * 8;
      P = wid * 64 + lane; r = P >> 3; c = (P & 7) ^ ((r >> 1) & 7); vs0 = r * 4096 + c * 8; }
    const bool two = wid < 4;
#define A2_ISSUE(u) do { const int u_ = (u) < NT ? (u) : NT - 1; LAS unsigned char* st_ = lds + ((u) % AF_NS) * AF_STG; \
        __builtin_amdgcn_global_load_lds((const unsigned*)(kg + (size_t)u_ * 64 * 96 + ks0), (LAS unsigned*)(st_ + wid * 1024), 16, 0, 0); \
        if (two) __builtin_amdgcn_global_load_lds((const unsigned*)(kg + (size_t)u_ * 64 * 96 + ks1), (LAS unsigned*)(st_ + (8 + wid) * 1024), 16, 0, 0); \
        __builtin_amdgcn_global_load_lds((const unsigned*)(vg + u_ * 64 + vs0), (LAS unsigned*)(st_ + AF_KB + wid * 1024), 16, 0, 0); } while (0)
#define A2_WAITBAR() do { if (two) asm volatile("s_waitcnt vmcnt(3)" ::: "memory"); else asm volatile("s_waitcnt vmcnt(2)" ::: "memory"); \
        asm volatile("s_waitcnt lgkmcnt(0)" ::: "memory"); __builtin_amdgcn_s_barrier(); asm volatile("" ::: "memory"); } while (0)
    const int pr = swap23(q), kx = (pr >> 2) & 3;
    const int kbe = pr * 192 + 16 * ((H ^ (kx & 1)) + 2 * (kx >> 1)), kbo = pr * 192 + 16 * ((H ^ (kx & 1)) + 2 * (1 ^ (kx >> 1)));
    const int vx = (q >> 1) & 7, vbase = AF_KB + q * 128 + 16 * (H ^ (vx & 1)), vxx = (vx >> 1) * 32;
    bf16x8 qa[6], qb[6];
#pragma unroll
    for (int s = 0; s < 6; ++s) { qa[s] = *(const bf16x8*)(qg + (size_t)(rowA + q) * 96 + 16 * s + 8 * H); qb[s] = *(const bf16x8*)(qg + (size_t)(rowB + q) * 96 + 16 * s + 8 * H); }
    asm volatile("s_waitcnt vmcnt(0) lgkmcnt(0)" ::: "memory"); __builtin_amdgcn_s_barrier(); asm volatile("" ::: "memory");
    A2_ISSUE(0); A2_ISSUE(1); A2_ISSUE(2); A2_ISSUE(3);
    A2_WAITBAR();
    f32x16 oa0 = {0}, oa1 = {0}, ob0 = {0}, ob1 = {0};
    float la = 0.f, lb = 0.f;
#define A2_ZERO (f32x16){0.f, 0.f, 0.f, 0.f, 0.f, 0.f, 0.f, 0.f, 0.f, 0.f, 0.f, 0.f, 0.f, 0.f, 0.f, 0.f}
#define A2_PACK2(PW, C) do { \
        PW[0] = (u32x4){cvtpk(C[0], C[1]), cvtpk(C[2], C[3]), cvtpk(C[4], C[5]), cvtpk(C[6], C[7])}; \
        PW[1] = (u32x4){cvtpk(C[8], C[9]), cvtpk(C[10], C[11]), cvtpk(C[12], C[13]), cvtpk(C[14], C[15])}; } while (0)
#define A2_HALF(t, hh) do { const LAS unsigned char* kb_ = lds + ((t) % AF_NS) * AF_STG + (hh) * (32 * 192); const LAS unsigned char* vb_ = lds + ((t) % AF_NS) * AF_STG + vbase; \
        if ((t) <= chB) {                                    \
            const bool both_ = (t) <= chA; \
            f32x16 sa = A2_ZERO, sb; \
            _Pragma("unroll") for (int s_ = 0; s_ < 6; ++s_) { const int o_ = ((s_ & 1) ? kbo : kbe) + 64 * (s_ >> 1); \
                const bf16x8 a_ = *(const LAS bf16x8*)(kb_ + o_); \
                sb = __builtin_amdgcn_mfma_f32_32x32x16_bf16(a_, qb[s_], s_ == 0 ? A2_ZERO : sb, 0, 0, 0); \
                if (both_) sa = __builtin_amdgcn_mfma_f32_32x32x16_bf16(a_, qa[s_], sa, 0, 0, 0); } \
            float pb = 0.f; \
            _Pragma("unroll") for (int r = 0; r < 16; ++r) { sb[r] = __builtin_amdgcn_exp2f(sb[r]); pb += sb[r]; } \
            lb += pb; \
            u32x4 pwa[2] = {(u32x4){0, 0, 0, 0}, (u32x4){0, 0, 0, 0}}, pwb[2]; A2_PACK2(pwb, sb); \
            if (both_) { float pa = 0.f; \
                _Pragma("unroll") for (int r = 0; r < 16; ++r) { sa[r] = __builtin_amdgcn_exp2f(sa[r]); pa += sa[r]; } \
                la += pa; A2_PACK2(pwa, sa); } \
            _Pragma("unroll") for (int k2 = 0; k2 < 2; ++k2) { const int vo = (((hh) * 2 + k2) * 32) ^ vxx; \
                const bf16x8 v0 = *(const LAS bf16x8*)(vb_ + vo), v1 = *(const LAS bf16x8*)(vb_ + vo + 32 * 128); \
                const bf16x8 xb = __builtin_bit_cast(bf16x8, pwb[k2]); \
                ob0 = __builtin_amdgcn_mfma_f32_32x32x16_bf16(v0, xb, ob0, 0, 0, 0); ob1 = __builtin_amdgcn_mfma_f32_32x32x16_bf16(v1, xb, ob1, 0, 0, 0); \
                if (both_) { const bf16x8 xa = __builtin_bit_cast(bf16x8, pwa[k2]); \
                    oa0 = __builtin_amdgcn_mfma_f32_32x32x16_bf16(v0, xa, oa0, 0, 0, 0); oa1 = __builtin_amdgcn_mfma_f32_32x32x16_bf16(v1, xa, oa1, 0, 0, 0); } } \
        } } while (0)
#define A2_STEP(t) do { A2_HALF(t, 0); __builtin_amdgcn_sched_barrier(0); A2_HALF(t, 1); __builtin_amdgcn_sched_barrier(0); } while (0)
#pragma unroll 1
    for (int t = 0; t < NT; t += 2) {
        A2_ISSUE(t + 4); A2_ISSUE(t + 5);
        A2_STEP(t);
        A2_STEP(t + 1);
        A2_WAITBAR();
    }
#undef A2_STEP
#undef A2_HALF
#undef A2_PACK2
#undef A2_ZERO
#undef A2_ISSUE
#undef A2_WAITBAR
    const int b = bh >> 3, hd = bh & 7;
    {
        const float ltot = la + __shfl_xor(la, 32), inv = 1.0f / ltot;
        bf16_t* dst = (bf16_t*)(ws + WS_CAT) + ((size_t)b * 4096 + rowA + q) * 1024 + 512 + hd * 64;
#pragma unroll
        for (int g = 0; g < 4; ++g) {
            u32x2 w; w.x = cvtpk(oa0[4 * g] * inv, oa0[4 * g + 1] * inv); w.y = cvtpk(oa0[4 * g + 2] * inv, oa0[4 * g + 3] * inv); *(u32x2*)(dst + 8 * g + 4 * H) = w;
            w.x = cvtpk(oa1[4 * g] * inv, oa1[4 * g + 1] * inv); w.y = cvtpk(oa1[4 * g + 2] * inv, oa1[4 * g + 3] * inv); *(u32x2*)(dst + 32 + 8 * g + 4 * H) = w;
        }
    }
    {
        const float ltot = lb + __shfl_xor(lb, 32), inv = 1.0f / ltot;
        bf16_t* dst = (bf16_t*)(ws + WS_CAT) + ((size_t)b * 4096 + rowB + q) * 1024 + 512 + hd * 64;
#pragma unroll
        for (int g = 0; g < 4; ++g) {
            u32x2 w; w.x = cvtpk(ob0[4 * g] * inv, ob0[4 * g + 1] * inv); w.y = cvtpk(ob0[4 * g + 2] * inv, ob0[4 * g + 3] * inv); *(u32x2*)(dst + 8 * g + 4 * H) = w;
            w.x = cvtpk(ob1[4 * g] * inv, ob1[4 * g + 1] * inv); w.y = cvtpk(ob1[4 * g + 2] * inv, ob1[4 * g + 3] * inv); *(u32x2*)(dst + 32 + 8 * g + 4 * H) = w;
        }
    }
}
__device__ __forceinline__ void phase2(CP p, LAS unsigned char* lds) {
    const int lane = threadIdx.x & 63;
    const float* qn = (const float*)p->in[15]; const float* kn = (const float*)p->in[16];
    float mq = 0.f, mk = 0.f;
    for (int j = lane; j < 96; j += 64) { mq = fmaxf(mq, fabsf(qn[j])); mk = fmaxf(mk, fabsf(kn[j])); }
#pragma unroll
    for (int o = 1; o < 64; o <<= 1) { mq = fmaxf(mq, __shfl_xor(mq, o)); mk = fmaxf(mk, __shfl_xor(mk, o)); }
    const float bound = 96.0f * mq * mk * QSCALE * 1.01f;
    if (bound <= 40.0f) {
        for (int u = vcu_id(); u < 256; u += gridDim.x) { const int bh = u >> 2, pr = u & 3; attn_unit2(p, lds, bh, 7 - pr); attn_unit2(p, lds, bh, pr); }
    } else {
        for (int u = vcu_id(); u < 512; u += gridDim.x) { const int bh = u >> 3, pr = u & 7; attn_unit(p, lds, bh, 15 - pr); attn_unit(p, lds, bh, pr); }
    }
    asm volatile("s_waitcnt vmcnt(0)" ::: "memory"); __syncthreads();
}

__device__ __forceinline__ void phase3(CP p, LAS unsigned char* lds) {
    const int tid = threadIdx.x, lane = tid & 63, wid = __builtin_amdgcn_readfirstlane(tid >> 6), wr = wid >> 2, wc = wid & 3, fr = lane & 15, fq = lane >> 4;
    unsigned char* ws = p->ws;
    const float* x = (const float*)p->in[0]; const float* mod = (const float*)(ws + WS_MOD); float* sq1 = (float*)(ws + WS_SSQ1);
    for (int u = vcu_id(); u < 512; u += gridDim.x) {
        const int pm = u >> 2, pn = u & 3;
        const bf16_t* ap[4]; const bf16_t* bp[4];
        stage_ptrs_dense<4>((const bf16_t*)(ws + WS_CAT), 1024, pm * 256, ap); stage_ptrs_dense<4>((const bf16_t*)(ws + WS_WOUT), 1024, pn * 256, bp);
        f32x4 acc[8][4];
#pragma unroll
        for (int m = 0; m < 8; ++m)
#pragma unroll
            for (int n = 0; n < 4; ++n) acc[m][n] = (f32x4){0.f, 0.f, 0.f, 0.f};
        gemm_block<8, 4, true>(lds, ap, bp, 16, acc);
        const int rowb = pm * 256 + wr * 128 + fr, b = (pm * 256) >> 12, colb = pn * 256 + wc * 64 + fq * 4;
        f32x4 ga[4];
#pragma unroll
        for (int n = 0; n < 4; ++n) ga[n] = *(const f32x4*)(mod + b * 6144 + 2048 + colb + n * 16);
#pragma unroll
        for (int mb = 0; mb < 8; mb += 4) {
            f32x4 xv[4][4];
#pragma unroll
            for (int m = 0; m < 4; ++m)
#pragma unroll
                for (int n = 0; n < 4; ++n) xv[m][n] = *(const f32x4*)(x + (size_t)(rowb + (mb + m) * 16) * DM + colb + n * 16);
#pragma unroll
            for (int m = 0; m < 4; ++m) { const size_t row = rowb + (mb + m) * 16; float s = 0.f;
#pragma unroll
                for (int n = 0; n < 4; ++n) { const f32x4 v = xv[m][n] + ga[n] * acc[mb + m][n];
                    *(f32x4*)(p->out + row * DM + colb + n * 16) = v; s += (v.x * v.x + v.y * v.y) + (v.z * v.z + v.w * v.w); }
                s += __shfl_xor(s, 16); s += __shfl_xor(s, 32);
                if (fq == 0) sq1[row * 16 + pn * 4 + wc] = s; }
        }
    }
}

constexpr int RROW = 2064;
__device__ __forceinline__ void phase3b(CP p, LAS unsigned char* lds, bool dry) {
    const int tid = threadIdx.x, lane = tid & 63, wave = __builtin_amdgcn_readfirstlane(tid >> 6), fr = lane & 15, fq = lane >> 4;
    unsigned char* ws = p->ws;
    const float* nf = (const float*)p->in[18]; const float* mod = (const float*)(ws + WS_MOD); const float* sq1 = (const float*)(ws + WS_SSQ1);
    const float* bg = (const float*)p->in[20]; const float* be = (const float*)p->in[22];
    bf16_t* h2 = (bf16_t*)(ws + WS_H); const bf16_t* wrh = (const bf16_t*)(ws + WS_WR); const bf16_t* wrl = wrh + 48 * 1024;
    LAS unsigned char* Ahi = lds; LAS unsigned char* Alo = lds + 32 * RROW; LAS float* part = (LAS float*)lds; LAS float* lg = (LAS float*)(lds + 8 * 32 * 48 * 4);
    unsigned* ctl = (unsigned*)(ws + WS_CTL); int* lists = (int*)(ws + WS_LIST); int* blists = (int*)(ws + WS_BLIST); float* tokw = (float*)(ws + WS_TOKW);
    bf16x8 Bh[3][4], Bl[3][4];
#pragma unroll
    for (int nt = 0; nt < 3; ++nt)
#pragma unroll
        for (int kk = 0; kk < 4; ++kk) { const size_t o = (size_t)(nt * 16 + fr) * 1024 + wave * 128 + kk * 32 + fq * 8; Bh[nt][kk] = *(const bf16x8*)(wrh + o); Bl[nt][kk] = *(const bf16x8*)(wrl + o); }
#pragma unroll 1
    for (int tile = blockIdx.x; tile < MT / 32; tile += gridDim.x) {
        const int r0 = tile * 32, b = r0 >> 12;
        {
            f32x4 gm[4], sh[4];
#pragma unroll
            for (int j = 0; j < 4; ++j) { const int col = 4 * lane + 256 * j; const f32x4 g = *(const f32x4*)(nf + col), s = *(const f32x4*)(mod + b * 6144 + 4096 + col);
                gm[j] = g * (s + 1.0f); sh[j] = *(const f32x4*)(mod + b * 6144 + 3072 + col); }
#pragma unroll
            for (int rb = 0; rb < 4; rb += 2) {
                f32x4 xr[2][4]; float rs[2];
#pragma unroll
                for (int rr = 0; rr < 2; ++rr) { const size_t row = r0 + wave * 4 + rb + rr; float ss = 0.f;
#pragma unroll
                    for (int k = 0; k < 4; ++k) { const f32x4 s4 = *(const f32x4*)(sq1 + row * 16 + 4 * k); ss += (s4.x + s4.y) + (s4.z + s4.w); }
                    rs[rr] = ss;
#pragma unroll
                    for (int j = 0; j < 4; ++j) xr[rr][j] = *(const f32x4*)(p->out + row * DM + 4 * lane + 256 * j); }
#pragma unroll
                for (int rr = 0; rr < 2; ++rr) {
                    const int lr = wave * 4 + rb + rr; const size_t row = r0 + lr;
                    const float rstd = __builtin_amdgcn_rsqf(rs[rr] * (1.0f / DM) + EPS);
#pragma unroll
                    for (int j = 0; j < 4; ++j) { const int col = 4 * lane + 256 * j; const f32x4 xv = xr[rr][j];
                        const f32x4 o = xv * rstd * gm[j] + sh[j];
                        u32x2 w; w.x = cvtpk(o.x, o.y); w.y = cvtpk(o.z, o.w);
                        *(u32x2*)(h2 + row * DM + col) = w; *(LAS u32x2*)(Ahi + lr * RROW + col * 2) = w;
                        const float lx = o.x - __builtin_bit_cast(float, w.x << 16), ly = o.y - __builtin_bit_cast(float, w.x & 0xffff0000u), lz = o.z - __builtin_bit_cast(float, w.y << 16), lw = o.w - __builtin_bit_cast(float, w.y & 0xffff0000u);
                        u32x2 wl; wl.x = cvtpk(lx, ly); wl.y = cvtpk(lz, lw); *(LAS u32x2*)(Alo + lr * RROW + col * 2) = wl; }
                }
            }
        }
        __syncthreads();
        f32x4 P[2][3];
#pragma unroll
        for (int mt = 0; mt < 2; ++mt)
#pragma unroll
            for (int nt = 0; nt < 3; ++nt) P[mt][nt] = (f32x4){0.f, 0.f, 0.f, 0.f};
#pragma unroll
        for (int mt = 0; mt < 2; ++mt)
#pragma unroll
            for (int kk = 0; kk < 4; ++kk) {
                const int ao = (mt * 16 + fr) * RROW + (wave * 128 + kk * 32 + fq * 8) * 2;
                const bf16x8 a_h = *(const LAS bf16x8*)(Ahi + ao), a_l = *(const LAS bf16x8*)(Alo + ao);
#pragma unroll
                for (int nt = 0; nt < 3; ++nt) {
                    P[mt][nt] = __builtin_amdgcn_mfma_f32_16x16x32_bf16(a_h, Bh[nt][kk], P[mt][nt], 0, 0, 0);
                    P[mt][nt] = __builtin_amdgcn_mfma_f32_16x16x32_bf16(a_l, Bh[nt][kk], P[mt][nt], 0, 0, 0);
                    P[mt][nt] = __builtin_amdgcn_mfma_f32_16x16x32_bf16(a_h, Bl[nt][kk], P[mt][nt], 0, 0, 0);
                }
            }
        __syncthreads();
#pragma unroll
        for (int mt = 0; mt < 2; ++mt)
#pragma unroll
            for (int nt = 0; nt < 3; ++nt)
#pragma unroll
                for (int j = 0; j < 4; ++j) part[(wave * 32 + mt * 16 + fq * 4 + j) * 48 + nt * 16 + fr] = P[mt][nt][j];
        __syncthreads();
#pragma unroll
        for (int i = 0; i < 3; ++i) { const int idx = tid + 512 * i; float v = 0.f;
#pragma unroll
            for (int w8 = 0; w8 < 8; ++w8) v += part[w8 * 1536 + idx];
            lg[idx] = v; }
        __syncthreads();
        if (tid < 32 && !dry) {
            const LAS float* l = lg + tid * 48; const int tok = r0 + tid;
            float gl[4]; int gi = 0; float gmx;
#pragma unroll
            for (int i = 0; i < 4; ++i) gl[i] = l[i] + bg[i];
            gmx = gl[0];
#pragma unroll
            for (int i = 1; i < 4; ++i) if (gl[i] > gmx) { gmx = gl[i]; gi = i; }
            float gs = 0.f;
#pragma unroll
            for (int i = 0; i < 4; ++i) gs += __expf(gl[i] - gmx);
            const float gtop = 1.0f / gs;
            float el[8];
#pragma unroll
            for (int i = 0; i < 8; ++i) el[i] = l[4 + gi * 8 + i] + be[gi * 8 + i];
            int e1 = 0; float m1 = el[0];
#pragma unroll
            for (int i = 1; i < 8; ++i) if (el[i] > m1) { m1 = el[i]; e1 = i; }
            int e2 = -1; float m2 = -INFINITY;
#pragma unroll
            for (int i = 0; i < 8; ++i) if (i != e1 && el[i] > m2) { m2 = el[i]; e2 = i; }
            const float p2 = __expf(m2 - m1);
            const float w1 = gtop / (1.0f + p2), w2 = gtop * p2 / (1.0f + p2);
            const int lo = e1 < e2 ? e1 : e2, hi = e1 < e2 ? e2 : e1;
            const float wlo = e1 < e2 ? w1 : w2, whi = e1 < e2 ? w2 : w1;
            const int bk = gi * 28 + lo * 8 - ((lo * (lo + 1)) >> 1) + (hi - lo - 1);
            const int El = gi * 8 + lo, Eh = gi * 8 + hi;
            const unsigned p1 = atomicAdd(ctl + CW_CNT + 64 * El, 1u), pp2 = atomicAdd(ctl + CW_CNT + 64 * Eh, 1u), p3 = atomicAdd(ctl + CW_CNT + 64 * (32 + bk), 1u);
            lists[(size_t)El * MT + p1] = tok * 2; lists[(size_t)Eh * MT + pp2] = tok * 2 + 1;
            blists[(size_t)bk * MT + p3] = tok;
            tokw[tok * 2] = wlo; tokw[tok * 2 + 1] = whi;
        }
        __syncthreads();
    }
}

struct U4a { int e, rt, ct, cnt; };
__device__ __forceinline__ int prefix_find(const LAS unsigned* pre, int n, int u) {
    const int lane = threadIdx.x & 63; int res = -1;
    for (int b0 = 0; b0 < n; b0 += 64) { const int i = b0 + lane; const bool hit = i < n && (int)pre[i] <= u && u < (int)pre[i + 1];
        const unsigned long long m = __ballot(hit); if (m) { res = b0 + __builtin_ctzll(m); break; } }
    return res;
}
__device__ __forceinline__ bool p4a_find(const LAS unsigned* cnts, const LAS unsigned* pre, int u, U4a& r) {
    const int i = prefix_find(pre, 32, u); if (i < 0) return false;
    const int uu = u - (int)pre[i]; r.e = i; r.rt = uu >> 1; r.ct = uu & 1; r.cnt = (int)cnts[i]; return true;
}
template <int MI, int NI>
__device__ __forceinline__ void p4a_ptrs(CP p, int e, int row0, int cnt, int col0, const bf16_t* (&ap)[MI / 2], const bf16_t* (&bp)[NI]) {
    const int tid = threadIdx.x, lane = tid & 63;
    const int* lst = (const int*)(p->ws + WS_LIST) + (size_t)e * MT + row0; const int nrow = cnt - row0;
    const bf16_t* h2 = (const bf16_t*)(p->ws + WS_H);
    int tok[MI / 2], C[MI / 2];
#pragma unroll
    for (int i = 0; i < MI / 2; ++i) { int R; stage_rc2((tid >> 6) * 1024 + i * 8192 + lane * 16, R, C[i]); tok[i] = lst[R < nrow ? R : 0] >> 1; }
#pragma unroll
    for (int i = 0; i < MI / 2; ++i) ap[i] = h2 + (size_t)tok[i] * 1024 + C[i];
    stage_ptrs_dense<NI>((const bf16_t*)(p->ws + WS_WGU) + (size_t)e * 512 * 1024, 1024, col0, bp);
}
template <int MI, int NI>
__device__ __forceinline__ void p4a_epilogue(CP p, int e, int row0, int cnt, int col0, const f32x4 (&acc)[MI][NI]) {
    const int tid = threadIdx.x, lane = tid & 63, wid = __builtin_amdgcn_readfirstlane(tid >> 6), wr = wid >> 2, wc = wid & 3, fr = lane & 15, fq = lane >> 4;
    unsigned char* ws = p->ws;
    const float* tokw = (const float*)(ws + WS_TOKW); bf16_t* ab = (bf16_t*)(ws + WS_ABUF);
    const int* lst = (const int*)(ws + WS_LIST) + (size_t)e * MT + row0; const int nrow = cnt - row0;
    int ent[MI]; float w[MI];
#pragma unroll
    for (int m = 0; m < MI; ++m) { const int R = wr * (MI * 16) + m * 16 + fr; ent[m] = lst[R < nrow ? R : 0]; }
#pragma unroll
    for (int m = 0; m < MI; ++m) w[m] = tokw[ent[m]];
#pragma unroll
    for (int m = 0; m < MI; ++m) { const int R = wr * (MI * 16) + m * 16 + fr; const float wm = w[m];
#pragma unroll
        for (int h = 0; h < NI / 2; ++h) { const f32x4 g = acc[m][2 * h], uu = acc[m][2 * h + 1];
            const int np = col0 + wc * (NI * 16) + h * 32 + fq * 4, ch = (np >> 8) * 128 + ((np >> 6) & 3) * 32 + ((np >> 5) & 1) * 16 + (np & 15);
            u32x2 o; o.x = cvtpk(g.x * __builtin_amdgcn_rcpf(1.0f + __expf(-g.x)) * uu.x * wm, g.y * __builtin_amdgcn_rcpf(1.0f + __expf(-g.y)) * uu.y * wm);
            o.y = cvtpk(g.z * __builtin_amdgcn_rcpf(1.0f + __expf(-g.z)) * uu.z * wm, g.w * __builtin_amdgcn_rcpf(1.0f + __expf(-g.w)) * uu.w * wm);
            if (R < nrow) *(u32x2*)(ab + (size_t)ent[m] * 256 + ch) = o; } }
}
__device__ __forceinline__ void phase4a(CP p, LAS unsigned char* lds, const LAS unsigned* cnts, const LAS unsigned* pre) {
    const int G = gridDim.x, v = vcu_id();
    const int U = (int)pre[32], F = U - U % G;
    {
        int u = v; U4a cur;
        if (u < F && p4a_find(cnts, pre, u, cur)) {
            const bf16_t* ap[4]; const bf16_t* bp[4];
            p4a_ptrs<8, 4>(p, cur.e, cur.rt * 256, cur.cnt, cur.ct * 256, ap, bp);
            __syncthreads();
            gemm_stage<8, 4, false>(lds, 0, ap, bp, 0, 0);
            for (;;) {
                f32x4 acc[8][4];
#pragma unroll
                for (int m = 0; m < 8; ++m)
#pragma unroll
                    for (int n = 0; n < 4; ++n) acc[m][n] = (f32x4){0.f, 0.f, 0.f, 0.f};
                gemm_main<8, 4, true, false>(lds, 0, ap, bp, 16, acc);
                U4a nxt; u += G; const bool has_next = u < F && p4a_find(cnts, pre, u, nxt);
                if (has_next) { p4a_ptrs<8, 4>(p, nxt.e, nxt.rt * 256, nxt.cnt, nxt.ct * 256, ap, bp); gemm_stage<8, 4, false>(lds, 0, ap, bp, 0, 0); }
                p4a_epilogue<8, 4>(p, cur.e, cur.rt * 256, cur.cnt, cur.ct * 256, acc);
                if (!has_next) break;
                cur = nxt;
                stage_ptrs_dense<4>((const bf16_t*)(p->ws + WS_WGU) + (size_t)cur.e * 512 * 1024, 1024, cur.ct * 256, bp);
            }
        }
    }
    asm volatile("s_waitcnt vmcnt(0)" ::: "memory"); __syncthreads();
#pragma unroll 1
    for (int sv = v; sv < 4 * (U - F); sv += G) {
        U4a t; if (!p4a_find(cnts, pre, F + (sv >> 2), t)) break;
        const int row0 = t.rt * 256 + ((sv >> 1) & 1) * 128, col0 = t.ct * 256 + (sv & 1) * 128;
        if (row0 < t.cnt) {
            const bf16_t* ap[2]; const bf16_t* bp[2];
            p4a_ptrs<4, 2>(p, t.e, row0, t.cnt, col0, ap, bp);
            __syncthreads();
            gemm_stage<4, 2, false>(lds, 0, ap, bp, 0, 0);
            f32x4 acc[4][2];
#pragma unroll
            for (int m = 0; m < 4; ++m)
#pragma unroll
                for (int n = 0; n < 2; ++n) acc[m][n] = (f32x4){0.f, 0.f, 0.f, 0.f};
            gemm_main<4, 2, true, false>(lds, 0, ap, bp, 16, acc);
            p4a_epilogue<4, 2>(p, t.e, row0, t.cnt, col0, acc);
        }
    }
    asm volatile("s_waitcnt vmcnt(0)" ::: "memory"); __syncthreads();
}
struct U4b { int bk, rt, ct, cnt; };
__device__ __forceinline__ bool p4b_find(const LAS unsigned* cnts, const LAS unsigned* pre, int u, U4b& r) {
    const int i = prefix_find(pre + 33, 112, u); if (i < 0) return false;
    const int uu = u - (int)pre[33 + i]; r.bk = i; r.rt = uu >> 2; r.ct = uu & 3; r.cnt = (int)cnts[32 + i]; return true;
}
__device__ __forceinline__ void p4b_ptrs(CP p, const U4b& u, const bf16_t* (&ap)[2], const bf16_t* (&bp)[4], const bf16_t* (&bq)[4]) {
    const int tid = threadIdx.x, lane = tid & 63;
    const int g = u.bk / 28; int pi = u.bk % 28, lo = 0; while (pi >= 7 - lo) { pi -= 7 - lo; ++lo; } const int hi = lo + 1 + pi;
    const int* lst = (const int*)(p->ws + WS_BLIST) + (size_t)u.bk * MT + u.rt * 128; const int nrow = u.cnt - u.rt * 128;
    const bf16_t* ab = (const bf16_t*)(p->ws + WS_ABUF);
#pragma unroll
    for (int i = 0; i < 2; ++i) { int R, C; stage_rc2((tid >> 6) * 1024 + i * 8192 + lane * 16, R, C); const int tok = lst[R < nrow ? R : 0]; ap[i] = ab + (size_t)tok * 512 + C; }
    stage_ptrs_dense<4>((const bf16_t*)(p->ws + WS_WD) + (size_t)(g * 8 + lo) * 1024 * 256, 256, u.ct * 256, bp);
    stage_ptrs_dense<4>((const bf16_t*)(p->ws + WS_WD) + (size_t)(g * 8 + hi) * 1024 * 256, 256, u.ct * 256, bq);
#pragma unroll
    for (int i = 0; i < 4; ++i) bq[i] -= 256;
}
__device__ __forceinline__ void phase4b(CP p, LAS unsigned char* lds, const LAS unsigned* cnts, const LAS unsigned* pre) {
    const int tid = threadIdx.x, lane = tid & 63, wid = __builtin_amdgcn_readfirstlane(tid >> 6), wr = wid >> 2, wc = wid & 3, fr = lane & 15, fq = lane >> 4;
    unsigned char* ws = p->ws;
    const float* mod = (const float*)(ws + WS_MOD); float* out = p->out;
    int u = vcu_id(); U4b cur;
    if (!p4b_find(cnts, pre, u, cur)) return;
    const bf16_t* ap[2]; const bf16_t* bp[4]; const bf16_t* bq[4];
    p4b_ptrs(p, cur, ap, bp, bq);
    int tok[4];
    { const int* lst = (const int*)(ws + WS_BLIST) + (size_t)cur.bk * MT + cur.rt * 128; const int nrow = cur.cnt - cur.rt * 128;
#pragma unroll
      for (int m = 0; m < 4; ++m) { const int R = wr * 64 + m * 16 + fr; tok[m] = lst[R < nrow ? R : 0]; } }
    __syncthreads();
    gemm_stage<4, 4, false>(lds, 0, ap, bp, 0, 0);
    for (;;) {
        const int colb = cur.ct * 256 + wc * 64 + fq * 4; const int nrow = cur.cnt - cur.rt * 128;
        f32x4 old[4][4];
#pragma unroll
        for (int m = 0; m < 4; ++m)
#pragma unroll
            for (int n = 0; n < 4; ++n) old[m][n] = *(const f32x4*)(out + (size_t)tok[m] * DM + colb + n * 16);
        f32x4 acc[4][4];
#pragma unroll
        for (int m = 0; m < 4; ++m)
#pragma unroll
            for (int n = 0; n < 4; ++n) acc[m][n] = (f32x4){0.f, 0.f, 0.f, 0.f};
        gemm_main2<4, 4, true, false>(lds, 0, ap, bp, bq, 4, 8, acc);
        U4b nxt; u += gridDim.x; const bool has_next = p4b_find(cnts, pre, u, nxt);
        int tokn[4] = {0, 0, 0, 0};
        if (has_next) { p4b_ptrs(p, nxt, ap, bp, bq); gemm_stage<4, 4, false>(lds, 0, ap, bp, 0, 0);
            const int* lst = (const int*)(ws + WS_BLIST) + (size_t)nxt.bk * MT + nxt.rt * 128; const int nr2 = nxt.cnt - nxt.rt * 128;
#pragma unroll
            for (int m = 0; m < 4; ++m) { const int R = wr * 64 + m * 16 + fr; tokn[m] = lst[R < nr2 ? R : 0]; } }
#pragma unroll
        for (int m = 0; m < 4; ++m) { const int R = wr * 64 + m * 16 + fr; const int b = tok[m] >> 12;
#pragma unroll
            for (int n = 0; n < 4; ++n) { const f32x4 gf = *(const f32x4*)(mod + b * 6144 + 5120 + colb + n * 16);
                const f32x4 o = old[m][n] + gf * acc[m][n]; if (R < nrow) *(f32x4*)(out + (size_t)tok[m] * DM + colb + n * 16) = o; } }
        if (!has_next) break;
        cur = nxt;
#pragma unroll
        for (int m = 0; m < 4; ++m) tok[m] = tokn[m];
    }
    asm volatile("s_waitcnt vmcnt(0)" ::: "memory"); __syncthreads();
}

__global__ void __launch_bounds__(512, 2) hybrid_block_fwd(Params p) {
    extern __shared__ __attribute__((aligned(16))) unsigned char lds_raw[];
    LAS unsigned char* lds = (LAS unsigned char*)lds_raw;
    volatile LAS unsigned* MISC = (volatile LAS unsigned*)(lds + MISC_OFF);
    LAS unsigned* cnts = (LAS unsigned*)(lds + MISC_OFF + 256);
    const int tid = threadIdx.x;
    if (tid < 16) MISC[tid] = 0u;
    __syncthreads();
    unsigned* ctl = (unsigned*)(p.ws + WS_CTL);
    const bool single = (p.ph_hi - p.ph_lo) > 1;
    XcdBarrier bar; bar.bar = ctl + CW_BAR; bar.x = 0; bar.st = nullptr;
    if (single) bar = xcd_barrier_post(ctl + CW_BAR, MISC + 8);
#ifndef PH_MASK
#define PH_MASK 0x1ff
#endif
#define IN(k) (((PH_MASK >> (k)) & 1) && p.ph_lo <= (k) && (k) < p.ph_hi)
#define SEAM(k) do { if (IN(k) && IN((k) + 1)) xcd_barrier(bar); } while (0)
    constexpr int T0 = TR_EARLY, T1 = T0 + TR_I3 + 1024, T2 = T1 + 1536, T3 = T0 + TR_I3 + TR_I4, T4 = T3 + 1024, T5 = T3 + TR_I5;
#define SEAM_W(k, a0, e0, a1, e1, fl) do { if (IN(k) && IN((k) + 1)) { if (N_LAUNCH_SPLIT) xcd_barrier(bar); else xcd_barrier_work(bar, get_params(), lds, a0, e0, a1, e1, fl); } } while (0)
#ifndef REPEAT_PH
#define REPEAT_PH -1
#endif
#define NREP(k) ((REPEAT_PH == (k)) ? 2 : 1)
    if (IN(0)) { for (int r_ = 0; r_ < NREP(0); ++r_) phase0(get_params(), lds); } SEAM_W(0, 0, T0, 0, 0, 1);
    if (IN(1)) { for (int r_ = 0; r_ < NREP(1); ++r_) phase1a(get_params()); } SEAM_W(1, T0, T1, 0, 0, 0);
    if (IN(2)) { for (int r_ = 0; r_ < NREP(2); ++r_) phase1b(get_params(), lds); } SEAM_W(2, T1, T2, 0, 0, 0);
    if (IN(3)) { for (int r_ = 0; r_ < NREP(3); ++r_) phase1c(get_params(), lds); } SEAM_W(3, 0, 0, 0, 0, 2);
    if (IN(4)) { for (int r_ = 0; r_ < NREP(4); ++r_) phase2(get_params(), lds); } SEAM_W(4, T2, T3, T5, TR_NIT, 0);
    if (IN(5)) { for (int r_ = 0; r_ < NREP(5); ++r_) phase3(get_params(), lds); } SEAM_W(5, T3, T4, 0, 0, 0);
    if (IN(6)) { for (int r_ = 0; r_ < NREP(6); ++r_) phase3b(get_params(), lds, r_ + 1 < NREP(6)); } SEAM_W(6, T4, T5, 0, 0, 0);
    LAS unsigned* pre = (LAS unsigned*)(lds + MISC_OFF + 256 + 640);
    if (IN(7) || IN(8)) {
        if (tid < 144) cnts[tid] = __hip_atomic_load(ctl + CW_CNT + 64 * tid, __ATOMIC_RELAXED, __HIP_MEMORY_SCOPE_AGENT);
        __syncthreads();
        if (tid == 0) { unsigned a = 0; for (int i = 0; i < 32; ++i) { pre[i] = a; a += ((cnts[i] + 255u) >> 8) * 2u; } pre[32] = a;
                        a = 0; for (int i = 0; i < 112; ++i) { pre[33 + i] = a; a += ((cnts[32 + i] + 127u) >> 7) * 4u; } pre[33 + 112] = a; }
        __syncthreads();
    }
    if (IN(7)) { for (int r_ = 0; r_ < NREP(7); ++r_) phase4a(get_params(), lds, cnts, pre); } SEAM(7);
    if (IN(8)) { phase4b(get_params(), lds, cnts, pre); }
#undef IN
#undef SEAM
}

extern "C" void kernel_launch(void* const* d_in, const int* in_sizes, int n_in, void* d_out, int out_size, void* d_ws, size_t ws_size, hipStream_t stream) {
    static int grid = 0;
    if (grid == 0) {
        if (n_in != 26 || out_size != MT * DM || ws_size < WS_END) { fprintf(stderr, "kernel_launch: unexpected problem (n_in %d out %d ws %zu)\n", n_in, out_size, ws_size); grid = -1; return; }
        int dev = 0, cus = 0, per_cu = 0;
        hipGetDevice(&dev); hipDeviceGetAttribute(&cus, hipDeviceAttributeMultiprocessorCount, dev);
        hipFuncSetAttribute((const void*)hybrid_block_fwd, hipFuncAttributeMaxDynamicSharedMemorySize, LDS_BYTES);
        hipOccupancyMaxActiveBlocksPerMultiprocessor(&per_cu, (const void*)hybrid_block_fwd, 512, LDS_BYTES);
        (void)hipGetLastError();
        if (per_cu < 1) { fprintf(stderr, "kernel_launch: occupancy query says %d blocks/CU\n", per_cu); per_cu = 1; }
        grid = cus;
    }
    if (grid < 0) return;
    hipMemsetAsync((char*)d_ws + WS_CTL, 0, CTL_BYTES, stream);
    Params prm{};
    for (int i = 0; i < 26; ++i) prm.in[i] = d_in[i];
    prm.out = (float*)d_out; prm.ws = (unsigned char*)d_ws;
#if N_LAUNCH_SPLIT
    for (int ph = 0; ph <= DBG_LAST_PHASE; ++ph) { prm.ph_lo = ph; prm.ph_hi = ph + 1; hipLaunchKernelGGL(hybrid_block_fwd, dim3(grid), dim3(512), LDS_BYTES, stream, prm); }
#else
    prm.ph_lo = 0; prm.ph_hi = DBG_LAST_PHASE + 1;
    hipLaunchKernelGGL(hybrid_block_fwd, dim3(grid), dim3(512), LDS_BYTES, stream, prm);
#endif
}
```

```cpp
#include <hip/hip_runtime.h>
#include <cstdio>
#include <cstdint>
#include <utility>

#ifndef N_LAUNCH_SPLIT
#define N_LAUNCH_SPLIT 0
#endif
#ifndef DBG_LAST_PHASE
#define DBG_LAST_PHASE 8
#endif

#define LAS __attribute__((address_space(3)))
#define GAS __attribute__((address_space(1)))
typedef unsigned short bf16_t;
typedef short bf16x8 __attribute__((ext_vector_type(8)));
typedef float f32x4 __attribute__((ext_vector_type(4)));
typedef float f32x2 __attribute__((ext_vector_type(2)));
typedef float f32x16 __attribute__((ext_vector_type(16)));
typedef unsigned u32x4 __attribute__((ext_vector_type(4)));
typedef unsigned u32x2 __attribute__((ext_vector_type(2)));
typedef __bf16 bf16x2_t __attribute__((ext_vector_type(2)));

constexpr int NB = 8, SEQ = 4096, DM = 1024, MT = NB * SEQ;
constexpr int NHEAD = 8, DQK = 96, DV = 64;
constexpr int NEXP = 32;
constexpr float EPS = 1e-6f;
constexpr float QSCALE = 0.14724444602590306f;
constexpr int NPH = 9;

constexpr size_t MiB = 1u << 20;
constexpr size_t WS_CTL = 0, CTL_BYTES = 128 * 1024;
constexpr size_t WS_MOD = 1 * MiB;
constexpr size_t WS_ROPE = 2 * MiB;
constexpr size_t WS_WIN = 6 * MiB;
constexpr size_t WS_WQ = 9 * MiB;
constexpr size_t WS_WKV = 9 * MiB + 512 * 1024;
constexpr size_t WS_WR = 9 * MiB + 768 * 1024;
constexpr size_t WS_WOUT = 10 * MiB;
constexpr size_t WS_WGU = 12 * MiB;
constexpr size_t WS_WD = 44 * MiB;
constexpr size_t WS_SSQQ = 60 * MiB;
constexpr size_t WS_SSQKV = 60 * MiB + 512 * 1024;
constexpr size_t WS_SSQKR = 60 * MiB + 768 * 1024;
constexpr size_t WS_SSQ1 = 61 * MiB;
constexpr size_t WS_TOKW = 63 * MiB;
constexpr size_t WS_KROPE = 64 * MiB;
constexpr size_t WS_CQ = 68 * MiB;
constexpr size_t WS_CKV = 84 * MiB;
constexpr size_t WS_LIST = 92 * MiB;
constexpr size_t WS_H = 100 * MiB;
constexpr size_t WS_U = 164 * MiB;
constexpr size_t WS_Q = 196 * MiB;
constexpr size_t WS_K = 244 * MiB;
constexpr size_t WS_VT = 292 * MiB;
constexpr size_t WS_CAT = 324 * MiB;
constexpr size_t WS_ABUF = 388 * MiB;
constexpr size_t WS_BLIST = 420 * MiB;
constexpr size_t WS_END = 435 * MiB;
constexpr int CW_BAR = 4096;
constexpr int CW_CNT = 16384;

constexpr int SCR_BYTES = 155648;
constexpr int MISC_OFF = SCR_BYTES;
constexpr int LDS_BYTES = SCR_BYTES + 2048;

__device__ __forceinline__ unsigned cvtpk(float lo, float hi) { f32x2 v = {lo, hi}; bf16x2_t b = __builtin_convertvector(v, bf16x2_t); return __builtin_bit_cast(unsigned, b); }
__device__ __forceinline__ float bf2f(unsigned short h) { return __builtin_bit_cast(float, (unsigned)h << 16); }
__device__ __forceinline__ unsigned short f2bf(float f) { return (unsigned short)(cvtpk(f, 0.f) & 0xffffu); }
__device__ __forceinline__ float sigmoidf_(float x) { return __builtin_amdgcn_rcpf(1.0f + __expf(-x)); }
__device__ __forceinline__ float siluf_(float x) { return x * __builtin_amdgcn_rcpf(1.0f + __expf(-x)); }
__device__ __forceinline__ float wave_sum(float v) {
#pragma unroll
    for (int o = 1; o < 64; o <<= 1) v += __shfl_xor(v, o);
    return v;
}

__device__ __forceinline__ int vcu_id() { const int g = gridDim.x, b = blockIdx.x; return (g & 7) == 0 ? (b & 7) * (g >> 3) + (b >> 3) : b; }
#define XB_TMO      128
#define XB_XCNT(j)  (256  + 64 * (j))
#define XB_XSUB(j)  (1280 + 64 * (j))
#define XB_XGEN(j)  (2304 + 64 * (j))
#define XB_TOP      3328
#define XB_TOPGEN   3392
#define XCD_BAR_WORDS 3456
#define XB_SPIN_CAP (1u << 20)
__device__ __forceinline__ unsigned xb_ld(unsigned* p)              { return __hip_atomic_load(p, __ATOMIC_RELAXED, __HIP_MEMORY_SCOPE_AGENT); }
__device__ __forceinline__ unsigned xb_add(unsigned* p, unsigned v) { return __hip_atomic_fetch_add(p, v, __ATOMIC_RELAXED, __HIP_MEMORY_SCOPE_AGENT); }
__device__ __forceinline__ unsigned xb_xcc_id() { return (unsigned)__builtin_amdgcn_s_getreg((3 << 11) | 20) & 0xFu; }
#define XB_SPIN(cond, bar) do { unsigned _sp = 0; while (cond) { __builtin_amdgcn_s_sleep(1); \
    if ((++_sp & 255u) == 0u) { if (xb_ld(&(bar)[XB_TMO])) break; if (_sp > XB_SPIN_CAP) { atomicAdd(&(bar)[XB_TMO], 1u); break; } } } } while (0)
struct XcdBarrier { unsigned* bar; unsigned x; volatile LAS unsigned* st; };
__device__ __forceinline__ XcdBarrier xcd_barrier_post(unsigned* bar, volatile LAS unsigned* st) {
    XcdBarrier b; b.bar = bar; b.x = xb_xcc_id(); b.st = st;
    if (threadIdx.x == 0) (void)xb_add(&bar[XB_XCNT(b.x)], 1u);
    return b;
}
__device__ __forceinline__ void xcd_barrier_complete(unsigned* bar, unsigned x, unsigned& nloc, unsigned& nx) {
    const unsigned G = gridDim.x * gridDim.y * gridDim.z;
    unsigned sum, cnt, mine, sp = 0u;
    for (;;) {
        sum = 0u; cnt = 0u; mine = 0u;
#pragma unroll
        for (unsigned j = 0; j < 16; ++j) { const unsigned c = xb_ld(&bar[XB_XCNT(j)]); sum += c; cnt += (c > 0u) ? 1u : 0u; mine = (j == x) ? c : mine; }
        if (sum == G) break;
        __builtin_amdgcn_s_sleep(1);
        if ((++sp & 255u) == 0u) { if (xb_ld(&bar[XB_TMO])) break; if (sp > XB_SPIN_CAP) { atomicAdd(&bar[XB_TMO], 1u); break; } }
    }
    nloc = mine > 0u ? mine : 1u; nx = cnt > 0u ? cnt : 1u;
}
__device__ __forceinline__ void xcd_barrier(const XcdBarrier& b) {
    asm volatile("s_waitcnt vmcnt(0)" ::: "memory");
    __syncthreads();
    if (threadIdx.x == 0) {
        unsigned* bar = b.bar;
        __builtin_amdgcn_s_waitcnt(0);
        unsigned nloc = b.st[0], nx = b.st[1];
        if (nloc == 0u) { xcd_barrier_complete(bar, b.x, nloc, nx); b.st[0] = nloc; b.st[1] = nx; }
        const unsigned old = xb_add(&bar[XB_XSUB(b.x)], 1u);
        const unsigned gen = old / nloc;
        if (old + 1u == (gen + 1u) * nloc) {
            __builtin_amdgcn_fence(__ATOMIC_RELEASE, "agent");
            asm volatile("s_waitcnt vmcnt(0)" ::: "memory");
            const unsigned og = xb_add(&bar[XB_TOP], 1u);
            const unsigned tg = og / nx;
            if (og + 1u == (tg + 1u) * nx) xb_add(&bar[XB_TOPGEN], 1u);
            else XB_SPIN(xb_ld(&bar[XB_TOPGEN]) == tg, bar);
            __builtin_amdgcn_fence(__ATOMIC_ACQUIRE, "agent");
            xb_add(&bar[XB_XGEN(b.x)], 1u);
            asm volatile("s_waitcnt vmcnt(0)" ::: "memory");
        } else {
            XB_SPIN(xb_ld(&bar[XB_XGEN(b.x)]) == gen, bar);
            __builtin_amdgcn_fence(__ATOMIC_ACQUIRE, "agent");
            asm volatile("s_waitcnt vmcnt(0)" ::: "memory");
        }
    }
    __syncthreads();
}

__device__ __forceinline__ int lds_byte2(int r, int c) { const int st = (r >> 4) * 2 + (c >> 5), ob = (r & 15) * 64 + (c & 31) * 2; return st * 1024 + (ob ^ (((ob >> 9) & 1) << 5)); }
__device__ __forceinline__ void stage_rc2(int b, int& R, int& C) { const int st = b >> 10, sb = b & 1023, swz = sb ^ (((sb >> 9) & 1) << 5); R = (st >> 1) * 16 + swz / 64; C = (st & 1) * 32 + (swz % 64) / 2; }

template <int MI, int NI, bool TRANS>
__device__ __forceinline__ void gemm_block(LAS unsigned char* lds, const bf16_t* const (&ap)[MI / 2], const bf16_t* const (&bp)[NI], int nkt, f32x4 (&acc)[MI][NI]) {
    constexpr int BM = 32 * MI, BN = 64 * NI, TA = BM * 128, TB = BN * 128, STG = TA + TB, GLA = MI / 2, GLB = NI;
    static_assert(2 * STG <= SCR_BYTES, "LDS");
    const int tid = threadIdx.x, lane = tid & 63, wid = __builtin_amdgcn_readfirstlane(tid >> 6), wr = wid >> 2, wc = wid & 3, fr = lane & 15, fq = lane >> 4;
    const int aoff = lds_byte2(wr * (MI * 16) + fr, fq * 8), boff = TA + lds_byte2(wc * (NI * 16) + fr, fq * 8);
#define GB_STAGE(buf, kt) do { \
        _Pragma("unroll") for (int i_ = 0; i_ < GLA; ++i_) __builtin_amdgcn_global_load_lds((const unsigned*)(ap[i_] + (kt) * 64), (LAS unsigned*)(lds + (buf) * STG + wid * 1024 + i_ * 8192), 16, 0, 0); \
        _Pragma("unroll") for (int i_ = 0; i_ < GLB; ++i_) __builtin_amdgcn_global_load_lds((const unsigned*)(bp[i_] + (kt) * 64), (LAS unsigned*)(lds + (buf) * STG + TA + wid * 1024 + i_ * 8192), 16, 0, 0); } while (0)
    GB_STAGE(0, 0);
    asm volatile("s_waitcnt vmcnt(0)" ::: "memory"); __syncthreads();
    for (int t = 0; t < nkt; ++t) {
        const int cur = t & 1;
        if (t + 1 < nkt) GB_STAGE(cur ^ 1, t + 1);
        const LAS unsigned char* sb = lds + cur * STG;
#pragma unroll
        for (int ks = 0; ks < 2; ++ks) {
            bf16x8 At[MI], Bf[NI];
#pragma unroll
            for (int m = 0; m < MI; ++m) At[m] = *(const LAS bf16x8*)(sb + aoff + m * 2048 + ks * 1024);
#pragma unroll
            for (int n = 0; n < NI; ++n) Bf[n] = *(const LAS bf16x8*)(sb + boff + n * 2048 + ks * 1024);
#pragma unroll
            for (int m = 0; m < MI; ++m)
#pragma unroll
                for (int n = 0; n < NI; ++n)
                    acc[m][n] = TRANS ? __builtin_amdgcn_mfma_f32_16x16x32_bf16(Bf[n], At[m], acc[m][n], 0, 0, 0)
                                      : __builtin_amdgcn_mfma_f32_16x16x32_bf16(At[m], Bf[n], acc[m][n], 0, 0, 0);
        }
        asm volatile("s_waitcnt vmcnt(0)" ::: "memory"); __syncthreads();
    }
#undef GB_STAGE
}
template <int MI, int NI, bool ARES>
__device__ __forceinline__ void gemm_stage(LAS unsigned char* lds, int abytes, const bf16_t* const (&ap)[MI / 2], const bf16_t* const (&bp)[NI], int buf, int kt) {
    constexpr int TA = MI * 32 * 128, TB = NI * 64 * 128, STG = ARES ? TB : TA + TB;
    const int wid = __builtin_amdgcn_readfirstlane(threadIdx.x >> 6);
    LAS unsigned char* base = lds + (ARES ? abytes : 0) + buf * STG + wid * 1024;
    if (!ARES) {
#pragma unroll
        for (int i = 0; i < MI / 2; ++i) __builtin_amdgcn_global_load_lds((const unsigned*)(ap[i] + kt * 64), (LAS unsigned*)(base + i * 8192), 16, 0, 0);
    }
#pragma unroll
    for (int i = 0; i < NI; ++i) __builtin_amdgcn_global_load_lds((const unsigned*)(bp[i] + kt * 64), (LAS unsigned*)(base + (ARES ? 0 : TA) + i * 8192), 16, 0, 0);
}
template <int MI>
__device__ __forceinline__ void gemm_load_ares(LAS unsigned char* lds, const bf16_t* const (&ap)[MI / 2], int nkt) {
    constexpr int TA = MI * 32 * 128;
    const int wid = __builtin_amdgcn_readfirstlane(threadIdx.x >> 6);
    for (int kt = 0; kt < nkt; ++kt) {
#pragma unroll
        for (int i = 0; i < MI / 2; ++i) __builtin_amdgcn_global_load_lds((const unsigned*)(ap[i] + kt * 64), (LAS unsigned*)(lds + kt * TA + wid * 1024 + i * 8192), 16, 0, 0);
    }
}
template <int MI, int NI, bool TRANS, bool ARES>
__device__ __forceinline__ void gemm_main2(LAS unsigned char* lds, int abytes, const bf16_t* const (&ap)[MI / 2], const bf16_t* const (&bp)[NI], const bf16_t* const (&bq)[NI], int ksplit, int nkt, f32x4 (&acc)[MI][NI]) {
    constexpr int TA = MI * 32 * 128, TB = NI * 64 * 128, STG = ARES ? TB : TA + TB;
    const int tid = threadIdx.x, lane = tid & 63, wid = __builtin_amdgcn_readfirstlane(tid >> 6), wr = wid >> 2, wc = wid & 3, fr = lane & 15, fq = lane >> 4;
    const int aoff = lds_byte2(wr * (MI * 16) + fr, fq * 8), boff = (ARES ? abytes : TA) + lds_byte2(wc * (NI * 16) + fr, fq * 8);
#pragma unroll 1
    for (int t = 0; t < nkt; ++t) {
        const int cur = t & 1;
        asm volatile("s_waitcnt vmcnt(0)" ::: "memory"); __syncthreads();
        if (t + 1 < nkt) { if (t + 1 < ksplit) gemm_stage<MI, NI, ARES>(lds, abytes, ap, bp, cur ^ 1, t + 1); else gemm_stage<MI, NI, ARES>(lds, abytes, ap, bq, cur ^ 1, t + 1); }
        const LAS unsigned char* sa = ARES ? lds + t * TA : lds + cur * STG;
        const LAS unsigned char* sb = lds + cur * STG;
#pragma unroll
        for (int ks = 0; ks < 2; ++ks) {
            bf16x8 At[MI], Bf[NI];
#pragma unroll
            for (int m = 0; m < MI; ++m) At[m] = *(const LAS bf16x8*)(sa + aoff + m * 2048 + ks * 1024);
#pragma unroll
            for (int n = 0; n < NI; ++n) Bf[n] = *(const LAS bf16x8*)(sb + boff + n * 2048 + ks * 1024);
#pragma unroll
            for (int m = 0; m < MI; ++m)
#pragma unroll
                for (int n = 0; n < NI; ++n)
                    acc[m][n] = TRANS ? __builtin_amdgcn_mfma_f32_16x16x32_bf16(Bf[n], At[m], acc[m][n], 0, 0, 0)
                                      : __builtin_amdgcn_mfma_f32_16x16x32_bf16(At[m], Bf[n], acc[m][n], 0, 0, 0);
        }
    }
    if (nkt & 1) __syncthreads();
}
template <int MI, int NI, bool TRANS, bool ARES>
__device__ __forceinline__ void gemm_main(LAS unsigned char* lds, int abytes, const bf16_t* const (&ap)[MI / 2], const bf16_t* const (&bp)[NI], int nkt, f32x4 (&acc)[MI][NI]) {
    gemm_main2<MI, NI, TRANS, ARES>(lds, abytes, ap, bp, bp, nkt, nkt, acc);
}
template <int GL>
__device__ __forceinline__ void stage_ptrs_dense(const bf16_t* base, size_t ld, int r0, const bf16_t* (&p)[GL]) {
    const int tid = threadIdx.x, lane = tid & 63, wid = tid >> 6;
#pragma unroll
    for (int i = 0; i < GL; ++i) { int R, C; stage_rc2(wid * 1024 + i * 8192 + lane * 16, R, C); p[i] = base + (size_t)(r0 + R) * ld + C; }
}

struct Params {
    const void* in[26];
    float* out;
    unsigned char* ws;
    int ph_lo, ph_hi;
};
typedef const __attribute__((address_space(4))) Params* CP;
__device__ __forceinline__ CP get_params() { CP q = (CP)__builtin_amdgcn_kernarg_segment_ptr(); asm volatile("" : "+s"(q)); return q; }

__device__ const float INVF[16] = {1.000000000e+00f, 5.623413324e-01f, 3.162277639e-01f, 1.778279394e-01f, 1.000000015e-01f, 5.623413250e-02f, 3.162277490e-02f, 1.778279431e-02f,
                                   9.999999776e-03f, 5.623413250e-03f, 3.162277630e-03f, 1.778279431e-03f, 1.000000047e-03f, 5.623413017e-04f, 3.162277571e-04f, 1.778279402e-04f};

__device__ __forceinline__ void tr_item(const float* srcp, int ldw, const float* kscale, bf16_t* WT, int Kd, int k0, int n0, LAS float* scr, int lane) {
#pragma unroll 8
    for (int i = 0; i < 32; ++i) { const int kk = 2 * i + (lane >> 5); float v = 0.f; if (srcp) { v = srcp[(size_t)(k0 + kk) * ldw]; if (kscale) v *= kscale[k0 + kk]; } scr[kk * 33 + (lane & 31)] = v; }
    asm volatile("s_waitcnt lgkmcnt(0)" ::: "memory");
    const int c = lane & 7;
#pragma unroll
    for (int j = 0; j < 4; ++j) { const int n = (lane >> 3) + 8 * j; const LAS float* s = scr + (8 * c) * 33 + n;
        u32x4 o; o.x = cvtpk(s[0 * 33], s[1 * 33]); o.y = cvtpk(s[2 * 33], s[3 * 33]); o.z = cvtpk(s[4 * 33], s[5 * 33]); o.w = cvtpk(s[6 * 33], s[7 * 33]);
        *(u32x4*)(WT + (size_t)(n0 + n) * Kd + k0 + 8 * c) = o; }
    asm volatile("s_waitcnt lgkmcnt(0)" ::: "memory");
}

constexpr int TR_I0 = 16 * 24, TR_I1 = 4 * 12, TR_I2 = 2 * 16, TR_I3 = 16 * 16, TR_I4 = 32 * 128, TR_I5 = 32 * 64, TR_I6 = 16 * 2;
constexpr int TR_NIT = TR_I0 + TR_I1 + TR_I2 + TR_I3 + TR_I4 + TR_I5 + TR_I6, TR_EARLY = TR_I0 + TR_I1 + TR_I2;
__device__ __forceinline__ void transpose_items(CP p, LAS unsigned char* lds, int it0, int it1) {
    const int tid = threadIdx.x, lane = tid & 63, wave = __builtin_amdgcn_readfirstlane(tid >> 6);
    const int G = gridDim.x, bid = blockIdx.x;
    unsigned char* ws = p->ws;
    {
        LAS unsigned* scr = (LAS unsigned*)(lds + 65536) + wave * 2112;
        const int gw = bid * 8 + wave, NGW = G * 8;
        const float* w_in = (const float*)p->in[6]; const float* qan = (const float*)p->in[11]; const float* w_qb = (const float*)p->in[12];
        const float* kvan = (const float*)p->in[13]; const float* w_kvb = (const float*)p->in[14]; const float* w_out = (const float*)p->in[17];
        const float* w_group = (const float*)p->in[19]; const float* w_expert = (const float*)p->in[21];
        const float* w_gate = (const float*)p->in[23]; const float* w_up = (const float*)p->in[24]; const float* w_down = (const float*)p->in[25];
        constexpr int I0 = TR_I0, I1 = TR_I1, I2 = TR_I2, I3 = TR_I3, I4 = TR_I4, I5 = TR_I5, I6 = TR_I6, NIT = TR_NIT;
        const int c4 = lane & 15, kp = lane >> 4;
        for (int it = it0 + gw; it < it1; it += NGW) {
            int r = it;
            if (r >= NIT - I6) {
                r -= NIT - I6;
                LAS float* fscr = (LAS float*)scr; const int nl = lane & 31;
                const int kb = r >> 1, nb = r & 1, n0 = nb * 32, np = n0 + nl, k0 = kb * 64;
                const float* srcp = nullptr; int ldw = 0;
                if (np < 4) { srcp = w_group + np; ldw = 4; } else if (np < 36) { srcp = w_expert + (np - 4); ldw = 32; }
#pragma unroll 8
                for (int i = 0; i < 32; ++i) { const int kk = 2 * i + (lane >> 5); fscr[kk * 33 + nl] = srcp ? srcp[(size_t)(k0 + kk) * ldw] : 0.f; }
                asm volatile("s_waitcnt lgkmcnt(0)" ::: "memory");
                const int c = lane & 7;
#pragma unroll
                for (int j = 0; j < 4; ++j) { const int n = (lane >> 3) + 8 * j; const LAS float* sp = fscr + (8 * c) * 33 + n;
                    float v[8], l[8];
#pragma unroll
                    for (int q = 0; q < 8; ++q) { v[q] = sp[q * 33]; l[q] = v[q] - bf2f(f2bf(v[q])); }
                    if (n0 + n < 48) {
                        u32x4 o; o.x = cvtpk(v[0], v[1]); o.y = cvtpk(v[2], v[3]); o.z = cvtpk(v[4], v[5]); o.w = cvtpk(v[6], v[7]);
                        *(u32x4*)((bf16_t*)(ws + WS_WR) + (size_t)(n0 + n) * 1024 + k0 + 8 * c) = o;
                        u32x4 o2; o2.x = cvtpk(l[0], l[1]); o2.y = cvtpk(l[2], l[3]); o2.z = cvtpk(l[4], l[5]); o2.w = cvtpk(l[6], l[7]);
                        *(u32x4*)((bf16_t*)(ws + WS_WR) + 48 * 1024 + (size_t)(n0 + n) * 1024 + k0 + 8 * c) = o2; } }
                asm volatile("s_waitcnt lgkmcnt(0)" ::: "memory");
                continue;
            }
            const float* srcp; int ldw, Kd, k0, n0; const float* ksc = nullptr; bf16_t* WT;
            if (r < I0) {
                const int kb = r / 24, nb = r % 24; n0 = nb * 64; k0 = kb * 64; const int np = n0 + 4 * c4;
                const int pn = np >> 8, wc = (np >> 6) & 3, n = (np >> 4) & 3, f = np & 15; int src;
                if (pn < 4) { const int ch = pn * 128 + wc * 32 + (n >> 1) * 16 + f; src = (n & 1) ? 512 + ch : ch; }
                else if (pn == 4) src = np;
                else { const int j = np - 1280; src = (j < 160) ? 1280 + j : -1; }
                srcp = src >= 0 ? w_in + src : nullptr; ldw = 1440; Kd = 1024; WT = (bf16_t*)(ws + WS_WIN);
            } else if ((r -= I0) < I1) {
                const int kb = r / 12, nb = r % 12; n0 = nb * 64; k0 = kb * 64;
                srcp = w_qb + n0 + 4 * c4; ldw = 768; Kd = 256; ksc = qan; WT = (bf16_t*)(ws + WS_WQ);
            } else if ((r -= I1) < I2) {
                const int kb = r / 16, nb = r % 16; n0 = nb * 64; k0 = kb * 64;
                srcp = w_kvb + n0 + 4 * c4; ldw = 1024; Kd = 128; ksc = kvan; WT = (bf16_t*)(ws + WS_WKV);
            } else if ((r -= I2) < I3) {
                const int kb = r / 16, nb = r % 16; n0 = nb * 64; k0 = kb * 64;
                srcp = w_out + n0 + 4 * c4; ldw = 1024; Kd = 1024; WT = (bf16_t*)(ws + WS_WOUT);
            } else if ((r -= I3) < I4) {
                const int e = r >> 7, q = r & 127, kb = q / 8, nb = q % 8; n0 = nb * 64; k0 = kb * 64; const int np = n0 + 4 * c4;
                const int ct = np >> 8, wc = (np >> 6) & 3, n = (np >> 4) & 3, f = np & 15, ch = ct * 128 + wc * 32 + (n >> 1) * 16 + f;
                srcp = ((n & 1) ? w_up : w_gate) + (size_t)e * 1024 * 256 + ch; ldw = 256; Kd = 1024; WT = (bf16_t*)(ws + WS_WGU) + (size_t)e * 512 * 1024;
            } else {
                r -= I4; const int e = r >> 6, q = r & 63, kb = q / 16, nb = q % 16; n0 = nb * 64; k0 = kb * 64;
                srcp = w_down + (size_t)e * 256 * 1024 + n0 + 4 * c4; ldw = 1024; Kd = 256; WT = (bf16_t*)(ws + WS_WD) + (size_t)e * 1024 * 256;
            }
            f32x4 v0[8], v1[8];
#pragma unroll
            for (int i = 0; i < 8; ++i) { const int k = k0 + 8 * i + 2 * kp;
                if (srcp) { v0[i] = *(const f32x4*)(srcp + (size_t)k * ldw); v1[i] = *(const f32x4*)(srcp + (size_t)(k + 1) * ldw); }
                else { v0[i] = (f32x4){0.f, 0.f, 0.f, 0.f}; v1[i] = v0[i]; } }
#pragma unroll
            for (int i = 0; i < 8; ++i) { const int k = k0 + 8 * i + 2 * kp; f32x4 a = v0[i], b = v1[i];
                if (ksc) { a = a * ksc[k]; b = b * ksc[k + 1]; }
                LAS unsigned* d = scr + (4 * c4) * 33 + 4 * i + kp;
                d[0] = cvtpk(a.x, b.x); d[33] = cvtpk(a.y, b.y); d[66] = cvtpk(a.z, b.z); d[99] = cvtpk(a.w, b.w); }
            asm volatile("s_waitcnt lgkmcnt(0)" ::: "memory");
            const int c = lane & 7;
#pragma unroll
            for (int j = 0; j < 8; ++j) { const int n = (lane >> 3) + 8 * j; const LAS unsigned* sp = scr + n * 33 + 4 * c;
                u32x4 o; o.x = sp[0]; o.y = sp[1]; o.z = sp[2]; o.w = sp[3];
                *(u32x4*)(WT + (size_t)(n0 + n) * Kd + k0 + 8 * c) = o; }
            asm volatile("s_waitcnt lgkmcnt(0)" ::: "memory");
        }
    }
}

__device__ __forceinline__ void rope_table(CP p) {
    const int* pos = (const int*)p->in[2]; f32x2* rt = (f32x2*)(p->ws + WS_ROPE);
    for (int e = blockIdx.x * 512 + threadIdx.x; e < MT * 16; e += gridDim.x * 512) {
        const int tok = e >> 4, i = e & 15;
        const float a32 = (float)pos[tok] * INVF[i];
        const double rev = (double)a32 * 0.15915494309189535;
        const float fr = (float)(rev - __builtin_rint(rev));
        rt[e] = (f32x2){__builtin_amdgcn_cosf(fr), __builtin_amdgcn_sinf(fr)};
    }
}

__device__ __forceinline__ void phase0(CP p, LAS unsigned char* lds) {
    const int tid = threadIdx.x, lane = tid & 63, wave = __builtin_amdgcn_readfirstlane(tid >> 6);
    const int G = gridDim.x, bid = blockIdx.x;
    unsigned char* ws = p->ws;
    if (bid < 192) {
        const float* c = (const float*)p->in[1]; const float* w_ada = (const float*)p->in[3]; const float* b_ada = (const float*)p->in[4];
        LAS float* sc = (LAS float*)lds;
        LAS float* red = (LAS float*)(lds + 32768);
        for (int i = tid; i < 8192; i += 512) sc[i] = siluf_(c[i]);
        __syncthreads();
        const int col = tid & 31, ks = tid >> 5, n0 = bid * 32;
        float a[8] = {0, 0, 0, 0, 0, 0, 0, 0};
#pragma unroll 8
        for (int i = 0; i < 64; ++i) { const int k = ks * 64 + i; const float w = w_ada[(size_t)k * 6144 + n0 + col];
#pragma unroll
            for (int b = 0; b < 8; ++b) a[b] += sc[b * 1024 + k] * w; }
#pragma unroll
        for (int b = 0; b < 8; ++b) red[(ks * 32 + col) * 8 + b] = a[b];
        __syncthreads();
        if (tid < 256) { const int cc = tid & 31, b = tid >> 5; float s = 0.f;
#pragma unroll
            for (int k2 = 0; k2 < 16; ++k2) s += red[(k2 * 32 + cc) * 8 + b];
            ((float*)(ws + WS_MOD))[b * 6144 + n0 + cc] = s + b_ada[n0 + cc]; }
        __syncthreads();
    }
    if (N_LAUNCH_SPLIT) { rope_table(p); transpose_items(p, lds, 0, TR_NIT); }
}

__device__ __forceinline__ void phase1a(CP p) {
    const int tid = threadIdx.x, lane = tid & 63, wave = tid >> 6;
    const int gw = blockIdx.x * 8 + wave, NGW = gridDim.x * 8;
    const float* x = (const float*)p->in[0]; const float* nm = (const float*)p->in[5]; const float* mod = (const float*)(p->ws + WS_MOD);
    bf16_t* h = (bf16_t*)(p->ws + WS_H);
    for (int grp = gw; grp < MT / 16; grp += NGW) {
        const int r0 = grp * 16, b = r0 >> 12;
        f32x4 gm[4], sh[4];
#pragma unroll
        for (int j = 0; j < 4; ++j) { const int col = 4 * lane + 256 * j; const f32x4 g = *(const f32x4*)(nm + col), s = *(const f32x4*)(mod + b * 6144 + 1024 + col);
            gm[j] = g * (s + 1.0f); sh[j] = *(const f32x4*)(mod + b * 6144 + col); }
#pragma unroll 1
        for (int rb = 0; rb < 16; rb += 4) {
            f32x4 v[4][4];
#pragma unroll
            for (int rr = 0; rr < 4; ++rr) { const float* xr = x + (size_t)(r0 + rb + rr) * DM;
#pragma unroll
                for (int j = 0; j < 4; ++j) v[rr][j] = *(const f32x4*)(xr + 4 * lane + 256 * j); }
#pragma unroll
            for (int rr = 0; rr < 4; ++rr) { float s = 0.f;
#pragma unroll
                for (int j = 0; j < 4; ++j) s += (v[rr][j].x * v[rr][j].x + v[rr][j].y * v[rr][j].y) + (v[rr][j].z * v[rr][j].z + v[rr][j].w * v[rr][j].w);
                const float rstd = __builtin_amdgcn_rsqf(wave_sum(s) * (1.0f / DM) + EPS);
                bf16_t* hr = h + (size_t)(r0 + rb + rr) * DM;
#pragma unroll
                for (int j = 0; j < 4; ++j) { const f32x4 o = v[rr][j] * rstd * gm[j] + sh[j]; u32x2 w; w.x = cvtpk(o.x, o.y); w.y = cvtpk(o.z, o.w); *(u32x2*)(hr + 4 * lane + 256 * j) = w; } }
        }
    }
}

__device__ __forceinline__ void phase1b(CP p, LAS unsigned char* lds) {
    const int tid = threadIdx.x, lane = tid & 63, wid = __builtin_amdgcn_readfirstlane(tid >> 6), wr = wid >> 2, wc = wid & 3, fr = lane & 15, fq = lane >> 4;
    unsigned char* ws = p->ws;
    const bf16_t* h = (const bf16_t*)(ws + WS_H); const bf16_t* win = (const bf16_t*)(ws + WS_WIN);
    for (int u = vcu_id(); u < 128 * 6; u += gridDim.x) {
        const int pm = u / 6, pn = u % 6;
        const bf16_t* ap[4]; const bf16_t* bp[4];
        stage_ptrs_dense<4>(h, 1024, pm * 256, ap); stage_ptrs_dense<4>(win, 1024, pn * 256, bp);
        f32x4 acc[8][4];
#pragma unroll
        for (int m = 0; m < 8; ++m)
#pragma unroll
            for (int n = 0; n < 4; ++n) acc[m][n] = (f32x4){0.f, 0.f, 0.f, 0.f};
        gemm_block<8, 4, true>(lds, ap, bp, 16, acc);
        const int rowb = pm * 256 + wr * 128 + fr;
        if (pn < 4) {
            bf16_t* ub = (bf16_t*)(ws + WS_U);
#pragma unroll
            for (int m = 0; m < 8; ++m) { const size_t row = rowb + m * 16;
#pragma unroll
                for (int h2 = 0; h2 < 2; ++h2) { const f32x4 v = acc[m][2 * h2], g = acc[m][2 * h2 + 1];
                    const int ch = pn * 128 + wc * 32 + h2 * 16 + fq * 4;
                    u32x2 w; w.x = cvtpk(v.x * sigmoidf_(g.x), v.y * sigmoidf_(g.y)); w.y = cvtpk(v.z * sigmoidf_(g.z), v.w * sigmoidf_(g.w));
                    *(u32x2*)(ub + row * 512 + ch) = w; } }
        } else if (pn == 4) {
            bf16_t* cq = (bf16_t*)(ws + WS_CQ); float* sq = (float*)(ws + WS_SSQQ);
#pragma unroll
            for (int m = 0; m < 8; ++m) { const size_t row = rowb + m * 16; float s = 0.f;
#pragma unroll
                for (int n = 0; n < 4; ++n) { const f32x4 v = acc[m][n]; s += (v.x * v.x + v.y * v.y) + (v.z * v.z + v.w * v.w);
                    u32x2 w; w.x = cvtpk(v.x, v.y); w.y = cvtpk(v.z, v.w); *(u32x2*)(cq + row * 256 + wc * 64 + n * 16 + fq * 4) = w; }
                s += __shfl_xor(s, 16); s += __shfl_xor(s, 32);
                if (fq == 0) sq[row * 4 + wc] = s; }
        } else {
            if (wc < 2) {
                bf16_t* ckv = (bf16_t*)(ws + WS_CKV); float* sq = (float*)(ws + WS_SSQKV);
#pragma unroll
                for (int m = 0; m < 8; ++m) { const size_t row = rowb + m * 16; float s = 0.f;
#pragma unroll
                    for (int n = 0; n < 4; ++n) { const f32x4 v = acc[m][n]; s += (v.x * v.x + v.y * v.y) + (v.z * v.z + v.w * v.w);
                        u32x2 w; w.x = cvtpk(v.x, v.y); w.y = cvtpk(v.z, v.w); *(u32x2*)(ckv + row * 128 + wc * 64 + n * 16 + fq * 4) = w; }
                    s += __shfl_xor(s, 16); s += __shfl_xor(s, 32);
                    if (fq == 0) sq[row * 2 + wc] = s; }
            } else if (wc == 2) {
                float* kr = (float*)(ws + WS_KROPE); float* sq = (float*)(ws + WS_SSQKR);
#pragma unroll
                for (int m = 0; m < 8; ++m) { const size_t row = rowb + m * 16; float s = 0.f;
#pragma unroll
                    for (int n = 0; n < 2; ++n) { const f32x4 v = acc[m][n]; s += (v.x * v.x + v.y * v.y) + (v.z * v.z + v.w * v.w);
                        *(f32x4*)(kr + row * 32 + n * 16 + fq * 4) = v; }
                    s += __shfl_xor(s, 16); s += __shfl_xor(s, 32);
                    if (fq == 0) sq[row] = s; }
            }
        }
    }
}

constexpr int EPI_SCR = 131072;
__device__ __forceinline__ void q_item(CP p, LAS unsigned char* lds, int item) {
    const int tid = threadIdx.x, lane = tid & 63, wid = __builtin_amdgcn_readfirstlane(tid >> 6), wr = wid >> 2, wc = wid & 3, fr = lane & 15, fq = lane >> 4;
    unsigned char* ws = p->ws;
    const int pm = item >> 1, ct = item & 1;
    const bf16_t* ap[2]; const bf16_t* bp[6];
    stage_ptrs_dense<2>((const bf16_t*)(ws + WS_CQ), 256, pm * 128, ap);
    stage_ptrs_dense<6>((const bf16_t*)(ws + WS_WQ), 256, ct * 384, bp);
    __syncthreads();
    gemm_stage<4, 6, false>(lds, 0, ap, bp, 0, 0);
    const float* sq = (const float*)(ws + WS_SSQQ); const float* qn = (const float*)p->in[15];
    const int rowb = pm * 128 + wr * 64 + fr, i0 = fq * 4;
    float rq[4]; f32x4 gq[6], cs01[4], cs23[4];
#pragma unroll
    for (int m = 0; m < 4; ++m) { const f32x4 s4 = *(const f32x4*)(sq + (size_t)(rowb + m * 16) * 4); rq[m] = __builtin_amdgcn_rsqf(((s4.x + s4.y) + (s4.z + s4.w)) * (1.0f / 256.0f) + EPS); }
#pragma unroll
    for (int n = 0; n < 6; ++n) gq[n] = *(const f32x4*)(qn + n * 16 + i0);
    const f32x2* rope = (const f32x2*)(ws + WS_ROPE);
#pragma unroll
    for (int m = 0; m < 4; ++m) { const size_t tok = rowb + m * 16; cs01[m] = *(const f32x4*)(rope + tok * 16 + i0); cs23[m] = *(const f32x4*)(rope + tok * 16 + i0 + 2); }
    f32x4 acc[4][6];
#pragma unroll
    for (int m = 0; m < 4; ++m)
#pragma unroll
        for (int n = 0; n < 6; ++n) acc[m][n] = (f32x4){0.f, 0.f, 0.f, 0.f};
    gemm_main<4, 6, true, false>(lds, 0, ap, bp, 4, acc);
    const int hd = ct * 4 + wc, bb = (pm * 128) >> 12, sb = rowb & 4095;
    bf16_t* dst0 = (bf16_t*)(ws + WS_Q) + ((size_t)(bb * 8 + hd) * 4096 + sb) * 96;
#pragma unroll
    for (int m = 0; m < 4; ++m) { float s = 0.f;
#pragma unroll
        for (int n = 0; n < 6; ++n) { acc[m][n] = acc[m][n] * rq[m]; const f32x4 v = acc[m][n]; s += (v.x * v.x + v.y * v.y) + (v.z * v.z + v.w * v.w); }
        s += __shfl_xor(s, 16); s += __shfl_xor(s, 32);
        const float rh = __builtin_amdgcn_rsqf(s * (1.0f / 96.0f) + EPS) * QSCALE;
        bf16_t* dst = dst0 + (m * 16) * 96;
#pragma unroll
        for (int n = 0; n < 4; ++n) { const f32x4 v = acc[m][n] * rh * gq[n]; u32x2 w; w.x = cvtpk(v.x, v.y); w.y = cvtpk(v.z, v.w); *(u32x2*)(dst + n * 16 + i0) = w; }
        const f32x4 x1 = acc[m][4] * rh * gq[4], x2 = acc[m][5] * rh * gq[5];
        const f32x4 c01 = cs01[m], c23 = cs23[m];
        f32x4 o1, o2;
        o1.x = x1.x * c01.x - x2.x * c01.y; o2.x = x1.x * c01.y + x2.x * c01.x;
        o1.y = x1.y * c01.z - x2.y * c01.w; o2.y = x1.y * c01.w + x2.y * c01.z;
        o1.z = x1.z * c23.x - x2.z * c23.y; o2.z = x1.z * c23.y + x2.z * c23.x;
        o1.w = x1.w * c23.z - x2.w * c23.w; o2.w = x1.w * c23.w + x2.w * c23.z;
        u32x2 w; w.x = cvtpk(o1.x, o1.y); w.y = cvtpk(o1.z, o1.w); *(u32x2*)(dst + 64 + i0) = w;
        w.x = cvtpk(o2.x, o2.y); w.y = cvtpk(o2.z, o2.w); *(u32x2*)(dst + 80 + i0) = w;
    }
}

constexpr int KV_SCR = 98304;
__device__ __forceinline__ void kv_item(CP p, LAS unsigned char* lds, int pm) {
    const int tid = threadIdx.x, lane = tid & 63, wid = __builtin_amdgcn_readfirstlane(tid >> 6), wr = wid >> 2, wc = wid & 3, fr = lane & 15, fq = lane >> 4;
    unsigned char* ws = p->ws;
    const bf16_t* ap[2]; const bf16_t* bp[4];
    stage_ptrs_dense<2>((const bf16_t*)(ws + WS_CKV), 128, pm * 128, ap);
    stage_ptrs_dense<4>((const bf16_t*)(ws + WS_WKV), 128, 0, bp);
    __syncthreads();
    gemm_load_ares<4>(lds, ap, 2);
    gemm_stage<4, 4, true>(lds, 32768, ap, bp, 0, 0);
    LAS float* kr_l = (LAS float*)(lds + KV_SCR); LAS float* rp_l = kr_l + 128 * 33; LAS float* rkv_l = rp_l + 128 * 34; LAS float* skr_l = rkv_l + 128;
    {
        const float* krp = (const float*)(ws + WS_KROPE) + (size_t)pm * 128 * 32; const float* rope = (const float*)(ws + WS_ROPE) + (size_t)pm * 128 * 32;
        f32x4 a[2], b[2];
#pragma unroll
        for (int k = 0; k < 2; ++k) { const int idx = tid + 512 * k; a[k] = *(const f32x4*)(krp + idx * 4); b[k] = *(const f32x4*)(rope + idx * 4); }
        float rk = 0.f, sk = 0.f;
        if (tid < 128) { const f32x2 s2 = *(const f32x2*)((const float*)(ws + WS_SSQKV) + (size_t)(pm * 128 + tid) * 2); rk = __builtin_amdgcn_rsqf((s2.x + s2.y) * (1.0f / 128.0f) + EPS); sk = ((const float*)(ws + WS_SSQKR))[pm * 128 + tid]; }
#pragma unroll
        for (int k = 0; k < 2; ++k) { const int idx = tid + 512 * k, row = idx >> 3, c4 = (idx & 7) * 4;
            LAS float* d = kr_l + row * 33 + c4; d[0] = a[k].x; d[1] = a[k].y; d[2] = a[k].z; d[3] = a[k].w;
            LAS float* e = rp_l + row * 34 + c4; e[0] = b[k].x; e[1] = b[k].y; e[2] = b[k].z; e[3] = b[k].w; }
        if (tid < 128) { rkv_l[tid] = rk; skr_l[tid] = sk; }
    }
    const float* kn = (const float*)p->in[16];
    const int rowl = wr * 64 + fq * 4, rowb = pm * 128 + rowl;
    float g[4];
#pragma unroll
    for (int n = 0; n < 4; ++n) g[n] = kn[n * 16 + fr];
    const float g1 = kn[64 + fr], g2 = kn[80 + fr];
    const int bb = (pm * 128) >> 12, sb = rowb & 4095;
#pragma unroll 1
    for (int pn = 0; pn < 4; ++pn) {
        f32x4 acc[4][4];
#pragma unroll
        for (int m = 0; m < 4; ++m)
#pragma unroll
            for (int n = 0; n < 4; ++n) acc[m][n] = (f32x4){0.f, 0.f, 0.f, 0.f};
        gemm_main<4, 4, false, true>(lds, 32768, ap, bp, 2, acc);
        if (pn < 3) {
#pragma unroll
            for (int i = 0; i < 4; ++i) bp[i] += 256 * 128;
            gemm_stage<4, 4, true>(lds, 32768, ap, bp, 0, 0);
        }
        const int hd = pn * 2 + (wc >> 1);
        if ((wc & 1) == 0) {
            bf16_t* dst_p = (bf16_t*)(ws + WS_K) + ((size_t)(bb * 8 + hd) * 4096 + sb) * 96 + fr;
#pragma unroll
            for (int m = 0; m < 4; ++m) {
#pragma unroll
                for (int j = 0; j < 4; ++j) {
                    const int o = m * 16 + j, rl = rowl + o;
                    const float rkv = rkv_l[rl];
                    float v[4], ss = 0.f;
#pragma unroll
                    for (int n = 0; n < 4; ++n) { v[n] = acc[m][n][j] * rkv; ss += v[n] * v[n]; }
                    ss += __shfl_xor(ss, 1); ss += __shfl_xor(ss, 2); ss += __shfl_xor(ss, 4); ss += __shfl_xor(ss, 8);
                    const float rk = __builtin_amdgcn_rsqf((ss + skr_l[rl]) * (1.0f / 96.0f) + EPS);
                    bf16_t* dst = dst_p + o * 96;
#pragma unroll
                    for (int n = 0; n < 4; ++n) dst[n * 16] = f2bf(v[n] * rk * g[n]);
                    const float x1 = kr_l[rl * 33 + fr] * rk * g1, x2 = kr_l[rl * 33 + 16 + fr] * rk * g2;
                    const float cs_c = rp_l[rl * 34 + 2 * fr], cs_s = rp_l[rl * 34 + 2 * fr + 1];
                    dst[64] = f2bf(x1 * cs_c - x2 * cs_s); dst[80] = f2bf(x1 * cs_s + x2 * cs_c);
                }
            }
        } else {
            bf16_t* vt_p = (bf16_t*)(ws + WS_VT) + ((size_t)(bb * 8 + hd) * 64 + fr) * 4096 + sb;
#pragma unroll
            for (int m = 0; m < 4; ++m) {
                float rkv[4];
#pragma unroll
                for (int j = 0; j < 4; ++j) rkv[j] = rkv_l[rowl + m * 16 + j];
#pragma unroll
                for (int n = 0; n < 4; ++n) { const f32x4 a = acc[m][n];
                    u32x2 w; w.x = cvtpk(a.x * rkv[0], a.y * rkv[1]); w.y = cvtpk(a.z * rkv[2], a.w * rkv[3]);
                    *(u32x2*)(vt_p + (size_t)(n * 16) * 4096 + m * 16) = w; }
            }
        }
    }
}

template <int R> __device__ __forceinline__ void conv_row(float (&o)[64], const float (&w)[31], float x) {
    constexpr int T0 = R > 30 ? R - 30 : 0, T1 = R < 63 ? R : 63;
#pragma unroll
    for (int t = T0; t <= T1; ++t) o[t] += w[R - t] * x;
}
template <int... R> __device__ __forceinline__ void conv_rows(float (&o)[64], const float (&w)[31], const float (&x)[94], std::integer_sequence<int, R...>) { (conv_row<R>(o, w, x[R]), ...); }
__device__ __forceinline__ void conv_unit(CP p, LAS unsigned char* lds, int cu) {
    const int tid = threadIdx.x, lane = tid & 63, wave = tid >> 6;
    const int b = cu >> 6, s0 = (cu & 63) * 64, c = tid;
    const bf16_t* ub = (const bf16_t*)(p->ws + WS_U) + ((size_t)b * 4096) * 512 + c;
    const float* cw = (const float*)p->in[7]; const float* cb = (const float*)p->in[8]; const float* lg = (const float*)p->in[9]; const float* lb = (const float*)p->in[10];
    float w[31];
#pragma unroll
    for (int j = 0; j < 31; ++j) w[j] = cw[j * 512 + c];
    float xin[94];
#pragma unroll
    for (int r = 0; r < 94; ++r) { const int s = s0 - 30 + r; xin[r] = bf2f(ub[(size_t)(s < 0 ? 0 : s) * 512]); }
    if (s0 == 0) {
#pragma unroll
        for (int r = 0; r < 30; ++r) xin[r] = 0.f;
    }
    float o[64];
    { const float bias = cb[c];
#pragma unroll
      for (int t = 0; t < 64; ++t) o[t] = bias; }
    conv_rows(o, w, xin, std::make_integer_sequence<int, 94>{});
    float s1, s2;
    {
        const bool b5 = lane & 32, b4 = lane & 16, b3 = lane & 8, b2 = lane & 4, b1 = lane & 2, b0 = lane & 1;
#define CONV_BFLY(RES, SQ) do { float a32[32]; \
        _Pragma("unroll") for (int i = 0; i < 32; ++i) { const float lo = SQ ? o[i] * o[i] : o[i], hi = SQ ? o[32 + i] * o[32 + i] : o[32 + i]; a32[i] = (b5 ? hi : lo) + __shfl_xor(b5 ? lo : hi, 32); } \
        float a16[16]; _Pragma("unroll") for (int i = 0; i < 16; ++i) a16[i] = (b4 ? a32[16 + i] : a32[i]) + __shfl_xor(b4 ? a32[i] : a32[16 + i], 16); \
        float a8[8]; _Pragma("unroll") for (int i = 0; i < 8; ++i) a8[i] = (b3 ? a16[8 + i] : a16[i]) + __shfl_xor(b3 ? a16[i] : a16[8 + i], 8); \
        float a4[4]; _Pragma("unroll") for (int i = 0; i < 4; ++i) a4[i] = (b2 ? a8[4 + i] : a8[i]) + __shfl_xor(b2 ? a8[i] : a8[4 + i], 4); \
        float a2[2]; _Pragma("unroll") for (int i = 0; i < 2; ++i) a2[i] = (b1 ? a4[2 + i] : a4[i]) + __shfl_xor(b1 ? a4[i] : a4[2 + i], 2); \
        RES = (b0 ? a2[1] : a2[0]) + __shfl_xor(b0 ? a2[0] : a2[1], 1); } while (0)
        CONV_BFLY(s1, false);
        asm volatile("" : "+v"(s1));
        CONV_BFLY(s2, true);
#undef CONV_BFLY
    }
    LAS float* red = (LAS float*)(lds + EPI_SCR);
    LAS float* stat = (LAS float*)(lds + EPI_SCR + 4096);
    red[(wave * 64 + lane) * 2] = s1; red[(wave * 64 + lane) * 2 + 1] = s2;
    __syncthreads();
    if (tid < 64) { float t1 = 0.f, t2 = 0.f;
#pragma unroll
        for (int k = 0; k < 8; ++k) { t1 += red[(k * 64 + tid) * 2]; t2 += red[(k * 64 + tid) * 2 + 1]; }
        const float mean = t1 * (1.0f / 512.0f); float var = t2 * (1.0f / 512.0f) - mean * mean; var = var < 0.f ? 0.f : var;
        stat[tid * 2] = mean; stat[tid * 2 + 1] = __builtin_amdgcn_rsqf(var + EPS); }
    __syncthreads();
    const float g = lg[c], bb = lb[c];
    bf16_t* cat = (bf16_t*)(p->ws + WS_CAT) + ((size_t)b * 4096 + s0) * 1024 + c;
#pragma unroll
    for (int t = 0; t < 64; ++t) { const float y = (o[t] - stat[t * 2]) * stat[t * 2 + 1] * g + bb; cat[(size_t)t * 1024] = f2bf(y * __builtin_amdgcn_rcpf(1.0f + __expf(-y))); }
    __syncthreads();
}

constexpr int CW_CONVQ = CW_CNT + 64 * 150;
__device__ __forceinline__ void xcd_barrier_work(const XcdBarrier& b, CP p, LAS unsigned char* lds, int a0, int e0, int a1, int e1, int flags) {
    asm volatile("s_waitcnt vmcnt(0)" ::: "memory");
    __syncthreads();
    unsigned gen = 0; bool leader = false;
    if (threadIdx.x == 0) {
        unsigned* bar = b.bar;
        __builtin_amdgcn_s_waitcnt(0);
        unsigned nloc = b.st[0], nx = b.st[1];
        if (nloc == 0u) { xcd_barrier_complete(bar, b.x, nloc, nx); b.st[0] = nloc; b.st[1] = nx; }
        const unsigned old = xb_add(&bar[XB_XSUB(b.x)], 1u);
        gen = old / nloc; leader = (old + 1u == (gen + 1u) * nloc);
        if (leader) {
            __builtin_amdgcn_fence(__ATOMIC_RELEASE, "agent");
            asm volatile("s_waitcnt vmcnt(0)" ::: "memory");
            const unsigned og = xb_add(&bar[XB_TOP], 1u);
            const unsigned tg = og / nx;
            if (og + 1u == (tg + 1u) * nx) xb_add(&bar[XB_TOPGEN], 1u);
            else XB_SPIN(xb_ld(&bar[XB_TOPGEN]) == tg, bar);
            __builtin_amdgcn_fence(__ATOMIC_ACQUIRE, "agent");
            xb_add(&bar[XB_XGEN(b.x)], 1u);
            asm volatile("s_waitcnt vmcnt(0)" ::: "memory");
        }
    }
    if (flags & 1) rope_table(p);
    transpose_items(p, lds, a0, e0);
    transpose_items(p, lds, a1, e1);
    if (flags & 2) {
        unsigned* q = (unsigned*)(p->ws + WS_CTL) + CW_CONVQ;
        volatile LAS unsigned* slot = (volatile LAS unsigned*)(lds + MISC_OFF + 1600);
        unsigned nxt = 0;
        if (threadIdx.x == 0) nxt = xb_add(q, 1u);
        for (;;) {
            if (threadIdx.x == 0) *slot = nxt;
            __syncthreads();
            const unsigned u = *slot;
            if (u >= 512u) break;
            if (threadIdx.x == 0) nxt = xb_add(q, 1u);
            conv_unit(p, lds, (int)u);
            __syncthreads();
        }
    }
    if (threadIdx.x == 0 && !leader) {
        unsigned* bar = b.bar;
        XB_SPIN(xb_ld(&bar[XB_XGEN(b.x)]) == gen, bar);
        __builtin_amdgcn_fence(__ATOMIC_ACQUIRE, "agent");
        asm volatile("s_waitcnt vmcnt(0)" ::: "memory");
    }
    __syncthreads();
}

__device__ __forceinline__ void phase1c(CP p, LAS unsigned char* lds) {
#ifndef SUBREP
#define SUBREP -1
#endif
#pragma unroll 1
    for (int r_ = 0; r_ < (SUBREP == 0 ? 2 : 1); ++r_)
    for (int u = blockIdx.x; u < 512; u += gridDim.x) q_item(p, lds, u);
#pragma unroll 1
    for (int r_ = 0; r_ < (SUBREP == 1 ? 2 : 1); ++r_)
    for (int u = blockIdx.x; u < 256; u += gridDim.x) kv_item(p, lds, u);
    __syncthreads();
    if (N_LAUNCH_SPLIT) { for (int u = blockIdx.x; u < 512; u += gridDim.x) conv_unit(p, lds, u); }
}

__device__ __forceinline__ int swap23(int r) { return (r & ~12) | ((r & 4) << 1) | ((r & 8) >> 1); }
constexpr int KROW = 208, VROW = 144, KBUF = 64 * KROW, VBUF = 64 * VROW, ABUF = KBUF + VBUF;
__device__ __forceinline__ void attn_unit(CP p, LAS unsigned char* lds, int bh, int qblk) {
    const int tid = threadIdx.x, lane = tid & 63, wid = __builtin_amdgcn_readfirstlane(tid >> 6), q = lane & 31, H = lane >> 5;
    unsigned char* ws = p->ws;
    const bf16_t* qg = (const bf16_t*)(ws + WS_Q) + (size_t)bh * 4096 * 96;
    const bf16_t* kg = (const bf16_t*)(ws + WS_K) + (size_t)bh * 4096 * 96;
    const bf16_t* vg = (const bf16_t*)(ws + WS_VT) + (size_t)bh * 64 * 4096;
    const int row0 = qblk * 256 + wid * 32, mychunk = 4 * qblk + (wid >> 1), NT = 4 * qblk + 4;
    bf16x8 qf[6];
#pragma unroll
    for (int s = 0; s < 6; ++s) qf[s] = *(const bf16x8*)(qg + (size_t)(row0 + q) * 96 + 16 * s + 8 * H);
    const int kr0 = tid / 12, kc0 = tid % 12, kr1 = (tid + 512) / 12, kc1 = (tid + 512) % 12, vd = tid >> 3, vc = tid & 7;
    const bool k1 = tid < 256;
    const bf16_t* ksrc0 = kg + (size_t)kr0 * 96 + kc0 * 8; const bf16_t* ksrc1 = kg + (size_t)kr1 * 96 + kc1 * 8; const bf16_t* vsrc = vg + (size_t)vd * 4096 + vc * 8;
    const int kdst0 = kr0 * KROW + kc0 * 16, kdst1 = kr1 * KROW + kc1 * 16, vdst = KBUF + vd * VROW + vc * 16;
    u32x4 rk0, rk1 = (u32x4){0, 0, 0, 0}, rv;
#define AT_LOAD(t) do { rk0 = *(const u32x4*)(ksrc0 + (size_t)(t) * 64 * 96); if (k1) rk1 = *(const u32x4*)(ksrc1 + (size_t)(t) * 64 * 96); rv = *(const u32x4*)(vsrc + (t) * 64); } while (0)
#define AT_WRITE(buf) do { LAS unsigned char* b_ = lds + (buf) * ABUF; *(LAS u32x4*)(b_ + kdst0) = rk0; if (k1) *(LAS u32x4*)(b_ + kdst1) = rk1; *(LAS u32x4*)(b_ + vdst) = rv; } while (0)
    AT_LOAD(0); AT_WRITE(0);
    __syncthreads();
    f32x16 o0 = {0}, o1 = {0};
    float mrun = -INFINITY, lsum = 0.f;
    const int koff = swap23(q) * KROW + 16 * H, voff = KBUF + q * VROW + 16 * H;
    for (int t = 0; t < NT; ++t) {
        if (t + 1 < NT) AT_LOAD(t + 1);
        if (t <= mychunk) {
            const LAS unsigned char* kb = lds + (t & 1) * ABUF + koff; const LAS unsigned char* vb = lds + (t & 1) * ABUF + voff;
            f32x16 s0 = {0}, s1 = {0};
#pragma unroll
            for (int s = 0; s < 6; ++s) {
                const bf16x8 a0 = *(const LAS bf16x8*)(kb + 32 * s), a1 = *(const LAS bf16x8*)(kb + 32 * KROW + 32 * s);
                s0 = __builtin_amdgcn_mfma_f32_32x32x16_bf16(a0, qf[s], s0, 0, 0, 0);
                s1 = __builtin_amdgcn_mfma_f32_32x32x16_bf16(a1, qf[s], s1, 0, 0, 0);
            }
            float mloc = s0[0];
#pragma unroll
            for (int r = 1; r < 16; ++r) mloc = fmaxf(mloc, s0[r]);
#pragma unroll
            for (int r = 0; r < 16; ++r) mloc = fmaxf(mloc, s1[r]);
            mloc = fmaxf(mloc, __shfl_xor(mloc, 32));
            const float mnew = fmaxf(mrun, mloc);
            const float alpha = __builtin_amdgcn_exp2f(mrun - mnew);
            mrun = mnew;
            float ps = 0.f;
#pragma unroll
            for (int r = 0; r < 16; ++r) { s0[r] = __builtin_amdgcn_exp2f(s0[r] - mnew); s1[r] = __builtin_amdgcn_exp2f(s1[r] - mnew); ps += s0[r] + s1[r]; }
            lsum = lsum * alpha + ps;
#pragma unroll
            for (int r = 0; r < 16; ++r) { o0[r] *= alpha; o1[r] *= alpha; }
            u32x4 pw[4];
            pw[0] = (u32x4){cvtpk(s0[0], s0[1]), cvtpk(s0[2], s0[3]), cvtpk(s0[4], s0[5]), cvtpk(s0[6], s0[7])};
            pw[1] = (u32x4){cvtpk(s0[8], s0[9]), cvtpk(s0[10], s0[11]), cvtpk(s0[12], s0[13]), cvtpk(s0[14], s0[15])};
            pw[2] = (u32x4){cvtpk(s1[0], s1[1]), cvtpk(s1[2], s1[3]), cvtpk(s1[4], s1[5]), cvtpk(s1[6], s1[7])};
            pw[3] = (u32x4){cvtpk(s1[8], s1[9]), cvtpk(s1[10], s1[11]), cvtpk(s1[12], s1[13]), cvtpk(s1[14], s1[15])};
#pragma unroll
            for (int ks = 0; ks < 4; ++ks) {
                const bf16x8 v0 = *(const LAS bf16x8*)(vb + 32 * ks), v1 = *(const LAS bf16x8*)(vb + 32 * VROW + 32 * ks);
                const bf16x8 pb = __builtin_bit_cast(bf16x8, pw[ks]);
                o0 = __builtin_amdgcn_mfma_f32_32x32x16_bf16(v0, pb, o0, 0, 0, 0);
                o1 = __builtin_amdgcn_mfma_f32_32x32x16_bf16(v1, pb, o1, 0, 0, 0);
            }
        }
        if (t + 1 < NT) AT_WRITE((t + 1) & 1);
        __syncthreads();
    }
#undef AT_LOAD
#undef AT_WRITE
    const float ltot = lsum + __shfl_xor(lsum, 32), inv = 1.0f / ltot;
    const int b = bh >> 3, hd = bh & 7;
    bf16_t* dst = (bf16_t*)(ws + WS_CAT) + ((size_t)b * 4096 + row0 + q) * 1024 + 512 + hd * 64;
#pragma unroll
    for (int g = 0; g < 4; ++g) {
        u32x2 w; w.x = cvtpk(o0[4 * g] * inv, o0[4 * g + 1] * inv); w.y = cvtpk(o0[4 * g + 2] * inv, o0[4 * g + 3] * inv); *(u32x2*)(dst + 8 * g + 4 * H) = w;
        w.x = cvtpk(o1[4 * g] * inv, o1[4 * g + 1] * inv); w.y = cvtpk(o1[4 * g + 2] * inv, o1[4 * g + 3] * inv); *(u32x2*)(dst + 32 + 8 * g + 4 * H) = w;
    }
}
constexpr int AF_NS = 6, AF_KB = 64 * 192, AF_STG = AF_KB + 64 * 128;
__device__ __forceinline__ void attn_unit_fast(CP p, LAS unsigned char* lds, int bh, int qblk) {
    const int tid = threadIdx.x, lane = tid & 63, wid = __builtin_amdgcn_readfirstlane(tid >> 6), q = lane & 31, H = lane >> 5;
    unsigned char* ws = p->ws;
    const bf16_t* qg = (const bf16_t*)(ws + WS_Q) + (size_t)bh * 4096 * 96;
    const bf16_t* kg = (const bf16_t*)(ws + WS_K) + (size_t)bh * 4096 * 96;
    const bf16_t* vg = (const bf16_t*)(ws + WS_VT) + (size_t)bh * 64 * 4096;
    const int row0 = qblk * 256 + wid * 32, mychunk = 4 * qblk + (wid >> 1), NT = 4 * qblk + 4;
    int ks0, ks1, vs0;
    { int P = wid * 64 + lane, r = P / 12, c = (P % 12) ^ ((r >> 2) & 3); ks0 = r * 96 + c * 8;
      P = (8 + (wid & 3)) * 64 + lane; r = P / 12; c = (P % 12) ^ ((r >> 2) & 3); ks1 = r * 96 + c * 8;
      P = wid * 64 + lane; r = P >> 3; c = (P & 7) ^ ((r >> 1) & 7); vs0 = r * 4096 + c * 8; }
    const bool two = wid < 4;
#define AF_ISSUE(u) do { const int u_ = (u) < NT ? (u) : NT - 1; LAS unsigned char* st_ = lds + ((u) % AF_NS) * AF_STG; \
        __builtin_amdgcn_global_load_lds((const unsigned*)(kg + (size_t)u_ * 64 * 96 + ks0), (LAS unsigned*)(st_ + wid * 1024), 16, 0, 0); \
        if (two) __builtin_amdgcn_global_load_lds((const unsigned*)(kg + (size_t)u_ * 64 * 96 + ks1), (LAS unsigned*)(st_ + (8 + wid) * 1024), 16, 0, 0); \
        __builtin_amdgcn_global_load_lds((const unsigned*)(vg + u_ * 64 + vs0), (LAS unsigned*)(st_ + AF_KB + wid * 1024), 16, 0, 0); } while (0)
#define AF_WAITBAR() do { if (two) asm volatile("s_waitcnt vmcnt(3)" ::: "memory"); else asm volatile("s_waitcnt vmcnt(2)" ::: "memory"); \
        asm volatile("s_waitcnt lgkmcnt(0)" ::: "memory"); __builtin_amdgcn_s_barrier(); asm volatile("" ::: "memory"); } while (0)
    static_assert(AF_NS == 6, "ring depth vs the issue / wait pattern below (one tile may stay in flight across a barrier)");
    const int pr = swap23(q), kx = (pr >> 2) & 3;
    const int kbe = pr * 192 + 16 * ((H ^ (kx & 1)) + 2 * (kx >> 1)), kbo = pr * 192 + 16 * ((H ^ (kx & 1)) + 2 * (1 ^ (kx >> 1)));
    const int vx = (q >> 1) & 7, vbase = AF_KB + q * 128 + 16 * (H ^ (vx & 1)), vxx = (vx >> 1) * 32;
    bf16x8 qf[6];
#pragma unroll
    for (int s = 0; s < 6; ++s) qf[s] = *(const bf16x8*)(qg + (size_t)(row0 + q) * 96 + 16 * s + 8 * H);
#define AF_QK(S0, S1, u) do { const LAS unsigned char* kb_ = lds + ((u) % AF_NS) * AF_STG; \
        { const bf16x8 a0_ = *(const LAS bf16x8*)(kb_ + kbe), a1_ = *(const LAS bf16x8*)(kb_ + kbe + 32 * 192); \
          S0 = __builtin_amdgcn_mfma_f32_32x32x16_bf16(a0_, qf[0], (f32x16){0.f, 0.f, 0.f, 0.f, 0.f, 0.f, 0.f, 0.f, 0.f, 0.f, 0.f, 0.f, 0.f, 0.f, 0.f, 0.f}, 0, 0, 0); \
          S1 = __builtin_amdgcn_mfma_f32_32x32x16_bf16(a1_, qf[0], (f32x16){0.f, 0.f, 0.f, 0.f, 0.f, 0.f, 0.f, 0.f, 0.f, 0.f, 0.f, 0.f, 0.f, 0.f, 0.f, 0.f}, 0, 0, 0); } \
        _Pragma("unroll") for (int s_ = 1; s_ < 6; ++s_) { const int o_ = ((s_ & 1) ? kbo : kbe) + 64 * (s_ >> 1); \
            const bf16x8 a0_ = *(const LAS bf16x8*)(kb_ + o_), a1_ = *(const LAS bf16x8*)(kb_ + o_ + 32 * 192); \
            S0 = __builtin_amdgcn_mfma_f32_32x32x16_bf16(a0_, qf[s_], S0, 0, 0, 0); \
            S1 = __builtin_amdgcn_mfma_f32_32x32x16_bf16(a1_, qf[s_], S1, 0, 0, 0); } } while (0)
    asm volatile("s_waitcnt vmcnt(0) lgkmcnt(0)" ::: "memory"); __builtin_amdgcn_s_barrier(); asm volatile("" ::: "memory");
    AF_ISSUE(0); AF_ISSUE(1); AF_ISSUE(2); AF_ISSUE(3);
    AF_WAITBAR();
    f32x16 o0 = {0}, o1 = {0}, c0, c1;
    float lsum = 0.f;
    AF_QK(c0, c1, 0);
#define AF_STEP(t, CA, CB, NA, NB) do { if ((t) <= mychunk) { \
            AF_QK(NA, NB, (t) + 1);                      \
            float ps = 0.f; \
            _Pragma("unroll") for (int r = 0; r < 16; ++r) { CA[r] = __builtin_amdgcn_exp2f(CA[r]); CB[r] = __builtin_amdgcn_exp2f(CB[r]); ps += CA[r] + CB[r]; } \
            lsum += ps; \
            u32x4 pw[4]; \
            pw[0] = (u32x4){cvtpk(CA[0], CA[1]), cvtpk(CA[2], CA[3]), cvtpk(CA[4], CA[5]), cvtpk(CA[6], CA[7])}; \
            pw[1] = (u32x4){cvtpk(CA[8], CA[9]), cvtpk(CA[10], CA[11]), cvtpk(CA[12], CA[13]), cvtpk(CA[14], CA[15])}; \
            pw[2] = (u32x4){cvtpk(CB[0], CB[1]), cvtpk(CB[2], CB[3]), cvtpk(CB[4], CB[5]), cvtpk(CB[6], CB[7])}; \
            pw[3] = (u32x4){cvtpk(CB[8], CB[9]), cvtpk(CB[10], CB[11]), cvtpk(CB[12], CB[13]), cvtpk(CB[14], CB[15])}; \
            const LAS unsigned char* vb = lds + ((t) % AF_NS) * AF_STG + vbase; \
            _Pragma("unroll") for (int ks = 0; ks < 4; ++ks) { \
                const int vo = (ks * 32) ^ vxx; \
                const bf16x8 v0 = *(const LAS bf16x8*)(vb + vo), v1 = *(const LAS bf16x8*)(vb + vo + 32 * 128); \
                const bf16x8 pb = __builtin_bit_cast(bf16x8, pw[ks]); \
                o0 = __builtin_amdgcn_mfma_f32_32x32x16_bf16(v0, pb, o0, 0, 0, 0); \
                o1 = __builtin_amdgcn_mfma_f32_32x32x16_bf16(v1, pb, o1, 0, 0, 0); } } } while (0)
    f32x16 d0, d1;
#pragma unroll 1
    for (int t = 0; t < NT; t += 2) {
        AF_ISSUE(t + 4); AF_ISSUE(t + 5);
        AF_STEP(t, c0, c1, d0, d1);
        AF_STEP(t + 1, d0, d1, c0, c1);
        AF_WAITBAR();
    }
#undef AF_STEP
#undef AF_ISSUE
#undef AF_WAITBAR
#undef AF_QK
    const float ltot = lsum + __shfl_xor(lsum, 32), inv = 1.0f / ltot;
    const int b = bh >> 3, hd = bh & 7;
    bf16_t* dst = (bf16_t*)(ws + WS_CAT) + ((size_t)b * 4096 + row0 + q) * 1024 + 512 + hd * 64;
#pragma unroll
    for (int g = 0; g < 4; ++g) {
        u32x2 w; w.x = cvtpk(o0[4 * g] * inv, o0[4 * g + 1] * inv); w.y = cvtpk(o0[4 * g + 2] * inv, o0[4 * g + 3] * inv); *(u32x2*)(dst + 8 * g + 4 * H) = w;
        w.x = cvtpk(o1[4 * g] * inv, o1[4 * g + 1] * inv); w.y = cvtpk(o1[4 * g + 2] * inv, o1[4 * g + 3] * inv); *(u32x2*)(dst + 32 + 8 * g + 4 * H) = w;
    }
}
__device__ __forceinline__ void attn_unit2(CP p, LAS unsigned char* lds, int bh, int QB) {
    int lane = threadIdx.x & 63; asm volatile("" : "+v"(lane));
    const int tid = threadIdx.x, wid = __builtin_amdgcn_readfirstlane(tid >> 6), q = lane & 31, H = lane >> 5;
    unsigned char* ws = p->ws;
    const bf16_t* qg = (const bf16_t*)(ws + WS_Q) + (size_t)bh * 4096 * 96;
    const bf16_t* kg = (const bf16_t*)(ws + WS_K) + (size_t)bh * 4096 * 96;
    const bf16_t* vg = (const bf16_t*)(ws + WS_VT) + (size_t)bh * 64 * 4096;
    const int rowA = QB * 512 + wid * 32, rowB = QB * 512 + (15 - wid) * 32;
    const int chA = 8 * QB + (wid >> 1), chB = 8 * QB + ((15 - wid) >> 1), NT = 8 * QB + 8;
    int ks0, ks1, vs0;
    { int P = wid * 64 + lane, r = P / 12, c = (P % 12) ^ ((r >> 2) & 3); ks0 = r * 96 + c * 8;
      P = (8 + (wid & 3)) * 64 + lane; r = P / 12; c = (P % 12) ^ ((r >> 2) & 3); ks1 = r * 96 + c * 8;
      P = wid * 64 + lane; r = P >> 3; c = (P & 7) ^ ((r >> 1) & 7); vs0 = r * 4096 + c * 8; }
    const bool two = wid < 4;
#define A2_ISSUE(u) do { const int u_ = (u) < NT ? (u) : NT - 1; LAS unsigned char* st_ = lds + ((u) % AF_NS) * AF_STG; \
        __builtin_amdgcn_global_load_lds((const unsigned*)(kg + (size_t)u_ * 64 * 96 + ks0), (LAS unsigned*)(st_ + wid * 1024), 16, 0, 0); \
        if (two) __builtin_amdgcn_global_load_lds((const unsigned*)(kg + (size_t)u_ * 64 * 96 + ks1), (LAS unsigned*)(st_ + (8 + wid) * 1024), 16, 0, 0); \
        __builtin_amdgcn_global_load_lds((const unsigned*)(vg + u_ * 64 + vs0), (LAS unsigned*)(st_ + AF_KB + wid * 1024), 16, 0, 0); } while (0)
#define A2_WAITBAR() do { if (two) asm volatile("s_waitcnt vmcnt(3)" ::: "memory"); else asm volatile("s_waitcnt vmcnt(2)" ::: "memory"); \
        asm volatile("s_waitcnt lgkmcnt(0)" ::: "memory"); __builtin_amdgcn_s_barrier(); asm volatile("" ::: "memory"); } while (0)
    const int pr = swap23(q), kx = (pr >> 2) & 3;
    const int kbe = pr * 192 + 16 * ((H ^ (kx & 1)) + 2 * (kx >> 1)), kbo = pr * 192 + 16 * ((H ^ (kx & 1)) + 2 * (1 ^ (kx >> 1)));
    const int vx = (q >> 1) & 7, vbase = AF_KB + q * 128 + 16 * (H ^ (vx & 1)), vxx = (vx >> 1) * 32;
    bf16x8 qa[6], qb[6];
#pragma unroll
    for (int s = 0; s < 6; ++s) { qa[s] = *(const bf16x8*)(qg + (size_t)(rowA + q) * 96 + 16 * s + 8 * H); qb[s] = *(const bf16x8*)(qg + (size_t)(rowB + q) * 96 + 16 * s + 8 * H); }
    asm volatile("s_waitcnt vmcnt(0) lgkmcnt(0)" ::: "memory"); __builtin_amdgcn_s_barrier(); asm volatile("" ::: "memory");
    A2_ISSUE(0); A2_ISSUE(1); A2_ISSUE(2); A2_ISSUE(3);
    A2_WAITBAR();
    f32x16 oa0 = {0}, oa1 = {0}, ob0 = {0}, ob1 = {0};
    float la = 0.f, lb = 0.f;
#define A2_ZERO (f32x16){0.f, 0.f, 0.f, 0.f, 0.f, 0.f, 0.f, 0.f, 0.f, 0.f, 0.f, 0.f, 0.f, 0.f, 0.f, 0.f}
#define A2_PACK2(PW, C) do { \
        PW[0] = (u32x4){cvtpk(C[0], C[1]), cvtpk(C[2], C[3]), cvtpk(C[4], C[5]), cvtpk(C[6], C[7])}; \
        PW[1] = (u32x4){cvtpk(C[8], C[9]), cvtpk(C[10], C[11]), cvtpk(C[12], C[13]), cvtpk(C[14], C[15])}; } while (0)
#define A2_HALF(t, hh) do { const LAS unsigned char* kb_ = lds + ((t) % AF_NS) * AF_STG + (hh) * (32 * 192); const LAS unsigned char* vb_ = lds + ((t) % AF_NS) * AF_STG + vbase; \
        if ((t) <= chB) {                                    \
            const bool both_ = (t) <= chA; \
            f32x16 sa = A2_ZERO, sb; \
            _Pragma("unroll") for (int s_ = 0; s_ < 6; ++s_) { const int o_ = ((s_ & 1) ? kbo : kbe) + 64 * (s_ >> 1); \
                const bf16x8 a_ = *(const LAS bf16x8*)(kb_ + o_); \
                sb = __builtin_amdgcn_mfma_f32_32x32x16_bf16(a_, qb[s_], s_ == 0 ? A2_ZERO : sb, 0, 0, 0); \
                if (both_) sa = __builtin_amdgcn_mfma_f32_32x32x16_bf16(a_, qa[s_], sa, 0, 0, 0); } \
            float pb = 0.f; \
            _Pragma("unroll") for (int r = 0; r < 16; ++r) { sb[r] = __builtin_amdgcn_exp2f(sb[r]); pb += sb[r]; } \
            lb += pb; \
            u32x4 pwa[2] = {(u32x4){0, 0, 0, 0}, (u32x4){0, 0, 0, 0}}, pwb[2]; A2_PACK2(pwb, sb); \
            if (both_) { float pa = 0.f; \
                _Pragma("unroll") for (int r = 0; r < 16; ++r) { sa[r] = __builtin_amdgcn_exp2f(sa[r]); pa += sa[r]; } \
                la += pa; A2_PACK2(pwa, sa); } \
            _Pragma("unroll") for (int k2 = 0; k2 < 2; ++k2) { const int vo = (((hh) * 2 + k2) * 32) ^ vxx; \
                const bf16x8 v0 = *(const LAS bf16x8*)(vb_ + vo), v1 = *(const LAS bf16x8*)(vb_ + vo + 32 * 128); \
                const bf16x8 xb = __builtin_bit_cast(bf16x8, pwb[k2]); \
                ob0 = __builtin_amdgcn_mfma_f32_32x32x16_bf16(v0, xb, ob0, 0, 0, 0); ob1 = __builtin_amdgcn_mfma_f32_32x32x16_bf16(v1, xb, ob1, 0, 0, 0); \
                if (both_) { const bf16x8 xa = __builtin_bit_cast(bf16x8, pwa[k2]); \
                    oa0 = __builtin_amdgcn_mfma_f32_32x32x16_bf16(v0, xa, oa0, 0, 0, 0); oa1 = __builtin_amdgcn_mfma_f32_32x32x16_bf16(v1, xa, oa1, 0, 0, 0); } } \
        } } while (0)
#define A2_STEP(t) do { A2_HALF(t, 0); __builtin_amdgcn_sched_barrier(0); A2_HALF(t, 1); __builtin_amdgcn_sched_barrier(0); } while (0)
#pragma unroll 1
    for (int t = 0; t < NT; t += 2) {
        A2_ISSUE(t + 4); A2_ISSUE(t + 5);
        A2_STEP(t);
        A2_STEP(t + 1);
        A2_WAITBAR();
    }
#undef A2_STEP
#undef A2_HALF
#undef A2_PACK2
#undef A2_ZERO
#undef A2_ISSUE
#undef A2_WAITBAR
    const int b = bh >> 3, hd = bh & 7;
    {
        const float ltot = la + __shfl_xor(la, 32), inv = 1.0f / ltot;
        bf16_t* dst = (bf16_t*)(ws + WS_CAT) + ((size_t)b * 4096 + rowA + q) * 1024 + 512 + hd * 64;
#pragma unroll
        for (int g = 0; g < 4; ++g) {
            u32x2 w; w.x = cvtpk(oa0[4 * g] * inv, oa0[4 * g + 1] * inv); w.y = cvtpk(oa0[4 * g + 2] * inv, oa0[4 * g + 3] * inv); *(u32x2*)(dst + 8 * g + 4 * H) = w;
            w.x = cvtpk(oa1[4 * g] * inv, oa1[4 * g + 1] * inv); w.y = cvtpk(oa1[4 * g + 2] * inv, oa1[4 * g + 3] * inv); *(u32x2*)(dst + 32 + 8 * g + 4 * H) = w;
        }
    }
    {
        const float ltot = lb + __shfl_xor(lb, 32), inv = 1.0f / ltot;
        bf16_t* dst = (bf16_t*)(ws + WS_CAT) + ((size_t)b * 4096 + rowB + q) * 1024 + 512 + hd * 64;
#pragma unroll
        for (int g = 0; g < 4; ++g) {
            u32x2 w; w.x = cvtpk(ob0[4 * g] * inv, ob0[4 * g + 1] * inv); w.y = cvtpk(ob0[4 * g + 2] * inv, ob0[4 * g + 3] * inv); *(u32x2*)(dst + 8 * g + 4 * H) = w;
            w.x = cvtpk(ob1[4 * g] * inv, ob1[4 * g + 1] * inv); w.y = cvtpk(ob1[4 * g + 2] * inv, ob1[4 * g + 3] * inv); *(u32x2*)(dst + 32 + 8 * g + 4 * H) = w;
        }
    }
}
__device__ __forceinline__ void phase2(CP p, LAS unsigned char* lds) {
    const int lane = threadIdx.x & 63;
    const float* qn = (const float*)p->in[15]; const float* kn = (const float*)p->in[16];
    float mq = 0.f, mk = 0.f;
    for (int j = lane; j < 96; j += 64) { mq = fmaxf(mq, fabsf(qn[j])); mk = fmaxf(mk, fabsf(kn[j])); }
#pragma unroll
    for (int o = 1; o < 64; o <<= 1) { mq = fmaxf(mq, __shfl_xor(mq, o)); mk = fmaxf(mk, __shfl_xor(mk, o)); }
    const float bound = 96.0f * mq * mk * QSCALE * 1.01f;
    if (bound <= 40.0f) {
        for (int u = vcu_id(); u < 256; u += gridDim.x) { const int bh = u >> 2, pr = u & 3; attn_unit2(p, lds, bh, 7 - pr); attn_unit2(p, lds, bh, pr); }
    } else {
        for (int u = vcu_id(); u < 512; u += gridDim.x) { const int bh = u >> 3, pr = u & 7; attn_unit(p, lds, bh, 15 - pr); attn_unit(p, lds, bh, pr); }
    }
    asm volatile("s_waitcnt vmcnt(0)" ::: "memory"); __syncthreads();
}

__device__ __forceinline__ void phase3(CP p, LAS unsigned char* lds) {
    const int tid = threadIdx.x, lane = tid & 63, wid = __builtin_amdgcn_readfirstlane(tid >> 6), wr = wid >> 2, wc = wid & 3, fr = lane & 15, fq = lane >> 4;
    unsigned char* ws = p->ws;
    const float* x = (const float*)p->in[0]; const float* mod = (const float*)(ws + WS_MOD); float* sq1 = (float*)(ws + WS_SSQ1);
    for (int u = vcu_id(); u < 512; u += gridDim.x) {
        const int pm = u >> 2, pn = u & 3;
        const bf16_t* ap[4]; const bf16_t* bp[4];
        stage_ptrs_dense<4>((const bf16_t*)(ws + WS_CAT), 1024, pm * 256, ap); stage_ptrs_dense<4>((const bf16_t*)(ws + WS_WOUT), 1024, pn * 256, bp);
        f32x4 acc[8][4];
#pragma unroll
        for (int m = 0; m < 8; ++m)
#pragma unroll
            for (int n = 0; n < 4; ++n) acc[m][n] = (f32x4){0.f, 0.f, 0.f, 0.f};
        gemm_block<8, 4, true>(lds, ap, bp, 16, acc);
        const int rowb = pm * 256 + wr * 128 + fr, b = (pm * 256) >> 12, colb = pn * 256 + wc * 64 + fq * 4;
        f32x4 ga[4];
#pragma unroll
        for (int n = 0; n < 4; ++n) ga[n] = *(const f32x4*)(mod + b * 6144 + 2048 + colb + n * 16);
#pragma unroll
        for (int mb = 0; mb < 8; mb += 4) {
            f32x4 xv[4][4];
#pragma unroll
            for (int m = 0; m < 4; ++m)
#pragma unroll
                for (int n = 0; n < 4; ++n) xv[m][n] = *(const f32x4*)(x + (size_t)(rowb + (mb + m) * 16) * DM + colb + n * 16);
#pragma unroll
            for (int m = 0; m < 4; ++m) { const size_t row = rowb + (mb + m) * 16; float s = 0.f;
#pragma unroll
                for (int n = 0; n < 4; ++n) { const f32x4 v = xv[m][n] + ga[n] * acc[mb + m][n];
                    *(f32x4*)(p->out + row * DM + colb + n * 16) = v; s += (v.x * v.x + v.y * v.y) + (v.z * v.z + v.w * v.w); }
                s += __shfl_xor(s, 16); s += __shfl_xor(s, 32);
                if (fq == 0) sq1[row * 16 + pn * 4 + wc] = s; }
        }
    }
}

constexpr int RROW = 2064;
__device__ __forceinline__ void phase3b(CP p, LAS unsigned char* lds, bool dry) {
    const int tid = threadIdx.x, lane = tid & 63, wave = __builtin_amdgcn_readfirstlane(tid >> 6), fr = lane & 15, fq = lane >> 4;
    unsigned char* ws = p->ws;
    const float* nf = (const float*)p->in[18]; const float* mod = (const float*)(ws + WS_MOD); const float* sq1 = (const float*)(ws + WS_SSQ1);
    const float* bg = (const float*)p->in[20]; const float* be = (const float*)p->in[22];
    bf16_t* h2 = (bf16_t*)(ws + WS_H); const bf16_t* wrh = (const bf16_t*)(ws + WS_WR); const bf16_t* wrl = wrh + 48 * 1024;
    LAS unsigned char* Ahi = lds; LAS unsigned char* Alo = lds + 32 * RROW; LAS float* part = (LAS float*)lds; LAS float* lg = (LAS float*)(lds + 133120);
    LAS int* dtok = (LAS int*)(lds + 139264); LAS int* dEl = dtok + 128; LAS int* dEh = dtok + 256; LAS int* dbk = dtok + 384;
    LAS unsigned* lcnt = (LAS unsigned*)(dtok + 512); LAS unsigned* lbase = lcnt + 144;
    unsigned* ctl = (unsigned*)(ws + WS_CTL); int* lists = (int*)(ws + WS_LIST); int* blists = (int*)(ws + WS_BLIST); float* tokw = (float*)(ws + WS_TOKW);
    const int G = gridDim.x, NTILE = MT / 32;
    bf16x8 Bh[3][4], Bl[3][4];
#pragma unroll
    for (int nt = 0; nt < 3; ++nt)
#pragma unroll
        for (int kk = 0; kk < 4; ++kk) { const size_t o = (size_t)(nt * 16 + fr) * 1024 + wave * 128 + kk * 32 + fq * 8; Bh[nt][kk] = *(const bf16x8*)(wrh + o); Bl[nt][kk] = *(const bf16x8*)(wrl + o); }
    if (tid < 144) lcnt[tid] = 0u;
    f32x4 xr[2][4]; float rs[2];
    LAS f32x4* gms = (LAS f32x4*)(lds + 143360);
#define P3B_LOADG(tl) do { const int b_ = ((tl) * 32) >> 12; if (tid < 256) { const int col = 4 * tid; \
        const f32x4 g = *(const f32x4*)(nf + col), s_ = *(const f32x4*)(mod + b_ * 6144 + 4096 + col); gms[2 * tid] = g * (s_ + 1.0f); gms[2 * tid + 1] = *(const f32x4*)(mod + b_ * 6144 + 3072 + col); } __syncthreads(); } while (0)
#define P3B_LOADX(tl, rb) do { _Pragma("unroll") for (int rr = 0; rr < 2; ++rr) { const size_t row = (size_t)(tl) * 32 + wave * 4 + (rb) + rr; float ss = 0.f; \
        _Pragma("unroll") for (int k = 0; k < 4; ++k) { const f32x4 s4 = *(const f32x4*)(sq1 + row * 16 + 4 * k); ss += (s4.x + s4.y) + (s4.z + s4.w); } rs[rr] = ss; \
        _Pragma("unroll") for (int j = 0; j < 4; ++j) xr[rr][j] = *(const f32x4*)(p->out + row * DM + 4 * lane + 256 * j); } } while (0)
#define P3B_PROC(tl, rb) do { _Pragma("unroll") for (int rr = 0; rr < 2; ++rr) { const int lr = wave * 4 + (rb) + rr; const size_t row = (size_t)(tl) * 32 + lr; \
        const float rstd = __builtin_amdgcn_rsqf(rs[rr] * (1.0f / DM) + EPS); \
        _Pragma("unroll") for (int j = 0; j < 4; ++j) { const int col = 4 * lane + 256 * j; const f32x4 xv = xr[rr][j]; \
            const f32x4 o = xv * rstd * gms[2 * (lane + 64 * j)] + gms[2 * (lane + 64 * j) + 1]; \
            u32x2 w; w.x = cvtpk(o.x, o.y); w.y = cvtpk(o.z, o.w); \
            *(u32x2*)(h2 + row * DM + col) = w; *(LAS u32x2*)(Ahi + lr * RROW + col * 2) = w; \
            const float lx = o.x - __builtin_bit_cast(float, w.x << 16), ly = o.y - __builtin_bit_cast(float, w.x & 0xffff0000u), lz = o.z - __builtin_bit_cast(float, w.y << 16), lw = o.w - __builtin_bit_cast(float, w.y & 0xffff0000u); \
            u32x2 wl; wl.x = cvtpk(lx, ly); wl.y = cvtpk(lz, lw); *(LAS u32x2*)(Alo + lr * RROW + col * 2) = wl; } } } while (0)
    const int TPB = (NTILE + G - 1) / G, tbeg = blockIdx.x * TPB, tend = tbeg + TPB < NTILE ? tbeg + TPB : NTILE;
    int nacc = 0, bcur = -1;
    { const int t0 = tbeg < NTILE ? tbeg : NTILE - 1; P3B_LOADX(t0, 0); }
#pragma unroll 1
    for (int tile = tbeg; tile < tend; ++tile) {
        const int r0 = tile * 32;
        if ((r0 >> 12) != bcur) { bcur = r0 >> 12; P3B_LOADG(tile); }
        P3B_PROC(tile, 0);
        P3B_LOADX(tile, 2);
        P3B_PROC(tile, 2);
        { const int tn = tile + 1 < NTILE ? tile + 1 : NTILE - 1; P3B_LOADX(tn, 0); }
        __syncthreads();
        f32x4 P[2][3];
#pragma unroll
        for (int mt = 0; mt < 2; ++mt)
#pragma unroll
            for (int nt = 0; nt < 3; ++nt) P[mt][nt] = (f32x4){0.f, 0.f, 0.f, 0.f};
#pragma unroll
        for (int mt = 0; mt < 2; ++mt)
#pragma unroll
            for (int kk = 0; kk < 4; ++kk) {
                const int ao = (mt * 16 + fr) * RROW + (wave * 128 + kk * 32 + fq * 8) * 2;
                const bf16x8 a_h = *(const LAS bf16x8*)(Ahi + ao), a_l = *(const LAS bf16x8*)(Alo + ao);
#pragma unroll
                for (int nt = 0; nt < 3; ++nt) {
                    P[mt][nt] = __builtin_amdgcn_mfma_f32_16x16x32_bf16(a_h, Bh[nt][kk], P[mt][nt], 0, 0, 0);
                    P[mt][nt] = __builtin_amdgcn_mfma_f32_16x16x32_bf16(a_l, Bh[nt][kk], P[mt][nt], 0, 0, 0);
                    P[mt][nt] = __builtin_amdgcn_mfma_f32_16x16x32_bf16(a_h, Bl[nt][kk], P[mt][nt], 0, 0, 0);
                }
            }
        __syncthreads();
#pragma unroll
        for (int mt = 0; mt < 2; ++mt)
#pragma unroll
            for (int nt = 0; nt < 3; ++nt)
#pragma unroll
                for (int j = 0; j < 4; ++j) part[(wave * 32 + mt * 16 + fq * 4 + j) * 48 + nt * 16 + fr] = P[mt][nt][j];
        __syncthreads();
#pragma unroll
        for (int i = 0; i < 3; ++i) { const int idx = tid + 512 * i; float v = 0.f;
#pragma unroll
            for (int w8 = 0; w8 < 8; ++w8) v += part[w8 * 1536 + idx];
            lg[idx] = v; }
        __syncthreads();
        if (tid < 32) {
            const LAS float* l = lg + tid * 48; const int tok = r0 + tid;
            float gl[4]; int gi = 0; float gmx;
#pragma unroll
            for (int i = 0; i < 4; ++i) gl[i] = l[i] + bg[i];
            gmx = gl[0];
#pragma unroll
            for (int i = 1; i < 4; ++i) if (gl[i] > gmx) { gmx = gl[i]; gi = i; }
            float gs = 0.f;
#pragma unroll
            for (int i = 0; i < 4; ++i) gs += __expf(gl[i] - gmx);
            const float gtop = 1.0f / gs;
            float el[8];
#pragma unroll
            for (int i = 0; i < 8; ++i) el[i] = l[4 + gi * 8 + i] + be[gi * 8 + i];
            int e1 = 0; float m1 = el[0];
#pragma unroll
            for (int i = 1; i < 8; ++i) if (el[i] > m1) { m1 = el[i]; e1 = i; }
            int e2 = -1; float m2 = -INFINITY;
#pragma unroll
            for (int i = 0; i < 8; ++i) if (i != e1 && el[i] > m2) { m2 = el[i]; e2 = i; }
            const float p2 = __expf(m2 - m1);
            const float w1 = gtop / (1.0f + p2), w2 = gtop * p2 / (1.0f + p2);
            const int lo = e1 < e2 ? e1 : e2, hi = e1 < e2 ? e2 : e1;
            const float wlo = e1 < e2 ? w1 : w2, whi = e1 < e2 ? w2 : w1;
            const int bk = gi * 28 + lo * 8 - ((lo * (lo + 1)) >> 1) + (hi - lo - 1);
            const int sl = nacc * 32 + tid;
            dtok[sl] = tok; dEl[sl] = gi * 8 + lo; dEh[sl] = gi * 8 + hi; dbk[sl] = 32 + bk;
            if (!dry) { tokw[tok * 2] = wlo; tokw[tok * 2 + 1] = whi; }
        }
        ++nacc;
        if (nacc == 4 || tile + 1 >= tend) {
            __syncthreads();
            const int ntok = nacc * 32; unsigned r1 = 0, r2 = 0, r3 = 0; int El = 0, Eh = 0, bk = 0, tok = 0;
            if (tid < ntok) { tok = dtok[tid]; El = dEl[tid]; Eh = dEh[tid]; bk = dbk[tid];
                r1 = __hip_atomic_fetch_add(lcnt + El, 1u, __ATOMIC_RELAXED, __HIP_MEMORY_SCOPE_WORKGROUP); r2 = __hip_atomic_fetch_add(lcnt + Eh, 1u, __ATOMIC_RELAXED, __HIP_MEMORY_SCOPE_WORKGROUP);
                r3 = __hip_atomic_fetch_add(lcnt + bk, 1u, __ATOMIC_RELAXED, __HIP_MEMORY_SCOPE_WORKGROUP); }
            __syncthreads();
            if (tid < 144) { const unsigned c = lcnt[tid]; if (c && !dry) lbase[tid] = atomicAdd(ctl + CW_CNT + 64 * tid, c); lcnt[tid] = 0u; }
            __syncthreads();
            if (tid < ntok && !dry) {
                lists[(size_t)El * MT + lbase[El] + r1] = tok * 2; lists[(size_t)Eh * MT + lbase[Eh] + r2] = tok * 2 + 1;
                blists[(size_t)(bk - 32) * MT + lbase[bk] + r3] = tok; }
            nacc = 0;
            __syncthreads();
        }
    }
#undef P3B_LOADG
#undef P3B_LOADX
#undef P3B_PROC
}

struct U4a { int e, rt, ct, cnt; };
__device__ __forceinline__ int prefix_find(const LAS unsigned* pre, int n, int u) {
    const int lane = threadIdx.x & 63; int res = -1;
    for (int b0 = 0; b0 < n; b0 += 64) { const int i = b0 + lane; const bool hit = i < n && (int)pre[i] <= u && u < (int)pre[i + 1];
        const unsigned long long m = __ballot(hit); if (m) { res = b0 + __builtin_ctzll(m); break; } }
    return res;
}
__device__ __forceinline__ bool p4a_find(const LAS unsigned* cnts, const LAS unsigned* pre, int u, U4a& r) {
    const int i = prefix_find(pre, 32, u); if (i < 0) return false;
    const int uu = u - (int)pre[i]; r.e = i; r.rt = uu >> 1; r.ct = uu & 1; r.cnt = (int)cnts[i]; return true;
}
template <int MI, int NI>
__device__ __forceinline__ void p4a_ptrs(CP p, int e, int row0, int cnt, int col0, const bf16_t* (&ap)[MI / 2], const bf16_t* (&bp)[NI]) {
    const int tid = threadIdx.x, lane = tid & 63;
    const int* lst = (const int*)(p->ws + WS_LIST) + (size_t)e * MT + row0; const int nrow = cnt - row0;
    const bf16_t* h2 = (const bf16_t*)(p->ws + WS_H);
    int tok[MI / 2], C[MI / 2];
#pragma unroll
    for (int i = 0; i < MI / 2; ++i) { int R; stage_rc2((tid >> 6) * 1024 + i * 8192 + lane * 16, R, C[i]); tok[i] = lst[R < nrow ? R : 0] >> 1; }
#pragma unroll
    for (int i = 0; i < MI / 2; ++i) ap[i] = h2 + (size_t)tok[i] * 1024 + C[i];
    stage_ptrs_dense<NI>((const bf16_t*)(p->ws + WS_WGU) + (size_t)e * 512 * 1024, 1024, col0, bp);
}
template <int MI, int NI>
__device__ __forceinline__ void p4a_epilogue(CP p, int e, int row0, int cnt, int col0, const f32x4 (&acc)[MI][NI]) {
    const int tid = threadIdx.x, lane = tid & 63, wid = __builtin_amdgcn_readfirstlane(tid >> 6), wr = wid >> 2, wc = wid & 3, fr = lane & 15, fq = lane >> 4;
    unsigned char* ws = p->ws;
    const float* tokw = (const float*)(ws + WS_TOKW); bf16_t* ab = (bf16_t*)(ws + WS_ABUF);
    const int* lst = (const int*)(ws + WS_LIST) + (size_t)e * MT + row0; const int nrow = cnt - row0;
    int ent[MI]; float w[MI];
#pragma unroll
    for (int m = 0; m < MI; ++m) { const int R = wr * (MI * 16) + m * 16 + fr; ent[m] = lst[R < nrow ? R : 0]; }
#pragma unroll
    for (int m = 0; m < MI; ++m) w[m] = tokw[ent[m]];
#pragma unroll
    for (int m = 0; m < MI; ++m) { const int R = wr * (MI * 16) + m * 16 + fr; const float wm = w[m];
#pragma unroll
        for (int h = 0; h < NI / 2; ++h) { const f32x4 g = acc[m][2 * h], uu = acc[m][2 * h + 1];
            const int np = col0 + wc * (NI * 16) + h * 32 + fq * 4, ch = (np >> 8) * 128 + ((np >> 6) & 3) * 32 + ((np >> 5) & 1) * 16 + (np & 15);
            u32x2 o; o.x = cvtpk(g.x * __builtin_amdgcn_rcpf(1.0f + __expf(-g.x)) * uu.x * wm, g.y * __builtin_amdgcn_rcpf(1.0f + __expf(-g.y)) * uu.y * wm);
            o.y = cvtpk(g.z * __builtin_amdgcn_rcpf(1.0f + __expf(-g.z)) * uu.z * wm, g.w * __builtin_amdgcn_rcpf(1.0f + __expf(-g.w)) * uu.w * wm);
            if (R < nrow) *(u32x2*)(ab + (size_t)ent[m] * 256 + ch) = o; } }
}
__device__ __forceinline__ void phase4a(CP p, LAS unsigned char* lds, const LAS unsigned* cnts, const LAS unsigned* pre) {
    const int G = gridDim.x, v = vcu_id();
    const int U = (int)pre[32], F = U - U % G;
    {
        int u = v; U4a cur;
        if (u < F && p4a_find(cnts, pre, u, cur)) {
            const bf16_t* ap[4]; const bf16_t* bp[4];
            p4a_ptrs<8, 4>(p, cur.e, cur.rt * 256, cur.cnt, cur.ct * 256, ap, bp);
            __syncthreads();
            gemm_stage<8, 4, false>(lds, 0, ap, bp, 0, 0);
            for (;;) {
                f32x4 acc[8][4];
#pragma unroll
                for (int m = 0; m < 8; ++m)
#pragma unroll
                    for (int n = 0; n < 4; ++n) acc[m][n] = (f32x4){0.f, 0.f, 0.f, 0.f};
                gemm_main<8, 4, true, false>(lds, 0, ap, bp, 16, acc);
                U4a nxt; u += G; const bool has_next = u < F && p4a_find(cnts, pre, u, nxt);
                if (has_next) { p4a_ptrs<8, 4>(p, nxt.e, nxt.rt * 256, nxt.cnt, nxt.ct * 256, ap, bp); gemm_stage<8, 4, false>(lds, 0, ap, bp, 0, 0); }
                p4a_epilogue<8, 4>(p, cur.e, cur.rt * 256, cur.cnt, cur.ct * 256, acc);
                if (!has_next) break;
                cur = nxt;
                stage_ptrs_dense<4>((const bf16_t*)(p->ws + WS_WGU) + (size_t)cur.e * 512 * 1024, 1024, cur.ct * 256, bp);
            }
        }
    }
    asm volatile("s_waitcnt vmcnt(0)" ::: "memory"); __syncthreads();
#pragma unroll 1
    for (int sv = v; sv < 4 * (U - F); sv += G) {
        U4a t; if (!p4a_find(cnts, pre, F + (sv >> 2), t)) break;
        const int row0 = t.rt * 256 + ((sv >> 1) & 1) * 128, col0 = t.ct * 256 + (sv & 1) * 128;
        if (row0 < t.cnt) {
            const bf16_t* ap[2]; const bf16_t* bp[2];
            p4a_ptrs<4, 2>(p, t.e, row0, t.cnt, col0, ap, bp);
            __syncthreads();
            gemm_stage<4, 2, false>(lds, 0, ap, bp, 0, 0);
            f32x4 acc[4][2];
#pragma unroll
            for (int m = 0; m < 4; ++m)
#pragma unroll
                for (int n = 0; n < 2; ++n) acc[m][n] = (f32x4){0.f, 0.f, 0.f, 0.f};
            gemm_main<4, 2, true, false>(lds, 0, ap, bp, 16, acc);
            p4a_epilogue<4, 2>(p, t.e, row0, t.cnt, col0, acc);
        }
    }
    asm volatile("s_waitcnt vmcnt(0)" ::: "memory"); __syncthreads();
}
struct U4b { int bk, rt, ct, cnt; };
__device__ __forceinline__ bool p4b_find(const LAS unsigned* cnts, const LAS unsigned* pre, int u, U4b& r) {
    const int i = prefix_find(pre + 33, 112, u); if (i < 0) return false;
    const int uu = u - (int)pre[33 + i]; r.bk = i; r.rt = uu >> 2; r.ct = uu & 3; r.cnt = (int)cnts[32 + i]; return true;
}
__device__ __forceinline__ void p4b_ptrs(CP p, const U4b& u, const bf16_t* (&ap)[2], const bf16_t* (&bp)[4], const bf16_t* (&bq)[4]) {
    const int tid = threadIdx.x, lane = tid & 63;
    const int g = u.bk / 28; int pi = u.bk % 28, lo = 0; while (pi >= 7 - lo) { pi -= 7 - lo; ++lo; } const int hi = lo + 1 + pi;
    const int* lst = (const int*)(p->ws + WS_BLIST) + (size_t)u.bk * MT + u.rt * 128; const int nrow = u.cnt - u.rt * 128;
    const bf16_t* ab = (const bf16_t*)(p->ws + WS_ABUF);
#pragma unroll
    for (int i = 0; i < 2; ++i) { int R, C; stage_rc2((tid >> 6) * 1024 + i * 8192 + lane * 16, R, C); const int tok = lst[R < nrow ? R : 0]; ap[i] = ab + (size_t)tok * 512 + C; }
    stage_ptrs_dense<4>((const bf16_t*)(p->ws + WS_WD) + (size_t)(g * 8 + lo) * 1024 * 256, 256, u.ct * 256, bp);
    stage_ptrs_dense<4>((const bf16_t*)(p->ws + WS_WD) + (size_t)(g * 8 + hi) * 1024 * 256, 256, u.ct * 256, bq);
#pragma unroll
    for (int i = 0; i < 4; ++i) bq[i] -= 256;
}
__device__ __forceinline__ void phase4b(CP p, LAS unsigned char* lds, const LAS unsigned* cnts, const LAS unsigned* pre) {
    const int tid = threadIdx.x, lane = tid & 63, wid = __builtin_amdgcn_readfirstlane(tid >> 6), wr = wid >> 2, wc = wid & 3, fr = lane & 15, fq = lane >> 4;
    unsigned char* ws = p->ws;
    const float* mod = (const float*)(ws + WS_MOD); float* out = p->out;
    int u = vcu_id(); U4b cur;
    if (!p4b_find(cnts, pre, u, cur)) return;
    const bf16_t* ap[2]; const bf16_t* bp[4]; const bf16_t* bq[4];
    p4b_ptrs(p, cur, ap, bp, bq);
    int tok[4];
    { const int* lst = (const int*)(ws + WS_BLIST) + (size_t)cur.bk * MT + cur.rt * 128; const int nrow = cur.cnt - cur.rt * 128;
#pragma unroll
      for (int m = 0; m < 4; ++m) { const int R = wr * 64 + m * 16 + fr; tok[m] = lst[R < nrow ? R : 0]; } }
    __syncthreads();
    gemm_stage<4, 4, false>(lds, 0, ap, bp, 0, 0);
    for (;;) {
        const int colb = cur.ct * 256 + wc * 64 + fq * 4; const int nrow = cur.cnt - cur.rt * 128;
        f32x4 old[4][4];
#pragma unroll
        for (int m = 0; m < 4; ++m)
#pragma unroll
            for (int n = 0; n < 4; ++n) old[m][n] = *(const f32x4*)(out + (size_t)tok[m] * DM + colb + n * 16);
        f32x4 acc[4][4];
#pragma unroll
        for (int m = 0; m < 4; ++m)
#pragma unroll
            for (int n = 0; n < 4; ++n) acc[m][n] = (f32x4){0.f, 0.f, 0.f, 0.f};
        gemm_main2<4, 4, true, false>(lds, 0, ap, bp, bq, 4, 8, acc);
        U4b nxt; u += gridDim.x; const bool has_next = p4b_find(cnts, pre, u, nxt);
        int tokn[4] = {0, 0, 0, 0};
        if (has_next) { p4b_ptrs(p, nxt, ap, bp, bq); gemm_stage<4, 4, false>(lds, 0, ap, bp, 0, 0);
            const int* lst = (const int*)(ws + WS_BLIST) + (size_t)nxt.bk * MT + nxt.rt * 128; const int nr2 = nxt.cnt - nxt.rt * 128;
#pragma unroll
            for (int m = 0; m < 4; ++m) { const int R = wr * 64 + m * 16 + fr; tokn[m] = lst[R < nr2 ? R : 0]; } }
#pragma unroll
        for (int m = 0; m < 4; ++m) { const int R = wr * 64 + m * 16 + fr; const int b = tok[m] >> 12;
#pragma unroll
            for (int n = 0; n < 4; ++n) { const f32x4 gf = *(const f32x4*)(mod + b * 6144 + 5120 + colb + n * 16);
                const f32x4 o = old[m][n] + gf * acc[m][n]; if (R < nrow) *(f32x4*)(out + (size_t)tok[m] * DM + colb + n * 16) = o; } }
        if (!has_next) break;
        cur = nxt;
#pragma unroll
        for (int m = 0; m < 4; ++m) tok[m] = tokn[m];
    }
    asm volatile("s_waitcnt vmcnt(0)" ::: "memory"); __syncthreads();
}

__global__ void __launch_bounds__(512, 2) hybrid_block_fwd(Params p) {
    extern __shared__ __attribute__((aligned(16))) unsigned char lds_raw[];
    LAS unsigned char* lds = (LAS unsigned char*)lds_raw;
    volatile LAS unsigned* MISC = (volatile LAS unsigned*)(lds + MISC_OFF);
    LAS unsigned* cnts = (LAS unsigned*)(lds + MISC_OFF + 256);
    const int tid = threadIdx.x;
    if (tid < 16) MISC[tid] = 0u;
    __syncthreads();
    unsigned* ctl = (unsigned*)(p.ws + WS_CTL);
    const bool single = (p.ph_hi - p.ph_lo) > 1;
    XcdBarrier bar; bar.bar = ctl + CW_BAR; bar.x = 0; bar.st = nullptr;
    if (single) bar = xcd_barrier_post(ctl + CW_BAR, MISC + 8);
#ifndef PH_MASK
#define PH_MASK 0x1ff
#endif
#define IN(k) (((PH_MASK >> (k)) & 1) && p.ph_lo <= (k) && (k) < p.ph_hi)
#define SEAM(k) do { if (IN(k) && IN((k) + 1)) xcd_barrier(bar); } while (0)
    constexpr int T0 = TR_EARLY, T1 = T0 + TR_I3 + 1024, T2 = T1 + 1536, T3 = T0 + TR_I3 + TR_I4, T4 = T3 + 1024, T5 = T3 + TR_I5;
#define SEAM_W(k, a0, e0, a1, e1, fl) do { if (IN(k) && IN((k) + 1)) { if (N_LAUNCH_SPLIT) xcd_barrier(bar); else xcd_barrier_work(bar, get_params(), lds, a0, e0, a1, e1, fl); } } while (0)
#ifndef REPEAT_PH
#define REPEAT_PH -1
#endif
#define NREP(k) ((REPEAT_PH == (k)) ? 2 : 1)
    if (IN(0)) { for (int r_ = 0; r_ < NREP(0); ++r_) phase0(get_params(), lds); } SEAM_W(0, 0, T0, 0, 0, 1);
    if (IN(1)) { for (int r_ = 0; r_ < NREP(1); ++r_) phase1a(get_params()); } SEAM_W(1, T0, T1, 0, 0, 0);
    if (IN(2)) { for (int r_ = 0; r_ < NREP(2); ++r_) phase1b(get_params(), lds); } SEAM_W(2, T1, T2, 0, 0, 0);
    if (IN(3)) { for (int r_ = 0; r_ < NREP(3); ++r_) phase1c(get_params(), lds); } SEAM_W(3, 0, 0, 0, 0, 2);
    if (IN(4)) { for (int r_ = 0; r_ < NREP(4); ++r_) phase2(get_params(), lds); } SEAM_W(4, T2, T3, T5, TR_NIT, 0);
    if (IN(5)) { for (int r_ = 0; r_ < NREP(5); ++r_) phase3(get_params(), lds); } SEAM_W(5, T3, T4, 0, 0, 0);
    if (IN(6)) { for (int r_ = 0; r_ < NREP(6); ++r_) phase3b(get_params(), lds, r_ + 1 < NREP(6)); } SEAM_W(6, T4, T5, 0, 0, 0);
    LAS unsigned* pre = (LAS unsigned*)(lds + MISC_OFF + 256 + 640);
    if (IN(7) || IN(8)) {
        if (tid < 144) cnts[tid] = __hip_atomic_load(ctl + CW_CNT + 64 * tid, __ATOMIC_RELAXED, __HIP_MEMORY_SCOPE_AGENT);
        __syncthreads();
        if (tid == 0) { unsigned a = 0; for (int i = 0; i < 32; ++i) { pre[i] = a; a += ((cnts[i] + 255u) >> 8) * 2u; } pre[32] = a;
                        a = 0; for (int i = 0; i < 112; ++i) { pre[33 + i] = a; a += ((cnts[32 + i] + 127u) >> 7) * 4u; } pre[33 + 112] = a; }
        __syncthreads();
    }
    if (IN(7)) { for (int r_ = 0; r_ < NREP(7); ++r_) phase4a(get_params(), lds, cnts, pre); } SEAM(7);
    if (IN(8)) { phase4b(get_params(), lds, cnts, pre); }
#undef IN
#undef SEAM
}

extern "C" void kernel_launch(void* const* d_in, const int* in_sizes, int n_in, void* d_out, int out_size, void* d_ws, size_t ws_size, hipStream_t stream) {
    static int grid = 0;
    if (grid == 0) {
        if (n_in != 26 || out_size != MT * DM || ws_size < WS_END) { fprintf(stderr, "kernel_launch: unexpected problem (n_in %d out %d ws %zu)\n", n_in, out_size, ws_size); grid = -1; return; }
        int dev = 0, cus = 0, per_cu = 0;
        hipGetDevice(&dev); hipDeviceGetAttribute(&cus, hipDeviceAttributeMultiprocessorCount, dev);
        hipFuncSetAttribute((const void*)hybrid_block_fwd, hipFuncAttributeMaxDynamicSharedMemorySize, LDS_BYTES);
        hipOccupancyMaxActiveBlocksPerMultiprocessor(&per_cu, (const void*)hybrid_block_fwd, 512, LDS_BYTES);
        (void)hipGetLastError();
        if (per_cu < 1) { fprintf(stderr, "kernel_launch: occupancy query says %d blocks/CU\n", per_cu); per_cu = 1; }
        grid = cus;
    }
    if (grid < 0) return;
    hipMemsetAsync((char*)d_ws + WS_CTL, 0, CTL_BYTES, stream);
    Params prm{};
    for (int i = 0; i < 26; ++i) prm.in[i] = d_in[i];
    prm.out = (float*)d_out; prm.ws = (unsigned char*)d_ws;
#if N_LAUNCH_SPLIT
    for (int ph = 0; ph <= DBG_LAST_PHASE; ++ph) { prm.ph_lo = ph; prm.ph_hi = ph + 1; hipLaunchKernelGGL(hybrid_block_fwd, dim3(grid), dim3(512), LDS_BYTES, stream, prm); }
#else
    prm.ph_lo = 0; prm.ph_hi = DBG_LAST_PHASE + 1;
    hipLaunchKernelGGL(hybrid_block_fwd, dim3(grid), dim3(512), LDS_BYTES, stream, prm);
#endif
}
```

```cpp
#include <hip/hip_runtime.h>
#include <cstdio>
#include <cstdint>
#include <utility>

#ifndef N_LAUNCH_SPLIT
#define N_LAUNCH_SPLIT 0
#endif
#ifndef DBG_LAST_PHASE
#define DBG_LAST_PHASE 8
#endif

#define LAS __attribute__((address_space(3)))
#define GAS __attribute__((address_space(1)))
typedef unsigned short bf16_t;
typedef short bf16x8 __attribute__((ext_vector_type(8)));
typedef float f32x4 __attribute__((ext_vector_type(4)));
typedef float f32x2 __attribute__((ext_vector_type(2)));
typedef float f32x16 __attribute__((ext_vector_type(16)));
typedef unsigned u32x4 __attribute__((ext_vector_type(4)));
typedef unsigned u32x2 __attribute__((ext_vector_type(2)));
typedef __bf16 bf16x2_t __attribute__((ext_vector_type(2)));

constexpr int NB = 8, SEQ = 4096, DM = 1024, MT = NB * SEQ;
constexpr int NHEAD = 8, DQK = 96, DV = 64;
constexpr int NEXP = 32;
constexpr float EPS = 1e-6f;
constexpr float QSCALE = 0.14724444602590306f;
constexpr int NPH = 9;

constexpr size_t MiB = 1u << 20;
constexpr size_t WS_CTL = 0, CTL_BYTES = 128 * 1024;
constexpr size_t WS_MOD = 1 * MiB;
constexpr size_t WS_ROPE = 2 * MiB;
constexpr size_t WS_WIN = 6 * MiB;
constexpr size_t WS_WQ = 9 * MiB;
constexpr size_t WS_WKV = 9 * MiB + 512 * 1024;
constexpr size_t WS_WR = 9 * MiB + 768 * 1024;
constexpr size_t WS_WOUT = 10 * MiB;
constexpr size_t WS_WGU = 12 * MiB;
constexpr size_t WS_WD = 44 * MiB;
constexpr size_t WS_SSQQ = 60 * MiB;
constexpr size_t WS_SSQKV = 60 * MiB + 512 * 1024;
constexpr size_t WS_SSQKR = 60 * MiB + 768 * 1024;
constexpr size_t WS_SSQ1 = 61 * MiB;
constexpr size_t WS_TOKW = 63 * MiB;
constexpr size_t WS_KROPE = 64 * MiB;
constexpr size_t WS_CQ = 68 * MiB;
constexpr size_t WS_CKV = 84 * MiB;
constexpr size_t WS_LIST = 92 * MiB;
constexpr size_t WS_H = 100 * MiB;
constexpr size_t WS_U = 164 * MiB;
constexpr size_t WS_Q = 196 * MiB;
constexpr size_t WS_K = 244 * MiB;
constexpr size_t WS_VT = 292 * MiB;
constexpr size_t WS_CAT = 324 * MiB;
constexpr size_t WS_ABUF = 388 * MiB;
constexpr size_t WS_BLIST = 420 * MiB;
constexpr size_t WS_END = 435 * MiB;
constexpr int CW_BAR = 4096;
constexpr int CW_CNT = 16384;

constexpr int SCR_BYTES = 155648;
constexpr int MISC_OFF = SCR_BYTES;
constexpr int LDS_BYTES = SCR_BYTES + 2048;

__device__ __forceinline__ unsigned cvtpk(float lo, float hi) { f32x2 v = {lo, hi}; bf16x2_t b = __builtin_convertvector(v, bf16x2_t); return __builtin_bit_cast(unsigned, b); }
__device__ __forceinline__ float bf2f(unsigned short h) { return __builtin_bit_cast(float, (unsigned)h << 16); }
__device__ __forceinline__ unsigned short f2bf(float f) { return (unsigned short)(cvtpk(f, 0.f) & 0xffffu); }
__device__ __forceinline__ float sigmoidf_(float x) { return __builtin_amdgcn_rcpf(1.0f + __expf(-x)); }
__device__ __forceinline__ float siluf_(float x) { return x * __builtin_amdgcn_rcpf(1.0f + __expf(-x)); }
__device__ __forceinline__ float wave_sum(float v) {
#pragma unroll
    for (int o = 1; o < 64; o <<= 1) v += __shfl_xor(v, o);
    return v;
}

__device__ __forceinline__ int vcu_id() { const int g = gridDim.x, b = blockIdx.x; return (g & 7) == 0 ? (b & 7) * (g >> 3) + (b >> 3) : b; }
#define XB_TMO      128
#define XB_XCNT(j)  (256  + 64 * (j))
#define XB_XSUB(j)  (1280 + 64 * (j))
#define XB_XGEN(j)  (2304 + 64 * (j))
#define XB_TOP      3328
#define XB_TOPGEN   3392
#define XCD_BAR_WORDS 3456
#define XB_SPIN_CAP (1u << 20)
__device__ __forceinline__ unsigned xb_ld(unsigned* p)              { return __hip_atomic_load(p, __ATOMIC_RELAXED, __HIP_MEMORY_SCOPE_AGENT); }
__device__ __forceinline__ unsigned xb_add(unsigned* p, unsigned v) { return __hip_atomic_fetch_add(p, v, __ATOMIC_RELAXED, __HIP_MEMORY_SCOPE_AGENT); }
__device__ __forceinline__ unsigned xb_xcc_id() { return (unsigned)__builtin_amdgcn_s_getreg((3 << 11) | 20) & 0xFu; }
#define XB_SPIN(cond, bar) do { unsigned _sp = 0; while (cond) { __builtin_amdgcn_s_sleep(1); \
    if ((++_sp & 255u) == 0u) { if (xb_ld(&(bar)[XB_TMO])) break; if (_sp > XB_SPIN_CAP) { atomicAdd(&(bar)[XB_TMO], 1u); break; } } } } while (0)
struct XcdBarrier { unsigned* bar; unsigned x; volatile LAS unsigned* st; };
__device__ __forceinline__ XcdBarrier xcd_barrier_post(unsigned* bar, volatile LAS unsigned* st) {
    XcdBarrier b; b.bar = bar; b.x = xb_xcc_id(); b.st = st;
    if (threadIdx.x == 0) (void)xb_add(&bar[XB_XCNT(b.x)], 1u);
    return b;
}
__device__ __forceinline__ void xcd_barrier_complete(unsigned* bar, unsigned x, unsigned& nloc, unsigned& nx) {
    const unsigned G = gridDim.x * gridDim.y * gridDim.z;
    unsigned sum, cnt, mine, sp = 0u;
    for (;;) {
        sum = 0u; cnt = 0u; mine = 0u;
#pragma unroll
        for (unsigned j = 0; j < 16; ++j) { const unsigned c = xb_ld(&bar[XB_XCNT(j)]); sum += c; cnt += (c > 0u) ? 1u : 0u; mine = (j == x) ? c : mine; }
        if (sum == G) break;
        __builtin_amdgcn_s_sleep(1);
        if ((++sp & 255u) == 0u) { if (xb_ld(&bar[XB_TMO])) break; if (sp > XB_SPIN_CAP) { atomicAdd(&bar[XB_TMO], 1u); break; } }
    }
    nloc = mine > 0u ? mine : 1u; nx = cnt > 0u ? cnt : 1u;
}
__device__ __forceinline__ void xcd_barrier(const XcdBarrier& b) {
    asm volatile("s_waitcnt vmcnt(0)" ::: "memory");
    __syncthreads();
    if (threadIdx.x == 0) {
        unsigned* bar = b.bar;
        __builtin_amdgcn_s_waitcnt(0);
        unsigned nloc = b.st[0], nx = b.st[1];
        if (nloc == 0u) { xcd_barrier_complete(bar, b.x, nloc, nx); b.st[0] = nloc; b.st[1] = nx; }
        const unsigned old = xb_add(&bar[XB_XSUB(b.x)], 1u);
        const unsigned gen = old / nloc;
        if (old + 1u == (gen + 1u) * nloc) {
            __builtin_amdgcn_fence(__ATOMIC_RELEASE, "agent");
            asm volatile("s_waitcnt vmcnt(0)" ::: "memory");
            const unsigned og = xb_add(&bar[XB_TOP], 1u);
            const unsigned tg = og / nx;
            if (og + 1u == (tg + 1u) * nx) xb_add(&bar[XB_TOPGEN], 1u);
            else XB_SPIN(xb_ld(&bar[XB_TOPGEN]) == tg, bar);
            __builtin_amdgcn_fence(__ATOMIC_ACQUIRE, "agent");
            xb_add(&bar[XB_XGEN(b.x)], 1u);
            asm volatile("s_waitcnt vmcnt(0)" ::: "memory");
        } else {
            XB_SPIN(xb_ld(&bar[XB_XGEN(b.x)]) == gen, bar);
            __builtin_amdgcn_fence(__ATOMIC_ACQUIRE, "agent");
            asm volatile("s_waitcnt vmcnt(0)" ::: "memory");
        }
    }
    __syncthreads();
}

__device__ __forceinline__ int lds_byte2(int r, int c) { const int st = (r >> 4) * 2 + (c >> 5), ob = (r & 15) * 64 + (c & 31) * 2; return st * 1024 + (ob ^ (((ob >> 9) & 1) << 5)); }
__device__ __forceinline__ void stage_rc2(int b, int& R, int& C) { const int st = b >> 10, sb = b & 1023, swz = sb ^ (((sb >> 9) & 1) << 5); R = (st >> 1) * 16 + swz / 64; C = (st & 1) * 32 + (swz % 64) / 2; }

template <int MI, int NI, bool TRANS>
__device__ __forceinline__ void gemm_block(LAS unsigned char* lds, const bf16_t* const (&ap)[MI / 2], const bf16_t* const (&bp)[NI], int nkt, f32x4 (&acc)[MI][NI]) {
    constexpr int BM = 32 * MI, BN = 64 * NI, TA = BM * 128, TB = BN * 128, STG = TA + TB, GLA = MI / 2, GLB = NI;
    static_assert(2 * STG <= SCR_BYTES, "LDS");
    const int tid = threadIdx.x, lane = tid & 63, wid = __builtin_amdgcn_readfirstlane(tid >> 6), wr = wid >> 2, wc = wid & 3, fr = lane & 15, fq = lane >> 4;
    const int aoff = lds_byte2(wr * (MI * 16) + fr, fq * 8), boff = TA + lds_byte2(wc * (NI * 16) + fr, fq * 8);
#define GB_STAGE(buf, kt) do { \
        _Pragma("unroll") for (int i_ = 0; i_ < GLA; ++i_) __builtin_amdgcn_global_load_lds((const unsigned*)(ap[i_] + (kt) * 64), (LAS unsigned*)(lds + (buf) * STG + wid * 1024 + i_ * 8192), 16, 0, 0); \
        _Pragma("unroll") for (int i_ = 0; i_ < GLB; ++i_) __builtin_amdgcn_global_load_lds((const unsigned*)(bp[i_] + (kt) * 64), (LAS unsigned*)(lds + (buf) * STG + TA + wid * 1024 + i_ * 8192), 16, 0, 0); } while (0)
    GB_STAGE(0, 0);
    asm volatile("s_waitcnt vmcnt(0)" ::: "memory"); __syncthreads();
    for (int t = 0; t < nkt; ++t) {
        const int cur = t & 1;
        if (t + 1 < nkt) GB_STAGE(cur ^ 1, t + 1);
        const LAS unsigned char* sb = lds + cur * STG;
#pragma unroll
        for (int ks = 0; ks < 2; ++ks) {
            bf16x8 At[MI], Bf[NI];
#pragma unroll
            for (int m = 0; m < MI; ++m) At[m] = *(const LAS bf16x8*)(sb + aoff + m * 2048 + ks * 1024);
#pragma unroll
            for (int n = 0; n < NI; ++n) Bf[n] = *(const LAS bf16x8*)(sb + boff + n * 2048 + ks * 1024);
#pragma unroll
            for (int m = 0; m < MI; ++m)
#pragma unroll
                for (int n = 0; n < NI; ++n)
                    acc[m][n] = TRANS ? __builtin_amdgcn_mfma_f32_16x16x32_bf16(Bf[n], At[m], acc[m][n], 0, 0, 0)
                                      : __builtin_amdgcn_mfma_f32_16x16x32_bf16(At[m], Bf[n], acc[m][n], 0, 0, 0);
        }
        asm volatile("s_waitcnt vmcnt(0)" ::: "memory"); __syncthreads();
    }
#undef GB_STAGE
}
template <int MI, int NI, bool ARES>
__device__ __forceinline__ void gemm_stage(LAS unsigned char* lds, int abytes, const bf16_t* const (&ap)[MI / 2], const bf16_t* const (&bp)[NI], int buf, int kt) {
    constexpr int TA = MI * 32 * 128, TB = NI * 64 * 128, STG = ARES ? TB : TA + TB;
    const int wid = __builtin_amdgcn_readfirstlane(threadIdx.x >> 6);
    LAS unsigned char* base = lds + (ARES ? abytes : 0) + buf * STG + wid * 1024;
    if (!ARES) {
#pragma unroll
        for (int i = 0; i < MI / 2; ++i) __builtin_amdgcn_global_load_lds((const unsigned*)(ap[i] + kt * 64), (LAS unsigned*)(base + i * 8192), 16, 0, 0);
    }
#pragma unroll
    for (int i = 0; i < NI; ++i) __builtin_amdgcn_global_load_lds((const unsigned*)(bp[i] + kt * 64), (LAS unsigned*)(base + (ARES ? 0 : TA) + i * 8192), 16, 0, 0);
}
template <int MI>
__device__ __forceinline__ void gemm_load_ares(LAS unsigned char* lds, const bf16_t* const (&ap)[MI / 2], int nkt) {
    constexpr int TA = MI * 32 * 128;
    const int wid = __builtin_amdgcn_readfirstlane(threadIdx.x >> 6);
    for (int kt = 0; kt < nkt; ++kt) {
#pragma unroll
        for (int i = 0; i < MI / 2; ++i) __builtin_amdgcn_global_load_lds((const unsigned*)(ap[i] + kt * 64), (LAS unsigned*)(lds + kt * TA + wid * 1024 + i * 8192), 16, 0, 0);
    }
}
template <int MI, int NI, bool TRANS, bool ARES>
__device__ __forceinline__ void gemm_main2(LAS unsigned char* lds, int abytes, const bf16_t* const (&ap)[MI / 2], const bf16_t* const (&bp)[NI], const bf16_t* const (&bq)[NI], int ksplit, int nkt, f32x4 (&acc)[MI][NI]) {
    constexpr int TA = MI * 32 * 128, TB = NI * 64 * 128, STG = ARES ? TB : TA + TB;
    const int tid = threadIdx.x, lane = tid & 63, wid = __builtin_amdgcn_readfirstlane(tid >> 6), wr = wid >> 2, wc = wid & 3, fr = lane & 15, fq = lane >> 4;
    const int aoff = lds_byte2(wr * (MI * 16) + fr, fq * 8), boff = (ARES ? abytes : TA) + lds_byte2(wc * (NI * 16) + fr, fq * 8);
#pragma unroll 1
    for (int t = 0; t < nkt; ++t) {
        const int cur = t & 1;
        asm volatile("s_waitcnt vmcnt(0)" ::: "memory"); __syncthreads();
        if (t + 1 < nkt) { if (t + 1 < ksplit) gemm_stage<MI, NI, ARES>(lds, abytes, ap, bp, cur ^ 1, t + 1); else gemm_stage<MI, NI, ARES>(lds, abytes, ap, bq, cur ^ 1, t + 1); }
        const LAS unsigned char* sa = ARES ? lds + t * TA : lds + cur * STG;
        const LAS unsigned char* sb = lds + cur * STG;
#pragma unroll
        for (int ks = 0; ks < 2; ++ks) {
            bf16x8 At[MI], Bf[NI];
#pragma unroll
            for (int m = 0; m < MI; ++m) At[m] = *(const LAS bf16x8*)(sa + aoff + m * 2048 + ks * 1024);
#pragma unroll
            for (int n = 0; n < NI; ++n) Bf[n] = *(const LAS bf16x8*)(sb + boff + n * 2048 + ks * 1024);
#pragma unroll
            for (int m = 0; m < MI; ++m)
#pragma unroll
                for (int n = 0; n < NI; ++n)
                    acc[m][n] = TRANS ? __builtin_amdgcn_mfma_f32_16x16x32_bf16(Bf[n], At[m], acc[m][n], 0, 0, 0)
                                      : __builtin_amdgcn_mfma_f32_16x16x32_bf16(At[m], Bf[n], acc[m][n], 0, 0, 0);
        }
    }
    if (nkt & 1) __syncthreads();
}
template <int MI, int NI, bool TRANS, bool ARES>
__device__ __forceinline__ void gemm_main(LAS unsigned char* lds, int abytes, const bf16_t* const (&ap)[MI / 2], const bf16_t* const (&bp)[NI], int nkt, f32x4 (&acc)[MI][NI]) {
    gemm_main2<MI, NI, TRANS, ARES>(lds, abytes, ap, bp, bp, nkt, nkt, acc);
}
template <int GL>
__device__ __forceinline__ void stage_ptrs_dense(const bf16_t* base, size_t ld, int r0, const bf16_t* (&p)[GL]) {
    const int tid = threadIdx.x, lane = tid & 63, wid = tid >> 6;
#pragma unroll
    for (int i = 0; i < GL; ++i) { int R, C; stage_rc2(wid * 1024 + i * 8192 + lane * 16, R, C); p[i] = base + (size_t)(r0 + R) * ld + C; }
}

struct Params {
    const void* in[26];
    float* out;
    unsigned char* ws;
    int ph_lo, ph_hi;
};
typedef const __attribute__((address_space(4))) Params* CP;
__device__ __forceinline__ CP get_params() { CP q = (CP)__builtin_amdgcn_kernarg_segment_ptr(); asm volatile("" : "+s"(q)); return q; }

__device__ const float INVF[16] = {1.000000000e+00f, 5.623413324e-01f, 3.162277639e-01f, 1.778279394e-01f, 1.000000015e-01f, 5.623413250e-02f, 3.162277490e-02f, 1.778279431e-02f,
                                   9.999999776e-03f, 5.623413250e-03f, 3.162277630e-03f, 1.778279431e-03f, 1.000000047e-03f, 5.623413017e-04f, 3.162277571e-04f, 1.778279402e-04f};

__device__ __forceinline__ void tr_item(const float* srcp, int ldw, const float* kscale, bf16_t* WT, int Kd, int k0, int n0, LAS float* scr, int lane) {
#pragma unroll 8
    for (int i = 0; i < 32; ++i) { const int kk = 2 * i + (lane >> 5); float v = 0.f; if (srcp) { v = srcp[(size_t)(k0 + kk) * ldw]; if (kscale) v *= kscale[k0 + kk]; } scr[kk * 33 + (lane & 31)] = v; }
    asm volatile("s_waitcnt lgkmcnt(0)" ::: "memory");
    const int c = lane & 7;
#pragma unroll
    for (int j = 0; j < 4; ++j) { const int n = (lane >> 3) + 8 * j; const LAS float* s = scr + (8 * c) * 33 + n;
        u32x4 o; o.x = cvtpk(s[0 * 33], s[1 * 33]); o.y = cvtpk(s[2 * 33], s[3 * 33]); o.z = cvtpk(s[4 * 33], s[5 * 33]); o.w = cvtpk(s[6 * 33], s[7 * 33]);
        *(u32x4*)(WT + (size_t)(n0 + n) * Kd + k0 + 8 * c) = o; }
    asm volatile("s_waitcnt lgkmcnt(0)" ::: "memory");
}

constexpr int TR_I0 = 16 * 24, TR_I1 = 4 * 12, TR_I2 = 2 * 16, TR_I3 = 16 * 16, TR_I4 = 32 * 128, TR_I5 = 32 * 64, TR_I6 = 16 * 2;
constexpr int TR_NIT = TR_I0 + TR_I1 + TR_I2 + TR_I3 + TR_I4 + TR_I5 + TR_I6, TR_EARLY = TR_I0 + TR_I1 + TR_I2;
__device__ __forceinline__ void transpose_items(CP p, LAS unsigned char* lds, int it0, int it1) {
    const int tid = threadIdx.x, lane = tid & 63, wave = __builtin_amdgcn_readfirstlane(tid >> 6);
    const int G = gridDim.x, bid = blockIdx.x;
    unsigned char* ws = p->ws;
    {
        LAS unsigned* scr = (LAS unsigned*)(lds + 65536) + wave * 2112;
        const int gw = bid * 8 + wave, NGW = G * 8;
        const float* w_in = (const float*)p->in[6]; const float* qan = (const float*)p->in[11]; const float* w_qb = (const float*)p->in[12];
        const float* kvan = (const float*)p->in[13]; const float* w_kvb = (const float*)p->in[14]; const float* w_out = (const float*)p->in[17];
        const float* w_group = (const float*)p->in[19]; const float* w_expert = (const float*)p->in[21];
        const float* w_gate = (const float*)p->in[23]; const float* w_up = (const float*)p->in[24]; const float* w_down = (const float*)p->in[25];
        constexpr int I0 = TR_I0, I1 = TR_I1, I2 = TR_I2, I3 = TR_I3, I4 = TR_I4, I5 = TR_I5, I6 = TR_I6, NIT = TR_NIT;
        const int c4 = lane & 15, kp = lane >> 4;
        for (int it = it0 + gw; it < it1; it += NGW) {
            int r = it;
            if (r >= NIT - I6) {
                r -= NIT - I6;
                LAS float* fscr = (LAS float*)scr; const int nl = lane & 31;
                const int kb = r >> 1, nb = r & 1, n0 = nb * 32, np = n0 + nl, k0 = kb * 64;
                const float* srcp = nullptr; int ldw = 0;
                if (np < 4) { srcp = w_group + np; ldw = 4; } else if (np < 36) { srcp = w_expert + (np - 4); ldw = 32; }
#pragma unroll 8
                for (int i = 0; i < 32; ++i) { const int kk = 2 * i + (lane >> 5); fscr[kk * 33 + nl] = srcp ? srcp[(size_t)(k0 + kk) * ldw] : 0.f; }
                asm volatile("s_waitcnt lgkmcnt(0)" ::: "memory");
                const int c = lane & 7;
#pragma unroll
                for (int j = 0; j < 4; ++j) { const int n = (lane >> 3) + 8 * j; const LAS float* sp = fscr + (8 * c) * 33 + n;
                    float v[8], l[8];
#pragma unroll
                    for (int q = 0; q < 8; ++q) { v[q] = sp[q * 33]; l[q] = v[q] - bf2f(f2bf(v[q])); }
                    if (n0 + n < 48) {
                        u32x4 o; o.x = cvtpk(v[0], v[1]); o.y = cvtpk(v[2], v[3]); o.z = cvtpk(v[4], v[5]); o.w = cvtpk(v[6], v[7]);
                        *(u32x4*)((bf16_t*)(ws + WS_WR) + (size_t)(n0 + n) * 1024 + k0 + 8 * c) = o;
                        u32x4 o2; o2.x = cvtpk(l[0], l[1]); o2.y = cvtpk(l[2], l[3]); o2.z = cvtpk(l[4], l[5]); o2.w = cvtpk(l[6], l[7]);
                        *(u32x4*)((bf16_t*)(ws + WS_WR) + 48 * 1024 + (size_t)(n0 + n) * 1024 + k0 + 8 * c) = o2; } }
                asm volatile("s_waitcnt lgkmcnt(0)" ::: "memory");
                continue;
            }
            const float* srcp; int ldw, Kd, k0, n0; const float* ksc = nullptr; bf16_t* WT;
            if (r < I0) {
                const int kb = r / 24, nb = r % 24; n0 = nb * 64; k0 = kb * 64; const int np = n0 + 4 * c4;
                const int pn = np >> 8, wc = (np >> 6) & 3, n = (np >> 4) & 3, f = np & 15; int src;
                if (pn < 4) { const int ch = pn * 128 + wc * 32 + (n >> 1) * 16 + f; src = (n & 1) ? 512 + ch : ch; }
                else if (pn == 4) src = np;
                else { const int j = np - 1280; src = (j < 160) ? 1280 + j : -1; }
                srcp = src >= 0 ? w_in + src : nullptr; ldw = 1440; Kd = 1024; WT = (bf16_t*)(ws + WS_WIN);
            } else if ((r -= I0) < I1) {
                const int kb = r / 12, nb = r % 12; n0 = nb * 64; k0 = kb * 64;
                srcp = w_qb + n0 + 4 * c4; ldw = 768; Kd = 256; ksc = qan; WT = (bf16_t*)(ws + WS_WQ);
            } else if ((r -= I1) < I2) {
                const int kb = r / 16, nb = r % 16; n0 = nb * 64; k0 = kb * 64;
                srcp = w_kvb + n0 + 4 * c4; ldw = 1024; Kd = 128; ksc = kvan; WT = (bf16_t*)(ws + WS_WKV);
            } else if ((r -= I2) < I3) {
                const int kb = r / 16, nb = r % 16; n0 = nb * 64; k0 = kb * 64;
                srcp = w_out + n0 + 4 * c4; ldw = 1024; Kd = 1024; WT = (bf16_t*)(ws + WS_WOUT);
            } else if ((r -= I3) < I4) {
                const int e = r >> 7, q = r & 127, kb = q / 8, nb = q % 8; n0 = nb * 64; k0 = kb * 64; const int np = n0 + 4 * c4;
                const int ct = np >> 8, wc = (np >> 6) & 3, n = (np >> 4) & 3, f = np & 15, ch = ct * 128 + wc * 32 + (n >> 1) * 16 + f;
                srcp = ((n & 1) ? w_up : w_gate) + (size_t)e * 1024 * 256 + ch; ldw = 256; Kd = 1024; WT = (bf16_t*)(ws + WS_WGU) + (size_t)e * 512 * 1024;
            } else {
                r -= I4; const int e = r >> 6, q = r & 63, kb = q / 16, nb = q % 16; n0 = nb * 64; k0 = kb * 64;
                srcp = w_down + (size_t)e * 256 * 1024 + n0 + 4 * c4; ldw = 1024; Kd = 256; WT = (bf16_t*)(ws + WS_WD) + (size_t)e * 1024 * 256;
            }
            f32x4 v0[8], v1[8];
#pragma unroll
            for (int i = 0; i < 8; ++i) { const int k = k0 + 8 * i + 2 * kp;
                if (srcp) { v0[i] = *(const f32x4*)(srcp + (size_t)k * ldw); v1[i] = *(const f32x4*)(srcp + (size_t)(k + 1) * ldw); }
                else { v0[i] = (f32x4){0.f, 0.f, 0.f, 0.f}; v1[i] = v0[i]; } }
#pragma unroll
            for (int i = 0; i < 8; ++i) { const int k = k0 + 8 * i + 2 * kp; f32x4 a = v0[i], b = v1[i];
                if (ksc) { a = a * ksc[k]; b = b * ksc[k + 1]; }
                LAS unsigned* d = scr + (4 * c4) * 33 + 4 * i + kp;
                d[0] = cvtpk(a.x, b.x); d[33] = cvtpk(a.y, b.y); d[66] = cvtpk(a.z, b.z); d[99] = cvtpk(a.w, b.w); }
            asm volatile("s_waitcnt lgkmcnt(0)" ::: "memory");
            const int c = lane & 7;
#pragma unroll
            for (int j = 0; j < 8; ++j) { const int n = (lane >> 3) + 8 * j; const LAS unsigned* sp = scr + n * 33 + 4 * c;
                u32x4 o; o.x = sp[0]; o.y = sp[1]; o.z = sp[2]; o.w = sp[3];
                *(u32x4*)(WT + (size_t)(n0 + n) * Kd + k0 + 8 * c) = o; }
            asm volatile("s_waitcnt lgkmcnt(0)" ::: "memory");
        }
    }
}

__device__ __forceinline__ void rope_table(CP p) {
    const int* pos = (const int*)p->in[2]; f32x2* rt = (f32x2*)(p->ws + WS_ROPE);
    for (int e = blockIdx.x * 512 + threadIdx.x; e < MT * 16; e += gridDim.x * 512) {
        const int tok = e >> 4, i = e & 15;
        const float a32 = (float)pos[tok] * INVF[i];
        const double rev = (double)a32 * 0.15915494309189535;
        const float fr = (float)(rev - __builtin_rint(rev));
        rt[e] = (f32x2){__builtin_amdgcn_cosf(fr), __builtin_amdgcn_sinf(fr)};
    }
}

__device__ __forceinline__ void phase0(CP p, LAS unsigned char* lds) {
    const int tid = threadIdx.x, lane = tid & 63, wave = __builtin_amdgcn_readfirstlane(tid >> 6);
    const int G = gridDim.x, bid = blockIdx.x;
    unsigned char* ws = p->ws;
    if (bid < 192) {
        const float* c = (const float*)p->in[1]; const float* w_ada = (const float*)p->in[3]; const float* b_ada = (const float*)p->in[4];
        LAS float* sc = (LAS float*)lds;
        LAS float* red = (LAS float*)(lds + 32768);
        for (int i = tid; i < 8192; i += 512) sc[i] = siluf_(c[i]);
        __syncthreads();
        const int col = tid & 31, ks = tid >> 5, n0 = bid * 32;
        float a[8] = {0, 0, 0, 0, 0, 0, 0, 0};
#pragma unroll 8
        for (int i = 0; i < 64; ++i) { const int k = ks * 64 + i; const float w = w_ada[(size_t)k * 6144 + n0 + col];
#pragma unroll
            for (int b = 0; b < 8; ++b) a[b] += sc[b * 1024 + k] * w; }
#pragma unroll
        for (int b = 0; b < 8; ++b) red[(ks * 32 + col) * 8 + b] = a[b];
        __syncthreads();
        if (tid < 256) { const int cc = tid & 31, b = tid >> 5; float s = 0.f;
#pragma unroll
            for (int k2 = 0; k2 < 16; ++k2) s += red[(k2 * 32 + cc) * 8 + b];
            ((float*)(ws + WS_MOD))[b * 6144 + n0 + cc] = s + b_ada[n0 + cc]; }
        __syncthreads();
    }
    if (N_LAUNCH_SPLIT) { rope_table(p); transpose_items(p, lds, 0, TR_NIT); }
}

__device__ __forceinline__ void phase1a(CP p, LAS unsigned char* lds) {
    const int tid = threadIdx.x, lane = tid & 63, wave = tid >> 6;
    const int NGW = gridDim.x * 8;
    const float* x = (const float*)p->in[0]; const float* nm = (const float*)p->in[5]; const float* mod = (const float*)(p->ws + WS_MOD);
    bf16_t* h = (bf16_t*)(p->ws + WS_H);
    LAS f32x4* gms = (LAS f32x4*)lds;
    int bcur = -1;
    for (int base = blockIdx.x * 8; base < MT / 16; base += NGW) {
        const int r0 = (base + wave) * 16, b = (base * 16) >> 12;
        if (b != bcur) { bcur = b; __syncthreads();
            if (tid < 256) { const int col = 4 * tid; const f32x4 g = *(const f32x4*)(nm + col), s_ = *(const f32x4*)(mod + b * 6144 + 1024 + col); gms[2 * tid] = g * (s_ + 1.0f); gms[2 * tid + 1] = *(const f32x4*)(mod + b * 6144 + col); }
            __syncthreads(); }
#define P1A_LOAD(v, rb) do { _Pragma("unroll") for (int rr = 0; rr < 4; ++rr) { const float* xr = x + (size_t)(r0 + (rb) + rr) * DM; \
            _Pragma("unroll") for (int j = 0; j < 4; ++j) v[rr][j] = *(const f32x4*)(xr + 4 * lane + 256 * j); } } while (0)
#define P1A_PROC(v, rb) do { _Pragma("unroll") for (int rr = 0; rr < 4; ++rr) { float s = 0.f; \
            _Pragma("unroll") for (int j = 0; j < 4; ++j) s += (v[rr][j].x * v[rr][j].x + v[rr][j].y * v[rr][j].y) + (v[rr][j].z * v[rr][j].z + v[rr][j].w * v[rr][j].w); \
            const float rstd = __builtin_amdgcn_rsqf(wave_sum(s) * (1.0f / DM) + EPS); \
            bf16_t* hr = h + (size_t)(r0 + (rb) + rr) * DM; \
            _Pragma("unroll") for (int j = 0; j < 4; ++j) { const f32x4 o = v[rr][j] * rstd * gms[2 * (lane + 64 * j)] + gms[2 * (lane + 64 * j) + 1]; u32x2 w; w.x = cvtpk(o.x, o.y); w.y = cvtpk(o.z, o.w); *(u32x2*)(hr + 4 * lane + 256 * j) = w; } } } while (0)
        f32x4 va[4][4], vb[4][4];
        P1A_LOAD(va, 0);
        P1A_LOAD(vb, 4); P1A_PROC(va, 0);
        P1A_LOAD(va, 8); P1A_PROC(vb, 4);
        P1A_LOAD(vb, 12); P1A_PROC(va, 8);
        P1A_PROC(vb, 12);
#undef P1A_LOAD
#undef P1A_PROC
    }
}

__device__ __forceinline__ void phase1b(CP p, LAS unsigned char* lds) {
    const int tid = threadIdx.x, lane = tid & 63, wid = __builtin_amdgcn_readfirstlane(tid >> 6), wr = wid >> 2, wc = wid & 3, fr = lane & 15, fq = lane >> 4;
    unsigned char* ws = p->ws;
    const bf16_t* h = (const bf16_t*)(ws + WS_H); const bf16_t* win = (const bf16_t*)(ws + WS_WIN);
    for (int u = vcu_id(); u < 128 * 6; u += gridDim.x) {
        const int pm = u / 6, pn = u % 6;
        const bf16_t* ap[4]; const bf16_t* bp[4];
        stage_ptrs_dense<4>(h, 1024, pm * 256, ap); stage_ptrs_dense<4>(win, 1024, pn * 256, bp);
        f32x4 acc[8][4];
#pragma unroll
        for (int m = 0; m < 8; ++m)
#pragma unroll
            for (int n = 0; n < 4; ++n) acc[m][n] = (f32x4){0.f, 0.f, 0.f, 0.f};
        gemm_block<8, 4, true>(lds, ap, bp, 16, acc);
        const int rowb = pm * 256 + wr * 128 + fr;
        if (pn < 4) {
            bf16_t* ub = (bf16_t*)(ws + WS_U);
#pragma unroll
            for (int m = 0; m < 8; ++m) { const size_t row = rowb + m * 16;
#pragma unroll
                for (int h2 = 0; h2 < 2; ++h2) { const f32x4 v = acc[m][2 * h2], g = acc[m][2 * h2 + 1];
                    const int ch = pn * 128 + wc * 32 + h2 * 16 + fq * 4;
                    u32x2 w; w.x = cvtpk(v.x * sigmoidf_(g.x), v.y * sigmoidf_(g.y)); w.y = cvtpk(v.z * sigmoidf_(g.z), v.w * sigmoidf_(g.w));
                    *(u32x2*)(ub + row * 512 + ch) = w; } }
        } else if (pn == 4) {
            bf16_t* cq = (bf16_t*)(ws + WS_CQ); float* sq = (float*)(ws + WS_SSQQ);
#pragma unroll
            for (int m = 0; m < 8; ++m) { const size_t row = rowb + m * 16; float s = 0.f;
#pragma unroll
                for (int n = 0; n < 4; ++n) { const f32x4 v = acc[m][n]; s += (v.x * v.x + v.y * v.y) + (v.z * v.z + v.w * v.w);
                    u32x2 w; w.x = cvtpk(v.x, v.y); w.y = cvtpk(v.z, v.w); *(u32x2*)(cq + row * 256 + wc * 64 + n * 16 + fq * 4) = w; }
                s += __shfl_xor(s, 16); s += __shfl_xor(s, 32);
                if (fq == 0) sq[row * 4 + wc] = s; }
        } else {
            if (wc < 2) {
                bf16_t* ckv = (bf16_t*)(ws + WS_CKV); float* sq = (float*)(ws + WS_SSQKV);
#pragma unroll
                for (int m = 0; m < 8; ++m) { const size_t row = rowb + m * 16; float s = 0.f;
#pragma unroll
                    for (int n = 0; n < 4; ++n) { const f32x4 v = acc[m][n]; s += (v.x * v.x + v.y * v.y) + (v.z * v.z + v.w * v.w);
                        u32x2 w; w.x = cvtpk(v.x, v.y); w.y = cvtpk(v.z, v.w); *(u32x2*)(ckv + row * 128 + wc * 64 + n * 16 + fq * 4) = w; }
                    s += __shfl_xor(s, 16); s += __shfl_xor(s, 32);
                    if (fq == 0) sq[row * 2 + wc] = s; }
            } else if (wc == 2) {
                float* kr = (float*)(ws + WS_KROPE); float* sq = (float*)(ws + WS_SSQKR);
#pragma unroll
                for (int m = 0; m < 8; ++m) { const size_t row = rowb + m * 16; float s = 0.f;
#pragma unroll
                    for (int n = 0; n < 2; ++n) { const f32x4 v = acc[m][n]; s += (v.x * v.x + v.y * v.y) + (v.z * v.z + v.w * v.w);
                        *(f32x4*)(kr + row * 32 + n * 16 + fq * 4) = v; }
                    s += __shfl_xor(s, 16); s += __shfl_xor(s, 32);
                    if (fq == 0) sq[row] = s; }
            }
        }
    }
}

constexpr int EPI_SCR = 131072;
__device__ __forceinline__ void q_item(CP p, LAS unsigned char* lds, int item) {
    const int tid = threadIdx.x, lane = tid & 63, wid = __builtin_amdgcn_readfirstlane(tid >> 6), wr = wid >> 2, wc = wid & 3, fr = lane & 15, fq = lane >> 4;
    unsigned char* ws = p->ws;
    const int pm = item >> 1, ct = item & 1;
    const bf16_t* ap[2]; const bf16_t* bp[6];
    stage_ptrs_dense<2>((const bf16_t*)(ws + WS_CQ), 256, pm * 128, ap);
    stage_ptrs_dense<6>((const bf16_t*)(ws + WS_WQ), 256, ct * 384, bp);
    __syncthreads();
    gemm_stage<4, 6, false>(lds, 0, ap, bp, 0, 0);
    const float* sq = (const float*)(ws + WS_SSQQ); const float* qn = (const float*)p->in[15];
    const int rowb = pm * 128 + wr * 64 + fr, i0 = fq * 4;
    float rq[4]; f32x4 gq[6], cs01[4], cs23[4];
#pragma unroll
    for (int m = 0; m < 4; ++m) { const f32x4 s4 = *(const f32x4*)(sq + (size_t)(rowb + m * 16) * 4); rq[m] = __builtin_amdgcn_rsqf(((s4.x + s4.y) + (s4.z + s4.w)) * (1.0f / 256.0f) + EPS); }
#pragma unroll
    for (int n = 0; n < 6; ++n) gq[n] = *(const f32x4*)(qn + n * 16 + i0);
    const f32x2* rope = (const f32x2*)(ws + WS_ROPE);
#pragma unroll
    for (int m = 0; m < 4; ++m) { const size_t tok = rowb + m * 16; cs01[m] = *(const f32x4*)(rope + tok * 16 + i0); cs23[m] = *(const f32x4*)(rope + tok * 16 + i0 + 2); }
    f32x4 acc[4][6];
#pragma unroll
    for (int m = 0; m < 4; ++m)
#pragma unroll
        for (int n = 0; n < 6; ++n) acc[m][n] = (f32x4){0.f, 0.f, 0.f, 0.f};
    gemm_main<4, 6, true, false>(lds, 0, ap, bp, 4, acc);
    const int hd = ct * 4 + wc, bb = (pm * 128) >> 12, sb = rowb & 4095;
    bf16_t* dst0 = (bf16_t*)(ws + WS_Q) + ((size_t)(bb * 8 + hd) * 4096 + sb) * 96;
#pragma unroll
    for (int m = 0; m < 4; ++m) { float s = 0.f;
#pragma unroll
        for (int n = 0; n < 6; ++n) { acc[m][n] = acc[m][n] * rq[m]; const f32x4 v = acc[m][n]; s += (v.x * v.x + v.y * v.y) + (v.z * v.z + v.w * v.w); }
        s += __shfl_xor(s, 16); s += __shfl_xor(s, 32);
        const float rh = __builtin_amdgcn_rsqf(s * (1.0f / 96.0f) + EPS) * QSCALE;
        bf16_t* dst = dst0 + (m * 16) * 96;
#pragma unroll
        for (int n = 0; n < 4; ++n) { const f32x4 v = acc[m][n] * rh * gq[n]; u32x2 w; w.x = cvtpk(v.x, v.y); w.y = cvtpk(v.z, v.w); *(u32x2*)(dst + n * 16 + i0) = w; }
        const f32x4 x1 = acc[m][4] * rh * gq[4], x2 = acc[m][5] * rh * gq[5];
        const f32x4 c01 = cs01[m], c23 = cs23[m];
        f32x4 o1, o2;
        o1.x = x1.x * c01.x - x2.x * c01.y; o2.x = x1.x * c01.y + x2.x * c01.x;
        o1.y = x1.y * c01.z - x2.y * c01.w; o2.y = x1.y * c01.w + x2.y * c01.z;
        o1.z = x1.z * c23.x - x2.z * c23.y; o2.z = x1.z * c23.y + x2.z * c23.x;
        o1.w = x1.w * c23.z - x2.w * c23.w; o2.w = x1.w * c23.w + x2.w * c23.z;
        u32x2 w; w.x = cvtpk(o1.x, o1.y); w.y = cvtpk(o1.z, o1.w); *(u32x2*)(dst + 64 + i0) = w;
        w.x = cvtpk(o2.x, o2.y); w.y = cvtpk(o2.z, o2.w); *(u32x2*)(dst + 80 + i0) = w;
    }
}

constexpr int KV_SCR = 98304;
__device__ __forceinline__ void kv_item(CP p, LAS unsigned char* lds, int pm) {
    const int tid = threadIdx.x, lane = tid & 63, wid = __builtin_amdgcn_readfirstlane(tid >> 6), wr = wid >> 2, wc = wid & 3, fr = lane & 15, fq = lane >> 4;
    unsigned char* ws = p->ws;
    const bf16_t* ap[2]; const bf16_t* bp[4];
    stage_ptrs_dense<2>((const bf16_t*)(ws + WS_CKV), 128, pm * 128, ap);
    stage_ptrs_dense<4>((const bf16_t*)(ws + WS_WKV), 128, 0, bp);
    __syncthreads();
    gemm_load_ares<4>(lds, ap, 2);
    gemm_stage<4, 4, true>(lds, 32768, ap, bp, 0, 0);
    LAS float* kr_l = (LAS float*)(lds + KV_SCR); LAS float* rp_l = kr_l + 128 * 33; LAS float* rkv_l = rp_l + 128 * 34; LAS float* skr_l = rkv_l + 128;
    {
        const float* krp = (const float*)(ws + WS_KROPE) + (size_t)pm * 128 * 32; const float* rope = (const float*)(ws + WS_ROPE) + (size_t)pm * 128 * 32;
        f32x4 a[2], b[2];
#pragma unroll
        for (int k = 0; k < 2; ++k) { const int idx = tid + 512 * k; a[k] = *(const f32x4*)(krp + idx * 4); b[k] = *(const f32x4*)(rope + idx * 4); }
        float rk = 0.f, sk = 0.f;
        if (tid < 128) { const f32x2 s2 = *(const f32x2*)((const float*)(ws + WS_SSQKV) + (size_t)(pm * 128 + tid) * 2); rk = __builtin_amdgcn_rsqf((s2.x + s2.y) * (1.0f / 128.0f) + EPS); sk = ((const float*)(ws + WS_SSQKR))[pm * 128 + tid]; }
#pragma unroll
        for (int k = 0; k < 2; ++k) { const int idx = tid + 512 * k, row = idx >> 3, c4 = (idx & 7) * 4;
            LAS float* d = kr_l + row * 33 + c4; d[0] = a[k].x; d[1] = a[k].y; d[2] = a[k].z; d[3] = a[k].w;
            LAS float* e = rp_l + row * 34 + c4; e[0] = b[k].x; e[1] = b[k].y; e[2] = b[k].z; e[3] = b[k].w; }
        if (tid < 128) { rkv_l[tid] = rk; skr_l[tid] = sk; }
    }
    const float* kn = (const float*)p->in[16];
    const int rowl = wr * 64 + fq * 4, rowb = pm * 128 + rowl;
    float g[4];
#pragma unroll
    for (int n = 0; n < 4; ++n) g[n] = kn[n * 16 + fr];
    const float g1 = kn[64 + fr], g2 = kn[80 + fr];
    const int bb = (pm * 128) >> 12, sb = rowb & 4095;
#pragma unroll 1
    for (int pn = 0; pn < 4; ++pn) {
        f32x4 acc[4][4];
#pragma unroll
        for (int m = 0; m < 4; ++m)
#pragma unroll
            for (int n = 0; n < 4; ++n) acc[m][n] = (f32x4){0.f, 0.f, 0.f, 0.f};
        gemm_main<4, 4, false, true>(lds, 32768, ap, bp, 2, acc);
        if (pn < 3) {
#pragma unroll
            for (int i = 0; i < 4; ++i) bp[i] += 256 * 128;
            gemm_stage<4, 4, true>(lds, 32768, ap, bp, 0, 0);
        }
        const int hd = pn * 2 + (wc >> 1);
        if ((wc & 1) == 0) {
            bf16_t* dst_p = (bf16_t*)(ws + WS_K) + ((size_t)(bb * 8 + hd) * 4096 + sb) * 96 + fr;
#pragma unroll
            for (int m = 0; m < 4; ++m) {
#pragma unroll
                for (int j = 0; j < 4; ++j) {
                    const int o = m * 16 + j, rl = rowl + o;
                    const float rkv = rkv_l[rl];
                    float v[4], ss = 0.f;
#pragma unroll
                    for (int n = 0; n < 4; ++n) { v[n] = acc[m][n][j] * rkv; ss += v[n] * v[n]; }
                    ss += __shfl_xor(ss, 1); ss += __shfl_xor(ss, 2); ss += __shfl_xor(ss, 4); ss += __shfl_xor(ss, 8);
                    const float rk = __builtin_amdgcn_rsqf((ss + skr_l[rl]) * (1.0f / 96.0f) + EPS);
                    bf16_t* dst = dst_p + o * 96;
#pragma unroll
                    for (int n = 0; n < 4; ++n) dst[n * 16] = f2bf(v[n] * rk * g[n]);
                    const float x1 = kr_l[rl * 33 + fr] * rk * g1, x2 = kr_l[rl * 33 + 16 + fr] * rk * g2;
                    const float cs_c = rp_l[rl * 34 + 2 * fr], cs_s = rp_l[rl * 34 + 2 * fr + 1];
                    dst[64] = f2bf(x1 * cs_c - x2 * cs_s); dst[80] = f2bf(x1 * cs_s + x2 * cs_c);
                }
            }
        } else {
            bf16_t* vt_p = (bf16_t*)(ws + WS_VT) + ((size_t)(bb * 8 + hd) * 64 + fr) * 4096 + sb;
#pragma unroll
            for (int m = 0; m < 4; ++m) {
                float rkv[4];
#pragma unroll
                for (int j = 0; j < 4; ++j) rkv[j] = rkv_l[rowl + m * 16 + j];
#pragma unroll
                for (int n = 0; n < 4; ++n) { const f32x4 a = acc[m][n];
                    u32x2 w; w.x = cvtpk(a.x * rkv[0], a.y * rkv[1]); w.y = cvtpk(a.z * rkv[2], a.w * rkv[3]);
                    *(u32x2*)(vt_p + (size_t)(n * 16) * 4096 + m * 16) = w; }
            }
        }
    }
}

template <int R> __device__ __forceinline__ void conv_row(float (&o)[64], const float (&w)[31], float x) {
    constexpr int T0 = R > 30 ? R - 30 : 0, T1 = R < 63 ? R : 63;
#pragma unroll
    for (int t = T0; t <= T1; ++t) o[t] += w[R - t] * x;
}
template <int... R> __device__ __forceinline__ void conv_rows(float (&o)[64], const float (&w)[31], const float (&x)[94], std::integer_sequence<int, R...>) { (conv_row<R>(o, w, x[R]), ...); }
__device__ __forceinline__ void conv_unit(CP p, LAS unsigned char* lds, int cu) {
    const int tid = threadIdx.x, lane = tid & 63, wave = tid >> 6;
    const int b = cu >> 6, s0 = (cu & 63) * 64, c = tid;
    const bf16_t* ub = (const bf16_t*)(p->ws + WS_U) + ((size_t)b * 4096) * 512 + c;
    const float* cw = (const float*)p->in[7]; const float* cb = (const float*)p->in[8]; const float* lg = (const float*)p->in[9]; const float* lb = (const float*)p->in[10];
    float w[31];
#pragma unroll
    for (int j = 0; j < 31; ++j) w[j] = cw[j * 512 + c];
    float xin[94];
#pragma unroll
    for (int r = 0; r < 94; ++r) { const int s = s0 - 30 + r; xin[r] = bf2f(ub[(size_t)(s < 0 ? 0 : s) * 512]); }
    if (s0 == 0) {
#pragma unroll
        for (int r = 0; r < 30; ++r) xin[r] = 0.f;
    }
    float o[64];
    { const float bias = cb[c];
#pragma unroll
      for (int t = 0; t < 64; ++t) o[t] = bias; }
    conv_rows(o, w, xin, std::make_integer_sequence<int, 94>{});
    float s1, s2;
    {
        const bool b5 = lane & 32, b4 = lane & 16, b3 = lane & 8, b2 = lane & 4, b1 = lane & 2, b0 = lane & 1;
#define CONV_BFLY(RES, SQ) do { float a32[32]; \
        _Pragma("unroll") for (int i = 0; i < 32; ++i) { const float lo = SQ ? o[i] * o[i] : o[i], hi = SQ ? o[32 + i] * o[32 + i] : o[32 + i]; a32[i] = (b5 ? hi : lo) + __shfl_xor(b5 ? lo : hi, 32); } \
        float a16[16]; _Pragma("unroll") for (int i = 0; i < 16; ++i) a16[i] = (b4 ? a32[16 + i] : a32[i]) + __shfl_xor(b4 ? a32[i] : a32[16 + i], 16); \
        float a8[8]; _Pragma("unroll") for (int i = 0; i < 8; ++i) a8[i] = (b3 ? a16[8 + i] : a16[i]) + __shfl_xor(b3 ? a16[i] : a16[8 + i], 8); \
        float a4[4]; _Pragma("unroll") for (int i = 0; i < 4; ++i) a4[i] = (b2 ? a8[4 + i] : a8[i]) + __shfl_xor(b2 ? a8[i] : a8[4 + i], 4); \
        float a2[2]; _Pragma("unroll") for (int i = 0; i < 2; ++i) a2[i] = (b1 ? a4[2 + i] : a4[i]) + __shfl_xor(b1 ? a4[i] : a4[2 + i], 2); \
        RES = (b0 ? a2[1] : a2[0]) + __shfl_xor(b0 ? a2[0] : a2[1], 1); } while (0)
        CONV_BFLY(s1, false);
        asm volatile("" : "+v"(s1));
        CONV_BFLY(s2, true);
#undef CONV_BFLY
    }
    LAS float* red = (LAS float*)(lds + EPI_SCR);
    LAS float* stat = (LAS float*)(lds + EPI_SCR + 4096);
    red[(wave * 64 + lane) * 2] = s1; red[(wave * 64 + lane) * 2 + 1] = s2;
    __syncthreads();
    if (tid < 64) { float t1 = 0.f, t2 = 0.f;
#pragma unroll
        for (int k = 0; k < 8; ++k) { t1 += red[(k * 64 + tid) * 2]; t2 += red[(k * 64 + tid) * 2 + 1]; }
        const float mean = t1 * (1.0f / 512.0f); float var = t2 * (1.0f / 512.0f) - mean * mean; var = var < 0.f ? 0.f : var;
        stat[tid * 2] = mean; stat[tid * 2 + 1] = __builtin_amdgcn_rsqf(var + EPS); }
    __syncthreads();
    const float g = lg[c], bb = lb[c];
    bf16_t* cat = (bf16_t*)(p->ws + WS_CAT) + ((size_t)b * 4096 + s0) * 1024 + c;
#pragma unroll
    for (int t = 0; t < 64; ++t) { const float y = (o[t] - stat[t * 2]) * stat[t * 2 + 1] * g + bb; cat[(size_t)t * 1024] = f2bf(y * __builtin_amdgcn_rcpf(1.0f + __expf(-y))); }
    __syncthreads();
}

constexpr int CW_CONVQ = CW_CNT + 64 * 150;
__device__ __forceinline__ void xcd_barrier_work(const XcdBarrier& b, CP p, LAS unsigned char* lds, int a0, int e0, int a1, int e1, int flags) {
    asm volatile("s_waitcnt vmcnt(0)" ::: "memory");
    __syncthreads();
    unsigned gen = 0; bool leader = false;
    if (threadIdx.x == 0) {
        unsigned* bar = b.bar;
        __builtin_amdgcn_s_waitcnt(0);
        unsigned nloc = b.st[0], nx = b.st[1];
        if (nloc == 0u) { xcd_barrier_complete(bar, b.x, nloc, nx); b.st[0] = nloc; b.st[1] = nx; }
        const unsigned old = xb_add(&bar[XB_XSUB(b.x)], 1u);
        gen = old / nloc; leader = (old + 1u == (gen + 1u) * nloc);
        if (leader) {
            __builtin_amdgcn_fence(__ATOMIC_RELEASE, "agent");
            asm volatile("s_waitcnt vmcnt(0)" ::: "memory");
            const unsigned og = xb_add(&bar[XB_TOP], 1u);
            const unsigned tg = og / nx;
            if (og + 1u == (tg + 1u) * nx) xb_add(&bar[XB_TOPGEN], 1u);
            else XB_SPIN(xb_ld(&bar[XB_TOPGEN]) == tg, bar);
            __builtin_amdgcn_fence(__ATOMIC_ACQUIRE, "agent");
            xb_add(&bar[XB_XGEN(b.x)], 1u);
            asm volatile("s_waitcnt vmcnt(0)" ::: "memory");
        }
    }
    if (flags & 1) rope_table(p);
    transpose_items(p, lds, a0, e0);
    transpose_items(p, lds, a1, e1);
    if (flags & 2) {
        unsigned* q = (unsigned*)(p->ws + WS_CTL) + CW_CONVQ;
        volatile LAS unsigned* slot = (volatile LAS unsigned*)(lds + MISC_OFF + 1600);
        unsigned nxt = 0;
        if (threadIdx.x == 0) nxt = xb_add(q, 1u);
        for (;;) {
            if (threadIdx.x == 0) *slot = nxt;
            __syncthreads();
            const unsigned u = *slot;
            if (u >= 512u) break;
            if (threadIdx.x == 0) nxt = xb_add(q, 1u);
            conv_unit(p, lds, (int)u);
            __syncthreads();
        }
    }
    if (threadIdx.x == 0 && !leader) {
        unsigned* bar = b.bar;
        XB_SPIN(xb_ld(&bar[XB_XGEN(b.x)]) == gen, bar);
        __builtin_amdgcn_fence(__ATOMIC_ACQUIRE, "agent");
        asm volatile("s_waitcnt vmcnt(0)" ::: "memory");
    }
    __syncthreads();
}

__device__ __forceinline__ void phase1c(CP p, LAS unsigned char* lds) {
#ifndef SUBREP
#define SUBREP -1
#endif
#pragma unroll 1
    for (int r_ = 0; r_ < (SUBREP == 0 ? 2 : 1); ++r_)
    for (int u = blockIdx.x; u < 512; u += gridDim.x) q_item(p, lds, u);
#pragma unroll 1
    for (int r_ = 0; r_ < (SUBREP == 1 ? 2 : 1); ++r_)
    for (int u = blockIdx.x; u < 256; u += gridDim.x) kv_item(p, lds, u);
    __syncthreads();
    if (N_LAUNCH_SPLIT) { for (int u = blockIdx.x; u < 512; u += gridDim.x) conv_unit(p, lds, u); }
}

__device__ __forceinline__ int swap23(int r) { return (r & ~12) | ((r & 4) << 1) | ((r & 8) >> 1); }
constexpr int KROW = 208, VROW = 144, KBUF = 64 * KROW, VBUF = 64 * VROW, ABUF = KBUF + VBUF;
__device__ __forceinline__ void attn_unit(CP p, LAS unsigned char* lds, int bh, int qblk) {
    const int tid = threadIdx.x, lane = tid & 63, wid = __builtin_amdgcn_readfirstlane(tid >> 6), q = lane & 31, H = lane >> 5;
    unsigned char* ws = p->ws;
    const bf16_t* qg = (const bf16_t*)(ws + WS_Q) + (size_t)bh * 4096 * 96;
    const bf16_t* kg = (const bf16_t*)(ws + WS_K) + (size_t)bh * 4096 * 96;
    const bf16_t* vg = (const bf16_t*)(ws + WS_VT) + (size_t)bh * 64 * 4096;
    const int row0 = qblk * 256 + wid * 32, mychunk = 4 * qblk + (wid >> 1), NT = 4 * qblk + 4;
    bf16x8 qf[6];
#pragma unroll
    for (int s = 0; s < 6; ++s) qf[s] = *(const bf16x8*)(qg + (size_t)(row0 + q) * 96 + 16 * s + 8 * H);
    const int kr0 = tid / 12, kc0 = tid % 12, kr1 = (tid + 512) / 12, kc1 = (tid + 512) % 12, vd = tid >> 3, vc = tid & 7;
    const bool k1 = tid < 256;
    const bf16_t* ksrc0 = kg + (size_t)kr0 * 96 + kc0 * 8; const bf16_t* ksrc1 = kg + (size_t)kr1 * 96 + kc1 * 8; const bf16_t* vsrc = vg + (size_t)vd * 4096 + vc * 8;
    const int kdst0 = kr0 * KROW + kc0 * 16, kdst1 = kr1 * KROW + kc1 * 16, vdst = KBUF + vd * VROW + vc * 16;
    u32x4 rk0, rk1 = (u32x4){0, 0, 0, 0}, rv;
#define AT_LOAD(t) do { rk0 = *(const u32x4*)(ksrc0 + (size_t)(t) * 64 * 96); if (k1) rk1 = *(const u32x4*)(ksrc1 + (size_t)(t) * 64 * 96); rv = *(const u32x4*)(vsrc + (t) * 64); } while (0)
#define AT_WRITE(buf) do { LAS unsigned char* b_ = lds + (buf) * ABUF; *(LAS u32x4*)(b_ + kdst0) = rk0; if (k1) *(LAS u32x4*)(b_ + kdst1) = rk1; *(LAS u32x4*)(b_ + vdst) = rv; } while (0)
    AT_LOAD(0); AT_WRITE(0);
    __syncthreads();
    f32x16 o0 = {0}, o1 = {0};
    float mrun = -INFINITY, lsum = 0.f;
    const int koff = swap23(q) * KROW + 16 * H, voff = KBUF + q * VROW + 16 * H;
    for (int t = 0; t < NT; ++t) {
        if (t + 1 < NT) AT_LOAD(t + 1);
        if (t <= mychunk) {
            const LAS unsigned char* kb = lds + (t & 1) * ABUF + koff; const LAS unsigned char* vb = lds + (t & 1) * ABUF + voff;
            f32x16 s0 = {0}, s1 = {0};
#pragma unroll
            for (int s = 0; s < 6; ++s) {
                const bf16x8 a0 = *(const LAS bf16x8*)(kb + 32 * s), a1 = *(const LAS bf16x8*)(kb + 32 * KROW + 32 * s);
                s0 = __builtin_amdgcn_mfma_f32_32x32x16_bf16(a0, qf[s], s0, 0, 0, 0);
                s1 = __builtin_amdgcn_mfma_f32_32x32x16_bf16(a1, qf[s], s1, 0, 0, 0);
            }
            float mloc = s0[0];
#pragma unroll
            for (int r = 1; r < 16; ++r) mloc = fmaxf(mloc, s0[r]);
#pragma unroll
            for (int r = 0; r < 16; ++r) mloc = fmaxf(mloc, s1[r]);
            mloc = fmaxf(mloc, __shfl_xor(mloc, 32));
            const float mnew = fmaxf(mrun, mloc);
            const float alpha = __builtin_amdgcn_exp2f(mrun - mnew);
            mrun = mnew;
            float ps = 0.f;
#pragma unroll
            for (int r = 0; r < 16; ++r) { s0[r] = __builtin_amdgcn_exp2f(s0[r] - mnew); s1[r] = __builtin_amdgcn_exp2f(s1[r] - mnew); ps += s0[r] + s1[r]; }
            lsum = lsum * alpha + ps;
#pragma unroll
            for (int r = 0; r < 16; ++r) { o0[r] *= alpha; o1[r] *= alpha; }
            u32x4 pw[4];
            pw[0] = (u32x4){cvtpk(s0[0], s0[1]), cvtpk(s0[2], s0[3]), cvtpk(s0[4], s0[5]), cvtpk(s0[6], s0[7])};
            pw[1] = (u32x4){cvtpk(s0[8], s0[9]), cvtpk(s0[10], s0[11]), cvtpk(s0[12], s0[13]), cvtpk(s0[14], s0[15])};
            pw[2] = (u32x4){cvtpk(s1[0], s1[1]), cvtpk(s1[2], s1[3]), cvtpk(s1[4], s1[5]), cvtpk(s1[6], s1[7])};
            pw[3] = (u32x4){cvtpk(s1[8], s1[9]), cvtpk(s1[10], s1[11]), cvtpk(s1[12], s1[13]), cvtpk(s1[14], s1[15])};
#pragma unroll
            for (int ks = 0; ks < 4; ++ks) {
                const bf16x8 v0 = *(const LAS bf16x8*)(vb + 32 * ks), v1 = *(const LAS bf16x8*)(vb + 32 * VROW + 32 * ks);
                const bf16x8 pb = __builtin_bit_cast(bf16x8, pw[ks]);
                o0 = __builtin_amdgcn_mfma_f32_32x32x16_bf16(v0, pb, o0, 0, 0, 0);
                o1 = __builtin_amdgcn_mfma_f32_32x32x16_bf16(v1, pb, o1, 0, 0, 0);
            }
        }
        if (t + 1 < NT) AT_WRITE((t + 1) & 1);
        __syncthreads();
    }
#undef AT_LOAD
#undef AT_WRITE
    const float ltot = lsum + __shfl_xor(lsum, 32), inv = 1.0f / ltot;
    const int b = bh >> 3, hd = bh & 7;
    bf16_t* dst = (bf16_t*)(ws + WS_CAT) + ((size_t)b * 4096 + row0 + q) * 1024 + 512 + hd * 64;
#pragma unroll
    for (int g = 0; g < 4; ++g) {
        u32x2 w; w.x = cvtpk(o0[4 * g] * inv, o0[4 * g + 1] * inv); w.y = cvtpk(o0[4 * g + 2] * inv, o0[4 * g + 3] * inv); *(u32x2*)(dst + 8 * g + 4 * H) = w;
        w.x = cvtpk(o1[4 * g] * inv, o1[4 * g + 1] * inv); w.y = cvtpk(o1[4 * g + 2] * inv, o1[4 * g + 3] * inv); *(u32x2*)(dst + 32 + 8 * g + 4 * H) = w;
    }
}
constexpr int AF_NS = 6, AF_KB = 64 * 192, AF_STG = AF_KB + 64 * 128;
__device__ __forceinline__ void attn_unit_fast(CP p, LAS unsigned char* lds, int bh, int qblk) {
    const int tid = threadIdx.x, lane = tid & 63, wid = __builtin_amdgcn_readfirstlane(tid >> 6), q = lane & 31, H = lane >> 5;
    unsigned char* ws = p->ws;
    const bf16_t* qg = (const bf16_t*)(ws + WS_Q) + (size_t)bh * 4096 * 96;
    const bf16_t* kg = (const bf16_t*)(ws + WS_K) + (size_t)bh * 4096 * 96;
    const bf16_t* vg = (const bf16_t*)(ws + WS_VT) + (size_t)bh * 64 * 4096;
    const int row0 = qblk * 256 + wid * 32, mychunk = 4 * qblk + (wid >> 1), NT = 4 * qblk + 4;
    int ks0, ks1, vs0;
    { int P = wid * 64 + lane, r = P / 12, c = (P % 12) ^ ((r >> 2) & 3); ks0 = r * 96 + c * 8;
      P = (8 + (wid & 3)) * 64 + lane; r = P / 12; c = (P % 12) ^ ((r >> 2) & 3); ks1 = r * 96 + c * 8;
      P = wid * 64 + lane; r = P >> 3; c = (P & 7) ^ ((r >> 1) & 7); vs0 = r * 4096 + c * 8; }
    const bool two = wid < 4;
#define AF_ISSUE(u) do { const int u_ = (u) < NT ? (u) : NT - 1; LAS unsigned char* st_ = lds + ((u) % AF_NS) * AF_STG; \
        __builtin_amdgcn_global_load_lds((const unsigned*)(kg + (size_t)u_ * 64 * 96 + ks0), (LAS unsigned*)(st_ + wid * 1024), 16, 0, 0); \
        if (two) __builtin_amdgcn_global_load_lds((const unsigned*)(kg + (size_t)u_ * 64 * 96 + ks1), (LAS unsigned*)(st_ + (8 + wid) * 1024), 16, 0, 0); \
        __builtin_amdgcn_global_load_lds((const unsigned*)(vg + u_ * 64 + vs0), (LAS unsigned*)(st_ + AF_KB + wid * 1024), 16, 0, 0); } while (0)
#define AF_WAITBAR() do { if (two) asm volatile("s_waitcnt vmcnt(3)" ::: "memory"); else asm volatile("s_waitcnt vmcnt(2)" ::: "memory"); \
        asm volatile("s_waitcnt lgkmcnt(0)" ::: "memory"); __builtin_amdgcn_s_barrier(); asm volatile("" ::: "memory"); } while (0)
    static_assert(AF_NS == 6, "ring depth vs the issue / wait pattern below (one tile may stay in flight across a barrier)");
    const int pr = swap23(q), kx = (pr >> 2) & 3;
    const int kbe = pr * 192 + 16 * ((H ^ (kx & 1)) + 2 * (kx >> 1)), kbo = pr * 192 + 16 * ((H ^ (kx & 1)) + 2 * (1 ^ (kx >> 1)));
    const int vx = (q >> 1) & 7, vbase = AF_KB + q * 128 + 16 * (H ^ (vx & 1)), vxx = (vx >> 1) * 32;
    bf16x8 qf[6];
#pragma unroll
    for (int s = 0; s < 6; ++s) qf[s] = *(const bf16x8*)(qg + (size_t)(row0 + q) * 96 + 16 * s + 8 * H);
#define AF_QK(S0, S1, u) do { const LAS unsigned char* kb_ = lds + ((u) % AF_NS) * AF_STG; \
        { const bf16x8 a0_ = *(const LAS bf16x8*)(kb_ + kbe), a1_ = *(const LAS bf16x8*)(kb_ + kbe + 32 * 192); \
          S0 = __builtin_amdgcn_mfma_f32_32x32x16_bf16(a0_, qf[0], (f32x16){0.f, 0.f, 0.f, 0.f, 0.f, 0.f, 0.f, 0.f, 0.f, 0.f, 0.f, 0.f, 0.f, 0.f, 0.f, 0.f}, 0, 0, 0); \
          S1 = __builtin_amdgcn_mfma_f32_32x32x16_bf16(a1_, qf[0], (f32x16){0.f, 0.f, 0.f, 0.f, 0.f, 0.f, 0.f, 0.f, 0.f, 0.f, 0.f, 0.f, 0.f, 0.f, 0.f, 0.f}, 0, 0, 0); } \
        _Pragma("unroll") for (int s_ = 1; s_ < 6; ++s_) { const int o_ = ((s_ & 1) ? kbo : kbe) + 64 * (s_ >> 1); \
            const bf16x8 a0_ = *(const LAS bf16x8*)(kb_ + o_), a1_ = *(const LAS bf16x8*)(kb_ + o_ + 32 * 192); \
            S0 = __builtin_amdgcn_mfma_f32_32x32x16_bf16(a0_, qf[s_], S0, 0, 0, 0); \
            S1 = __builtin_amdgcn_mfma_f32_32x32x16_bf16(a1_, qf[s_], S1, 0, 0, 0); } } while (0)
    asm volatile("s_waitcnt vmcnt(0) lgkmcnt(0)" ::: "memory"); __builtin_amdgcn_s_barrier(); asm volatile("" ::: "memory");
    AF_ISSUE(0); AF_ISSUE(1); AF_ISSUE(2); AF_ISSUE(3);
    AF_WAITBAR();
    f32x16 o0 = {0}, o1 = {0}, c0, c1;
    float lsum = 0.f;
    AF_QK(c0, c1, 0);
#define AF_STEP(t, CA, CB, NA, NB) do { if ((t) <= mychunk) { \
            AF_QK(NA, NB, (t) + 1);                      \
            float ps = 0.f; \
            _Pragma("unroll") for (int r = 0; r < 16; ++r) { CA[r] = __builtin_amdgcn_exp2f(CA[r]); CB[r] = __builtin_amdgcn_exp2f(CB[r]); ps += CA[r] + CB[r]; } \
            lsum += ps; \
            u32x4 pw[4]; \
            pw[0] = (u32x4){cvtpk(CA[0], CA[1]), cvtpk(CA[2], CA[3]), cvtpk(CA[4], CA[5]), cvtpk(CA[6], CA[7])}; \
            pw[1] = (u32x4){cvtpk(CA[8], CA[9]), cvtpk(CA[10], CA[11]), cvtpk(CA[12], CA[13]), cvtpk(CA[14], CA[15])}; \
            pw[2] = (u32x4){cvtpk(CB[0], CB[1]), cvtpk(CB[2], CB[3]), cvtpk(CB[4], CB[5]), cvtpk(CB[6], CB[7])}; \
            pw[3] = (u32x4){cvtpk(CB[8], CB[9]), cvtpk(CB[10], CB[11]), cvtpk(CB[12], CB[13]), cvtpk(CB[14], CB[15])}; \
            const LAS unsigned char* vb = lds + ((t) % AF_NS) * AF_STG + vbase; \
            _Pragma("unroll") for (int ks = 0; ks < 4; ++ks) { \
                const int vo = (ks * 32) ^ vxx; \
                const bf16x8 v0 = *(const LAS bf16x8*)(vb + vo), v1 = *(const LAS bf16x8*)(vb + vo + 32 * 128); \
                const bf16x8 pb = __builtin_bit_cast(bf16x8, pw[ks]); \
                o0 = __builtin_amdgcn_mfma_f32_32x32x16_bf16(v0, pb, o0, 0, 0, 0); \
                o1 = __builtin_amdgcn_mfma_f32_32x32x16_bf16(v1, pb, o1, 0, 0, 0); } } } while (0)
    f32x16 d0, d1;
#pragma unroll 1
    for (int t = 0; t < NT; t += 2) {
        AF_ISSUE(t + 4); AF_ISSUE(t + 5);
        AF_STEP(t, c0, c1, d0, d1);
        AF_STEP(t + 1, d0, d1, c0, c1);
        AF_WAITBAR();
    }
#undef AF_STEP
#undef AF_ISSUE
#undef AF_WAITBAR
#undef AF_QK
    const float ltot = lsum + __shfl_xor(lsum, 32), inv = 1.0f / ltot;
    const int b = bh >> 3, hd = bh & 7;
    bf16_t* dst = (bf16_t*)(ws + WS_CAT) + ((size_t)b * 4096 + row0 + q) * 1024 + 512 + hd * 64;
#pragma unroll
    for (int g = 0; g < 4; ++g) {
        u32x2 w; w.x = cvtpk(o0[4 * g] * inv, o0[4 * g + 1] * inv); w.y = cvtpk(o0[4 * g + 2] * inv, o0[4 * g + 3] * inv); *(u32x2*)(dst + 8 * g + 4 * H) = w;
        w.x = cvtpk(o1[4 * g] * inv, o1[4 * g + 1] * inv); w.y = cvtpk(o1[4 * g + 2] * inv, o1[4 * g + 3] * inv); *(u32x2*)(dst + 32 + 8 * g + 4 * H) = w;
    }
}
__device__ __forceinline__ void attn_unit2(CP p, LAS unsigned char* lds, int bh, int QB) {
    int lane = threadIdx.x & 63; asm volatile("" : "+v"(lane));
    const int tid = threadIdx.x, wid = __builtin_amdgcn_readfirstlane(tid >> 6), q = lane & 31, H = lane >> 5;
    unsigned char* ws = p->ws;
    const bf16_t* qg = (const bf16_t*)(ws + WS_Q) + (size_t)bh * 4096 * 96;
    const bf16_t* kg = (const bf16_t*)(ws + WS_K) + (size_t)bh * 4096 * 96;
    const bf16_t* vg = (const bf16_t*)(ws + WS_VT) + (size_t)bh * 64 * 4096;
    const int rowA = QB * 512 + wid * 32, rowB = QB * 512 + (15 - wid) * 32;
    const int chA = 8 * QB + (wid >> 1), chB = 8 * QB + ((15 - wid) >> 1), NT = 8 * QB + 8;
    int ks0, ks1, vs0;
    { int P = wid * 64 + lane, r = P / 12, c = (P % 12) ^ ((r >> 2) & 3); ks0 = r * 96 + c * 8;
      P = (8 + (wid & 3)) * 64 + lane; r = P / 12; c = (P % 12) ^ ((r >> 2) & 3); ks1 = r * 96 + c * 8;
      P = wid * 64 + lane; r = P >> 3; c = (P & 7) ^ ((r >> 1) & 7); vs0 = r * 4096 + c * 8; }
    const bool two = wid < 4;
#define A2_ISSUE(u) do { const int u_ = (u) < NT ? (u) : NT - 1; LAS unsigned char* st_ = lds + ((u) % AF_NS) * AF_STG; \
        __builtin_amdgcn_global_load_lds((const unsigned*)(kg + (size_t)u_ * 64 * 96 + ks0), (LAS unsigned*)(st_ + wid * 1024), 16, 0, 0); \
        if (two) __builtin_amdgcn_global_load_lds((const unsigned*)(kg + (size_t)u_ * 64 * 96 + ks1), (LAS unsigned*)(st_ + (8 + wid) * 1024), 16, 0, 0); \
        __builtin_amdgcn_global_load_lds((const unsigned*)(vg + u_ * 64 + vs0), (LAS unsigned*)(st_ + AF_KB + wid * 1024), 16, 0, 0); } while (0)
#define A2_WAITBAR() do { if (two) asm volatile("s_waitcnt vmcnt(3)" ::: "memory"); else asm volatile("s_waitcnt vmcnt(2)" ::: "memory"); \
        asm volatile("s_waitcnt lgkmcnt(0)" ::: "memory"); __builtin_amdgcn_s_barrier(); asm volatile("" ::: "memory"); } while (0)
    const int pr = swap23(q), kx = (pr >> 2) & 3;
    const int kbe = pr * 192 + 16 * ((H ^ (kx & 1)) + 2 * (kx >> 1)), kbo = pr * 192 + 16 * ((H ^ (kx & 1)) + 2 * (1 ^ (kx >> 1)));
    const int vx = (q >> 1) & 7, vbase = AF_KB + q * 128 + 16 * (H ^ (vx & 1)), vxx = (vx >> 1) * 32;
    bf16x8 qa[6], qb[6];
#pragma unroll
    for (int s = 0; s < 6; ++s) { qa[s] = *(const bf16x8*)(qg + (size_t)(rowA + q) * 96 + 16 * s + 8 * H); qb[s] = *(const bf16x8*)(qg + (size_t)(rowB + q) * 96 + 16 * s + 8 * H); }
    asm volatile("s_waitcnt vmcnt(0) lgkmcnt(0)" ::: "memory"); __builtin_amdgcn_s_barrier(); asm volatile("" ::: "memory");
    A2_ISSUE(0); A2_ISSUE(1); A2_ISSUE(2); A2_ISSUE(3);
    A2_WAITBAR();
    f32x16 oa0 = {0}, oa1 = {0}, ob0 = {0}, ob1 = {0};
    float la = 0.f, lb = 0.f;
#define A2_ZERO (f32x16){0.f, 0.f, 0.f, 0.f, 0.f, 0.f, 0.f, 0.f, 0.f, 0.f, 0.f, 0.f, 0.f, 0.f, 0.f, 0.f}
#define A2_PACK2(PW, C) do { \
        PW[0] = (u32x4){cvtpk(C[0], C[1]), cvtpk(C[2], C[3]), cvtpk(C[4], C[5]), cvtpk(C[6], C[7])}; \
        PW[1] = (u32x4){cvtpk(C[8], C[9]), cvtpk(C[10], C[11]), cvtpk(C[12], C[13]), cvtpk(C[14], C[15])}; } while (0)
#define A2_HALF(t, hh) do { const LAS unsigned char* kb_ = lds + ((t) % AF_NS) * AF_STG + (hh) * (32 * 192); const LAS unsigned char* vb_ = lds + ((t) % AF_NS) * AF_STG + vbase; \
        if ((t) <= chB) {                                    \
            const bool both_ = (t) <= chA; \
            f32x16 sa = A2_ZERO, sb; \
            _Pragma("unroll") for (int s_ = 0; s_ < 6; ++s_) { const int o_ = ((s_ & 1) ? kbo : kbe) + 64 * (s_ >> 1); \
                const bf16x8 a_ = *(const LAS bf16x8*)(kb_ + o_); \
                sb = __builtin_amdgcn_mfma_f32_32x32x16_bf16(a_, qb[s_], s_ == 0 ? A2_ZERO : sb, 0, 0, 0); \
                if (both_) sa = __builtin_amdgcn_mfma_f32_32x32x16_bf16(a_, qa[s_], sa, 0, 0, 0); } \
            float pb = 0.f; \
            _Pragma("unroll") for (int r = 0; r < 16; ++r) { sb[r] = __builtin_amdgcn_exp2f(sb[r]); pb += sb[r]; } \
            lb += pb; \
            u32x4 pwa[2] = {(u32x4){0, 0, 0, 0}, (u32x4){0, 0, 0, 0}}, pwb[2]; A2_PACK2(pwb, sb); \
            if (both_) { float pa = 0.f; \
                _Pragma("unroll") for (int r = 0; r < 16; ++r) { sa[r] = __builtin_amdgcn_exp2f(sa[r]); pa += sa[r]; } \
                la += pa; A2_PACK2(pwa, sa); } \
            _Pragma("unroll") for (int k2 = 0; k2 < 2; ++k2) { const int vo = (((hh) * 2 + k2) * 32) ^ vxx; \
                const bf16x8 v0 = *(const LAS bf16x8*)(vb_ + vo), v1 = *(const LAS bf16x8*)(vb_ + vo + 32 * 128); \
                const bf16x8 xb = __builtin_bit_cast(bf16x8, pwb[k2]); \
                ob0 = __builtin_amdgcn_mfma_f32_32x32x16_bf16(v0, xb, ob0, 0, 0, 0); ob1 = __builtin_amdgcn_mfma_f32_32x32x16_bf16(v1, xb, ob1, 0, 0, 0); \
                if (both_) { const bf16x8 xa = __builtin_bit_cast(bf16x8, pwa[k2]); \
                    oa0 = __builtin_amdgcn_mfma_f32_32x32x16_bf16(v0, xa, oa0, 0, 0, 0); oa1 = __builtin_amdgcn_mfma_f32_32x32x16_bf16(v1, xa, oa1, 0, 0, 0); } } \
        } } while (0)
#define A2_STEP(t) do { A2_HALF(t, 0); __builtin_amdgcn_sched_barrier(0); A2_HALF(t, 1); __builtin_amdgcn_sched_barrier(0); } while (0)
#pragma unroll 1
    for (int t = 0; t < NT; t += 2) {
        A2_ISSUE(t + 4); A2_ISSUE(t + 5);
        A2_STEP(t);
        A2_STEP(t + 1);
        A2_WAITBAR();
    }
#undef A2_STEP
#undef A2_HALF
#undef A2_PACK2
#undef A2_ZERO
#undef A2_ISSUE
#undef A2_WAITBAR
    const int b = bh >> 3, hd = bh & 7;
    {
        const float ltot = la + __shfl_xor(la, 32), inv = 1.0f / ltot;
        bf16_t* dst = (bf16_t*)(ws + WS_CAT) + ((size_t)b * 4096 + rowA + q) * 1024 + 512 + hd * 64;
#pragma unroll
        for (int g = 0; g < 4; ++g) {
            u32x2 w; w.x = cvtpk(oa0[4 * g] * inv, oa0[4 * g + 1] * inv); w.y = cvtpk(oa0[4 * g + 2] * inv, oa0[4 * g + 3] * inv); *(u32x2*)(dst + 8 * g + 4 * H) = w;
            w.x = cvtpk(oa1[4 * g] * inv, oa1[4 * g + 1] * inv); w.y = cvtpk(oa1[4 * g + 2] * inv, oa1[4 * g + 3] * inv); *(u32x2*)(dst + 32 + 8 * g + 4 * H) = w;
        }
    }
    {
        const float ltot = lb + __shfl_xor(lb, 32), inv = 1.0f / ltot;
        bf16_t* dst = (bf16_t*)(ws + WS_CAT) + ((size_t)b * 4096 + rowB + q) * 1024 + 512 + hd * 64;
#pragma unroll
        for (int g = 0; g < 4; ++g) {
            u32x2 w; w.x = cvtpk(ob0[4 * g] * inv, ob0[4 * g + 1] * inv); w.y = cvtpk(ob0[4 * g + 2] * inv, ob0[4 * g + 3] * inv); *(u32x2*)(dst + 8 * g + 4 * H) = w;
            w.x = cvtpk(ob1[4 * g] * inv, ob1[4 * g + 1] * inv); w.y = cvtpk(ob1[4 * g + 2] * inv, ob1[4 * g + 3] * inv); *(u32x2*)(dst + 32 + 8 * g + 4 * H) = w;
        }
    }
}
__device__ __forceinline__ void phase2(CP p, LAS unsigned char* lds) {
    const int lane = threadIdx.x & 63;
    const float* qn = (const float*)p->in[15]; const float* kn = (const float*)p->in[16];
    float mq = 0.f, mk = 0.f;
    for (int j = lane; j < 96; j += 64) { mq = fmaxf(mq, fabsf(qn[j])); mk = fmaxf(mk, fabsf(kn[j])); }
#pragma unroll
    for (int o = 1; o < 64; o <<= 1) { mq = fmaxf(mq, __shfl_xor(mq, o)); mk = fmaxf(mk, __shfl_xor(mk, o)); }
    const float bound = 96.0f * mq * mk * QSCALE * 1.01f;
    if (bound <= 40.0f) {
        for (int u = vcu_id(); u < 256; u += gridDim.x) { const int bh = u >> 2, pr = u & 3; attn_unit2(p, lds, bh, 7 - pr); attn_unit2(p, lds, bh, pr); }
    } else {
        for (int u = vcu_id(); u < 512; u += gridDim.x) { const int bh = u >> 3, pr = u & 7; attn_unit(p, lds, bh, 15 - pr); attn_unit(p, lds, bh, pr); }
    }
    asm volatile("s_waitcnt vmcnt(0)" ::: "memory"); __syncthreads();
}

__device__ __forceinline__ void phase3(CP p, LAS unsigned char* lds) {
    const int tid = threadIdx.x, lane = tid & 63, wid = __builtin_amdgcn_readfirstlane(tid >> 6), wr = wid >> 2, wc = wid & 3, fr = lane & 15, fq = lane >> 4;
    unsigned char* ws = p->ws;
    const float* x = (const float*)p->in[0]; const float* mod = (const float*)(ws + WS_MOD); float* sq1 = (float*)(ws + WS_SSQ1);
    for (int u = vcu_id(); u < 512; u += gridDim.x) {
        const int pm = u >> 2, pn = u & 3;
        const bf16_t* ap[4]; const bf16_t* bp[4];
        stage_ptrs_dense<4>((const bf16_t*)(ws + WS_CAT), 1024, pm * 256, ap); stage_ptrs_dense<4>((const bf16_t*)(ws + WS_WOUT), 1024, pn * 256, bp);
        f32x4 acc[8][4];
#pragma unroll
        for (int m = 0; m < 8; ++m)
#pragma unroll
            for (int n = 0; n < 4; ++n) acc[m][n] = (f32x4){0.f, 0.f, 0.f, 0.f};
        gemm_block<8, 4, true>(lds, ap, bp, 16, acc);
        const int rowb = pm * 256 + wr * 128 + fr, b = (pm * 256) >> 12, colb = pn * 256 + wc * 64 + fq * 4;
        f32x4 ga[4];
#pragma unroll
        for (int n = 0; n < 4; ++n) ga[n] = *(const f32x4*)(mod + b * 6144 + 2048 + colb + n * 16);
#pragma unroll
        for (int mb = 0; mb < 8; mb += 4) {
            f32x4 xv[4][4];
#pragma unroll
            for (int m = 0; m < 4; ++m)
#pragma unroll
                for (int n = 0; n < 4; ++n) xv[m][n] = *(const f32x4*)(x + (size_t)(rowb + (mb + m) * 16) * DM + colb + n * 16);
#pragma unroll
            for (int m = 0; m < 4; ++m) { const size_t row = rowb + (mb + m) * 16; float s = 0.f;
#pragma unroll
                for (int n = 0; n < 4; ++n) { const f32x4 v = xv[m][n] + ga[n] * acc[mb + m][n];
                    *(f32x4*)(p->out + row * DM + colb + n * 16) = v; s += (v.x * v.x + v.y * v.y) + (v.z * v.z + v.w * v.w); }
                s += __shfl_xor(s, 16); s += __shfl_xor(s, 32);
                if (fq == 0) sq1[row * 16 + pn * 4 + wc] = s; }
        }
    }
}

constexpr int RROW = 2064;
__device__ __forceinline__ void phase3b(CP p, LAS unsigned char* lds, bool dry) {
    const int tid = threadIdx.x, lane = tid & 63, wave = __builtin_amdgcn_readfirstlane(tid >> 6), fr = lane & 15, fq = lane >> 4;
    unsigned char* ws = p->ws;
    const float* nf = (const float*)p->in[18]; const float* mod = (const float*)(ws + WS_MOD); const float* sq1 = (const float*)(ws + WS_SSQ1);
    const float* bg = (const float*)p->in[20]; const float* be = (const float*)p->in[22];
    bf16_t* h2 = (bf16_t*)(ws + WS_H); const bf16_t* wrh = (const bf16_t*)(ws + WS_WR); const bf16_t* wrl = wrh + 48 * 1024;
    LAS unsigned char* Ahi = lds; LAS unsigned char* Alo = lds + 32 * RROW; LAS float* part = (LAS float*)lds; LAS float* lg = (LAS float*)(lds + 133120);
    LAS int* dtok = (LAS int*)(lds + 139264); LAS int* dEl = dtok + 128; LAS int* dEh = dtok + 256; LAS int* dbk = dtok + 384;
    LAS unsigned* lcnt = (LAS unsigned*)(dtok + 512); LAS unsigned* lbase = lcnt + 144;
    unsigned* ctl = (unsigned*)(ws + WS_CTL); int* lists = (int*)(ws + WS_LIST); int* blists = (int*)(ws + WS_BLIST); float* tokw = (float*)(ws + WS_TOKW);
    const int G = gridDim.x, NTILE = MT / 32;
    bf16x8 Bh[3][4], Bl[3][4];
#pragma unroll
    for (int nt = 0; nt < 3; ++nt)
#pragma unroll
        for (int kk = 0; kk < 4; ++kk) { const size_t o = (size_t)(nt * 16 + fr) * 1024 + wave * 128 + kk * 32 + fq * 8; Bh[nt][kk] = *(const bf16x8*)(wrh + o); Bl[nt][kk] = *(const bf16x8*)(wrl + o); }
    if (tid < 144) lcnt[tid] = 0u;
    f32x4 xr[2][4]; float rs[2];
    LAS f32x4* gms = (LAS f32x4*)(lds + 143360);
#define P3B_LOADG(tl) do { const int b_ = ((tl) * 32) >> 12; if (tid < 256) { const int col = 4 * tid; \
        const f32x4 g = *(const f32x4*)(nf + col), s_ = *(const f32x4*)(mod + b_ * 6144 + 4096 + col); gms[2 * tid] = g * (s_ + 1.0f); gms[2 * tid + 1] = *(const f32x4*)(mod + b_ * 6144 + 3072 + col); } __syncthreads(); } while (0)
#define P3B_LOADX(tl, rb) do { _Pragma("unroll") for (int rr = 0; rr < 2; ++rr) { const size_t row = (size_t)(tl) * 32 + wave * 4 + (rb) + rr; float ss = 0.f; \
        _Pragma("unroll") for (int k = 0; k < 4; ++k) { const f32x4 s4 = *(const f32x4*)(sq1 + row * 16 + 4 * k); ss += (s4.x + s4.y) + (s4.z + s4.w); } rs[rr] = ss; \
        _Pragma("unroll") for (int j = 0; j < 4; ++j) xr[rr][j] = *(const f32x4*)(p->out + row * DM + 4 * lane + 256 * j); } } while (0)
#define P3B_PROC(tl, rb) do { _Pragma("unroll") for (int rr = 0; rr < 2; ++rr) { const int lr = wave * 4 + (rb) + rr; const size_t row = (size_t)(tl) * 32 + lr; \
        const float rstd = __builtin_amdgcn_rsqf(rs[rr] * (1.0f / DM) + EPS); \
        _Pragma("unroll") for (int j = 0; j < 4; ++j) { const int col = 4 * lane + 256 * j; const f32x4 xv = xr[rr][j]; \
            const f32x4 o = xv * rstd * gms[2 * (lane + 64 * j)] + gms[2 * (lane + 64 * j) + 1]; \
            u32x2 w; w.x = cvtpk(o.x, o.y); w.y = cvtpk(o.z, o.w); \
            *(u32x2*)(h2 + row * DM + col) = w; *(LAS u32x2*)(Ahi + lr * RROW + col * 2) = w; \
            const float lx = o.x - __builtin_bit_cast(float, w.x << 16), ly = o.y - __builtin_bit_cast(float, w.x & 0xffff0000u), lz = o.z - __builtin_bit_cast(float, w.y << 16), lw = o.w - __builtin_bit_cast(float, w.y & 0xffff0000u); \
            u32x2 wl; wl.x = cvtpk(lx, ly); wl.y = cvtpk(lz, lw); *(LAS u32x2*)(Alo + lr * RROW + col * 2) = wl; } } } while (0)
    const int TPB = (NTILE + G - 1) / G, tbeg = blockIdx.x * TPB, tend = tbeg + TPB < NTILE ? tbeg + TPB : NTILE;
    int nacc = 0, bcur = -1;
    { const int t0 = tbeg < NTILE ? tbeg : NTILE - 1; P3B_LOADX(t0, 0); }
#pragma unroll 1
    for (int tile = tbeg; tile < tend; ++tile) {
        const int r0 = tile * 32;
        if ((r0 >> 12) != bcur) { bcur = r0 >> 12; P3B_LOADG(tile); }
        P3B_PROC(tile, 0);
        P3B_LOADX(tile, 2);
        P3B_PROC(tile, 2);
        { const int tn = tile + 1 < NTILE ? tile + 1 : NTILE - 1; P3B_LOADX(tn, 0); }
        __syncthreads();
        f32x4 P[2][3];
#pragma unroll
        for (int mt = 0; mt < 2; ++mt)
#pragma unroll
            for (int nt = 0; nt < 3; ++nt) P[mt][nt] = (f32x4){0.f, 0.f, 0.f, 0.f};
#pragma unroll
        for (int mt = 0; mt < 2; ++mt)
#pragma unroll
            for (int kk = 0; kk < 4; ++kk) {
                const int ao = (mt * 16 + fr) * RROW + (wave * 128 + kk * 32 + fq * 8) * 2;
                const bf16x8 a_h = *(const LAS bf16x8*)(Ahi + ao), a_l = *(const LAS bf16x8*)(Alo + ao);
#pragma unroll
                for (int nt = 0; nt < 3; ++nt) {
                    P[mt][nt] = __builtin_amdgcn_mfma_f32_16x16x32_bf16(a_h, Bh[nt][kk], P[mt][nt], 0, 0, 0);
                    P[mt][nt] = __builtin_amdgcn_mfma_f32_16x16x32_bf16(a_l, Bh[nt][kk], P[mt][nt], 0, 0, 0);
                    P[mt][nt] = __builtin_amdgcn_mfma_f32_16x16x32_bf16(a_h, Bl[nt][kk], P[mt][nt], 0, 0, 0);
                }
            }
        __syncthreads();
#pragma unroll
        for (int mt = 0; mt < 2; ++mt)
#pragma unroll
            for (int nt = 0; nt < 3; ++nt)
#pragma unroll
                for (int j = 0; j < 4; ++j) part[(wave * 32 + mt * 16 + fq * 4 + j) * 48 + nt * 16 + fr] = P[mt][nt][j];
        __syncthreads();
#pragma unroll
        for (int i = 0; i < 3; ++i) { const int idx = tid + 512 * i; float v = 0.f;
#pragma unroll
            for (int w8 = 0; w8 < 8; ++w8) v += part[w8 * 1536 + idx];
            lg[idx] = v; }
        __syncthreads();
        if (tid < 32) {
            const LAS float* l = lg + tid * 48; const int tok = r0 + tid;
            float gl[4]; int gi = 0; float gmx;
#pragma unroll
            for (int i = 0; i < 4; ++i) gl[i] = l[i] + bg[i];
            gmx = gl[0];
#pragma unroll
            for (int i = 1; i < 4; ++i) if (gl[i] > gmx) { gmx = gl[i]; gi = i; }
            float gs = 0.f;
#pragma unroll
            for (int i = 0; i < 4; ++i) gs += __expf(gl[i] - gmx);
            const float gtop = 1.0f / gs;
            float el[8];
#pragma unroll
            for (int i = 0; i < 8; ++i) el[i] = l[4 + gi * 8 + i] + be[gi * 8 + i];
            int e1 = 0; float m1 = el[0];
#pragma unroll
            for (int i = 1; i < 8; ++i) if (el[i] > m1) { m1 = el[i]; e1 = i; }
            int e2 = -1; float m2 = -INFINITY;
#pragma unroll
            for (int i = 0; i < 8; ++i) if (i != e1 && el[i] > m2) { m2 = el[i]; e2 = i; }
            const float p2 = __expf(m2 - m1);
            const float w1 = gtop / (1.0f + p2), w2 = gtop * p2 / (1.0f + p2);
            const int lo = e1 < e2 ? e1 : e2, hi = e1 < e2 ? e2 : e1;
            const float wlo = e1 < e2 ? w1 : w2, whi = e1 < e2 ? w2 : w1;
            const int bk = gi * 28 + lo * 8 - ((lo * (lo + 1)) >> 1) + (hi - lo - 1);
            const int sl = nacc * 32 + tid;
            dtok[sl] = tok; dEl[sl] = gi * 8 + lo; dEh[sl] = gi * 8 + hi; dbk[sl] = 32 + bk;
            if (!dry) { tokw[tok * 2] = wlo; tokw[tok * 2 + 1] = whi; }
        }
        ++nacc;
        if (nacc == 4 || tile + 1 >= tend) {
            __syncthreads();
            const int ntok = nacc * 32; unsigned r1 = 0, r2 = 0, r3 = 0; int El = 0, Eh = 0, bk = 0, tok = 0;
            if (tid < ntok) { tok = dtok[tid]; El = dEl[tid]; Eh = dEh[tid]; bk = dbk[tid];
                r1 = __hip_atomic_fetch_add(lcnt + El, 1u, __ATOMIC_RELAXED, __HIP_MEMORY_SCOPE_WORKGROUP); r2 = __hip_atomic_fetch_add(lcnt + Eh, 1u, __ATOMIC_RELAXED, __HIP_MEMORY_SCOPE_WORKGROUP);
                r3 = __hip_atomic_fetch_add(lcnt + bk, 1u, __ATOMIC_RELAXED, __HIP_MEMORY_SCOPE_WORKGROUP); }
            __syncthreads();
            if (tid < 144) { const unsigned c = lcnt[tid]; if (c && !dry) lbase[tid] = atomicAdd(ctl + CW_CNT + 64 * tid, c); lcnt[tid] = 0u; }
            __syncthreads();
            if (tid < ntok && !dry) {
                lists[(size_t)El * MT + lbase[El] + r1] = tok * 2; lists[(size_t)Eh * MT + lbase[Eh] + r2] = tok * 2 + 1;
                blists[(size_t)(bk - 32) * MT + lbase[bk] + r3] = tok; }
            nacc = 0;
            __syncthreads();
        }
    }
#undef P3B_LOADG
#undef P3B_LOADX
#undef P3B_PROC
}

struct U4a { int e, rt, ct, cnt; };
__device__ __forceinline__ int prefix_find(const LAS unsigned* pre, int n, int u) {
    const int lane = threadIdx.x & 63; int res = -1;
    for (int b0 = 0; b0 < n; b0 += 64) { const int i = b0 + lane; const bool hit = i < n && (int)pre[i] <= u && u < (int)pre[i + 1];
        const unsigned long long m = __ballot(hit); if (m) { res = b0 + __builtin_ctzll(m); break; } }
    return res;
}
__device__ __forceinline__ bool p4a_find(const LAS unsigned* cnts, const LAS unsigned* pre, int u, U4a& r) {
    const int i = prefix_find(pre, 32, u); if (i < 0) return false;
    const int uu = u - (int)pre[i]; r.e = i; r.rt = uu >> 1; r.ct = uu & 1; r.cnt = (int)cnts[i]; return true;
}
template <int MI, int NI>
__device__ __forceinline__ void p4a_ptrs(CP p, int e, int row0, int cnt, int col0, const bf16_t* (&ap)[MI / 2], const bf16_t* (&bp)[NI]) {
    const int tid = threadIdx.x, lane = tid & 63;
    const int* lst = (const int*)(p->ws + WS_LIST) + (size_t)e * MT + row0; const int nrow = cnt - row0;
    const bf16_t* h2 = (const bf16_t*)(p->ws + WS_H);
    int tok[MI / 2], C[MI / 2];
#pragma unroll
    for (int i = 0; i < MI / 2; ++i) { int R; stage_rc2((tid >> 6) * 1024 + i * 8192 + lane * 16, R, C[i]); tok[i] = lst[R < nrow ? R : 0] >> 1; }
#pragma unroll
    for (int i = 0; i < MI / 2; ++i) ap[i] = h2 + (size_t)tok[i] * 1024 + C[i];
    stage_ptrs_dense<NI>((const bf16_t*)(p->ws + WS_WGU) + (size_t)e * 512 * 1024, 1024, col0, bp);
}
template <int MI, int NI>
__device__ __forceinline__ void p4a_epilogue(CP p, int e, int row0, int cnt, int col0, const f32x4 (&acc)[MI][NI]) {
    const int tid = threadIdx.x, lane = tid & 63, wid = __builtin_amdgcn_readfirstlane(tid >> 6), wr = wid >> 2, wc = wid & 3, fr = lane & 15, fq = lane >> 4;
    unsigned char* ws = p->ws;
    const float* tokw = (const float*)(ws + WS_TOKW); bf16_t* ab = (bf16_t*)(ws + WS_ABUF);
    const int* lst = (const int*)(ws + WS_LIST) + (size_t)e * MT + row0; const int nrow = cnt - row0;
    int ent[MI]; float w[MI];
#pragma unroll
    for (int m = 0; m < MI; ++m) { const int R = wr * (MI * 16) + m * 16 + fr; ent[m] = lst[R < nrow ? R : 0]; }
#pragma unroll
    for (int m = 0; m < MI; ++m) w[m] = tokw[ent[m]];
#pragma unroll
    for (int m = 0; m < MI; ++m) { const int R = wr * (MI * 16) + m * 16 + fr; const float wm = w[m];
#pragma unroll
        for (int h = 0; h < NI / 2; ++h) { const f32x4 g = acc[m][2 * h], uu = acc[m][2 * h + 1];
            const int np = col0 + wc * (NI * 16) + h * 32 + fq * 4, ch = (np >> 8) * 128 + ((np >> 6) & 3) * 32 + ((np >> 5) & 1) * 16 + (np & 15);
            u32x2 o; o.x = cvtpk(g.x * __builtin_amdgcn_rcpf(1.0f + __expf(-g.x)) * uu.x * wm, g.y * __builtin_amdgcn_rcpf(1.0f + __expf(-g.y)) * uu.y * wm);
            o.y = cvtpk(g.z * __builtin_amdgcn_rcpf(1.0f + __expf(-g.z)) * uu.z * wm, g.w * __builtin_amdgcn_rcpf(1.0f + __expf(-g.w)) * uu.w * wm);
            if (R < nrow) *(u32x2*)(ab + (size_t)ent[m] * 256 + ch) = o; } }
}
__device__ __forceinline__ void phase4a(CP p, LAS unsigned char* lds, const LAS unsigned* cnts, const LAS unsigned* pre) {
    const int G = gridDim.x, v = vcu_id();
    const int U = (int)pre[32], F = U - U % G;
    {
        int u = v; U4a cur;
        if (u < F && p4a_find(cnts, pre, u, cur)) {
            const bf16_t* ap[4]; const bf16_t* bp[4];
            p4a_ptrs<8, 4>(p, cur.e, cur.rt * 256, cur.cnt, cur.ct * 256, ap, bp);
            __syncthreads();
            gemm_stage<8, 4, false>(lds, 0, ap, bp, 0, 0);
            for (;;) {
                f32x4 acc[8][4];
#pragma unroll
                for (int m = 0; m < 8; ++m)
#pragma unroll
                    for (int n = 0; n < 4; ++n) acc[m][n] = (f32x4){0.f, 0.f, 0.f, 0.f};
                gemm_main<8, 4, true, false>(lds, 0, ap, bp, 16, acc);
                U4a nxt; u += G; const bool has_next = u < F && p4a_find(cnts, pre, u, nxt);
                if (has_next) { p4a_ptrs<8, 4>(p, nxt.e, nxt.rt * 256, nxt.cnt, nxt.ct * 256, ap, bp); gemm_stage<8, 4, false>(lds, 0, ap, bp, 0, 0); }
                p4a_epilogue<8, 4>(p, cur.e, cur.rt * 256, cur.cnt, cur.ct * 256, acc);
                if (!has_next) break;
                cur = nxt;
                stage_ptrs_dense<4>((const bf16_t*)(p->ws + WS_WGU) + (size_t)cur.e * 512 * 1024, 1024, cur.ct * 256, bp);
            }
        }
    }
    asm volatile("s_waitcnt vmcnt(0)" ::: "memory"); __syncthreads();
#pragma unroll 1
    for (int sv = v; sv < 4 * (U - F); sv += G) {
        U4a t; if (!p4a_find(cnts, pre, F + (sv >> 2), t)) break;
        const int row0 = t.rt * 256 + ((sv >> 1) & 1) * 128, col0 = t.ct * 256 + (sv & 1) * 128;
        if (row0 < t.cnt) {
            const bf16_t* ap[2]; const bf16_t* bp[2];
            p4a_ptrs<4, 2>(p, t.e, row0, t.cnt, col0, ap, bp);
            __syncthreads();
            gemm_stage<4, 2, false>(lds, 0, ap, bp, 0, 0);
            f32x4 acc[4][2];
#pragma unroll
            for (int m = 0; m < 4; ++m)
#pragma unroll
                for (int n = 0; n < 2; ++n) acc[m][n] = (f32x4){0.f, 0.f, 0.f, 0.f};
            gemm_main<4, 2, true, false>(lds, 0, ap, bp, 16, acc);
            p4a_epilogue<4, 2>(p, t.e, row0, t.cnt, col0, acc);
        }
    }
    asm volatile("s_waitcnt vmcnt(0)" ::: "memory"); __syncthreads();
}
struct U4b { int bk, rt, ct, cnt; };
__device__ __forceinline__ bool p4b_find(const LAS unsigned* cnts, const LAS unsigned* pre, int u, U4b& r) {
    const int i = prefix_find(pre + 33, 112, u); if (i < 0) return false;
    const int uu = u - (int)pre[33 + i]; r.bk = i; r.rt = uu >> 2; r.ct = uu & 3; r.cnt = (int)cnts[32 + i]; return true;
}
__device__ __forceinline__ void p4b_ptrs(CP p, const U4b& u, const bf16_t* (&ap)[2], const bf16_t* (&bp)[4], const bf16_t* (&bq)[4]) {
    const int tid = threadIdx.x, lane = tid & 63;
    const int g = u.bk / 28; int pi = u.bk % 28, lo = 0; while (pi >= 7 - lo) { pi -= 7 - lo; ++lo; } const int hi = lo + 1 + pi;
    const int* lst = (const int*)(p->ws + WS_BLIST) + (size_t)u.bk * MT + u.rt * 128; const int nrow = u.cnt - u.rt * 128;
    const bf16_t* ab = (const bf16_t*)(p->ws + WS_ABUF);
#pragma unroll
    for (int i = 0; i < 2; ++i) { int R, C; stage_rc2((tid >> 6) * 1024 + i * 8192 + lane * 16, R, C); const int tok = lst[R < nrow ? R : 0]; ap[i] = ab + (size_t)tok * 512 + C; }
    stage_ptrs_dense<4>((const bf16_t*)(p->ws + WS_WD) + (size_t)(g * 8 + lo) * 1024 * 256, 256, u.ct * 256, bp);
    stage_ptrs_dense<4>((const bf16_t*)(p->ws + WS_WD) + (size_t)(g * 8 + hi) * 1024 * 256, 256, u.ct * 256, bq);
#pragma unroll
    for (int i = 0; i < 4; ++i) bq[i] -= 256;
}
__device__ __forceinline__ void phase4b(CP p, LAS unsigned char* lds, const LAS unsigned* cnts, const LAS unsigned* pre) {
    const int tid = threadIdx.x, lane = tid & 63, wid = __builtin_amdgcn_readfirstlane(tid >> 6), wr = wid >> 2, wc = wid & 3, fr = lane & 15, fq = lane >> 4;
    unsigned char* ws = p->ws;
    const float* mod = (const float*)(ws + WS_MOD); float* out = p->out;
    int u = vcu_id(); U4b cur;
    if (!p4b_find(cnts, pre, u, cur)) return;
    const bf16_t* ap[2]; const bf16_t* bp[4]; const bf16_t* bq[4];
    p4b_ptrs(p, cur, ap, bp, bq);
    int tok[4];
    { const int* lst = (const int*)(ws + WS_BLIST) + (size_t)cur.bk * MT + cur.rt * 128; const int nrow = cur.cnt - cur.rt * 128;
#pragma unroll
      for (int m = 0; m < 4; ++m) { const int R = wr * 64 + m * 16 + fr; tok[m] = lst[R < nrow ? R : 0]; } }
    __syncthreads();
    gemm_stage<4, 4, false>(lds, 0, ap, bp, 0, 0);
    for (;;) {
        const int colb = cur.ct * 256 + wc * 64 + fq * 4; const int nrow = cur.cnt - cur.rt * 128;
        f32x4 old[4][4];
#pragma unroll
        for (int m = 0; m < 4; ++m)
#pragma unroll
            for (int n = 0; n < 4; ++n) old[m][n] = *(const f32x4*)(out + (size_t)tok[m] * DM + colb + n * 16);
        f32x4 acc[4][4];
#pragma unroll
        for (int m = 0; m < 4; ++m)
#pragma unroll
            for (int n = 0; n < 4; ++n) acc[m][n] = (f32x4){0.f, 0.f, 0.f, 0.f};
        gemm_main2<4, 4, true, false>(lds, 0, ap, bp, bq, 4, 8, acc);
        U4b nxt; u += gridDim.x; const bool has_next = p4b_find(cnts, pre, u, nxt);
        int tokn[4] = {0, 0, 0, 0};
        if (has_next) { p4b_ptrs(p, nxt, ap, bp, bq); gemm_stage<4, 4, false>(lds, 0, ap, bp, 0, 0);
            const int* lst = (const int*)(ws + WS_BLIST) + (size_t)nxt.bk * MT + nxt.rt * 128; const int nr2 = nxt.cnt - nxt.rt * 128;
#pragma unroll
            for (int m = 0; m < 4; ++m) { const int R = wr * 64 + m * 16 + fr; tokn[m] = lst[R < nr2 ? R : 0]; } }
#pragma unroll
        for (int m = 0; m < 4; ++m) { const int R = wr * 64 + m * 16 + fr; const int b = tok[m] >> 12;
#pragma unroll
            for (int n = 0; n < 4; ++n) { const f32x4 gf = *(const f32x4*)(mod + b * 6144 + 5120 + colb + n * 16);
                const f32x4 o = old[m][n] + gf * acc[m][n]; if (R < nrow) *(f32x4*)(out + (size_t)tok[m] * DM + colb + n * 16) = o; } }
        if (!has_next) break;
        cur = nxt;
#pragma unroll
        for (int m = 0; m < 4; ++m) tok[m] = tokn[m];
    }
    asm volatile("s_waitcnt vmcnt(0)" ::: "memory"); __syncthreads();
}

__global__ void __launch_bounds__(512, 2) hybrid_block_fwd(Params p) {
    extern __shared__ __attribute__((aligned(16))) unsigned char lds_raw[];
    LAS unsigned char* lds = (LAS unsigned char*)lds_raw;
    volatile LAS unsigned* MISC = (volatile LAS unsigned*)(lds + MISC_OFF);
    LAS unsigned* cnts = (LAS unsigned*)(lds + MISC_OFF + 256);
    const int tid = threadIdx.x;
    if (tid < 16) MISC[tid] = 0u;
    __syncthreads();
    unsigned* ctl = (unsigned*)(p.ws + WS_CTL);
    const bool single = (p.ph_hi - p.ph_lo) > 1;
    XcdBarrier bar; bar.bar = ctl + CW_BAR; bar.x = 0; bar.st = nullptr;
    if (single) bar = xcd_barrier_post(ctl + CW_BAR, MISC + 8);
#ifndef PH_MASK
#define PH_MASK 0x1ff
#endif
#define IN(k) (((PH_MASK >> (k)) & 1) && p.ph_lo <= (k) && (k) < p.ph_hi)
#define SEAM(k) do { if (IN(k) && IN((k) + 1)) xcd_barrier(bar); } while (0)
    constexpr int T0 = TR_EARLY, T1 = T0 + TR_I3 + 1024, T2 = T1 + 1536, T3 = T0 + TR_I3 + TR_I4, T4 = T3 + 1024, T5 = T3 + TR_I5;
#define SEAM_W(k, a0, e0, a1, e1, fl) do { if (IN(k) && IN((k) + 1)) { if (N_LAUNCH_SPLIT) xcd_barrier(bar); else xcd_barrier_work(bar, get_params(), lds, a0, e0, a1, e1, fl); } } while (0)
#ifndef REPEAT_PH
#define REPEAT_PH -1
#endif
#define NREP(k) ((REPEAT_PH == (k)) ? 2 : 1)
    if (IN(0)) { for (int r_ = 0; r_ < NREP(0); ++r_) phase0(get_params(), lds); } SEAM_W(0, 0, T0, 0, 0, 1);
    if (IN(1)) { for (int r_ = 0; r_ < NREP(1); ++r_) phase1a(get_params(), lds); } SEAM_W(1, T0, T1, 0, 0, 0);
    if (IN(2)) { for (int r_ = 0; r_ < NREP(2); ++r_) phase1b(get_params(), lds); } SEAM_W(2, T1, T2, 0, 0, 0);
    if (IN(3)) { for (int r_ = 0; r_ < NREP(3); ++r_) phase1c(get_params(), lds); } SEAM_W(3, 0, 0, 0, 0, 2);
    if (IN(4)) { for (int r_ = 0; r_ < NREP(4); ++r_) phase2(get_params(), lds); } SEAM_W(4, T2, T3, T5, TR_NIT, 0);
    if (IN(5)) { for (int r_ = 0; r_ < NREP(5); ++r_) phase3(get_params(), lds); } SEAM_W(5, T3, T4, 0, 0, 0);
    if (IN(6)) { for (int r_ = 0; r_ < NREP(6); ++r_) phase3b(get_params(), lds, r_ + 1 < NREP(6)); } SEAM_W(6, T4, T5, 0, 0, 0);
    LAS unsigned* pre = (LAS unsigned*)(lds + MISC_OFF + 256 + 640);
    if (IN(7) || IN(8)) {
        if (tid < 144) cnts[tid] = __hip_atomic_load(ctl + CW_CNT + 64 * tid, __ATOMIC_RELAXED, __HIP_MEMORY_SCOPE_AGENT);
        __syncthreads();
        if (tid == 0) { unsigned a = 0; for (int i = 0; i < 32; ++i) { pre[i] = a; a += ((cnts[i] + 255u) >> 8) * 2u; } pre[32] = a;
                        a = 0; for (int i = 0; i < 112; ++i) { pre[33 + i] = a; a += ((cnts[32 + i] + 127u) >> 7) * 4u; } pre[33 + 112] = a; }
        __syncthreads();
    }
    if (IN(7)) { for (int r_ = 0; r_ < NREP(7); ++r_) phase4a(get_params(), lds, cnts, pre); } SEAM(7);
    if (IN(8)) { phase4b(get_params(), lds, cnts, pre); }
#undef IN
#undef SEAM
}

extern "C" void kernel_launch(void* const* d_in, const int* in_sizes, int n_in, void* d_out, int out_size, void* d_ws, size_t ws_size, hipStream_t stream) {
    static int grid = 0;
    if (grid == 0) {
        if (n_in != 26 || out_size != MT * DM || ws_size < WS_END) { fprintf(stderr, "kernel_launch: unexpected problem (n_in %d out %d ws %zu)\n", n_in, out_size, ws_size); grid = -1; return; }
        int dev = 0, cus = 0, per_cu = 0;
        hipGetDevice(&dev); hipDeviceGetAttribute(&cus, hipDeviceAttributeMultiprocessorCount, dev);
        hipFuncSetAttribute((const void*)hybrid_block_fwd, hipFuncAttributeMaxDynamicSharedMemorySize, LDS_BYTES);
        hipOccupancyMaxActiveBlocksPerMultiprocessor(&per_cu, (const void*)hybrid_block_fwd, 512, LDS_BYTES);
        (void)hipGetLastError();
        if (per_cu < 1) { fprintf(stderr, "kernel_launch: occupancy query says %d blocks/CU\n", per_cu); per_cu = 1; }
        grid = cus;
    }
    if (grid < 0) return;
    hipMemsetAsync((char*)d_ws + WS_CTL, 0, CTL_BYTES, stream);
    Params prm{};
    for (int i = 0; i < 26; ++i) prm.in[i] = d_in[i];
    prm.out = (float*)d_out; prm.ws = (unsigned char*)d_ws;
#if N_LAUNCH_SPLIT
    for (int ph = 0; ph <= DBG_LAST_PHASE; ++ph) { prm.ph_lo = ph; prm.ph_hi = ph + 1; hipLaunchKernelGGL(hybrid_block_fwd, dim3(grid), dim3(512), LDS_BYTES, stream, prm); }
#else
    prm.ph_lo = 0; prm.ph_hi = DBG_LAST_PHASE + 1;
    hipLaunchKernelGGL(hybrid_block_fwd, dim3(grid), dim3(512), LDS_BYTES, stream, prm);
#endif
}
```

```cpp
#include <hip/hip_runtime.h>
#include <cstdio>
#include <cstdint>
#include <utility>

#ifndef N_LAUNCH_SPLIT
#define N_LAUNCH_SPLIT 0
#endif
#ifndef DBG_LAST_PHASE
#define DBG_LAST_PHASE 8
#endif

#define LAS __attribute__((address_space(3)))
#define GAS __attribute__((address_space(1)))
typedef unsigned short bf16_t;
typedef short bf16x8 __attribute__((ext_vector_type(8)));
typedef float f32x4 __attribute__((ext_vector_type(4)));
typedef float f32x2 __attribute__((ext_vector_type(2)));
typedef float f32x16 __attribute__((ext_vector_type(16)));
typedef unsigned u32x4 __attribute__((ext_vector_type(4)));
typedef unsigned u32x2 __attribute__((ext_vector_type(2)));
typedef __bf16 bf16x2_t __attribute__((ext_vector_type(2)));

constexpr int NB = 8, SEQ = 4096, DM = 1024, MT = NB * SEQ;
constexpr int NHEAD = 8, DQK = 96, DV = 64;
constexpr int NEXP = 32;
constexpr float EPS = 1e-6f;
constexpr float QSCALE = 0.14724444602590306f;
constexpr int NPH = 9;

constexpr size_t MiB = 1u << 20;
constexpr size_t WS_CTL = 0, CTL_BYTES = 128 * 1024;
constexpr size_t WS_MOD = 1 * MiB;
constexpr size_t WS_ROPE = 2 * MiB;
constexpr size_t WS_WIN = 6 * MiB;
constexpr size_t WS_WQ = 9 * MiB;
constexpr size_t WS_WKV = 9 * MiB + 512 * 1024;
constexpr size_t WS_WR = 9 * MiB + 768 * 1024;
constexpr size_t WS_WOUT = 10 * MiB;
constexpr size_t WS_WGU = 12 * MiB;
constexpr size_t WS_WD = 44 * MiB;
constexpr size_t WS_SSQQ = 60 * MiB;
constexpr size_t WS_SSQKV = 60 * MiB + 512 * 1024;
constexpr size_t WS_SSQKR = 60 * MiB + 768 * 1024;
constexpr size_t WS_SSQ1 = 61 * MiB;
constexpr size_t WS_TOKW = 63 * MiB;
constexpr size_t WS_KROPE = 64 * MiB;
constexpr size_t WS_CQ = 68 * MiB;
constexpr size_t WS_CKV = 84 * MiB;
constexpr size_t WS_LIST = 92 * MiB;
constexpr size_t WS_WLIST = 96 * MiB;
constexpr size_t WS_H = 100 * MiB;
constexpr size_t WS_U = 164 * MiB;
constexpr size_t WS_Q = 196 * MiB;
constexpr size_t WS_X1 = WS_Q;
constexpr size_t WS_K = 244 * MiB;
constexpr size_t WS_VT = 292 * MiB;
constexpr size_t WS_CAT = 324 * MiB;
constexpr size_t WS_ABUF = 388 * MiB;
constexpr size_t WS_BLIST = 420 * MiB;
constexpr size_t WS_END = 435 * MiB;
constexpr int CW_BAR = 4096;
constexpr int CW_CNT = 16384;

constexpr int SCR_BYTES = 155648;
constexpr int MISC_OFF = SCR_BYTES;
constexpr int LDS_BYTES = SCR_BYTES + 2048;

__device__ __forceinline__ unsigned cvtpk(float lo, float hi) { f32x2 v = {lo, hi}; bf16x2_t b = __builtin_convertvector(v, bf16x2_t); return __builtin_bit_cast(unsigned, b); }
__device__ __forceinline__ float bf2f(unsigned short h) { return __builtin_bit_cast(float, (unsigned)h << 16); }
__device__ __forceinline__ unsigned short f2bf(float f) { return (unsigned short)(cvtpk(f, 0.f) & 0xffffu); }
__device__ __forceinline__ float sigmoidf_(float x) { return __builtin_amdgcn_rcpf(1.0f + __expf(-x)); }
__device__ __forceinline__ float siluf_(float x) { return x * __builtin_amdgcn_rcpf(1.0f + __expf(-x)); }
__device__ __forceinline__ float wave_sum(float v) {
#pragma unroll
    for (int o = 1; o < 64; o <<= 1) v += __shfl_xor(v, o);
    return v;
}

__device__ __forceinline__ int vcu_id() { const int g = gridDim.x, b = blockIdx.x; return (g & 7) == 0 ? (b & 7) * (g >> 3) + (b >> 3) : b; }
__device__ __forceinline__ bool batch_aligned() { return gridDim.x == 256; }
#define XB_TMO      128
#define XB_XCNT(j)  (256  + 64 * (j))
#define XB_XSUB(j)  (1280 + 64 * (j))
#define XB_XGEN(j)  (2304 + 64 * (j))
#define XB_TOP      3328
#define XB_TOPGEN   3392
#define XCD_BAR_WORDS 3456
#define XB_SPIN_CAP (1u << 20)
__device__ __forceinline__ unsigned xb_ld(unsigned* p)              { return __hip_atomic_load(p, __ATOMIC_RELAXED, __HIP_MEMORY_SCOPE_AGENT); }
__device__ __forceinline__ unsigned xb_add(unsigned* p, unsigned v) { return __hip_atomic_fetch_add(p, v, __ATOMIC_RELAXED, __HIP_MEMORY_SCOPE_AGENT); }
__device__ __forceinline__ unsigned xb_xcc_id() { return (unsigned)__builtin_amdgcn_s_getreg((3 << 11) | 20) & 0xFu; }
#define XB_SPIN(cond, bar) do { unsigned _sp = 0; while (cond) { __builtin_amdgcn_s_sleep(1); \
    if ((++_sp & 255u) == 0u) { if (xb_ld(&(bar)[XB_TMO])) break; if (_sp > XB_SPIN_CAP) { atomicAdd(&(bar)[XB_TMO], 1u); break; } } } } while (0)
struct XcdBarrier { unsigned* bar; unsigned x; volatile LAS unsigned* st; };
__device__ __forceinline__ XcdBarrier xcd_barrier_post(unsigned* bar, volatile LAS unsigned* st) {
    XcdBarrier b; b.bar = bar; b.x = xb_xcc_id(); b.st = st;
    if (threadIdx.x == 0) (void)xb_add(&bar[XB_XCNT(b.x)], 1u);
    return b;
}
__device__ __forceinline__ void xcd_barrier_complete(unsigned* bar, unsigned x, unsigned& nloc, unsigned& nx) {
    const unsigned G = gridDim.x * gridDim.y * gridDim.z;
    unsigned sum, cnt, mine, sp = 0u;
    for (;;) {
        sum = 0u; cnt = 0u; mine = 0u;
#pragma unroll
        for (unsigned j = 0; j < 16; ++j) { const unsigned c = xb_ld(&bar[XB_XCNT(j)]); sum += c; cnt += (c > 0u) ? 1u : 0u; mine = (j == x) ? c : mine; }
        if (sum == G) break;
        __builtin_amdgcn_s_sleep(1);
        if ((++sp & 255u) == 0u) { if (xb_ld(&bar[XB_TMO])) break; if (sp > XB_SPIN_CAP) { atomicAdd(&bar[XB_TMO], 1u); break; } }
    }
    nloc = mine > 0u ? mine : 1u; nx = cnt > 0u ? cnt : 1u;
}
__device__ __forceinline__ void xcd_barrier(const XcdBarrier& b) {
    asm volatile("s_waitcnt vmcnt(0)" ::: "memory");
    __syncthreads();
    if (threadIdx.x == 0) {
        unsigned* bar = b.bar;
        __builtin_amdgcn_s_waitcnt(0);
        unsigned nloc = b.st[0], nx = b.st[1];
        if (nloc == 0u) { xcd_barrier_complete(bar, b.x, nloc, nx); b.st[0] = nloc; b.st[1] = nx; }
        const unsigned old = xb_add(&bar[XB_XSUB(b.x)], 1u);
        const unsigned gen = old / nloc;
        if (old + 1u == (gen + 1u) * nloc) {
            __builtin_amdgcn_fence(__ATOMIC_RELEASE, "agent");
            asm volatile("s_waitcnt vmcnt(0)" ::: "memory");
            const unsigned og = xb_add(&bar[XB_TOP], 1u);
            const unsigned tg = og / nx;
            if (og + 1u == (tg + 1u) * nx) xb_add(&bar[XB_TOPGEN], 1u);
            else XB_SPIN(xb_ld(&bar[XB_TOPGEN]) == tg, bar);
            __builtin_amdgcn_fence(__ATOMIC_ACQUIRE, "agent");
            xb_add(&bar[XB_XGEN(b.x)], 1u);
            asm volatile("s_waitcnt vmcnt(0)" ::: "memory");
        } else {
            XB_SPIN(xb_ld(&bar[XB_XGEN(b.x)]) == gen, bar);
            __builtin_amdgcn_fence(__ATOMIC_ACQUIRE, "agent");
            asm volatile("s_waitcnt vmcnt(0)" ::: "memory");
        }
    }
    __syncthreads();
}

__device__ __forceinline__ int lds_byte2(int r, int c) { const int st = (r >> 4) * 2 + (c >> 5), ob = (r & 15) * 64 + (c & 31) * 2; return st * 1024 + (ob ^ (((ob >> 9) & 1) << 5)); }
__device__ __forceinline__ void stage_rc2(int b, int& R, int& C) { const int st = b >> 10, sb = b & 1023, swz = sb ^ (((sb >> 9) & 1) << 5); R = (st >> 1) * 16 + swz / 64; C = (st & 1) * 32 + (swz % 64) / 2; }

__device__ __forceinline__ int lds_byte3(int r, int c) { return (r >> 3) * 1024 + (r & 7) * 128 + ((((c >> 3) ^ r) & 7) << 4) + (c & 7) * 2; }
__device__ __forceinline__ void stage_rc3(int b, int& R, int& C) { const int st = b >> 10, l16 = (b & 1023) >> 4, rr = l16 >> 3; R = st * 8 + rr; C = ((l16 ^ rr) & 7) * 8; }
template <int GL>
__device__ __forceinline__ void stage_ptrs_dense3(const bf16_t* base, size_t ld, int r0, const bf16_t* (&p)[GL]) {
    const int tid = threadIdx.x, lane = tid & 63, wid = tid >> 6;
#pragma unroll
    for (int i = 0; i < GL; ++i) { int R, C; stage_rc3(wid * 1024 + i * 8192 + lane * 16, R, C); p[i] = base + (size_t)(r0 + R) * ld + C; }
}
template <int MI, int NI, bool TRANS>
__device__ __forceinline__ void gemm_block(LAS unsigned char* lds, const bf16_t* const (&ap)[MI / 2], const bf16_t* const (&bp)[NI], int nkt, f32x4 (&acc)[MI][NI]) {
    constexpr int BM = 32 * MI, BN = 64 * NI, TA = BM * 128, TB = BN * 128, STG = TA + TB, GLA = MI / 2, GLB = NI;
    static_assert(2 * STG <= SCR_BYTES, "LDS");
    const int tid = threadIdx.x, lane = tid & 63, wid = __builtin_amdgcn_readfirstlane(tid >> 6), wr = wid >> 2, wc = wid & 3, fr = lane & 15, fq = lane >> 4;
    const int aoff = lds_byte2(wr * (MI * 16) + fr, fq * 8), boff = TA + lds_byte2(wc * (NI * 16) + fr, fq * 8);
#define GB_STAGE(buf, kt) do { \
        _Pragma("unroll") for (int i_ = 0; i_ < GLA; ++i_) __builtin_amdgcn_global_load_lds((const unsigned*)(ap[i_] + (kt) * 64), (LAS unsigned*)(lds + (buf) * STG + wid * 1024 + i_ * 8192), 16, 0, 0); \
        _Pragma("unroll") for (int i_ = 0; i_ < GLB; ++i_) __builtin_amdgcn_global_load_lds((const unsigned*)(bp[i_] + (kt) * 64), (LAS unsigned*)(lds + (buf) * STG + TA + wid * 1024 + i_ * 8192), 16, 0, 0); } while (0)
    GB_STAGE(0, 0);
    asm volatile("s_waitcnt vmcnt(0)" ::: "memory"); __syncthreads();
    for (int t = 0; t < nkt; ++t) {
        const int cur = t & 1;
        if (t + 1 < nkt) GB_STAGE(cur ^ 1, t + 1);
        const LAS unsigned char* sb = lds + cur * STG;
#pragma unroll
        for (int ks = 0; ks < 2; ++ks) {
            bf16x8 At[MI], Bf[NI];
#pragma unroll
            for (int m = 0; m < MI; ++m) At[m] = *(const LAS bf16x8*)(sb + aoff + m * 2048 + ks * 1024);
#pragma unroll
            for (int n = 0; n < NI; ++n) Bf[n] = *(const LAS bf16x8*)(sb + boff + n * 2048 + ks * 1024);
#pragma unroll
            for (int m = 0; m < MI; ++m)
#pragma unroll
                for (int n = 0; n < NI; ++n)
                    acc[m][n] = TRANS ? __builtin_amdgcn_mfma_f32_16x16x32_bf16(Bf[n], At[m], acc[m][n], 0, 0, 0)
                                      : __builtin_amdgcn_mfma_f32_16x16x32_bf16(At[m], Bf[n], acc[m][n], 0, 0, 0);
        }
        asm volatile("s_waitcnt vmcnt(0)" ::: "memory"); __syncthreads();
    }
#undef GB_STAGE
}
template <int MI, int NI, bool ARES>
__device__ __forceinline__ void gemm_stage(LAS unsigned char* lds, int abytes, const bf16_t* const (&ap)[MI / 2], const bf16_t* const (&bp)[NI], int buf, int kt) {
    constexpr int TA = MI * 32 * 128, TB = NI * 64 * 128, STG = ARES ? TB : TA + TB;
    const int wid = __builtin_amdgcn_readfirstlane(threadIdx.x >> 6);
    LAS unsigned char* base = lds + (ARES ? abytes : 0) + buf * STG + wid * 1024;
    if (!ARES) {
#pragma unroll
        for (int i = 0; i < MI / 2; ++i) __builtin_amdgcn_global_load_lds((const unsigned*)(ap[i] + kt * 64), (LAS unsigned*)(base + i * 8192), 16, 0, 0);
    }
#pragma unroll
    for (int i = 0; i < NI; ++i) __builtin_amdgcn_global_load_lds((const unsigned*)(bp[i] + kt * 64), (LAS unsigned*)(base + (ARES ? 0 : TA) + i * 8192), 16, 0, 0);
}
template <int MI>
__device__ __forceinline__ void gemm_load_ares(LAS unsigned char* lds, const bf16_t* const (&ap)[MI / 2], int nkt) {
    constexpr int TA = MI * 32 * 128;
    const int wid = __builtin_amdgcn_readfirstlane(threadIdx.x >> 6);
    for (int kt = 0; kt < nkt; ++kt) {
#pragma unroll
        for (int i = 0; i < MI / 2; ++i) __builtin_amdgcn_global_load_lds((const unsigned*)(ap[i] + kt * 64), (LAS unsigned*)(lds + kt * TA + wid * 1024 + i * 8192), 16, 0, 0);
    }
}
template <int MI, int NI, bool TRANS, bool ARES>
__device__ __forceinline__ void gemm_main2(LAS unsigned char* lds, int abytes, const bf16_t* const (&ap)[MI / 2], const bf16_t* const (&bp)[NI], const bf16_t* const (&bq)[NI], int ksplit, int nkt, f32x4 (&acc)[MI][NI]) {
    constexpr int TA = MI * 32 * 128, TB = NI * 64 * 128, STG = ARES ? TB : TA + TB;
    const int tid = threadIdx.x, lane = tid & 63, wid = __builtin_amdgcn_readfirstlane(tid >> 6), wr = wid >> 2, wc = wid & 3, fr = lane & 15, fq = lane >> 4;
    const int aoff = lds_byte2(wr * (MI * 16) + fr, fq * 8), boff = (ARES ? abytes : TA) + lds_byte2(wc * (NI * 16) + fr, fq * 8);
#pragma unroll 1
    for (int t = 0; t < nkt; ++t) {
        const int cur = t & 1;
        asm volatile("s_waitcnt vmcnt(0)" ::: "memory"); __syncthreads();
        if (t + 1 < nkt) { if (t + 1 < ksplit) gemm_stage<MI, NI, ARES>(lds, abytes, ap, bp, cur ^ 1, t + 1); else gemm_stage<MI, NI, ARES>(lds, abytes, ap, bq, cur ^ 1, t + 1); }
        const LAS unsigned char* sa = ARES ? lds + t * TA : lds + cur * STG;
        const LAS unsigned char* sb = lds + cur * STG;
#pragma unroll
        for (int ks = 0; ks < 2; ++ks) {
            bf16x8 At[MI], Bf[NI];
#pragma unroll
            for (int m = 0; m < MI; ++m) At[m] = *(const LAS bf16x8*)(sa + aoff + m * 2048 + ks * 1024);
#pragma unroll
            for (int n = 0; n < NI; ++n) Bf[n] = *(const LAS bf16x8*)(sb + boff + n * 2048 + ks * 1024);
#pragma unroll
            for (int m = 0; m < MI; ++m)
#pragma unroll
                for (int n = 0; n < NI; ++n)
                    acc[m][n] = TRANS ? __builtin_amdgcn_mfma_f32_16x16x32_bf16(Bf[n], At[m], acc[m][n], 0, 0, 0)
                                      : __builtin_amdgcn_mfma_f32_16x16x32_bf16(At[m], Bf[n], acc[m][n], 0, 0, 0);
        }
    }
    if (nkt & 1) __syncthreads();
}
template <int MI, int NI, bool TRANS, bool ARES>
__device__ __forceinline__ void gemm_main(LAS unsigned char* lds, int abytes, const bf16_t* const (&ap)[MI / 2], const bf16_t* const (&bp)[NI], int nkt, f32x4 (&acc)[MI][NI]) {
    gemm_main2<MI, NI, TRANS, ARES>(lds, abytes, ap, bp, bp, nkt, nkt, acc);
}
__device__ __forceinline__ void gemm_main_ares_sw(LAS unsigned char* lds, int abytes, const bf16_t* const (&ap)[2], const bf16_t* const (&bp)[4], int nkt, f32x4 (&acc)[4][4], bool swap) {
    constexpr int MI = 4, NI = 4, TA = MI * 32 * 128, TB = NI * 64 * 128, STG = TB;
    const int tid = threadIdx.x, lane = tid & 63, wid = __builtin_amdgcn_readfirstlane(tid >> 6), wr = wid >> 2, wc = wid & 3, fr = lane & 15, fq = lane >> 4;
    const int aoff = lds_byte2(wr * (MI * 16) + fr, fq * 8), boff = abytes + lds_byte2(wc * (NI * 16) + fr, fq * 8);
#pragma unroll 1
    for (int t = 0; t < nkt; ++t) {
        const int cur = t & 1;
        asm volatile("s_waitcnt vmcnt(0)" ::: "memory"); __syncthreads();
        if (t + 1 < nkt) gemm_stage<MI, NI, true>(lds, abytes, ap, bp, cur ^ 1, t + 1);
        const LAS unsigned char* sa = lds + t * TA;
        const LAS unsigned char* sb = lds + cur * STG;
#pragma unroll
        for (int ks = 0; ks < 2; ++ks) {
            bf16x8 At[MI], Bf[NI];
#pragma unroll
            for (int m = 0; m < MI; ++m) At[m] = *(const LAS bf16x8*)(sa + aoff + m * 2048 + ks * 1024);
#pragma unroll
            for (int n = 0; n < NI; ++n) Bf[n] = *(const LAS bf16x8*)(sb + boff + n * 2048 + ks * 1024);
            if (swap) {
#pragma unroll
                for (int m = 0; m < MI; ++m)
#pragma unroll
                    for (int n = 0; n < NI; ++n) acc[m][n] = __builtin_amdgcn_mfma_f32_16x16x32_bf16(Bf[n], At[m], acc[m][n], 0, 0, 0);
            } else {
#pragma unroll
                for (int m = 0; m < MI; ++m)
#pragma unroll
                    for (int n = 0; n < NI; ++n) acc[m][n] = __builtin_amdgcn_mfma_f32_16x16x32_bf16(At[m], Bf[n], acc[m][n], 0, 0, 0);
            }
        }
    }
    if (nkt & 1) __syncthreads();
}
template <int GL>
__device__ __forceinline__ void stage_ptrs_dense(const bf16_t* base, size_t ld, int r0, const bf16_t* (&p)[GL]) {
    const int tid = threadIdx.x, lane = tid & 63, wid = tid >> 6;
#pragma unroll
    for (int i = 0; i < GL; ++i) { int R, C; stage_rc2(wid * 1024 + i * 8192 + lane * 16, R, C); p[i] = base + (size_t)(r0 + R) * ld + C; }
}

struct Params {
    const void* in[26];
    float* out;
    unsigned char* ws;
    int ph_lo, ph_hi;
};
typedef const __attribute__((address_space(4))) Params* CP;
__device__ __forceinline__ CP get_params() { CP q = (CP)__builtin_amdgcn_kernarg_segment_ptr(); asm volatile("" : "+s"(q)); return q; }

__device__ const float INVF[16] = {1.000000000e+00f, 5.623413324e-01f, 3.162277639e-01f, 1.778279394e-01f, 1.000000015e-01f, 5.623413250e-02f, 3.162277490e-02f, 1.778279431e-02f,
                                   9.999999776e-03f, 5.623413250e-03f, 3.162277630e-03f, 1.778279431e-03f, 1.000000047e-03f, 5.623413017e-04f, 3.162277571e-04f, 1.778279402e-04f};

__device__ __forceinline__ void tr_item(const float* srcp, int ldw, const float* kscale, bf16_t* WT, int Kd, int k0, int n0, LAS float* scr, int lane) {
#pragma unroll 8
    for (int i = 0; i < 32; ++i) { const int kk = 2 * i + (lane >> 5); float v = 0.f; if (srcp) { v = srcp[(size_t)(k0 + kk) * ldw]; if (kscale) v *= kscale[k0 + kk]; } scr[kk * 33 + (lane & 31)] = v; }
    asm volatile("s_waitcnt lgkmcnt(0)" ::: "memory");
    const int c = lane & 7;
#pragma unroll
    for (int j = 0; j < 4; ++j) { const int n = (lane >> 3) + 8 * j; const LAS float* s = scr + (8 * c) * 33 + n;
        u32x4 o; o.x = cvtpk(s[0 * 33], s[1 * 33]); o.y = cvtpk(s[2 * 33], s[3 * 33]); o.z = cvtpk(s[4 * 33], s[5 * 33]); o.w = cvtpk(s[6 * 33], s[7 * 33]);
        *(u32x4*)(WT + (size_t)(n0 + n) * Kd + k0 + 8 * c) = o; }
    asm volatile("s_waitcnt lgkmcnt(0)" ::: "memory");
}

constexpr int TR_I0 = 16 * 24, TR_I1 = 4 * 12, TR_I2 = 2 * 16, TR_I3 = 16 * 16, TR_I4 = 32 * 128, TR_I5 = 32 * 64, TR_I6 = 16 * 2;
constexpr int TR_NIT = TR_I0 + TR_I1 + TR_I2 + TR_I3 + TR_I4 + TR_I5 + TR_I6, TR_EARLY = TR_I0 + TR_I1 + TR_I2;
__device__ __forceinline__ void transpose_items(CP p, LAS unsigned char* lds, int it0, int it1) {
    const int tid = threadIdx.x, lane = tid & 63, wave = __builtin_amdgcn_readfirstlane(tid >> 6);
    const int G = gridDim.x, bid = blockIdx.x;
    unsigned char* ws = p->ws;
    {
        LAS unsigned* scr = (LAS unsigned*)(lds + 65536) + wave * 2112;
        const int gw = bid * 8 + wave, NGW = G * 8;
        const float* w_in = (const float*)p->in[6]; const float* qan = (const float*)p->in[11]; const float* w_qb = (const float*)p->in[12];
        const float* kvan = (const float*)p->in[13]; const float* w_kvb = (const float*)p->in[14]; const float* w_out = (const float*)p->in[17];
        const float* w_group = (const float*)p->in[19]; const float* w_expert = (const float*)p->in[21];
        const float* w_gate = (const float*)p->in[23]; const float* w_up = (const float*)p->in[24]; const float* w_down = (const float*)p->in[25];
        constexpr int I0 = TR_I0, I1 = TR_I1, I2 = TR_I2, I3 = TR_I3, I4 = TR_I4, I5 = TR_I5, I6 = TR_I6, NIT = TR_NIT;
        const int c4 = lane & 15, kp = lane >> 4;
        for (int it = it0 + gw; it < it1; it += NGW) {
            int r = it;
            if (r >= NIT - I6) {
                r -= NIT - I6;
                LAS float* fscr = (LAS float*)scr; const int nl = lane & 31;
                const int kb = r >> 1, nb = r & 1, n0 = nb * 32, np = n0 + nl, k0 = kb * 64;
                const float* srcp = nullptr; int ldw = 0;
                if (np < 4) { srcp = w_group + np; ldw = 4; } else if (np < 36) { srcp = w_expert + (np - 4); ldw = 32; }
#pragma unroll 8
                for (int i = 0; i < 32; ++i) { const int kk = 2 * i + (lane >> 5); fscr[kk * 33 + nl] = srcp ? srcp[(size_t)(k0 + kk) * ldw] : 0.f; }
                asm volatile("s_waitcnt lgkmcnt(0)" ::: "memory");
                const int c = lane & 7;
#pragma unroll
                for (int j = 0; j < 4; ++j) { const int n = (lane >> 3) + 8 * j; const LAS float* sp = fscr + (8 * c) * 33 + n;
                    float v[8], l[8];
#pragma unroll
                    for (int q = 0; q < 8; ++q) { v[q] = sp[q * 33]; l[q] = v[q] - bf2f(f2bf(v[q])); }
                    if (n0 + n < 48) {
                        u32x4 o; o.x = cvtpk(v[0], v[1]); o.y = cvtpk(v[2], v[3]); o.z = cvtpk(v[4], v[5]); o.w = cvtpk(v[6], v[7]);
                        *(u32x4*)((bf16_t*)(ws + WS_WR) + (size_t)(n0 + n) * 1024 + k0 + 8 * c) = o;
                        u32x4 o2; o2.x = cvtpk(l[0], l[1]); o2.y = cvtpk(l[2], l[3]); o2.z = cvtpk(l[4], l[5]); o2.w = cvtpk(l[6], l[7]);
                        *(u32x4*)((bf16_t*)(ws + WS_WR) + 48 * 1024 + (size_t)(n0 + n) * 1024 + k0 + 8 * c) = o2; } }
                asm volatile("s_waitcnt lgkmcnt(0)" ::: "memory");
                continue;
            }
            const float* srcp; int ldw, Kd, k0, n0; const float* ksc = nullptr; bf16_t* WT;
            if (r < I0) {
                const int kb = r / 24, nb = r % 24; n0 = nb * 64; k0 = kb * 64; const int np = n0 + 4 * c4;
                const int pn = np >> 8, wc = (np >> 6) & 3, n = (np >> 4) & 3, f = np & 15; int src;
                if (pn < 4) { const int ch = pn * 128 + wc * 32 + (n >> 1) * 16 + f; src = (n & 1) ? 512 + ch : ch; }
                else if (pn == 4) src = np;
                else { const int j = np - 1280; src = (j < 160) ? 1280 + j : -1; }
                srcp = src >= 0 ? w_in + src : nullptr; ldw = 1440; Kd = 1024; WT = (bf16_t*)(ws + WS_WIN);
            } else if ((r -= I0) < I1) {
                const int kb = r / 12, nb = r % 12; n0 = nb * 64; k0 = kb * 64;
                srcp = w_qb + n0 + 4 * c4; ldw = 768; Kd = 256; ksc = qan; WT = (bf16_t*)(ws + WS_WQ);
            } else if ((r -= I1) < I2) {
                const int kb = r / 16, nb = r % 16; n0 = nb * 64; k0 = kb * 64;
                srcp = w_kvb + n0 + 4 * c4; ldw = 1024; Kd = 128; ksc = kvan; WT = (bf16_t*)(ws + WS_WKV);
            } else if ((r -= I2) < I3) {
                const int kb = r / 16, nb = r % 16; n0 = nb * 64; k0 = kb * 64;
                srcp = w_out + n0 + 4 * c4; ldw = 1024; Kd = 1024; WT = (bf16_t*)(ws + WS_WOUT);
            } else if ((r -= I3) < I4) {
                const int e = r >> 7, q = r & 127, kb = q / 8, nb = q % 8; n0 = nb * 64; k0 = kb * 64; const int np = n0 + 4 * c4;
                const int ct = np >> 8, wc = (np >> 6) & 3, n = (np >> 4) & 3, f = np & 15, ch = ct * 128 + wc * 32 + (n >> 1) * 16 + f;
                srcp = ((n & 1) ? w_up : w_gate) + (size_t)e * 1024 * 256 + ch; ldw = 256; Kd = 1024; WT = (bf16_t*)(ws + WS_WGU) + (size_t)e * 512 * 1024;
            } else {
                r -= I4; const int e = r >> 6, q = r & 63, kb = q / 16, nb = q % 16; n0 = nb * 64; k0 = kb * 64;
                srcp = w_down + (size_t)e * 256 * 1024 + n0 + 4 * c4; ldw = 1024; Kd = 256; WT = (bf16_t*)(ws + WS_WD) + (size_t)e * 1024 * 256;
            }
            f32x4 v0[8], v1[8];
#pragma unroll
            for (int i = 0; i < 8; ++i) { const int k = k0 + 8 * i + 2 * kp;
                if (srcp) { v0[i] = __builtin_nontemporal_load((const f32x4*)(srcp + (size_t)k * ldw)); v1[i] = __builtin_nontemporal_load((const f32x4*)(srcp + (size_t)(k + 1) * ldw)); }
                else { v0[i] = (f32x4){0.f, 0.f, 0.f, 0.f}; v1[i] = v0[i]; } }
#pragma unroll
            for (int i = 0; i < 8; ++i) { const int k = k0 + 8 * i + 2 * kp; f32x4 a = v0[i], b = v1[i];
                if (ksc) { a = a * ksc[k]; b = b * ksc[k + 1]; }
                LAS unsigned* d = scr + (4 * c4) * 33 + 4 * i + kp;
                d[0] = cvtpk(a.x, b.x); d[33] = cvtpk(a.y, b.y); d[66] = cvtpk(a.z, b.z); d[99] = cvtpk(a.w, b.w); }
            asm volatile("s_waitcnt lgkmcnt(0)" ::: "memory");
            const int c = lane & 7;
            const bool late = it >= TR_EARLY + TR_I3;
#pragma unroll
            for (int j = 0; j < 8; ++j) { const int n = (lane >> 3) + 8 * j; const LAS unsigned* sp = scr + n * 33 + 4 * c;
                u32x4 o; o.x = sp[0]; o.y = sp[1]; o.z = sp[2]; o.w = sp[3];
                if (late) __builtin_nontemporal_store(o, (u32x4*)(WT + (size_t)(n0 + n) * Kd + k0 + 8 * c)); else *(u32x4*)(WT + (size_t)(n0 + n) * Kd + k0 + 8 * c) = o; }
            asm volatile("s_waitcnt lgkmcnt(0)" ::: "memory");
        }
    }
}

__device__ __forceinline__ void rope_table(CP p) {
    const int* pos = (const int*)p->in[2]; f32x2* rt = (f32x2*)(p->ws + WS_ROPE);
    for (int e = blockIdx.x * 512 + threadIdx.x; e < MT * 16; e += gridDim.x * 512) {
        const int tok = e >> 4, i = e & 15;
        const float a32 = (float)pos[tok] * INVF[i];
        const double rev = (double)a32 * 0.15915494309189535;
        const float fr = (float)(rev - __builtin_rint(rev));
        rt[e] = (f32x2){__builtin_amdgcn_cosf(fr), __builtin_amdgcn_sinf(fr)};
    }
}

__device__ __forceinline__ void phase0(CP p, LAS unsigned char* lds) {
    const int tid = threadIdx.x, lane = tid & 63, wave = __builtin_amdgcn_readfirstlane(tid >> 6);
    const int G = gridDim.x, bid = blockIdx.x;
    unsigned char* ws = p->ws;
    if (bid < 192) {
        const float* c = (const float*)p->in[1]; const float* w_ada = (const float*)p->in[3]; const float* b_ada = (const float*)p->in[4];
        LAS float* sc = (LAS float*)lds;
        LAS float* red = (LAS float*)(lds + 32768);
        const int col = tid & 31, ks = tid >> 5, n0 = bid * 32;
        float wv[64];
#pragma unroll
        for (int i = 0; i < 64; ++i) wv[i] = __builtin_nontemporal_load(w_ada + (size_t)(ks * 64 + i) * 6144 + n0 + col);
        for (int i = tid; i < 8192; i += 512) sc[i] = siluf_(c[i]);
        __syncthreads();
        float a[8] = {0, 0, 0, 0, 0, 0, 0, 0};
#pragma unroll
        for (int i = 0; i < 64; ++i) { const int k = ks * 64 + i;
#pragma unroll
            for (int b = 0; b < 8; ++b) a[b] += sc[b * 1024 + k] * wv[i]; }
#pragma unroll
        for (int b = 0; b < 8; ++b) red[(ks * 32 + col) * 8 + b] = a[b];
        __syncthreads();
        if (tid < 256) { const int cc = tid & 31, b = tid >> 5; float s = 0.f;
#pragma unroll
            for (int k2 = 0; k2 < 16; ++k2) s += red[(k2 * 32 + cc) * 8 + b];
            ((float*)(ws + WS_MOD))[b * 6144 + n0 + cc] = s + b_ada[n0 + cc]; }
        __syncthreads();
    }
    if (N_LAUNCH_SPLIT) { rope_table(p); transpose_items(p, lds, 0, TR_NIT); }
}

__device__ __forceinline__ void phase1a(CP p, LAS unsigned char* lds) {
    const int tid = threadIdx.x, lane = tid & 63, wave = tid >> 6;
    const int NGW = gridDim.x * 8;
    const float* x = (const float*)p->in[0]; const float* nm = (const float*)p->in[5]; const float* mod = (const float*)(p->ws + WS_MOD);
    bf16_t* h = (bf16_t*)(p->ws + WS_H);
    LAS f32x4* gms = (LAS f32x4*)lds;
    int bcur = -1;
    for (int base = (batch_aligned() ? vcu_id() : (int)blockIdx.x) * 8; base < MT / 16; base += NGW) {
        const int r0 = (base + wave) * 16, b = (base * 16) >> 12;
        if (b != bcur) { bcur = b; __syncthreads();
            if (tid < 256) { const int col = 4 * tid; const f32x4 g = *(const f32x4*)(nm + col), s_ = *(const f32x4*)(mod + b * 6144 + 1024 + col); gms[2 * tid] = g * (s_ + 1.0f); gms[2 * tid + 1] = *(const f32x4*)(mod + b * 6144 + col); }
            __syncthreads(); }
#define P1A_LOAD(v, rb) do { _Pragma("unroll") for (int rr = 0; rr < 4; ++rr) { const float* xr = x + (size_t)(r0 + (rb) + rr) * DM; \
            _Pragma("unroll") for (int j = 0; j < 4; ++j) v[rr][j] = __builtin_nontemporal_load((const f32x4*)(xr + 4 * lane + 256 * j)); } } while (0)
#define P1A_PROC(v, rb) do { _Pragma("unroll") for (int rr = 0; rr < 4; ++rr) { float s = 0.f; \
            _Pragma("unroll") for (int j = 0; j < 4; ++j) s += (v[rr][j].x * v[rr][j].x + v[rr][j].y * v[rr][j].y) + (v[rr][j].z * v[rr][j].z + v[rr][j].w * v[rr][j].w); \
            const float rstd = __builtin_amdgcn_rsqf(wave_sum(s) * (1.0f / DM) + EPS); \
            bf16_t* hr = h + (size_t)(r0 + (rb) + rr) * DM; \
            _Pragma("unroll") for (int j = 0; j < 4; ++j) { const f32x4 o = v[rr][j] * rstd * gms[2 * (lane + 64 * j)] + gms[2 * (lane + 64 * j) + 1]; u32x2 w; w.x = cvtpk(o.x, o.y); w.y = cvtpk(o.z, o.w); *(u32x2*)(hr + 4 * lane + 256 * j) = w; } } } while (0)
        f32x4 va[4][4], vb[4][4];
        P1A_LOAD(va, 0);
        P1A_LOAD(vb, 4); P1A_PROC(va, 0);
        P1A_LOAD(va, 8); P1A_PROC(vb, 4);
        P1A_LOAD(vb, 12); P1A_PROC(va, 8);
        P1A_PROC(vb, 12);
#undef P1A_LOAD
#undef P1A_PROC
    }
}

__device__ __forceinline__ void phase1b(CP p, LAS unsigned char* lds) {
    const int tid = threadIdx.x, lane = tid & 63, wid = __builtin_amdgcn_readfirstlane(tid >> 6), wr = wid >> 2, wc = wid & 3, fr = lane & 15, fq = lane >> 4;
    unsigned char* ws = p->ws;
    const bf16_t* h = (const bf16_t*)(ws + WS_H); const bf16_t* win = (const bf16_t*)(ws + WS_WIN);
    for (int u = vcu_id(); u < 128 * 6; u += gridDim.x) {
        int pm = u / 6, pn = u % 6;
        if (batch_aligned()) { const int t = (u & 31) + 32 * (u >> 8); pm = 16 * ((u >> 5) & 7) + t / 6; pn = t % 6; }
        const bf16_t* ap[4]; const bf16_t* bp[4];
        stage_ptrs_dense<4>(h, 1024, pm * 256, ap); stage_ptrs_dense<4>(win, 1024, pn * 256, bp);
        f32x4 acc[8][4];
#pragma unroll
        for (int m = 0; m < 8; ++m)
#pragma unroll
            for (int n = 0; n < 4; ++n) acc[m][n] = (f32x4){0.f, 0.f, 0.f, 0.f};
        gemm_block<8, 4, true>(lds, ap, bp, 16, acc);
        const int rowb = pm * 256 + wr * 128 + fr;
        if (pn < 4) {
            bf16_t* ub = (bf16_t*)(ws + WS_U);
#pragma unroll
            for (int m = 0; m < 8; ++m) { const size_t row = rowb + m * 16;
#pragma unroll
                for (int h2 = 0; h2 < 2; ++h2) { const f32x4 v = acc[m][2 * h2], g = acc[m][2 * h2 + 1];
                    const int ch = pn * 128 + wc * 32 + h2 * 16 + fq * 4;
                    u32x2 w; w.x = cvtpk(v.x * sigmoidf_(g.x), v.y * sigmoidf_(g.y)); w.y = cvtpk(v.z * sigmoidf_(g.z), v.w * sigmoidf_(g.w));
                    *(u32x2*)(ub + row * 512 + ch) = w; } }
        } else if (pn == 4) {
            bf16_t* cq = (bf16_t*)(ws + WS_CQ); float* sq = (float*)(ws + WS_SSQQ);
#pragma unroll
            for (int m = 0; m < 8; ++m) { const size_t row = rowb + m * 16; float s = 0.f;
#pragma unroll
                for (int n = 0; n < 4; ++n) { const f32x4 v = acc[m][n]; s += (v.x * v.x + v.y * v.y) + (v.z * v.z + v.w * v.w);
                    u32x2 w; w.x = cvtpk(v.x, v.y); w.y = cvtpk(v.z, v.w); *(u32x2*)(cq + row * 256 + wc * 64 + n * 16 + fq * 4) = w; }
                s += __shfl_xor(s, 16); s += __shfl_xor(s, 32);
                if (fq == 0) sq[row * 4 + wc] = s; }
        } else {
            if (wc < 2) {
                bf16_t* ckv = (bf16_t*)(ws + WS_CKV); float* sq = (float*)(ws + WS_SSQKV);
#pragma unroll
                for (int m = 0; m < 8; ++m) { const size_t row = rowb + m * 16; float s = 0.f;
#pragma unroll
                    for (int n = 0; n < 4; ++n) { const f32x4 v = acc[m][n]; s += (v.x * v.x + v.y * v.y) + (v.z * v.z + v.w * v.w);
                        u32x2 w; w.x = cvtpk(v.x, v.y); w.y = cvtpk(v.z, v.w); *(u32x2*)(ckv + row * 128 + wc * 64 + n * 16 + fq * 4) = w; }
                    s += __shfl_xor(s, 16); s += __shfl_xor(s, 32);
                    if (fq == 0) sq[row * 2 + wc] = s; }
            } else if (wc == 2) {
                float* kr = (float*)(ws + WS_KROPE); float* sq = (float*)(ws + WS_SSQKR);
#pragma unroll
                for (int m = 0; m < 8; ++m) { const size_t row = rowb + m * 16; float s = 0.f;
#pragma unroll
                    for (int n = 0; n < 2; ++n) { const f32x4 v = acc[m][n]; s += (v.x * v.x + v.y * v.y) + (v.z * v.z + v.w * v.w);
                        *(f32x4*)(kr + row * 32 + n * 16 + fq * 4) = v; }
                    s += __shfl_xor(s, 16); s += __shfl_xor(s, 32);
                    if (fq == 0) sq[row] = s; }
            }
        }
    }
}

constexpr int EPI_SCR = 131072;
constexpr int QB_OFF = 65536, QB_SLOT = 24576;
__device__ __forceinline__ void q_stage_b(LAS unsigned char* lds, const bf16_t* const (&bp)[3], int slot, int q) {
    const int wid = __builtin_amdgcn_readfirstlane(threadIdx.x >> 6);
#pragma unroll
    for (int i = 0; i < 3; ++i) __builtin_amdgcn_global_load_lds((const unsigned*)(bp[i] + q * 32), (LAS unsigned*)(lds + QB_OFF + slot * QB_SLOT + (wid + 8 * i) * 1024), 16, 0, 0);
}
__device__ __forceinline__ void gemm_q(LAS unsigned char* lds, const bf16_t* const (&bp)[3], f32x4 (&acc)[4][6]) {
    const int tid = threadIdx.x, lane = tid & 63, wid = __builtin_amdgcn_readfirstlane(tid >> 6), wr = wid >> 2, wc = wid & 3, fr = lane & 15, fq = lane >> 4;
    const int aoff = lds_byte2(wr * 64 + fr, fq * 8);
    const int boff = QB_OFF + (wc * 6) * 1024 + ((fr * 64 + fq * 16) ^ (((fr >> 3) & 1) << 5));
    int slot = 0;
#pragma unroll 1
    for (int q = 0; q < 8; ++q) {
        if (q == 7) asm volatile("s_waitcnt vmcnt(0)" ::: "memory"); else asm volatile("s_waitcnt vmcnt(3)" ::: "memory");
        __builtin_amdgcn_s_barrier();
        asm volatile("" ::: "memory");
        if (q + 2 < 8) q_stage_b(lds, bp, slot >= 1 ? slot - 1 : 2, q + 2);
        const LAS unsigned char* sa = lds + (q >> 1) * 16384 + (q & 1) * 1024 + aoff;
        const LAS unsigned char* sb = lds + boff + slot * QB_SLOT;
        bf16x8 At[4], Bf[6];
#pragma unroll
        for (int m = 0; m < 4; ++m) At[m] = *(const LAS bf16x8*)(sa + m * 2048);
#pragma unroll
        for (int n = 0; n < 6; ++n) Bf[n] = *(const LAS bf16x8*)(sb + n * 1024);
#pragma unroll
        for (int m = 0; m < 4; ++m)
#pragma unroll
            for (int n = 0; n < 6; ++n) acc[m][n] = __builtin_amdgcn_mfma_f32_16x16x32_bf16(Bf[n], At[m], acc[m][n], 0, 0, 0);
        slot = slot == 2 ? 0 : slot + 1;
    }
}
__device__ __forceinline__ void q_item(CP p, LAS unsigned char* lds, int item) {
    const int tid = threadIdx.x, lane = tid & 63, wid = __builtin_amdgcn_readfirstlane(tid >> 6), wr = wid >> 2, wc = wid & 3, fr = lane & 15, fq = lane >> 4;
    unsigned char* ws = p->ws;
    const int pm = item >> 1, ct = item & 1;
    const bf16_t* ap[2]; const bf16_t* bp[3];
    stage_ptrs_dense<2>((const bf16_t*)(ws + WS_CQ), 256, pm * 128, ap);
    { const int b_ = lane * 16, swz = b_ ^ (((b_ >> 9) & 1) << 5), Rl = swz >> 6, Cl = (swz & 63) >> 1;
#pragma unroll
      for (int i = 0; i < 3; ++i) bp[i] = (const bf16_t*)(ws + WS_WQ) + (size_t)(ct * 384 + (wid + 8 * i) * 16 + Rl) * 256 + Cl; }
    const float* sq = (const float*)(ws + WS_SSQQ); const float* qn = (const float*)p->in[15];
    const int rowb = pm * 128 + wr * 64 + fr, i0 = fq * 4;
    float rq[4]; f32x4 gq[6], cs01[4], cs23[4];
#pragma unroll
    for (int m = 0; m < 4; ++m) { const f32x4 s4 = *(const f32x4*)(sq + (size_t)(rowb + m * 16) * 4); rq[m] = __builtin_amdgcn_rsqf(((s4.x + s4.y) + (s4.z + s4.w)) * (1.0f / 256.0f) + EPS); }
#pragma unroll
    for (int n = 0; n < 6; ++n) gq[n] = *(const f32x4*)(qn + n * 16 + i0);
    const f32x2* rope = (const f32x2*)(ws + WS_ROPE);
#pragma unroll
    for (int m = 0; m < 4; ++m) { const size_t tok = rowb + m * 16; cs01[m] = *(const f32x4*)(rope + tok * 16 + i0); cs23[m] = *(const f32x4*)(rope + tok * 16 + i0 + 2); }
    __syncthreads();
    gemm_load_ares<4>(lds, ap, 4); q_stage_b(lds, bp, 0, 0); q_stage_b(lds, bp, 1, 1);
    f32x4 acc[4][6];
#pragma unroll
    for (int m = 0; m < 4; ++m)
#pragma unroll
        for (int n = 0; n < 6; ++n) acc[m][n] = (f32x4){0.f, 0.f, 0.f, 0.f};
    gemm_q(lds, bp, acc);
    const int hd = ct * 4 + wc, bb = (pm * 128) >> 12, sb = rowb & 4095;
    bf16_t* dst0 = (bf16_t*)(ws + WS_Q) + ((size_t)(bb * 8 + hd) * 4096 + sb) * 96;
#pragma unroll
    for (int m = 0; m < 4; ++m) { float s = 0.f;
#pragma unroll
        for (int n = 0; n < 6; ++n) { acc[m][n] = acc[m][n] * rq[m]; const f32x4 v = acc[m][n]; s += (v.x * v.x + v.y * v.y) + (v.z * v.z + v.w * v.w); }
        s += __shfl_xor(s, 16); s += __shfl_xor(s, 32);
        const float rh = __builtin_amdgcn_rsqf(s * (1.0f / 96.0f) + EPS) * QSCALE;
        bf16_t* dst = dst0 + (m * 16) * 96;
#pragma unroll
        for (int n = 0; n < 4; ++n) { const f32x4 v = acc[m][n] * rh * gq[n]; u32x2 w; w.x = cvtpk(v.x, v.y); w.y = cvtpk(v.z, v.w); *(u32x2*)(dst + n * 16 + i0) = w; }
        const f32x4 x1 = acc[m][4] * rh * gq[4], x2 = acc[m][5] * rh * gq[5];
        const f32x4 c01 = cs01[m], c23 = cs23[m];
        f32x4 o1, o2;
        o1.x = x1.x * c01.x - x2.x * c01.y; o2.x = x1.x * c01.y + x2.x * c01.x;
        o1.y = x1.y * c01.z - x2.y * c01.w; o2.y = x1.y * c01.w + x2.y * c01.z;
        o1.z = x1.z * c23.x - x2.z * c23.y; o2.z = x1.z * c23.y + x2.z * c23.x;
        o1.w = x1.w * c23.z - x2.w * c23.w; o2.w = x1.w * c23.w + x2.w * c23.z;
        u32x2 w; w.x = cvtpk(o1.x, o1.y); w.y = cvtpk(o1.z, o1.w); *(u32x2*)(dst + 64 + i0) = w;
        w.x = cvtpk(o2.x, o2.y); w.y = cvtpk(o2.z, o2.w); *(u32x2*)(dst + 80 + i0) = w;
    }
}

constexpr int KV_SCR = 98304;
__device__ __forceinline__ void kv_item(CP p, LAS unsigned char* lds, int pm) {
    const int tid = threadIdx.x, lane = tid & 63, wid = __builtin_amdgcn_readfirstlane(tid >> 6), wr = wid >> 2, wc = wid & 3, fr = lane & 15, fq = lane >> 4;
    unsigned char* ws = p->ws;
    const bf16_t* ap[2]; const bf16_t* bp[4];
    stage_ptrs_dense<2>((const bf16_t*)(ws + WS_CKV), 128, pm * 128, ap);
    stage_ptrs_dense<4>((const bf16_t*)(ws + WS_WKV), 128, 0, bp);
    __syncthreads();
    gemm_load_ares<4>(lds, ap, 2);
    gemm_stage<4, 4, true>(lds, 32768, ap, bp, 0, 0);
    LAS float* kr_l = (LAS float*)(lds + KV_SCR); LAS float* rp_l = kr_l + 128 * 33; LAS float* rkv_l = rp_l + 128 * 34; LAS float* skr_l = rkv_l + 128;
    {
        const float* krp = (const float*)(ws + WS_KROPE) + (size_t)pm * 128 * 32; const float* rope = (const float*)(ws + WS_ROPE) + (size_t)pm * 128 * 32;
        f32x4 a[2], b[2];
#pragma unroll
        for (int k = 0; k < 2; ++k) { const int idx = tid + 512 * k; a[k] = *(const f32x4*)(krp + idx * 4); b[k] = *(const f32x4*)(rope + idx * 4); }
        float rk = 0.f, sk = 0.f;
        if (tid < 128) { const f32x2 s2 = *(const f32x2*)((const float*)(ws + WS_SSQKV) + (size_t)(pm * 128 + tid) * 2); rk = __builtin_amdgcn_rsqf((s2.x + s2.y) * (1.0f / 128.0f) + EPS); sk = ((const float*)(ws + WS_SSQKR))[pm * 128 + tid]; }
#pragma unroll
        for (int k = 0; k < 2; ++k) { const int idx = tid + 512 * k, row = idx >> 3, c4 = (idx & 7) * 4;
            LAS float* d = kr_l + row * 33 + c4; d[0] = a[k].x; d[1] = a[k].y; d[2] = a[k].z; d[3] = a[k].w;
            LAS float* e = rp_l + row * 34 + c4; e[0] = b[k].x; e[1] = b[k].y; e[2] = b[k].z; e[3] = b[k].w; }
        if (tid < 128) { rkv_l[tid] = rk; skr_l[tid] = sk; }
    }
    const float* kn = (const float*)p->in[16];
    const bool kw = (wc & 1) == 0;
    const int bb = (pm * 128) >> 12;
    LAS float* gk_l = skr_l + 128;
    if (tid < 96) gk_l[tid] = kn[tid];
#pragma unroll 1
    for (int pn = 0; pn < 4; ++pn) {
        f32x4 acc[4][4];
#pragma unroll
        for (int m = 0; m < 4; ++m)
#pragma unroll
            for (int n = 0; n < 4; ++n) acc[m][n] = (f32x4){0.f, 0.f, 0.f, 0.f};
        gemm_main_ares_sw(lds, 32768, ap, bp, 2, acc, kw);
        if (pn < 3) {
#pragma unroll
            for (int i = 0; i < 4; ++i) bp[i] += 256 * 128;
            gemm_stage<4, 4, true>(lds, 32768, ap, bp, 0, 0);
        }
        const int hd = pn * 2 + (wc >> 1);
        if (kw) {
            const int rowl = wr * 64 + fr, sb = (pm * 128 + rowl) & 4095;
            bf16_t* dst_p = (bf16_t*)(ws + WS_K) + ((size_t)(bb * 8 + hd) * 4096 + sb) * 96 + fq * 4;
#pragma unroll
            for (int m = 0; m < 4; ++m) {
                const int rl = rowl + m * 16;
                const float rkv = rkv_l[rl];
                float ss = 0.f;
#pragma unroll
                for (int n = 0; n < 4; ++n) { acc[m][n] = acc[m][n] * rkv; const f32x4 v = acc[m][n]; ss += (v.x * v.x + v.y * v.y) + (v.z * v.z + v.w * v.w); }
                ss += __shfl_xor(ss, 16); ss += __shfl_xor(ss, 32);
                const float rk = __builtin_amdgcn_rsqf((ss + skr_l[rl]) * (1.0f / 96.0f) + EPS);
                bf16_t* dst = dst_p + (m * 16) * 96;
#pragma unroll
                for (int n = 0; n < 4; ++n) { const f32x4 v = acc[m][n] * rk * *(const LAS f32x4*)(gk_l + n * 16 + fq * 4); u32x2 w; w.x = cvtpk(v.x, v.y); w.y = cvtpk(v.z, v.w); *(u32x2*)(dst + n * 16) = w; }
                const LAS float* kr = kr_l + rl * 33 + fq * 4; const LAS float* rp = rp_l + rl * 34 + fq * 8;
                f32x4 x1, x2, cc, sn;
                x1.x = kr[0]; x1.y = kr[1]; x1.z = kr[2]; x1.w = kr[3]; x2.x = kr[16]; x2.y = kr[17]; x2.z = kr[18]; x2.w = kr[19];
                cc.x = rp[0]; sn.x = rp[1]; cc.y = rp[2]; sn.y = rp[3]; cc.z = rp[4]; sn.z = rp[5]; cc.w = rp[6]; sn.w = rp[7];
                x1 = x1 * rk * *(const LAS f32x4*)(gk_l + 64 + fq * 4); x2 = x2 * rk * *(const LAS f32x4*)(gk_l + 80 + fq * 4);
                const f32x4 o1 = x1 * cc - x2 * sn, o2 = x1 * sn + x2 * cc;
                u32x2 w; w.x = cvtpk(o1.x, o1.y); w.y = cvtpk(o1.z, o1.w); *(u32x2*)(dst + 64) = w;
                w.x = cvtpk(o2.x, o2.y); w.y = cvtpk(o2.z, o2.w); *(u32x2*)(dst + 80) = w;
            }
        } else {
            const int rowl = wr * 64 + fq * 4, sb = (pm * 128 + rowl) & 4095;
            bf16_t* vt_p = (bf16_t*)(ws + WS_VT) + ((size_t)(bb * 8 + hd) * 64 + fr) * 4096 + sb;
#pragma unroll
            for (int m = 0; m < 4; ++m) {
                float rkv[4];
#pragma unroll
                for (int j = 0; j < 4; ++j) rkv[j] = rkv_l[rowl + m * 16 + j];
#pragma unroll
                for (int n = 0; n < 4; ++n) { const f32x4 a = acc[m][n];
                    u32x2 w; w.x = cvtpk(a.x * rkv[0], a.y * rkv[1]); w.y = cvtpk(a.z * rkv[2], a.w * rkv[3]);
                    *(u32x2*)(vt_p + (size_t)(n * 16) * 4096 + m * 16) = w; }
            }
        }
    }
}

template <int R> __device__ __forceinline__ void conv_row(float (&o)[64], const float (&w)[31], float x) {
    constexpr int T0 = R > 30 ? R - 30 : 0, T1 = R < 63 ? R : 63;
#pragma unroll
    for (int t = T0; t <= T1; ++t) o[t] += w[R - t] * x;
}
template <int... R> __device__ __forceinline__ void conv_rows(float (&o)[64], const float (&w)[31], const float (&x)[94], std::integer_sequence<int, R...>) { (conv_row<R>(o, w, x[R]), ...); }
__device__ __forceinline__ void conv_load_w(CP p, float (&w)[31]) {
    const float* cw = (const float*)p->in[7]; const int c = threadIdx.x;
#pragma unroll
    for (int j = 0; j < 31; ++j) w[j] = cw[j * 512 + c];
}
__device__ __forceinline__ void conv_unit(CP p, LAS unsigned char* lds, int cu, const float (&w)[31]) {
    const int tid = threadIdx.x, lane = tid & 63, wave = tid >> 6;
    const int b = cu >> 6, s0 = (cu & 63) * 64, c = tid;
    const bf16_t* ub = (const bf16_t*)(p->ws + WS_U) + ((size_t)b * 4096) * 512 + c;
    const float* cw = (const float*)p->in[7]; const float* cb = (const float*)p->in[8]; const float* lg = (const float*)p->in[9]; const float* lb = (const float*)p->in[10];
    float xin[94];
#pragma unroll
    for (int r = 0; r < 94; ++r) { const int s = s0 - 30 + r; xin[r] = bf2f(__builtin_nontemporal_load(ub + (size_t)(s < 0 ? 0 : s) * 512)); }
    if (s0 == 0) {
#pragma unroll
        for (int r = 0; r < 30; ++r) xin[r] = 0.f;
    }
    float o[64];
    { const float bias = cb[c];
#pragma unroll
      for (int t = 0; t < 64; ++t) o[t] = bias; }
    conv_rows(o, w, xin, std::make_integer_sequence<int, 94>{});
    float s1, s2;
    {
        const bool b5 = lane & 32, b4 = lane & 16, b3 = lane & 8, b2 = lane & 4, b1 = lane & 2, b0 = lane & 1;
#define CONV_BFLY(RES, SQ) do { float a32[32]; \
        _Pragma("unroll") for (int i = 0; i < 32; ++i) { const float lo = SQ ? o[i] * o[i] : o[i], hi = SQ ? o[32 + i] * o[32 + i] : o[32 + i]; a32[i] = (b5 ? hi : lo) + __shfl_xor(b5 ? lo : hi, 32); } \
        float a16[16]; _Pragma("unroll") for (int i = 0; i < 16; ++i) a16[i] = (b4 ? a32[16 + i] : a32[i]) + __shfl_xor(b4 ? a32[i] : a32[16 + i], 16); \
        float a8[8]; _Pragma("unroll") for (int i = 0; i < 8; ++i) a8[i] = (b3 ? a16[8 + i] : a16[i]) + __shfl_xor(b3 ? a16[i] : a16[8 + i], 8); \
        float a4[4]; _Pragma("unroll") for (int i = 0; i < 4; ++i) a4[i] = (b2 ? a8[4 + i] : a8[i]) + __shfl_xor(b2 ? a8[i] : a8[4 + i], 4); \
        float a2[2]; _Pragma("unroll") for (int i = 0; i < 2; ++i) a2[i] = (b1 ? a4[2 + i] : a4[i]) + __shfl_xor(b1 ? a4[i] : a4[2 + i], 2); \
        RES = (b0 ? a2[1] : a2[0]) + __shfl_xor(b0 ? a2[0] : a2[1], 1); } while (0)
        CONV_BFLY(s1, false);
        asm volatile("" : "+v"(s1));
        CONV_BFLY(s2, true);
#undef CONV_BFLY
    }
    LAS float* red = (LAS float*)(lds + EPI_SCR);
    LAS float* stat = (LAS float*)(lds + EPI_SCR + 4096);
    red[(wave * 64 + lane) * 2] = s1; red[(wave * 64 + lane) * 2 + 1] = s2;
    __syncthreads();
    if (tid < 64) { float t1 = 0.f, t2 = 0.f;
#pragma unroll
        for (int k = 0; k < 8; ++k) { t1 += red[(k * 64 + tid) * 2]; t2 += red[(k * 64 + tid) * 2 + 1]; }
        const float mean = t1 * (1.0f / 512.0f); float var = t2 * (1.0f / 512.0f) - mean * mean; var = var < 0.f ? 0.f : var;
        stat[tid * 2] = mean; stat[tid * 2 + 1] = __builtin_amdgcn_rsqf(var + EPS); }
    __syncthreads();
    const float g = lg[c], bb = lb[c];
    bf16_t* cat = (bf16_t*)(p->ws + WS_CAT) + ((size_t)b * 4096 + s0) * 1024 + c;
#pragma unroll
    for (int t = 0; t < 64; ++t) { const float y = (o[t] - stat[t * 2]) * stat[t * 2 + 1] * g + bb; cat[(size_t)t * 1024] = f2bf(y * __builtin_amdgcn_rcpf(1.0f + __expf(-y))); }
    __syncthreads();
}

constexpr int CW_CONVQ = CW_CNT + 64 * 150;
__device__ __forceinline__ void xcd_barrier_work(const XcdBarrier& b, CP p, LAS unsigned char* lds, int a0, int e0, int a1, int e1, int flags) {
    asm volatile("s_waitcnt vmcnt(0)" ::: "memory");
    __syncthreads();
    unsigned gen = 0; bool leader = false;
    if (threadIdx.x == 0) {
        unsigned* bar = b.bar;
        __builtin_amdgcn_s_waitcnt(0);
        unsigned nloc = b.st[0], nx = b.st[1];
        if (nloc == 0u) { xcd_barrier_complete(bar, b.x, nloc, nx); b.st[0] = nloc; b.st[1] = nx; }
        const unsigned old = xb_add(&bar[XB_XSUB(b.x)], 1u);
        gen = old / nloc; leader = (old + 1u == (gen + 1u) * nloc);
        if (leader) {
            __builtin_amdgcn_fence(__ATOMIC_RELEASE, "agent");
            asm volatile("s_waitcnt vmcnt(0)" ::: "memory");
            const unsigned og = xb_add(&bar[XB_TOP], 1u);
            const unsigned tg = og / nx;
            if (og + 1u == (tg + 1u) * nx) xb_add(&bar[XB_TOPGEN], 1u);
            else XB_SPIN(xb_ld(&bar[XB_TOPGEN]) == tg, bar);
            __builtin_amdgcn_fence(__ATOMIC_ACQUIRE, "agent");
            xb_add(&bar[XB_XGEN(b.x)], 1u);
            asm volatile("s_waitcnt vmcnt(0)" ::: "memory");
        }
    }
    if (flags & 1) rope_table(p);
    transpose_items(p, lds, a0, e0);
    transpose_items(p, lds, a1, e1);
    if (flags & 2) {
        volatile LAS unsigned* slot = (volatile LAS unsigned*)(lds + MISC_OFF + 1600);
        const bool ba = batch_aligned(); const int xq = ba ? (vcu_id() >> 5) : 0; const unsigned nq = ba ? 64u : 512u;
        unsigned* q = (unsigned*)(p->ws + WS_CTL) + CW_CONVQ + 64 * xq;
        unsigned nxt = 0;
        if (threadIdx.x == 0) nxt = xb_add(q, 1u);
        float cwt[31]; conv_load_w(p, cwt);
        for (;;) {
            if (threadIdx.x == 0) *slot = nxt;
            __syncthreads();
            const unsigned u = *slot;
            if (u >= nq) break;
            if (threadIdx.x == 0) nxt = xb_add(q, 1u);
            conv_unit(p, lds, (int)u + 64 * xq, cwt);
            __syncthreads();
        }
    }
    if (threadIdx.x == 0 && !leader) {
        unsigned* bar = b.bar;
        XB_SPIN(xb_ld(&bar[XB_XGEN(b.x)]) == gen, bar);
        __builtin_amdgcn_fence(__ATOMIC_ACQUIRE, "agent");
        asm volatile("s_waitcnt vmcnt(0)" ::: "memory");
    }
    __syncthreads();
}

__device__ __forceinline__ void phase1c(CP p, LAS unsigned char* lds) {
#ifndef SUBREP
#define SUBREP -1
#endif
#pragma unroll 1
    for (int r_ = 0; r_ < (SUBREP == 0 ? 2 : 1); ++r_)
    for (int u = vcu_id(); u < 512; u += gridDim.x) q_item(p, lds, batch_aligned() ? 64 * ((u >> 5) & 7) + (u & 31) + 32 * (u >> 8) : u);
#pragma unroll 1
    for (int r_ = 0; r_ < (SUBREP == 1 ? 2 : 1); ++r_)
    for (int u = vcu_id(); u < 256; u += gridDim.x) kv_item(p, lds, u);
    __syncthreads();
    if (N_LAUNCH_SPLIT) { float cwt[31]; conv_load_w(p, cwt); for (int u = blockIdx.x; u < 512; u += gridDim.x) conv_unit(p, lds, u, cwt); }
}

__device__ __forceinline__ int swap23(int r) { return (r & ~12) | ((r & 4) << 1) | ((r & 8) >> 1); }
constexpr int KROW = 208, VROW = 144, KBUF = 64 * KROW, VBUF = 64 * VROW, ABUF = KBUF + VBUF;
__device__ __forceinline__ void attn_unit(CP p, LAS unsigned char* lds, int bh, int qblk) {
    const int tid = threadIdx.x, lane = tid & 63, wid = __builtin_amdgcn_readfirstlane(tid >> 6), q = lane & 31, H = lane >> 5;
    unsigned char* ws = p->ws;
    const bf16_t* qg = (const bf16_t*)(ws + WS_Q) + (size_t)bh * 4096 * 96;
    const bf16_t* kg = (const bf16_t*)(ws + WS_K) + (size_t)bh * 4096 * 96;
    const bf16_t* vg = (const bf16_t*)(ws + WS_VT) + (size_t)bh * 64 * 4096;
    const int row0 = qblk * 256 + wid * 32, mychunk = 4 * qblk + (wid >> 1), NT = 4 * qblk + 4;
    bf16x8 qf[6];
#pragma unroll
    for (int s = 0; s < 6; ++s) qf[s] = *(const bf16x8*)(qg + (size_t)(row0 + q) * 96 + 16 * s + 8 * H);
    const int kr0 = tid / 12, kc0 = tid % 12, kr1 = (tid + 512) / 12, kc1 = (tid + 512) % 12, vd = tid >> 3, vc = tid & 7;
    const bool k1 = tid < 256;
    const bf16_t* ksrc0 = kg + (size_t)kr0 * 96 + kc0 * 8; const bf16_t* ksrc1 = kg + (size_t)kr1 * 96 + kc1 * 8; const bf16_t* vsrc = vg + (size_t)vd * 4096 + vc * 8;
    const int kdst0 = kr0 * KROW + kc0 * 16, kdst1 = kr1 * KROW + kc1 * 16, vdst = KBUF + vd * VROW + vc * 16;
    u32x4 rk0, rk1 = (u32x4){0, 0, 0, 0}, rv;
#define AT_LOAD(t) do { rk0 = *(const u32x4*)(ksrc0 + (size_t)(t) * 64 * 96); if (k1) rk1 = *(const u32x4*)(ksrc1 + (size_t)(t) * 64 * 96); rv = *(const u32x4*)(vsrc + (t) * 64); } while (0)
#define AT_WRITE(buf) do { LAS unsigned char* b_ = lds + (buf) * ABUF; *(LAS u32x4*)(b_ + kdst0) = rk0; if (k1) *(LAS u32x4*)(b_ + kdst1) = rk1; *(LAS u32x4*)(b_ + vdst) = rv; } while (0)
    AT_LOAD(0); AT_WRITE(0);
    __syncthreads();
    f32x16 o0 = {0}, o1 = {0};
    float mrun = -INFINITY, lsum = 0.f;
    const int koff = swap23(q) * KROW + 16 * H, voff = KBUF + q * VROW + 16 * H;
    for (int t = 0; t < NT; ++t) {
        if (t + 1 < NT) AT_LOAD(t + 1);
        if (t <= mychunk) {
            const LAS unsigned char* kb = lds + (t & 1) * ABUF + koff; const LAS unsigned char* vb = lds + (t & 1) * ABUF + voff;
            f32x16 s0 = {0}, s1 = {0};
#pragma unroll
            for (int s = 0; s < 6; ++s) {
                const bf16x8 a0 = *(const LAS bf16x8*)(kb + 32 * s), a1 = *(const LAS bf16x8*)(kb + 32 * KROW + 32 * s);
                s0 = __builtin_amdgcn_mfma_f32_32x32x16_bf16(a0, qf[s], s0, 0, 0, 0);
                s1 = __builtin_amdgcn_mfma_f32_32x32x16_bf16(a1, qf[s], s1, 0, 0, 0);
            }
            float mloc = s0[0];
#pragma unroll
            for (int r = 1; r < 16; ++r) mloc = fmaxf(mloc, s0[r]);
#pragma unroll
            for (int r = 0; r < 16; ++r) mloc = fmaxf(mloc, s1[r]);
            mloc = fmaxf(mloc, __shfl_xor(mloc, 32));
            const float mnew = fmaxf(mrun, mloc);
            const float alpha = __builtin_amdgcn_exp2f(mrun - mnew);
            mrun = mnew;
            float ps = 0.f;
#pragma unroll
            for (int r = 0; r < 16; ++r) { s0[r] = __builtin_amdgcn_exp2f(s0[r] - mnew); s1[r] = __builtin_amdgcn_exp2f(s1[r] - mnew); ps += s0[r] + s1[r]; }
            lsum = lsum * alpha + ps;
#pragma unroll
            for (int r = 0; r < 16; ++r) { o0[r] *= alpha; o1[r] *= alpha; }
            u32x4 pw[4];
            pw[0] = (u32x4){cvtpk(s0[0], s0[1]), cvtpk(s0[2], s0[3]), cvtpk(s0[4], s0[5]), cvtpk(s0[6], s0[7])};
            pw[1] = (u32x4){cvtpk(s0[8], s0[9]), cvtpk(s0[10], s0[11]), cvtpk(s0[12], s0[13]), cvtpk(s0[14], s0[15])};
            pw[2] = (u32x4){cvtpk(s1[0], s1[1]), cvtpk(s1[2], s1[3]), cvtpk(s1[4], s1[5]), cvtpk(s1[6], s1[7])};
            pw[3] = (u32x4){cvtpk(s1[8], s1[9]), cvtpk(s1[10], s1[11]), cvtpk(s1[12], s1[13]), cvtpk(s1[14], s1[15])};
#pragma unroll
            for (int ks = 0; ks < 4; ++ks) {
                const bf16x8 v0 = *(const LAS bf16x8*)(vb + 32 * ks), v1 = *(const LAS bf16x8*)(vb + 32 * VROW + 32 * ks);
                const bf16x8 pb = __builtin_bit_cast(bf16x8, pw[ks]);
                o0 = __builtin_amdgcn_mfma_f32_32x32x16_bf16(v0, pb, o0, 0, 0, 0);
                o1 = __builtin_amdgcn_mfma_f32_32x32x16_bf16(v1, pb, o1, 0, 0, 0);
            }
        }
        if (t + 1 < NT) AT_WRITE((t + 1) & 1);
        __syncthreads();
    }
#undef AT_LOAD
#undef AT_WRITE
    const float ltot = lsum + __shfl_xor(lsum, 32), inv = 1.0f / ltot;
    const int b = bh >> 3, hd = bh & 7;
    bf16_t* dst = (bf16_t*)(ws + WS_CAT) + ((size_t)b * 4096 + row0 + q) * 1024 + 512 + hd * 64;
#pragma unroll
    for (int g = 0; g < 4; ++g) {
        u32x2 w; w.x = cvtpk(o0[4 * g] * inv, o0[4 * g + 1] * inv); w.y = cvtpk(o0[4 * g + 2] * inv, o0[4 * g + 3] * inv); *(u32x2*)(dst + 8 * g + 4 * H) = w;
        w.x = cvtpk(o1[4 * g] * inv, o1[4 * g + 1] * inv); w.y = cvtpk(o1[4 * g + 2] * inv, o1[4 * g + 3] * inv); *(u32x2*)(dst + 32 + 8 * g + 4 * H) = w;
    }
}
constexpr int AF_NS = 6, AF_KB = 64 * 192, AF_STG = AF_KB + 64 * 128;
__device__ __forceinline__ void attn_unit_fast(CP p, LAS unsigned char* lds, int bh, int qblk) {
    const int tid = threadIdx.x, lane = tid & 63, wid = __builtin_amdgcn_readfirstlane(tid >> 6), q = lane & 31, H = lane >> 5;
    unsigned char* ws = p->ws;
    const bf16_t* qg = (const bf16_t*)(ws + WS_Q) + (size_t)bh * 4096 * 96;
    const bf16_t* kg = (const bf16_t*)(ws + WS_K) + (size_t)bh * 4096 * 96;
    const bf16_t* vg = (const bf16_t*)(ws + WS_VT) + (size_t)bh * 64 * 4096;
    const int row0 = qblk * 256 + wid * 32, mychunk = 4 * qblk + (wid >> 1), NT = 4 * qblk + 4;
    int ks0, ks1, vs0;
    { int P = wid * 64 + lane, r = P / 12, c = (P % 12) ^ ((r >> 2) & 3); ks0 = r * 96 + c * 8;
      P = (8 + (wid & 3)) * 64 + lane; r = P / 12; c = (P % 12) ^ ((r >> 2) & 3); ks1 = r * 96 + c * 8;
      P = wid * 64 + lane; r = P >> 3; c = (P & 7) ^ ((r >> 1) & 7); vs0 = r * 4096 + c * 8; }
    const bool two = wid < 4;
#define AF_ISSUE(u) do { const int u_ = (u) < NT ? (u) : NT - 1; LAS unsigned char* st_ = lds + ((u) % AF_NS) * AF_STG; \
        __builtin_amdgcn_global_load_lds((const unsigned*)(kg + (size_t)u_ * 64 * 96 + ks0), (LAS unsigned*)(st_ + wid * 1024), 16, 0, 0); \
        if (two) __builtin_amdgcn_global_load_lds((const unsigned*)(kg + (size_t)u_ * 64 * 96 + ks1), (LAS unsigned*)(st_ + (8 + wid) * 1024), 16, 0, 0); \
        __builtin_amdgcn_global_load_lds((const unsigned*)(vg + u_ * 64 + vs0), (LAS unsigned*)(st_ + AF_KB + wid * 1024), 16, 0, 0); } while (0)
#define AF_WAITBAR() do { if (two) asm volatile("s_waitcnt vmcnt(3)" ::: "memory"); else asm volatile("s_waitcnt vmcnt(2)" ::: "memory"); \
        asm volatile("s_waitcnt lgkmcnt(0)" ::: "memory"); __builtin_amdgcn_s_barrier(); asm volatile("" ::: "memory"); } while (0)
    static_assert(AF_NS == 6, "ring depth vs the issue / wait pattern below (one tile may stay in flight across a barrier)");
    const int pr = swap23(q), kx = (pr >> 2) & 3;
    const int kbe = pr * 192 + 16 * ((H ^ (kx & 1)) + 2 * (kx >> 1)), kbo = pr * 192 + 16 * ((H ^ (kx & 1)) + 2 * (1 ^ (kx >> 1)));
    const int vx = (q >> 1) & 7, vbase = AF_KB + q * 128 + 16 * (H ^ (vx & 1)), vxx = (vx >> 1) * 32;
    bf16x8 qf[6];
#pragma unroll
    for (int s = 0; s < 6; ++s) qf[s] = *(const bf16x8*)(qg + (size_t)(row0 + q) * 96 + 16 * s + 8 * H);
#define AF_QK(S0, S1, u) do { const LAS unsigned char* kb_ = lds + ((u) % AF_NS) * AF_STG; \
        { const bf16x8 a0_ = *(const LAS bf16x8*)(kb_ + kbe), a1_ = *(const LAS bf16x8*)(kb_ + kbe + 32 * 192); \
          S0 = __builtin_amdgcn_mfma_f32_32x32x16_bf16(a0_, qf[0], (f32x16){0.f, 0.f, 0.f, 0.f, 0.f, 0.f, 0.f, 0.f, 0.f, 0.f, 0.f, 0.f, 0.f, 0.f, 0.f, 0.f}, 0, 0, 0); \
          S1 = __builtin_amdgcn_mfma_f32_32x32x16_bf16(a1_, qf[0], (f32x16){0.f, 0.f, 0.f, 0.f, 0.f, 0.f, 0.f, 0.f, 0.f, 0.f, 0.f, 0.f, 0.f, 0.f, 0.f, 0.f}, 0, 0, 0); } \
        _Pragma("unroll") for (int s_ = 1; s_ < 6; ++s_) { const int o_ = ((s_ & 1) ? kbo : kbe) + 64 * (s_ >> 1); \
            const bf16x8 a0_ = *(const LAS bf16x8*)(kb_ + o_), a1_ = *(const LAS bf16x8*)(kb_ + o_ + 32 * 192); \
            S0 = __builtin_amdgcn_mfma_f32_32x32x16_bf16(a0_, qf[s_], S0, 0, 0, 0); \
            S1 = __builtin_amdgcn_mfma_f32_32x32x16_bf16(a1_, qf[s_], S1, 0, 0, 0); } } while (0)
    asm volatile("s_waitcnt vmcnt(0) lgkmcnt(0)" ::: "memory"); __builtin_amdgcn_s_barrier(); asm volatile("" ::: "memory");
    AF_ISSUE(0); AF_ISSUE(1); AF_ISSUE(2); AF_ISSUE(3);
    AF_WAITBAR();
    f32x16 o0 = {0}, o1 = {0}, c0, c1;
    float lsum = 0.f;
    AF_QK(c0, c1, 0);
#define AF_STEP(t, CA, CB, NA, NB) do { if ((t) <= mychunk) { \
            AF_QK(NA, NB, (t) + 1);                      \
            float ps = 0.f; \
            _Pragma("unroll") for (int r = 0; r < 16; ++r) { CA[r] = __builtin_amdgcn_exp2f(CA[r]); CB[r] = __builtin_amdgcn_exp2f(CB[r]); ps += CA[r] + CB[r]; } \
            lsum += ps; \
            u32x4 pw[4]; \
            pw[0] = (u32x4){cvtpk(CA[0], CA[1]), cvtpk(CA[2], CA[3]), cvtpk(CA[4], CA[5]), cvtpk(CA[6], CA[7])}; \
            pw[1] = (u32x4){cvtpk(CA[8], CA[9]), cvtpk(CA[10], CA[11]), cvtpk(CA[12], CA[13]), cvtpk(CA[14], CA[15])}; \
            pw[2] = (u32x4){cvtpk(CB[0], CB[1]), cvtpk(CB[2], CB[3]), cvtpk(CB[4], CB[5]), cvtpk(CB[6], CB[7])}; \
            pw[3] = (u32x4){cvtpk(CB[8], CB[9]), cvtpk(CB[10], CB[11]), cvtpk(CB[12], CB[13]), cvtpk(CB[14], CB[15])}; \
            const LAS unsigned char* vb = lds + ((t) % AF_NS) * AF_STG + vbase; \
            _Pragma("unroll") for (int ks = 0; ks < 4; ++ks) { \
                const int vo = (ks * 32) ^ vxx; \
                const bf16x8 v0 = *(const LAS bf16x8*)(vb + vo), v1 = *(const LAS bf16x8*)(vb + vo + 32 * 128); \
                const bf16x8 pb = __builtin_bit_cast(bf16x8, pw[ks]); \
                o0 = __builtin_amdgcn_mfma_f32_32x32x16_bf16(v0, pb, o0, 0, 0, 0); \
                o1 = __builtin_amdgcn_mfma_f32_32x32x16_bf16(v1, pb, o1, 0, 0, 0); } } } while (0)
    f32x16 d0, d1;
#pragma unroll 1
    for (int t = 0; t < NT; t += 2) {
        AF_ISSUE(t + 4); AF_ISSUE(t + 5);
        AF_STEP(t, c0, c1, d0, d1);
        AF_STEP(t + 1, d0, d1, c0, c1);
        AF_WAITBAR();
    }
#undef AF_STEP
#undef AF_ISSUE
#undef AF_WAITBAR
#undef AF_QK
    const float ltot = lsum + __shfl_xor(lsum, 32), inv = 1.0f / ltot;
    const int b = bh >> 3, hd = bh & 7;
    bf16_t* dst = (bf16_t*)(ws + WS_CAT) + ((size_t)b * 4096 + row0 + q) * 1024 + 512 + hd * 64;
#pragma unroll
    for (int g = 0; g < 4; ++g) {
        u32x2 w; w.x = cvtpk(o0[4 * g] * inv, o0[4 * g + 1] * inv); w.y = cvtpk(o0[4 * g + 2] * inv, o0[4 * g + 3] * inv); *(u32x2*)(dst + 8 * g + 4 * H) = w;
        w.x = cvtpk(o1[4 * g] * inv, o1[4 * g + 1] * inv); w.y = cvtpk(o1[4 * g + 2] * inv, o1[4 * g + 3] * inv); *(u32x2*)(dst + 32 + 8 * g + 4 * H) = w;
    }
}
__device__ __forceinline__ void attn_unit2(CP p, LAS unsigned char* lds, int bh, int QB) {
    int lane = threadIdx.x & 63; asm volatile("" : "+v"(lane));
    const int tid = threadIdx.x, wid = __builtin_amdgcn_readfirstlane(tid >> 6), q = lane & 31, H = lane >> 5;
    unsigned char* ws = p->ws;
    const bf16_t* qg = (const bf16_t*)(ws + WS_Q) + (size_t)bh * 4096 * 96;
    const bf16_t* kg = (const bf16_t*)(ws + WS_K) + (size_t)bh * 4096 * 96;
    const bf16_t* vg = (const bf16_t*)(ws + WS_VT) + (size_t)bh * 64 * 4096;
    const int rowA = QB * 512 + wid * 32, rowB = QB * 512 + (15 - wid) * 32;
    const int chA = 8 * QB + (wid >> 1), chB = 8 * QB + ((15 - wid) >> 1), NT = 8 * QB + 8;
    int ks0, ks1, vs0;
    { int P = wid * 64 + lane, r = P / 12, c = (P % 12) ^ ((r >> 2) & 3); ks0 = r * 96 + c * 8;
      P = (8 + (wid & 3)) * 64 + lane; r = P / 12; c = (P % 12) ^ ((r >> 2) & 3); ks1 = r * 96 + c * 8;
      P = wid * 64 + lane; r = P >> 3; c = (P & 7) ^ ((r >> 1) & 7); vs0 = r * 4096 + c * 8; }
    const bool two = wid < 4;
#define A2_ISSUE(u) do { const int u_ = (u) < NT ? (u) : NT - 1; LAS unsigned char* st_ = lds + ((u) % AF_NS) * AF_STG; \
        __builtin_amdgcn_global_load_lds((const unsigned*)(kg + (size_t)u_ * 64 * 96 + ks0), (LAS unsigned*)(st_ + wid * 1024), 16, 0, 0); \
        if (two) __builtin_amdgcn_global_load_lds((const unsigned*)(kg + (size_t)u_ * 64 * 96 + ks1), (LAS unsigned*)(st_ + (8 + wid) * 1024), 16, 0, 0); \
        __builtin_amdgcn_global_load_lds((const unsigned*)(vg + u_ * 64 + vs0), (LAS unsigned*)(st_ + AF_KB + wid * 1024), 16, 0, 0); } while (0)
#define A2_WAITBAR() do { if (two) asm volatile("s_waitcnt vmcnt(3)" ::: "memory"); else asm volatile("s_waitcnt vmcnt(2)" ::: "memory"); \
        asm volatile("s_waitcnt lgkmcnt(0)" ::: "memory"); __builtin_amdgcn_s_barrier(); asm volatile("" ::: "memory"); } while (0)
    const int pr = swap23(q), kx = (pr >> 2) & 3;
    const int kbe = pr * 192 + 16 * ((H ^ (kx & 1)) + 2 * (kx >> 1)), kbo = pr * 192 + 16 * ((H ^ (kx & 1)) + 2 * (1 ^ (kx >> 1)));
    const int vx = (q >> 1) & 7, vbase = AF_KB + q * 128 + 16 * (H ^ (vx & 1)), vxx = (vx >> 1) * 32;
    bf16x8 qa[6], qb[6];
#pragma unroll
    for (int s = 0; s < 6; ++s) { qa[s] = *(const bf16x8*)(qg + (size_t)(rowA + q) * 96 + 16 * s + 8 * H); qb[s] = *(const bf16x8*)(qg + (size_t)(rowB + q) * 96 + 16 * s + 8 * H); }
    asm volatile("s_waitcnt vmcnt(0) lgkmcnt(0)" ::: "memory"); __builtin_amdgcn_s_barrier(); asm volatile("" ::: "memory");
    A2_ISSUE(0); A2_ISSUE(1); A2_ISSUE(2); A2_ISSUE(3);
    A2_WAITBAR();
    f32x16 oa0 = {0}, oa1 = {0}, ob0 = {0}, ob1 = {0};
    float la = 0.f, lb = 0.f;
#define A2_ZERO (f32x16){0.f, 0.f, 0.f, 0.f, 0.f, 0.f, 0.f, 0.f, 0.f, 0.f, 0.f, 0.f, 0.f, 0.f, 0.f, 0.f}
#define A2_PACK2(PW, C) do { \
        PW[0] = (u32x4){cvtpk(C[0], C[1]), cvtpk(C[2], C[3]), cvtpk(C[4], C[5]), cvtpk(C[6], C[7])}; \
        PW[1] = (u32x4){cvtpk(C[8], C[9]), cvtpk(C[10], C[11]), cvtpk(C[12], C[13]), cvtpk(C[14], C[15])}; } while (0)
#define A2_HALF(t, hh) do { const LAS unsigned char* kb_ = lds + ((t) % AF_NS) * AF_STG + (hh) * (32 * 192); const LAS unsigned char* vb_ = lds + ((t) % AF_NS) * AF_STG + vbase; \
        if ((t) <= chB) {                                    \
            const bool both_ = (t) <= chA; \
            f32x16 sa = A2_ZERO, sb; \
            _Pragma("unroll") for (int s_ = 0; s_ < 6; ++s_) { const int o_ = ((s_ & 1) ? kbo : kbe) + 64 * (s_ >> 1); \
                const bf16x8 a_ = *(const LAS bf16x8*)(kb_ + o_); \
                sb = __builtin_amdgcn_mfma_f32_32x32x16_bf16(a_, qb[s_], s_ == 0 ? A2_ZERO : sb, 0, 0, 0); \
                if (both_) sa = __builtin_amdgcn_mfma_f32_32x32x16_bf16(a_, qa[s_], sa, 0, 0, 0); } \
            float pb = 0.f; \
            _Pragma("unroll") for (int r = 0; r < 16; ++r) { sb[r] = __builtin_amdgcn_exp2f(sb[r]); pb += sb[r]; } \
            lb += pb; \
            u32x4 pwa[2] = {(u32x4){0, 0, 0, 0}, (u32x4){0, 0, 0, 0}}, pwb[2]; A2_PACK2(pwb, sb); \
            if (both_) { float pa = 0.f; \
                _Pragma("unroll") for (int r = 0; r < 16; ++r) { sa[r] = __builtin_amdgcn_exp2f(sa[r]); pa += sa[r]; } \
                la += pa; A2_PACK2(pwa, sa); } \
            _Pragma("unroll") for (int k2 = 0; k2 < 2; ++k2) { const int vo = (((hh) * 2 + k2) * 32) ^ vxx; \
                const bf16x8 v0 = *(const LAS bf16x8*)(vb_ + vo), v1 = *(const LAS bf16x8*)(vb_ + vo + 32 * 128); \
                const bf16x8 xb = __builtin_bit_cast(bf16x8, pwb[k2]); \
                ob0 = __builtin_amdgcn_mfma_f32_32x32x16_bf16(v0, xb, ob0, 0, 0, 0); ob1 = __builtin_amdgcn_mfma_f32_32x32x16_bf16(v1, xb, ob1, 0, 0, 0); \
                if (both_) { const bf16x8 xa = __builtin_bit_cast(bf16x8, pwa[k2]); \
                    oa0 = __builtin_amdgcn_mfma_f32_32x32x16_bf16(v0, xa, oa0, 0, 0, 0); oa1 = __builtin_amdgcn_mfma_f32_32x32x16_bf16(v1, xa, oa1, 0, 0, 0); } } \
        } } while (0)
#define A2_STEP(t) do { A2_HALF(t, 0); __builtin_amdgcn_sched_barrier(0); A2_HALF(t, 1); __builtin_amdgcn_sched_barrier(0); } while (0)
#pragma unroll 1
    for (int t = 0; t < NT; t += 2) {
        A2_ISSUE(t + 4); A2_ISSUE(t + 5);
        A2_STEP(t);
        A2_STEP(t + 1);
        A2_WAITBAR();
    }
#undef A2_STEP
#undef A2_HALF
#undef A2_PACK2
#undef A2_ZERO
#undef A2_ISSUE
#undef A2_WAITBAR
    const int b = bh >> 3, hd = bh & 7;
    {
        const float ltot = la + __shfl_xor(la, 32), inv = 1.0f / ltot;
        bf16_t* dst = (bf16_t*)(ws + WS_CAT) + ((size_t)b * 4096 + rowA + q) * 1024 + 512 + hd * 64;
#pragma unroll
        for (int g = 0; g < 4; ++g) {
            u32x2 w; w.x = cvtpk(oa0[4 * g] * inv, oa0[4 * g + 1] * inv); w.y = cvtpk(oa0[4 * g + 2] * inv, oa0[4 * g + 3] * inv); *(u32x2*)(dst + 8 * g + 4 * H) = w;
            w.x = cvtpk(oa1[4 * g] * inv, oa1[4 * g + 1] * inv); w.y = cvtpk(oa1[4 * g + 2] * inv, oa1[4 * g + 3] * inv); *(u32x2*)(dst + 32 + 8 * g + 4 * H) = w;
        }
    }
    {
        const float ltot = lb + __shfl_xor(lb, 32), inv = 1.0f / ltot;
        bf16_t* dst = (bf16_t*)(ws + WS_CAT) + ((size_t)b * 4096 + rowB + q) * 1024 + 512 + hd * 64;
#pragma unroll
        for (int g = 0; g < 4; ++g) {
            u32x2 w; w.x = cvtpk(ob0[4 * g] * inv, ob0[4 * g + 1] * inv); w.y = cvtpk(ob0[4 * g + 2] * inv, ob0[4 * g + 3] * inv); *(u32x2*)(dst + 8 * g + 4 * H) = w;
            w.x = cvtpk(ob1[4 * g] * inv, ob1[4 * g + 1] * inv); w.y = cvtpk(ob1[4 * g + 2] * inv, ob1[4 * g + 3] * inv); *(u32x2*)(dst + 32 + 8 * g + 4 * H) = w;
        }
    }
}
__device__ __forceinline__ void phase2(CP p, LAS unsigned char* lds) {
    const int lane = threadIdx.x & 63;
    const float* qn = (const float*)p->in[15]; const float* kn = (const float*)p->in[16];
    float mq = 0.f, mk = 0.f;
    for (int j = lane; j < 96; j += 64) { mq = fmaxf(mq, fabsf(qn[j])); mk = fmaxf(mk, fabsf(kn[j])); }
#pragma unroll
    for (int o = 1; o < 64; o <<= 1) { mq = fmaxf(mq, __shfl_xor(mq, o)); mk = fmaxf(mk, __shfl_xor(mk, o)); }
    const float bound = 96.0f * mq * mk * QSCALE * 1.01f;
    if (bound <= 40.0f) {
        for (int u = vcu_id(); u < 256; u += gridDim.x) { const int bh = u >> 2, pr = u & 3; attn_unit2(p, lds, bh, 7 - pr); attn_unit2(p, lds, bh, pr); }
    } else {
        for (int u = vcu_id(); u < 512; u += gridDim.x) { const int bh = u >> 3, pr = u & 7; attn_unit(p, lds, bh, 15 - pr); attn_unit(p, lds, bh, pr); }
    }
    asm volatile("s_waitcnt vmcnt(0)" ::: "memory"); __syncthreads();
}

__device__ __forceinline__ void phase3(CP p, LAS unsigned char* lds) {
    const int tid = threadIdx.x, lane = tid & 63, wid = __builtin_amdgcn_readfirstlane(tid >> 6), wr = wid >> 2, wc = wid & 3, fr = lane & 15, fq = lane >> 4;
    unsigned char* ws = p->ws;
    const float* x = (const float*)p->in[0]; const float* mod = (const float*)(ws + WS_MOD); float* sq1 = (float*)(ws + WS_SSQ1); bf16_t* x1b = (bf16_t*)(ws + WS_X1);
    for (int u = vcu_id(); u < 512; u += gridDim.x) {
        int pm = u >> 2, pn = u & 3;
        if (batch_aligned()) { const int t = (u & 31) + 32 * (u >> 8); pm = 16 * ((u >> 5) & 7) + (t >> 2); pn = t & 3; }
        const bf16_t* ap[4]; const bf16_t* bp[4];
        stage_ptrs_dense<4>((const bf16_t*)(ws + WS_CAT), 1024, pm * 256, ap); stage_ptrs_dense<4>((const bf16_t*)(ws + WS_WOUT), 1024, pn * 256, bp);
        f32x4 acc[8][4];
#pragma unroll
        for (int m = 0; m < 8; ++m)
#pragma unroll
            for (int n = 0; n < 4; ++n) acc[m][n] = (f32x4){0.f, 0.f, 0.f, 0.f};
        gemm_block<8, 4, true>(lds, ap, bp, 16, acc);
        const int rowb = pm * 256 + wr * 128 + fr, b = (pm * 256) >> 12, colb = pn * 256 + wc * 64 + fq * 4;
        f32x4 ga[4];
#pragma unroll
        for (int n = 0; n < 4; ++n) ga[n] = *(const f32x4*)(mod + b * 6144 + 2048 + colb + n * 16);
#pragma unroll
        for (int mb = 0; mb < 8; mb += 4) {
            f32x4 xv[4][4];
#pragma unroll
            for (int m = 0; m < 4; ++m)
#pragma unroll
                for (int n = 0; n < 4; ++n) xv[m][n] = __builtin_nontemporal_load((const f32x4*)(x + (size_t)(rowb + (mb + m) * 16) * DM + colb + n * 16));
#pragma unroll
            for (int m = 0; m < 4; ++m) { const size_t row = rowb + (mb + m) * 16; float s = 0.f;
#pragma unroll
                for (int n = 0; n < 4; ++n) { const f32x4 v = xv[m][n] + ga[n] * acc[mb + m][n];
                    u32x2 w; w.x = cvtpk(v.x, v.y); w.y = cvtpk(v.z, v.w); *(u32x2*)(x1b + row * DM + colb + n * 16) = w; s += (v.x * v.x + v.y * v.y) + (v.z * v.z + v.w * v.w); }
                s += __shfl_xor(s, 16); s += __shfl_xor(s, 32);
                if (fq == 0) sq1[row * 16 + pn * 4 + wc] = s; }
        }
    }
}

constexpr int RROW = 2064;
__device__ __forceinline__ void phase3b(CP p, LAS unsigned char* lds, bool dry) {
    const int tid = threadIdx.x, lane = tid & 63, wave = __builtin_amdgcn_readfirstlane(tid >> 6), fr = lane & 15, fq = lane >> 4;
    unsigned char* ws = p->ws;
    const float* nf = (const float*)p->in[18]; const float* mod = (const float*)(ws + WS_MOD); const float* sq1 = (const float*)(ws + WS_SSQ1);
    const float* bg = (const float*)p->in[20]; const float* be = (const float*)p->in[22];
    bf16_t* h2 = (bf16_t*)(ws + WS_H); const bf16_t* wrh = (const bf16_t*)(ws + WS_WR); const bf16_t* wrl = wrh + 48 * 1024;
    LAS unsigned char* Ahi = lds; LAS unsigned char* Alo = lds + 32 * RROW; LAS float* part = (LAS float*)lds; LAS float* lg = (LAS float*)(lds + 133120);
    LAS int* dtok = (LAS int*)(lds + 139264); LAS int* dEl = dtok + 128; LAS int* dEh = dtok + 256; LAS int* dbk = dtok + 384; LAS float* dWl = (LAS float*)(dtok + 512); LAS float* dWh = dWl + 128;
    LAS unsigned* lcnt = (LAS unsigned*)(dtok + 768); LAS unsigned* lbase = lcnt + 144;
    float* wlist = (float*)(ws + WS_WLIST);
    unsigned* ctl = (unsigned*)(ws + WS_CTL); int* lists = (int*)(ws + WS_LIST); int* blists = (int*)(ws + WS_BLIST); float* tokw = (float*)(ws + WS_TOKW);
    const int G = gridDim.x, NTILE = MT / 32;
    bf16x8 Bh[3][4], Bl[3][4];
#pragma unroll
    for (int nt = 0; nt < 3; ++nt)
#pragma unroll
        for (int kk = 0; kk < 4; ++kk) { const size_t o = (size_t)(nt * 16 + fr) * 1024 + wave * 128 + kk * 32 + fq * 8; Bh[nt][kk] = *(const bf16x8*)(wrh + o); Bl[nt][kk] = *(const bf16x8*)(wrl + o); }
    if (tid < 144) lcnt[tid] = 0u;
    u32x2 xw[4][4]; float sqv[4];
    LAS f32x4* gms = (LAS f32x4*)(lds + 144384);
#define P3B_LOADG(tl) do { const int b_ = ((tl) * 32) >> 12; if (tid < 256) { const int col = 4 * tid; \
        const f32x4 g = *(const f32x4*)(nf + col), s_ = *(const f32x4*)(mod + b_ * 6144 + 4096 + col); gms[2 * tid] = g * (s_ + 1.0f); gms[2 * tid + 1] = *(const f32x4*)(mod + b_ * 6144 + 3072 + col); } __syncthreads(); } while (0)
#define P3B_LOADX(tl) do { _Pragma("unroll") for (int rr = 0; rr < 4; ++rr) { const size_t row = (size_t)(tl) * 32 + wave * 4 + rr; sqv[rr] = sq1[row * 16 + (lane & 15)]; \
        _Pragma("unroll") for (int j = 0; j < 4; ++j) xw[rr][j] = *(const u32x2*)((const bf16_t*)(ws + WS_X1) + row * DM + 4 * lane + 256 * j); } } while (0)
#define P3B_PROC(tl) do { _Pragma("unroll") for (int rr = 0; rr < 4; ++rr) { const int lr = wave * 4 + rr; const size_t row = (size_t)(tl) * 32 + lr; \
        float ss = sqv[rr]; ss += __shfl_xor(ss, 1); ss += __shfl_xor(ss, 2); ss += __shfl_xor(ss, 4); ss += __shfl_xor(ss, 8); \
        const float rstd = __builtin_amdgcn_rsqf(ss * (1.0f / DM) + EPS); \
        _Pragma("unroll") for (int j = 0; j < 4; ++j) { const int col = 4 * lane + 256 * j; const u32x2 w_ = xw[rr][j]; \
            const f32x4 xv = {__builtin_bit_cast(float, w_.x << 16), __builtin_bit_cast(float, w_.x & 0xffff0000u), __builtin_bit_cast(float, w_.y << 16), __builtin_bit_cast(float, w_.y & 0xffff0000u)}; \
            const f32x4 o = xv * rstd * gms[2 * (lane + 64 * j)] + gms[2 * (lane + 64 * j) + 1]; \
            u32x2 w; w.x = cvtpk(o.x, o.y); w.y = cvtpk(o.z, o.w); \
            *(u32x2*)(h2 + row * DM + col) = w; *(LAS u32x2*)(Ahi + lr * RROW + col * 2) = w; \
            const float lx = o.x - __builtin_bit_cast(float, w.x << 16), ly = o.y - __builtin_bit_cast(float, w.x & 0xffff0000u), lz = o.z - __builtin_bit_cast(float, w.y << 16), lw = o.w - __builtin_bit_cast(float, w.y & 0xffff0000u); \
            u32x2 wl; wl.x = cvtpk(lx, ly); wl.y = cvtpk(lz, lw); *(LAS u32x2*)(Alo + lr * RROW + col * 2) = wl; } } } while (0)
    int slotb = blockIdx.x;
    if (batch_aligned()) slotb = vcu_id();
    const int TPB = (NTILE + G - 1) / G, tbeg = slotb * TPB, tend = tbeg + TPB < NTILE ? tbeg + TPB : NTILE;
    int nacc = 0, bcur = -1;
    { const int t0 = tbeg < NTILE ? tbeg : NTILE - 1; P3B_LOADX(t0); }
#pragma unroll 1
    for (int tile = tbeg; tile < tend; ++tile) {
        const int r0 = tile * 32;
        if ((r0 >> 12) != bcur) { bcur = r0 >> 12; P3B_LOADG(tile); }
        P3B_PROC(tile);
        { const int tn = tile + 1 < NTILE ? tile + 1 : NTILE - 1; P3B_LOADX(tn); }
        __syncthreads();
        f32x4 P[2][3];
#pragma unroll
        for (int mt = 0; mt < 2; ++mt)
#pragma unroll
            for (int nt = 0; nt < 3; ++nt) P[mt][nt] = (f32x4){0.f, 0.f, 0.f, 0.f};
#pragma unroll
        for (int mt = 0; mt < 2; ++mt)
#pragma unroll
            for (int kk = 0; kk < 4; ++kk) {
                const int ao = (mt * 16 + fr) * RROW + (wave * 128 + kk * 32 + fq * 8) * 2;
                const bf16x8 a_h = *(const LAS bf16x8*)(Ahi + ao), a_l = *(const LAS bf16x8*)(Alo + ao);
#pragma unroll
                for (int nt = 0; nt < 3; ++nt) {
                    P[mt][nt] = __builtin_amdgcn_mfma_f32_16x16x32_bf16(a_h, Bh[nt][kk], P[mt][nt], 0, 0, 0);
                    P[mt][nt] = __builtin_amdgcn_mfma_f32_16x16x32_bf16(a_l, Bh[nt][kk], P[mt][nt], 0, 0, 0);
                    P[mt][nt] = __builtin_amdgcn_mfma_f32_16x16x32_bf16(a_h, Bl[nt][kk], P[mt][nt], 0, 0, 0);
                }
            }
        __syncthreads();
#pragma unroll
        for (int mt = 0; mt < 2; ++mt)
#pragma unroll
            for (int nt = 0; nt < 3; ++nt)
#pragma unroll
                for (int j = 0; j < 4; ++j) part[(wave * 32 + mt * 16 + fq * 4 + j) * 48 + nt * 16 + fr] = P[mt][nt][j];
        __syncthreads();
#pragma unroll
        for (int i = 0; i < 3; ++i) { const int idx = tid + 512 * i; float v = 0.f;
#pragma unroll
            for (int w8 = 0; w8 < 8; ++w8) v += part[w8 * 1536 + idx];
            lg[idx] = v; }
        __syncthreads();
        if (tid < 32) {
            const LAS float* l = lg + tid * 48; const int tok = r0 + tid;
            float gl[4]; int gi = 0; float gmx;
#pragma unroll
            for (int i = 0; i < 4; ++i) gl[i] = l[i] + bg[i];
            gmx = gl[0];
#pragma unroll
            for (int i = 1; i < 4; ++i) if (gl[i] > gmx) { gmx = gl[i]; gi = i; }
            float gs = 0.f;
#pragma unroll
            for (int i = 0; i < 4; ++i) gs += __expf(gl[i] - gmx);
            const float gtop = 1.0f / gs;
            float el[8];
#pragma unroll
            for (int i = 0; i < 8; ++i) el[i] = l[4 + gi * 8 + i] + be[gi * 8 + i];
            int e1 = 0; float m1 = el[0];
#pragma unroll
            for (int i = 1; i < 8; ++i) if (el[i] > m1) { m1 = el[i]; e1 = i; }
            int e2 = -1; float m2 = -INFINITY;
#pragma unroll
            for (int i = 0; i < 8; ++i) if (i != e1 && el[i] > m2) { m2 = el[i]; e2 = i; }
            const float p2 = __expf(m2 - m1);
            const float w1 = gtop / (1.0f + p2), w2 = gtop * p2 / (1.0f + p2);
            const int lo = e1 < e2 ? e1 : e2, hi = e1 < e2 ? e2 : e1;
            const float wlo = e1 < e2 ? w1 : w2, whi = e1 < e2 ? w2 : w1;
            const int bk = gi * 28 + lo * 8 - ((lo * (lo + 1)) >> 1) + (hi - lo - 1);
            const int sl = nacc * 32 + tid;
            dtok[sl] = tok; dEl[sl] = gi * 8 + lo; dEh[sl] = gi * 8 + hi; dbk[sl] = 32 + bk; dWl[sl] = wlo; dWh[sl] = whi;
        }
        ++nacc;
        if (nacc == 4 || tile + 1 >= tend) {
            __syncthreads();
            const int ntok = nacc * 32; unsigned r1 = 0, r2 = 0, r3 = 0; int El = 0, Eh = 0, bk = 0, tok = 0;
            if (tid < ntok) { tok = dtok[tid]; El = dEl[tid]; Eh = dEh[tid]; bk = dbk[tid];
                r1 = __hip_atomic_fetch_add(lcnt + El, 1u, __ATOMIC_RELAXED, __HIP_MEMORY_SCOPE_WORKGROUP); r2 = __hip_atomic_fetch_add(lcnt + Eh, 1u, __ATOMIC_RELAXED, __HIP_MEMORY_SCOPE_WORKGROUP);
                r3 = __hip_atomic_fetch_add(lcnt + bk, 1u, __ATOMIC_RELAXED, __HIP_MEMORY_SCOPE_WORKGROUP); }
            __syncthreads();
            if (tid < 144) { const unsigned c = lcnt[tid]; if (c && !dry) lbase[tid] = atomicAdd(ctl + CW_CNT + 64 * tid, c); lcnt[tid] = 0u; }
            __syncthreads();
            if (tid < ntok && !dry) {
                lists[(size_t)El * MT + lbase[El] + r1] = tok * 2; lists[(size_t)Eh * MT + lbase[Eh] + r2] = tok * 2 + 1;
                wlist[(size_t)El * MT + lbase[El] + r1] = dWl[tid]; wlist[(size_t)Eh * MT + lbase[Eh] + r2] = dWh[tid];
                blists[(size_t)(bk - 32) * MT + lbase[bk] + r3] = tok; }
            nacc = 0;
            __syncthreads();
        }
    }
#undef P3B_LOADG
#undef P3B_LOADX
#undef P3B_PROC
}

struct U4a { int e, rt, ct, cnt; };
__device__ __forceinline__ int prefix_find(const LAS unsigned* pre, int n, int u) {
    const int lane = threadIdx.x & 63; int res = -1;
    for (int b0 = 0; b0 < n; b0 += 64) { const int i = b0 + lane; const bool hit = i < n && (int)pre[i] <= u && u < (int)pre[i + 1];
        const unsigned long long m = __ballot(hit); if (m) { res = b0 + __builtin_ctzll(m); break; } }
    return res;
}
__device__ __forceinline__ bool p4a_find(const LAS unsigned* cnts, const LAS unsigned* pre, int u, U4a& r) {
    const int i = prefix_find(pre, 32, u); if (i < 0) return false;
    const int uu = u - (int)pre[i]; r.e = i; r.rt = uu >> 1; r.ct = uu & 1; r.cnt = (int)cnts[i]; return true;
}
template <int MI, int NI>
__device__ __forceinline__ void p4a_ptrs(CP p, int e, int row0, int cnt, int col0, const bf16_t* (&ap)[MI / 2], const bf16_t* (&bp)[NI]) {
    const int tid = threadIdx.x, lane = tid & 63;
    const int* lst = (const int*)(p->ws + WS_LIST) + (size_t)e * MT + row0; const int nrow = cnt - row0;
    const bf16_t* h2 = (const bf16_t*)(p->ws + WS_H);
    int tok[MI / 2], C[MI / 2];
#pragma unroll
    for (int i = 0; i < MI / 2; ++i) { int R; stage_rc2((tid >> 6) * 1024 + i * 8192 + lane * 16, R, C[i]); tok[i] = lst[R < nrow ? R : 0] >> 1; }
#pragma unroll
    for (int i = 0; i < MI / 2; ++i) ap[i] = h2 + (size_t)tok[i] * 1024 + C[i];
    stage_ptrs_dense<NI>((const bf16_t*)(p->ws + WS_WGU) + (size_t)e * 512 * 1024, 1024, col0, bp);
}
template <int MI, int NI>
__device__ __forceinline__ void p4a_epilogue(CP p, int e, int row0, int cnt, int col0, const f32x4 (&acc)[MI][NI]) {
    const int tid = threadIdx.x, lane = tid & 63, wid = __builtin_amdgcn_readfirstlane(tid >> 6), wr = wid >> 2, wc = wid & 3, fr = lane & 15, fq = lane >> 4;
    unsigned char* ws = p->ws;
    bf16_t* ab = (bf16_t*)(ws + WS_ABUF);
    const int* lst = (const int*)(ws + WS_LIST) + (size_t)e * MT + row0; const float* wl = (const float*)(ws + WS_WLIST) + (size_t)e * MT + row0; const int nrow = cnt - row0;
    int ent[MI]; float w[MI];
#pragma unroll
    for (int m = 0; m < MI; ++m) { const int R = wr * (MI * 16) + m * 16 + fr; ent[m] = lst[R < nrow ? R : 0]; w[m] = wl[R < nrow ? R : 0]; }
#pragma unroll
    for (int m = 0; m < MI; ++m) { const int R = wr * (MI * 16) + m * 16 + fr; const float wm = w[m];
#pragma unroll
        for (int h = 0; h < NI / 2; ++h) { const f32x4 g = acc[m][2 * h], uu = acc[m][2 * h + 1];
            const int np = col0 + wc * (NI * 16) + h * 32 + fq * 4, ch = (np >> 8) * 128 + ((np >> 6) & 3) * 32 + ((np >> 5) & 1) * 16 + (np & 15);
            u32x2 o; o.x = cvtpk(g.x * __builtin_amdgcn_rcpf(1.0f + __expf(-g.x)) * uu.x * wm, g.y * __builtin_amdgcn_rcpf(1.0f + __expf(-g.y)) * uu.y * wm);
            o.y = cvtpk(g.z * __builtin_amdgcn_rcpf(1.0f + __expf(-g.z)) * uu.z * wm, g.w * __builtin_amdgcn_rcpf(1.0f + __expf(-g.w)) * uu.w * wm);
            if (R < nrow) *(u32x2*)(ab + (size_t)ent[m] * 256 + ch) = o; } }
}
__device__ __forceinline__ void gemm_tail22(LAS unsigned char* lds, const bf16_t* const (&ap)[1], const bf16_t* const (&bp)[2], f32x4 (&acc)[2][2]) {
    constexpr int TA = 2 * 32 * 128, TB = 2 * 64 * 128, STG = TA + TB, NKT = 16;
    static_assert(4 * STG <= SCR_BYTES, "LDS");
    const int tid = threadIdx.x, lane = tid & 63, wid = __builtin_amdgcn_readfirstlane(tid >> 6), wr = wid >> 2, wc = wid & 3, fr = lane & 15, fq = lane >> 4;
    const int aoff = lds_byte2(wr * 32 + fr, fq * 8), boff = TA + lds_byte2(wc * 32 + fr, fq * 8);
    LAS unsigned char* sbase = lds + wid * 1024;
#define T22_STAGE(slot, kt) do { LAS unsigned char* b_ = sbase + (slot) * STG; const int ko_ = (kt) * 64; \
        __builtin_amdgcn_global_load_lds((const unsigned*)(ap[0] + ko_), (LAS unsigned*)(b_), 16, 0, 0); \
        _Pragma("unroll") for (int i = 0; i < 2; ++i) __builtin_amdgcn_global_load_lds((const unsigned*)(bp[i] + ko_), (LAS unsigned*)(b_ + TA + i * 8192), 16, 0, 0); } while (0)
    __builtin_amdgcn_s_barrier();
    asm volatile("" ::: "memory");
    T22_STAGE(0, 0); T22_STAGE(1, 1); T22_STAGE(2, 2);
#pragma unroll 1
    for (int t = 0; t < NKT; ++t) {
        if (t + 2 < NKT) asm volatile("s_waitcnt vmcnt(6)" ::: "memory"); else if (t + 1 < NKT) asm volatile("s_waitcnt vmcnt(3)" ::: "memory"); else asm volatile("s_waitcnt vmcnt(0)" ::: "memory");
        __builtin_amdgcn_s_barrier();
        asm volatile("" ::: "memory");
        if (t + 3 < NKT) T22_STAGE((t + 3) & 3, t + 3);
        const LAS unsigned char* sa = lds + (t & 3) * STG;
#pragma unroll
        for (int ks = 0; ks < 2; ++ks) {
            bf16x8 At[2], Bf[2];
#pragma unroll
            for (int m = 0; m < 2; ++m) At[m] = *(const LAS bf16x8*)(sa + aoff + m * 2048 + ks * 1024);
#pragma unroll
            for (int n = 0; n < 2; ++n) Bf[n] = *(const LAS bf16x8*)(sa + boff + n * 2048 + ks * 1024);
#pragma unroll
            for (int m = 0; m < 2; ++m)
#pragma unroll
                for (int n = 0; n < 2; ++n) acc[m][n] = __builtin_amdgcn_mfma_f32_16x16x32_bf16(Bf[n], At[m], acc[m][n], 0, 0, 0);
        }
    }
#undef T22_STAGE
}
__device__ __forceinline__ void phase4a(CP p, LAS unsigned char* lds, const LAS unsigned* cnts, const LAS unsigned* pre) {
    const int G = gridDim.x, v = vcu_id();
    const int U = (int)pre[32], F = U - U % G;
    {
        int u = v; U4a cur;
        if (u < F && p4a_find(cnts, pre, u, cur)) {
            const bf16_t* ap[4]; const bf16_t* bp[4];
            p4a_ptrs<8, 4>(p, cur.e, cur.rt * 256, cur.cnt, cur.ct * 256, ap, bp);
            __syncthreads();
            gemm_stage<8, 4, false>(lds, 0, ap, bp, 0, 0);
            for (;;) {
                f32x4 acc[8][4];
#pragma unroll
                for (int m = 0; m < 8; ++m)
#pragma unroll
                    for (int n = 0; n < 4; ++n) acc[m][n] = (f32x4){0.f, 0.f, 0.f, 0.f};
                U4a nxt; u += G; const bool has_next = u < F && p4a_find(cnts, pre, u, nxt);
                if (!has_next) nxt = cur;
                int tkn[4];
                { const int* lst = (const int*)(p->ws + WS_LIST) + (size_t)nxt.e * MT + nxt.rt * 256; const int nrow = nxt.cnt - nxt.rt * 256; const int tid_ = threadIdx.x;
#pragma unroll
                  for (int i = 0; i < 4; ++i) { int R, C; stage_rc2((tid_ >> 6) * 1024 + i * 8192 + (tid_ & 63) * 16, R, C); tkn[i] = lst[R < nrow ? R : 0] >> 1; } }
                gemm_main<8, 4, true, false>(lds, 0, ap, bp, 16, acc);
                if (has_next) {
                    const bf16_t* h2 = (const bf16_t*)(p->ws + WS_H); const int tid_ = threadIdx.x;
#pragma unroll
                    for (int i = 0; i < 4; ++i) { int R, C; stage_rc2((tid_ >> 6) * 1024 + i * 8192 + (tid_ & 63) * 16, R, C); ap[i] = h2 + (size_t)tkn[i] * 1024 + C; }
                    stage_ptrs_dense<4>((const bf16_t*)(p->ws + WS_WGU) + (size_t)nxt.e * 512 * 1024, 1024, nxt.ct * 256, bp);
                    gemm_stage<8, 4, false>(lds, 0, ap, bp, 0, 0); }
                p4a_epilogue<8, 4>(p, cur.e, cur.rt * 256, cur.cnt, cur.ct * 256, acc);
                if (!has_next) break;
                cur = nxt;
                stage_ptrs_dense<4>((const bf16_t*)(p->ws + WS_WGU) + (size_t)cur.e * 512 * 1024, 1024, cur.ct * 256, bp);
            }
        }
    }
    asm volatile("s_waitcnt vmcnt(0)" ::: "memory"); __syncthreads();
    const int tailu = U - F;
    if (tailu <= 64) {
        const int ln = threadIdx.x & 63;
        int e_ = 0, rt_ = 0, ct_ = 0, cnt_ = 0, np_ = 0;
        if (ln < tailu) {
            const int uu = F + ln; int e = 0;
            for (int k = 0; k < 32; ++k) if ((int)pre[k + 1] <= uu) e = k + 1;
            const int loc = uu - (int)pre[e];
            e_ = e; rt_ = loc >> 1; ct_ = loc & 1; cnt_ = (int)cnts[e];
            const int nr = cnt_ - rt_ * 256;
            np_ = (nr >= 256 ? 4 : ((nr + 63) >> 6)) * 2;
        }
        int sc = np_;
#pragma unroll
        for (int o = 1; o < 64; o <<= 1) { const int t_ = __shfl_up(sc, o); if (ln >= o) sc += t_; }
        const int total = __shfl(sc, 63), excl = sc - np_;
#pragma unroll 1
        for (int sv = v; sv < total; sv += G) {
            const unsigned long long mk = __ballot(excl <= sv && sv < sc);
            if (mk == 0ull) break;
            const int src = __builtin_ctzll(mk);
            U4a t; t.e = __shfl(e_, src); t.rt = __shfl(rt_, src); t.ct = __shfl(ct_, src); t.cnt = __shfl(cnt_, src);
            const int q = sv - __shfl(excl, src);
            const int row0 = t.rt * 256 + (q >> 1) * 64, col0 = t.ct * 256 + (q & 1) * 128;
            const bf16_t* ap[1]; const bf16_t* bp[2];
            p4a_ptrs<2, 2>(p, t.e, row0, t.cnt, col0, ap, bp);
            f32x4 acc[2][2];
#pragma unroll
            for (int m = 0; m < 2; ++m)
#pragma unroll
                for (int n = 0; n < 2; ++n) acc[m][n] = (f32x4){0.f, 0.f, 0.f, 0.f};
            gemm_tail22(lds, ap, bp, acc);
            p4a_epilogue<2, 2>(p, t.e, row0, t.cnt, col0, acc);
        }
    } else if (tailu * 8 <= 3 * G) {
#pragma unroll 1
        for (int sv = v; sv < 8 * tailu; sv += G) {
            U4a t; if (!p4a_find(cnts, pre, F + (sv >> 3), t)) break;
            const int row0 = t.rt * 256 + ((sv >> 1) & 3) * 64, col0 = t.ct * 256 + (sv & 1) * 128;
            if (row0 < t.cnt) {
                const bf16_t* ap[1]; const bf16_t* bp[2];
                p4a_ptrs<2, 2>(p, t.e, row0, t.cnt, col0, ap, bp);
                f32x4 acc[2][2];
#pragma unroll
                for (int m = 0; m < 2; ++m)
#pragma unroll
                    for (int n = 0; n < 2; ++n) acc[m][n] = (f32x4){0.f, 0.f, 0.f, 0.f};
                gemm_tail22(lds, ap, bp, acc);
                p4a_epilogue<2, 2>(p, t.e, row0, t.cnt, col0, acc);
            }
        }
    } else {
#pragma unroll 1
        for (int sv = v; sv < 4 * tailu; sv += G) {
            U4a t; if (!p4a_find(cnts, pre, F + (sv >> 2), t)) break;
            const int row0 = t.rt * 256 + ((sv >> 1) & 1) * 128, col0 = t.ct * 256 + (sv & 1) * 128;
            if (row0 < t.cnt) {
                const bf16_t* ap[2]; const bf16_t* bp[2];
                p4a_ptrs<4, 2>(p, t.e, row0, t.cnt, col0, ap, bp);
                __syncthreads();
                gemm_stage<4, 2, false>(lds, 0, ap, bp, 0, 0);
                f32x4 acc[4][2];
#pragma unroll
                for (int m = 0; m < 4; ++m)
#pragma unroll
                    for (int n = 0; n < 2; ++n) acc[m][n] = (f32x4){0.f, 0.f, 0.f, 0.f};
                gemm_main<4, 2, true, false>(lds, 0, ap, bp, 16, acc);
                p4a_epilogue<4, 2>(p, t.e, row0, t.cnt, col0, acc);
            }
        }
    }
    asm volatile("s_waitcnt vmcnt(0)" ::: "memory"); __syncthreads();
}
struct U4b { int bk, rt, ct, cnt; };
__device__ __forceinline__ bool p4b_find(const LAS unsigned* cnts, const LAS unsigned* pre, int u, U4b& r) {
    const int i = prefix_find(pre + 33, 112, u); if (i < 0) return false;
    const int uu = u - (int)pre[33 + i]; r.bk = i; r.rt = uu >> 2; r.ct = uu & 3; r.cnt = (int)cnts[32 + i]; return true;
}
__device__ __forceinline__ float swap1f(float v) { float r; asm volatile("s_nop 1\n\tv_mov_b32_dpp %0, %1 quad_perm:[1,0,3,2] row_mask:0xf bank_mask:0xf" : "=v"(r) : "v"(v)); return r; }
__device__ __forceinline__ int swap1i(int v) { int r; asm volatile("s_nop 1\n\tv_mov_b32_dpp %0, %1 quad_perm:[1,0,3,2] row_mask:0xf bank_mask:0xf" : "=v"(r) : "v"(v)); return r; }
__device__ __forceinline__ void p4b_pair(int bk, int& elo, int& ehi) { const int g = bk / 28; int pi = bk % 28, lo = 0; while (pi >= 7 - lo) { pi -= 7 - lo; ++lo; } elo = g * 8 + lo; ehi = g * 8 + lo + 1 + pi; }
template <class F>
__device__ __forceinline__ void gemm_p4b(LAS unsigned char* lds, const bf16_t* const (&ap)[2], const bf16_t* const (&bp)[4], const bf16_t* const (&bq)[4], f32x4 (&acc)[4][4], F&& hook) {
    constexpr int TA = 4 * 32 * 128, TB = 4 * 64 * 128, STG = TA + TB;
    static_assert(3 * STG + 8192 <= SCR_BYTES, "LDS");
    const int tid = threadIdx.x, lane = tid & 63, wid = __builtin_amdgcn_readfirstlane(tid >> 6), wr = wid >> 2, wc = wid & 3, fr = lane & 15, fq = lane >> 4;
    const int aoff = lds_byte3(wr * 64 + fr, fq * 8), boff = TA + lds_byte3(wc * 64 + fr, fq * 8);
    LAS unsigned char* sbase = lds + wid * 1024;
#define P4B_STAGE(slot, kt) do { LAS unsigned char* b_ = sbase + (slot) * STG; const int ko_ = (kt) * 64; \
        _Pragma("unroll") for (int i = 0; i < 2; ++i) __builtin_amdgcn_global_load_lds((const unsigned*)(ap[i] + ko_), (LAS unsigned*)(b_ + i * 8192), 16, 0, 0); \
        if ((kt) < 4) { _Pragma("unroll") for (int i = 0; i < 4; ++i) __builtin_amdgcn_global_load_lds((const unsigned*)(bp[i] + ko_), (LAS unsigned*)(b_ + TA + i * 8192), 16, 0, 0); } \
        else { _Pragma("unroll") for (int i = 0; i < 4; ++i) __builtin_amdgcn_global_load_lds((const unsigned*)(bq[i] + ko_), (LAS unsigned*)(b_ + TA + i * 8192), 16, 0, 0); } } while (0)
    __syncthreads();
    P4B_STAGE(1, 1);
    int slot = 0;
#pragma unroll 1
    for (int t = 0; t < 8; ++t) {
        if (t == 7) asm volatile("s_waitcnt vmcnt(0)" ::: "memory");
        else if (t == 1 || t == 2) asm volatile("s_waitcnt vmcnt(22)" ::: "memory");
        else asm volatile("s_waitcnt vmcnt(6)" ::: "memory");
        __builtin_amdgcn_s_barrier();
        asm volatile("" ::: "memory");
        if (t + 2 < 8) { const int s2 = slot >= 1 ? slot - 1 : 2; P4B_STAGE(s2, t + 2); }
        if (t == 0) hook();
        const LAS unsigned char* sa = lds + slot * STG;
#pragma unroll
        for (int ks = 0; ks < 2; ++ks) {
            bf16x8 At[4], Bf[4];
#pragma unroll
            for (int m = 0; m < 4; ++m) At[m] = *(const LAS bf16x8*)(sa + (aoff ^ (ks * 64)) + m * 2048);
#pragma unroll
            for (int n = 0; n < 4; ++n) Bf[n] = *(const LAS bf16x8*)(sa + (boff ^ (ks * 64)) + n * 2048);
#pragma unroll
            for (int m = 0; m < 4; ++m)
#pragma unroll
                for (int n = 0; n < 4; ++n) acc[m][n] = __builtin_amdgcn_mfma_f32_16x16x32_bf16(Bf[n], At[m], acc[m][n], 0, 0, 0);
        }
        slot = slot == 2 ? 0 : slot + 1;
    }
}
__device__ __forceinline__ void phase4b(CP p, LAS unsigned char* lds, const LAS unsigned* cnts, const LAS unsigned* pre) {
    const int tid = threadIdx.x, lane = tid & 63, wid = __builtin_amdgcn_readfirstlane(tid >> 6), wr = wid >> 2, wc = wid & 3, fr = lane & 15, fq = lane >> 4;
    unsigned char* ws = p->ws;
    const float* mod = (const float*)(ws + WS_MOD); float* out = p->out; const bf16_t* x1b = (const bf16_t*)(ws + WS_X1);
    const bf16_t* ab = (const bf16_t*)(ws + WS_ABUF); const bf16_t* wd = (const bf16_t*)(ws + WS_WD); const int* bl = (const int*)(ws + WS_BLIST);
    LAS f32x4* gfl = (LAS f32x4*)(lds + 147456);
    int u = vcu_id(); U4b cur;
    if (!p4b_find(cnts, pre, u, cur)) return;
    int ctl_ = -1;
    int RA[2], CA[2];
#pragma unroll
    for (int i = 0; i < 2; ++i) stage_rc3((tid >> 6) * 1024 + i * 8192 + lane * 16, RA[i], CA[i]);
    const bf16_t* ap[2]; const bf16_t* bp[4]; const bf16_t* bq[4];
    int tok[4], tka[2];
    { const int* lst = bl + (size_t)cur.bk * MT + cur.rt * 128; const int nrow = cur.cnt - cur.rt * 128;
#pragma unroll
      for (int i = 0; i < 2; ++i) tka[i] = lst[RA[i] < nrow ? RA[i] : 0];
#pragma unroll
      for (int m = 0; m < 4; ++m) { const int R = wr * 64 + m * 16 + fr; tok[m] = lst[R < nrow ? R : 0]; } }
    { int elo, ehi; p4b_pair(cur.bk, elo, ehi);
#pragma unroll
      for (int i = 0; i < 2; ++i) ap[i] = ab + (size_t)tka[i] * 512 + CA[i];
      stage_ptrs_dense3<4>(wd + (size_t)elo * 1024 * 256, 256, cur.ct * 256, bp); stage_ptrs_dense3<4>(wd + (size_t)ehi * 1024 * 256, 256, cur.ct * 256, bq);
#pragma unroll
      for (int i = 0; i < 4; ++i) bq[i] -= 256; }
    __syncthreads();
    { constexpr int TA = 4 * 32 * 128;
      LAS unsigned char* b_ = lds + wid * 1024;
#pragma unroll
      for (int i = 0; i < 2; ++i) __builtin_amdgcn_global_load_lds((const unsigned*)(ap[i]), (LAS unsigned*)(b_ + i * 8192), 16, 0, 0);
#pragma unroll
      for (int i = 0; i < 4; ++i) __builtin_amdgcn_global_load_lds((const unsigned*)(bp[i]), (LAS unsigned*)(b_ + TA + i * 8192), 16, 0, 0); }
    for (;;) {
        const int colb = cur.ct * 256 + wc * 64 + fq * 4; const int nrow = cur.cnt - cur.rt * 128;
        if (cur.ct != ctl_) { ctl_ = cur.ct;
            __syncthreads();
            { const int bb = tid >> 6, c4 = tid & 63; gfl[tid] = *(const f32x4*)(mod + bb * 6144 + 5120 + cur.ct * 256 + c4 * 4); }
        }
        U4b nxt; u += gridDim.x; const bool has_next = p4b_find(cnts, pre, u, nxt);
        int tokn[4] = {0, 0, 0, 0}, tkan[2] = {0, 0};
        if (has_next) { const int* lst = bl + (size_t)nxt.bk * MT + nxt.rt * 128; const int nr2 = nxt.cnt - nxt.rt * 128;
#pragma unroll
            for (int i = 0; i < 2; ++i) tkan[i] = lst[RA[i] < nr2 ? RA[i] : 0];
#pragma unroll
            for (int m = 0; m < 4; ++m) { const int R = wr * 64 + m * 16 + fr; tokn[m] = lst[R < nr2 ? R : 0]; } }
        u32x2 old[4][4]; f32x4 acc[4][4];
#pragma unroll
        for (int m = 0; m < 4; ++m)
#pragma unroll
            for (int n = 0; n < 4; ++n) acc[m][n] = (f32x4){0.f, 0.f, 0.f, 0.f};
        gemm_p4b(lds, ap, bp, bq, acc, [&]() {
#pragma unroll
            for (int m = 0; m < 4; ++m)
#pragma unroll
                for (int n = 0; n < 4; ++n) old[m][n] = *(const u32x2*)(x1b + (size_t)tok[m] * DM + colb + n * 16);
        });
        if (has_next) { int elo, ehi; p4b_pair(nxt.bk, elo, ehi);
#pragma unroll
            for (int i = 0; i < 2; ++i) ap[i] = ab + (size_t)tkan[i] * 512 + CA[i];
            stage_ptrs_dense3<4>(wd + (size_t)elo * 1024 * 256, 256, nxt.ct * 256, bp); stage_ptrs_dense3<4>(wd + (size_t)ehi * 1024 * 256, 256, nxt.ct * 256, bq);
#pragma unroll
            for (int i = 0; i < 4; ++i) bq[i] -= 256;
            constexpr int TA = 4 * 32 * 128;
            LAS unsigned char* b_ = lds + wid * 1024;
#pragma unroll
            for (int i = 0; i < 2; ++i) __builtin_amdgcn_global_load_lds((const unsigned*)(ap[i]), (LAS unsigned*)(b_ + i * 8192), 16, 0, 0);
#pragma unroll
            for (int i = 0; i < 4; ++i) __builtin_amdgcn_global_load_lds((const unsigned*)(bp[i]), (LAS unsigned*)(b_ + TA + i * 8192), 16, 0, 0); }
#pragma unroll
        for (int m = 0; m < 4; ++m) { const int R = wr * 64 + m * 16 + fr; const int b = tok[m] >> 12;
            const bool odd = fr & 1; const int tokp = swap1i(tok[m]);
            const int tok_e = odd ? tokp : tok[m], tok_o = odd ? tok[m] : tokp;
            const bool ok_e = (R & ~1) < nrow, ok_o = (R | 1) < nrow;
#pragma unroll
            for (int np = 0; np < 4; np += 2) {
                const u32x2 r0 = old[m][np], r1 = old[m][np + 1];
                const f32x4 x0 = {__builtin_bit_cast(float, r0.x << 16), __builtin_bit_cast(float, r0.x & 0xffff0000u), __builtin_bit_cast(float, r0.y << 16), __builtin_bit_cast(float, r0.y & 0xffff0000u)};
                const f32x4 x1v = {__builtin_bit_cast(float, r1.x << 16), __builtin_bit_cast(float, r1.x & 0xffff0000u), __builtin_bit_cast(float, r1.y << 16), __builtin_bit_cast(float, r1.y & 0xffff0000u)};
                const f32x4 o0 = x0 + gfl[b * 64 + wc * 16 + np * 4 + fq] * acc[m][np], o1 = x1v + gfl[b * 64 + wc * 16 + (np + 1) * 4 + fq] * acc[m][np + 1];
                const f32x4 give = odd ? o0 : o1; f32x4 got;
                got.x = swap1f(give.x); got.y = swap1f(give.y); got.z = swap1f(give.z); got.w = swap1f(give.w);
                const int cn = colb + (np + (odd ? 1 : 0)) * 16;
                const f32x4 ve = odd ? got : o0, vo = odd ? o1 : got;
                if (ok_e) __builtin_nontemporal_store(ve, (f32x4*)(out + (size_t)tok_e * DM + cn));
                if (ok_o) __builtin_nontemporal_store(vo, (f32x4*)(out + (size_t)tok_o * DM + cn));
            } }
        if (!has_next) break;
        cur = nxt;
#pragma unroll
        for (int m = 0; m < 4; ++m) tok[m] = tokn[m];
    }
    asm volatile("s_waitcnt vmcnt(0)" ::: "memory"); __syncthreads();
#undef P4B_STAGE
}
__global__ void __launch_bounds__(512, 2) hybrid_block_fwd(Params p) {
    extern __shared__ __attribute__((aligned(16))) unsigned char lds_raw[];
    LAS unsigned char* lds = (LAS unsigned char*)lds_raw;
    volatile LAS unsigned* MISC = (volatile LAS unsigned*)(lds + MISC_OFF);
    LAS unsigned* cnts = (LAS unsigned*)(lds + MISC_OFF + 256);
    const int tid = threadIdx.x;
    if (tid < 16) MISC[tid] = 0u;
    __syncthreads();
    unsigned* ctl = (unsigned*)(p.ws + WS_CTL);
    const bool single = (p.ph_hi - p.ph_lo) > 1;
    XcdBarrier bar; bar.bar = ctl + CW_BAR; bar.x = 0; bar.st = nullptr;
    if (single) bar = xcd_barrier_post(ctl + CW_BAR, MISC + 8);
#ifndef PH_MASK
#define PH_MASK 0x1ff
#endif
#define IN(k) (((PH_MASK >> (k)) & 1) && p.ph_lo <= (k) && (k) < p.ph_hi)
#define SEAM(k) do { if (IN(k) && IN((k) + 1)) xcd_barrier(bar); } while (0)
    constexpr int T0 = TR_EARLY, T1 = T0 + TR_I3 + 1024, T2 = T1 + 1536, T3 = T0 + TR_I3 + TR_I4, T4 = T3 + 1024, T5 = T3 + TR_I5;
#define SEAM_W(k, a0, e0, a1, e1, fl) do { if (IN(k) && IN((k) + 1)) { if (N_LAUNCH_SPLIT) xcd_barrier(bar); else xcd_barrier_work(bar, get_params(), lds, a0, e0, a1, e1, fl); } } while (0)
#ifndef REPEAT_PH
#define REPEAT_PH -1
#endif
#define NREP(k) ((REPEAT_PH == (k)) ? 2 : 1)
    if (IN(0)) { for (int r_ = 0; r_ < NREP(0); ++r_) phase0(get_params(), lds); } SEAM_W(0, 0, T0, 0, 0, 1);
    if (IN(1)) { for (int r_ = 0; r_ < NREP(1); ++r_) phase1a(get_params(), lds); } SEAM_W(1, T0, T1, 0, 0, 0);
    if (IN(2)) { for (int r_ = 0; r_ < NREP(2); ++r_) phase1b(get_params(), lds); } SEAM_W(2, T1, T2, 0, 0, 0);
    if (IN(3)) { for (int r_ = 0; r_ < NREP(3); ++r_) phase1c(get_params(), lds); } SEAM_W(3, 0, 0, 0, 0, 2);
    if (IN(4)) { for (int r_ = 0; r_ < NREP(4); ++r_) phase2(get_params(), lds); } SEAM_W(4, T2, T3, T5, TR_NIT, 0);
    if (IN(5)) { for (int r_ = 0; r_ < NREP(5); ++r_) phase3(get_params(), lds); } SEAM_W(5, T3, T4, 0, 0, 0);
    if (IN(6)) { for (int r_ = 0; r_ < NREP(6); ++r_) phase3b(get_params(), lds, r_ + 1 < NREP(6)); } SEAM_W(6, T4, T5, 0, 0, 0);
    LAS unsigned* pre = (LAS unsigned*)(lds + MISC_OFF + 256 + 640);
    if (IN(7) || IN(8)) {
        if (tid < 144) cnts[tid] = __hip_atomic_load(ctl + CW_CNT + 64 * tid, __ATOMIC_RELAXED, __HIP_MEMORY_SCOPE_AGENT);
        __syncthreads();
        if (tid == 0) { unsigned a = 0; for (int i = 0; i < 32; ++i) { pre[i] = a; a += ((cnts[i] + 255u) >> 8) * 2u; } pre[32] = a;
                        a = 0; for (int i = 0; i < 112; ++i) { pre[33 + i] = a; a += ((cnts[32 + i] + 127u) >> 7) * 4u; } pre[33 + 112] = a; }
        __syncthreads();
    }
    if (IN(7)) { for (int r_ = 0; r_ < NREP(7); ++r_) phase4a(get_params(), lds, cnts, pre); } SEAM(7);
    if (IN(8)) { phase4b(get_params(), lds, cnts, pre); }
#undef IN
#undef SEAM
}

extern "C" void kernel_launch(void* const* d_in, const int* in_sizes, int n_in, void* d_out, int out_size, void* d_ws, size_t ws_size, hipStream_t stream) {
    static int grid = 0;
    if (grid == 0) {
        if (n_in != 26 || out_size != MT * DM || ws_size < WS_END) { fprintf(stderr, "kernel_launch: unexpected problem (n_in %d out %d ws %zu)\n", n_in, out_size, ws_size); grid = -1; return; }
        int dev = 0, cus = 0, per_cu = 0;
        hipGetDevice(&dev); hipDeviceGetAttribute(&cus, hipDeviceAttributeMultiprocessorCount, dev);
        hipFuncSetAttribute((const void*)hybrid_block_fwd, hipFuncAttributeMaxDynamicSharedMemorySize, LDS_BYTES);
        hipOccupancyMaxActiveBlocksPerMultiprocessor(&per_cu, (const void*)hybrid_block_fwd, 512, LDS_BYTES);
        (void)hipGetLastError();
        if (per_cu < 1) { fprintf(stderr, "kernel_launch: occupancy query says %d blocks/CU\n", per_cu); per_cu = 1; }
        grid = cus;
    }
    if (grid < 0) return;
    hipMemsetAsync((char*)d_ws + WS_CTL, 0, CTL_BYTES, stream);
    Params prm{};
    for (int i = 0; i < 26; ++i) prm.in[i] = d_in[i];
    prm.out = (float*)d_out; prm.ws = (unsigned char*)d_ws;
#if N_LAUNCH_SPLIT
    for (int ph = 0; ph <= DBG_LAST_PHASE; ++ph) { prm.ph_lo = ph; prm.ph_hi = ph + 1; hipLaunchKernelGGL(hybrid_block_fwd, dim3(grid), dim3(512), LDS_BYTES, stream, prm); }
#else
    prm.ph_lo = 0; prm.ph_hi = DBG_LAST_PHASE + 1;
    hipLaunchKernelGGL(hybrid_block_fwd, dim3(grid), dim3(512), LDS_BYTES, stream, prm);
#endif
}
```
